# Optimizing an MI355X kernel written in HIP

```python
import jax, jax.numpy as jnp
from jax import lax
import numpy as np

D_MODEL = 1024
BATCH = 8
SEQ = 4096
DEPTH = 4

CHUNK = 64
N_MIXERS = 2
N_A_LAYERS = (DEPTH + 1) // 2
N_B_LAYERS = DEPTH // 2

SGU_CHUNK = 2 * CHUNK
SGU_HALF = D_MODEL
SGU_GROUPS = 16
SGU_GROUP_DIM = SGU_HALF // SGU_GROUPS

RWKV_HEAD_DIM = 64
RWKV_HEADS = D_MODEL // RWKV_HEAD_DIM
DECAY_LORA = 64
AAA_LORA = 64
GATE_LORA = 160
GN_EPS = 64e-5
N_SHIFT_MIX = 6

FFN_DIM = 2816
CONV_WIDTH = 3
RMS_EPS = 1e-6

kernel_name = "hybrid_sgu_rwkv7_convffn_trunk"


def rms_norm(x, g):
    xf = x.astype(jnp.float32)
    y = xf * lax.rsqrt(jnp.mean(xf * xf, axis=-1, keepdims=True) + RMS_EPS)
    return (y * g.astype(jnp.float32)).astype(x.dtype)


def sgu_mixer(h, w_in, b_in, g_v, w_s, b_s, w_out):
    B, S, _ = h.shape
    z = jax.nn.gelu(h @ w_in + b_in, approximate=False)
    u, v = jnp.split(z, 2, axis=-1)
    v = rms_norm(v, g_v)
    n_blk = S // SGU_CHUNK
    v = v.reshape(B, n_blk, SGU_CHUNK, SGU_GROUPS, SGU_GROUP_DIM)
    causal = jnp.tril(jnp.ones((SGU_CHUNK, SGU_CHUNK), dtype=bool))
    w_causal = jnp.where(causal[None], w_s, 0)
    v = jnp.einsum('gts,bnsgc->bntgc', w_causal, v) + b_s.T[None, None, :, :, None]
    y = u * v.reshape(B, S, SGU_HALF)
    return y @ w_out


def token_shift(x):
    return jnp.pad(x, ((0, 0), (1, 0), (0, 0)))[:, :-1]


def wkv7_scan(r, w, k, v, a, b):
    B, S, H, N = r.shape

    def step(state, inp):
        r_t, w_t, k_t, v_t, a_t, b_t = inp
        sa = jnp.einsum('bhvk,bhk->bhv', state, a_t)
        state = (state * w_t[:, :, None, :]
                 + sa[..., None] * b_t[:, :, None, :]
                 + v_t[..., None] * k_t[:, :, None, :])
        y_t = jnp.einsum('bhvk,bhk->bhv', state, r_t)
        return state, y_t

    xs = tuple(jnp.swapaxes(t, 0, 1) for t in (r, w, k, v, a, b))
    s0 = jnp.zeros((B, H, N, N), jnp.float32)
    _, ys = lax.scan(step, s0, xs)
    return jnp.swapaxes(ys, 0, 1)


def rwkv7_mixer(h, mu, w_r, w_k, w_v, w_o, w0, w1, w2, a0, a1, a2,
                g1, g2, k_k, k_a, r_k, ln_w, ln_b):
    B, S, D = h.shape
    H, N = RWKV_HEADS, RWKV_HEAD_DIM
    f32 = jnp.float32
    xx = token_shift(h) - h
    xr = h + xx * mu[0]
    xw = h + xx * mu[1]
    xk = h + xx * mu[2]
    xv = h + xx * mu[3]
    xa = h + xx * mu[4]
    xg = h + xx * mu[5]
    r = xr @ w_r
    k = xk @ w_k
    v = xv @ w_v
    w = -jax.nn.softplus(-(w0 + jnp.tanh(xw @ w1) @ w2)) - 0.5
    a = jax.nn.sigmoid(a0 + (xa @ a1) @ a2)
    g = jax.nn.sigmoid(xg @ g1) @ g2

    def heads(t):
        return t.reshape(B, S, H, N).astype(f32)

    kk = heads(k * k_k)
    kk = kk * lax.rsqrt(jnp.maximum(jnp.sum(kk * kk, -1, keepdims=True), 1e-24))
    k = k * (1 + (a - 1) * k_a)
    r_h, k_h, v_h, a_h = heads(r), heads(k), heads(v), heads(a)
    decay = jnp.exp(-jnp.exp(heads(w)))
    y = wkv7_scan(r_h, decay, k_h, v_h, -kk, kk * a_h)
    mean = jnp.mean(y, -1, keepdims=True)
    var = jnp.mean(jnp.square(y - mean), -1, keepdims=True)
    y = ((y - mean) * lax.rsqrt(var + GN_EPS)).reshape(B, S, D)
    y = y * ln_w.astype(f32) + ln_b.astype(f32)
    bonus = jnp.sum(r_h * k_h * r_k.astype(f32), -1, keepdims=True) * v_h
    y = (y + bonus.reshape(B, S, D)).astype(h.dtype)
    return (y * g) @ w_o


def conv_ffn(h, w_up, conv_w, conv_b, w_down):
    S = h.shape[1]
    z = h @ w_up
    zp = jnp.pad(z, ((0, 0), (CONV_WIDTH - 1, 0), (0, 0)))
    z = sum(zp[:, j:j + S] * conv_w[j] for j in range(CONV_WIDTH)) + conv_b
    gate, val = jnp.split(z, 2, axis=-1)
    return (jax.nn.silu(gate) * val) @ w_down


def setup_inputs(seed: int = 0) -> dict:
    key = jax.random.key(seed)
    ks = iter(jax.random.split(key, 40))
    f32 = jnp.float32

    def nrm(shape, scale):
        return jax.random.normal(next(ks), shape, f32) * scale

    def gain(shape):
        return 1.0 + 0.05 * jax.random.normal(next(ks), shape, f32)

    D, NA, NB = D_MODEL, N_A_LAYERS, N_B_LAYERS
    H2, F2 = 2 * SGU_HALF, 2 * FFN_DIM
    return {
        "x": nrm((BATCH, SEQ, D), 1.0),
        "norm_mix_g": gain((DEPTH, D)),
        "norm_ffn_g": gain((DEPTH, D)),
        "norm_final_g": gain((D,)),
        "sgu_w_in": nrm((NA, D, H2), D ** -0.5),
        "sgu_b_in": nrm((NA, H2), 0.02),
        "sgu_g_v": gain((NA, SGU_HALF)),
        "sgu_w_s": nrm((NA, SGU_GROUPS, SGU_CHUNK, SGU_CHUNK), 0.5 * SGU_CHUNK ** -0.5),
        "sgu_b_s": gain((NA, SGU_GROUPS, SGU_CHUNK)),
        "sgu_w_out": nrm((NA, SGU_HALF, D), SGU_HALF ** -0.5),
        "rwkv_mu": jax.random.uniform(next(ks), (NB, N_SHIFT_MIX, D), f32),
        "rwkv_w_r": nrm((NB, D, D), D ** -0.5),
        "rwkv_w_k": nrm((NB, D, D), D ** -0.5),
        "rwkv_w_v": nrm((NB, D, D), D ** -0.5),
        "rwkv_w_o": nrm((NB, D, D), D ** -0.5),
        "rwkv_w0": jax.random.uniform(next(ks), (NB, D), f32, minval=-6.0, maxval=-1.0),
        "rwkv_w1": nrm((NB, D, DECAY_LORA), 0.1 * D ** -0.5),
        "rwkv_w2": nrm((NB, DECAY_LORA, D), 0.1 * DECAY_LORA ** -0.5),
        "rwkv_a0": nrm((NB, D), 0.1),
        "rwkv_a1": nrm((NB, D, AAA_LORA), 0.1 * D ** -0.5),
        "rwkv_a2": nrm((NB, AAA_LORA, D), 0.1 * AAA_LORA ** -0.5),
        "rwkv_g1": nrm((NB, D, GATE_LORA), D ** -0.5),
        "rwkv_g2": nrm((NB, GATE_LORA, D), GATE_LORA ** -0.5),
        "rwkv_k_k": 0.85 + 0.05 * jax.random.normal(next(ks), (NB, D), f32),
        "rwkv_k_a": gain((NB, D)),
        "rwkv_r_k": nrm((NB, RWKV_HEADS, RWKV_HEAD_DIM), 0.1),
        "rwkv_ln_w": gain((NB, D)),
        "rwkv_ln_b": nrm((NB, D), 0.02),
        "ffn_w_up": nrm((DEPTH, D, F2), D ** -0.5),
        "ffn_conv_w": nrm((DEPTH, CONV_WIDTH, F2), CONV_WIDTH ** -0.5),
        "ffn_conv_b": nrm((DEPTH, F2), 0.02),
        "ffn_w_down": nrm((DEPTH, FFN_DIM, D), FFN_DIM ** -0.5),
    }


def reference(x, norm_mix_g, norm_ffn_g, norm_final_g,
              sgu_w_in, sgu_b_in, sgu_g_v, sgu_w_s, sgu_b_s, sgu_w_out,
              rwkv_mu, rwkv_w_r, rwkv_w_k, rwkv_w_v, rwkv_w_o,
              rwkv_w0, rwkv_w1, rwkv_w2, rwkv_a0, rwkv_a1, rwkv_a2,
              rwkv_g1, rwkv_g2, rwkv_k_k, rwkv_k_a, rwkv_r_k, rwkv_ln_w, rwkv_ln_b,
              ffn_w_up, ffn_conv_w, ffn_conv_b, ffn_w_down):
    h = x
    for i in range(DEPTH):
        hn = rms_norm(h, norm_mix_g[i])
        j = i // N_MIXERS
        if i % N_MIXERS == 0:
            h = h + sgu_mixer(hn, sgu_w_in[j], sgu_b_in[j], sgu_g_v[j],
                              sgu_w_s[j], sgu_b_s[j], sgu_w_out[j])
        else:
            h = h + rwkv7_mixer(hn, rwkv_mu[j], rwkv_w_r[j], rwkv_w_k[j], rwkv_w_v[j], rwkv_w_o[j],
                                rwkv_w0[j], rwkv_w1[j], rwkv_w2[j],
                                rwkv_a0[j], rwkv_a1[j], rwkv_a2[j],
                                rwkv_g1[j], rwkv_g2[j], rwkv_k_k[j], rwkv_k_a[j], rwkv_r_k[j],
                                rwkv_ln_w[j], rwkv_ln_b[j])
        h = h + conv_ffn(rms_norm(h, norm_ffn_g[i]), ffn_w_up[i], ffn_conv_w[i],
                         ffn_conv_b[i], ffn_w_down[i])
    return rms_norm(h, norm_final_g)
```

```cpp
#include <hip/hip_runtime.h>
#include <hip/hip_cooperative_groups.h>
#include <cstdio>
#include <cstdint>
#include <cmath>
namespace cg = cooperative_groups;
namespace pg8 {
#define PG8_LAS __attribute__((address_space(3)))
typedef unsigned short bf16_t;
typedef short bf16x8 __attribute__((ext_vector_type(8)));
typedef float f32x4 __attribute__((ext_vector_type(4)));
typedef float f32x2 __attribute__((ext_vector_type(2)));
typedef unsigned u32x4 __attribute__((ext_vector_type(4)));
typedef unsigned u32x2 __attribute__((ext_vector_type(2)));
constexpr int BM = 256, BK = 64, HALF = 128, HTB = HALF * BK * 2  , STAGE_BYTES = 8 * HTB, NXCD = 8, WGM = 8;

__host__ __device__ __forceinline__ int lds_byte(int r, int c) { const int st = (r >> 4) * 2 + (c >> 5), rr = r & 15, cc = c & 31, ob = rr * 64 + cc * 2; return st * 1024 + (ob ^ (((ob >> 9) & 1) << 5)); }
__host__ __device__ __forceinline__ void stage_rc(int b, int& R, int& C) { const int st = b / 1024, sb = b % 1024, swz = sb ^ (((sb >> 9) & 1) << 5); R = (st >> 1) * 16 + swz / 64; C = (st & 1) * 32 + (swz % 64) / 2; }
__host__ __device__ __forceinline__ int perm32(int rho) { const int n = rho >> 4, i = rho & 15; return 8 * (i >> 2) + 4 * n + (i & 3); }

struct Unit { int pm, pn; };
struct Gemm { const bf16_t* A; const bf16_t* Bt; int M, N, K, lda; };

struct StaticOrder {
    int nM, nN, nwg, G, c;
    __host__ __device__ void init(int nM_, int N, int G_, int c_) { nM = nM_; nN = N / BM; nwg = nM * nN; G = G_; c = c_; }
    __host__ __device__ bool next(int i, Unit& u) const {
        const long L = (long)i * G + c; if (L >= nwg) return false;
        int wgid = (int)L; { const int q = nwg / NXCD, r = nwg % NXCD, xcd = wgid % NXCD, off = wgid / NXCD; wgid = (xcd < r ? xcd * (q + 1) : r * (q + 1) + (xcd - r) * q) + off; }
        const int nig = WGM * nN, gid = wgid / nig, fm = gid * WGM, gsz = (nM - fm) < WGM ? (nM - fm) : WGM;
        u.pm = fm + ((wgid % nig) % gsz); u.pn = (wgid % nig) / gsz; return true;
    }
};

__device__ __forceinline__ unsigned cvt_pk_bf16(float lo, float hi) { unsigned r; asm volatile("v_cvt_pk_bf16_f32 %0, %1, %2" : "=v"(r) : "v"(lo), "v"(hi)); return r; }
__device__ __forceinline__ f32x2 gelu_pk(f32x2 v) {
    const f32x2 av = __builtin_elementwise_abs(v), d = av * 0.2316418882f + 1.0f;
    f32x2 t; t.x = __builtin_amdgcn_rcpf(d.x); t.y = __builtin_amdgcn_rcpf(d.y);
    f32x2 q = t * 0.5307027145f + (-0.7265760135f); q = q * t + 0.7107068705f; q = q * t + (-0.142248368f); q = q * t + 0.127414796f; q = q * t;
    const f32x2 s = (v * v) * (-0.72134752044f);
    f32x2 e; e.x = __builtin_amdgcn_exp2f(s.x); e.y = __builtin_amdgcn_exp2f(s.y);
    const f32x2 m = v * (q * e), r = v - m;
    f32x2 o; o.x = v.x < 0.f ? m.x : r.x; o.y = v.y < 0.f ? m.y : r.y; return o;
}

template <class Epi, class Sched, int AMAP, bool KDBL, bool ALIGN_EPI>
__device__ __forceinline__ void gemm_phase(PG8_LAS unsigned char* lds, const int tid, const Gemm g, const Sched& S, const Epi& E) {
    const int wid = __builtin_amdgcn_readfirstlane(tid >> 6), lane = tid & 63, wr = wid >> 2, wc = wid & 3, fr = lane & 15, fq = lane >> 4;
    const int K = g.K, nt = K / BK, lda = g.lda;
    unsigned voffA[2], voffB[2];
#pragma unroll
    for (int i = 0; i < 2; ++i) { int R, C; stage_rc(tid * 16 + i * 8192, R, C); const int Rb = Epi::PERM ? ((R & ~31) + perm32(R & 31)) : R;
        const int Ra = (AMAP == 2) ? (R - 2 * (R >> 6)) : R;
        voffA[i] = (unsigned)(Ra * lda + C) * 2u; voffB[i] = (unsigned)(Rb * K + C) * 2u; }
    const size_t kstep = (size_t)(BK * 2);
    const size_t hstepA = (size_t)((AMAP == 2) ? 124 : HALF) * lda * 2;
    const size_t hstepB = (size_t)HALF * K * 2;
    const size_t tstepB = 2 * hstepB;
    const size_t rowA = (size_t)lda * 2;
    const unsigned ldsw = (unsigned)wid * 1024u;
    const int aoff = lds_byte(wr * 64 + fr, fq * 8), boff = lds_byte(wc * 32 + fr, fq * 8);
#define PG8_ABASE(pm) ((const char*)g.A + (AMAP == 1 ? (size_t)(((pm) >> 4) * 4104 + 8 + ((pm) & 15) * 256) * rowA : (AMAP == 2 ? (size_t)(pm) * 248 * rowA : (size_t)(pm) * 256 * rowA)))
#define PG8_KA(base, t) (KDBL ? ((base) + (size_t)((t) & 15) * kstep - (size_t)((t) >> 4) * rowA) : ((base) + (size_t)(t) * kstep))
#define PG8_SA(b, h) (((b) * 2 + (h)) * HTB)
#define PG8_SB(b, h) ((4 + (b) * 2 + (h)) * HTB)
#define PG8_STAGE(bufoff, gbase, voff) do { _Pragma("unroll") for (int _i = 0; _i < 2; ++_i) \
        __builtin_amdgcn_global_load_lds((const unsigned*)((const char*)(gbase) + (voff)[_i]), (PG8_LAS unsigned*)(lds + (bufoff) + ldsw + _i * 8192), 16, 0, 0); } while (0)
#define PG8_LDA(dst, b, h) do { _Pragma("unroll") for (int m = 0; m < 4; ++m) _Pragma("unroll") for (int k = 0; k < 2; ++k) dst[m][k] = *(const PG8_LAS bf16x8*)(lds + PG8_SA(b, h) + aoff + m * 2048 + k * 1024); } while (0)
#define PG8_LDB(dst, b, h) do { _Pragma("unroll") for (int n = 0; n < 2; ++n) _Pragma("unroll") for (int k = 0; k < 2; ++k) dst[n][k] = *(const PG8_LAS bf16x8*)(lds + PG8_SB(b, h) + boff + n * 2048 + k * 1024); } while (0)
#define PG8_MMA(ai, bj, At, Bt) do { __builtin_amdgcn_s_setprio(1); _Pragma("unroll") for (int m = 0; m < 4; ++m) _Pragma("unroll") for (int n = 0; n < 2; ++n) _Pragma("unroll") for (int k = 0; k < 2; ++k) \
        acc[ai][bj][m][n] = __builtin_amdgcn_mfma_f32_16x16x32_bf16(Bt[n][k], At[m][k], acc[ai][bj][m][n], 0, 0, 0); __builtin_amdgcn_s_setprio(0); } while (0)
#define PG8_WAIT_V(n) asm volatile("s_waitcnt vmcnt(" #n ")" ::: "memory")
#define PG8_WAIT_L(n) asm volatile("s_waitcnt lgkmcnt(" #n ")" ::: "memory")
#define PG8_BAR __builtin_amdgcn_s_barrier()
#define PG8_SCHED __builtin_amdgcn_sched_barrier(0)
    Unit cur, nxt; int ui = 0;
    if (!S.next(0, cur)) return;
    f32x4 acc[2][2][4][2];
#pragma unroll
    for (int a = 0; a < 2; ++a)
#pragma unroll
        for (int b = 0; b < 2; ++b)
#pragma unroll
            for (int m = 0; m < 4; ++m)
#pragma unroll
                for (int n = 0; n < 2; ++n) acc[a][b][m][n] = (f32x4){0.f, 0.f, 0.f, 0.f};
    bf16x8 At[4][2], B0[2][2], B1[2][2];
    const char* cA = PG8_ABASE(cur.pm); const char* cB = (const char*)g.Bt + (size_t)cur.pn * tstepB;
    {
        const char* cA1 = PG8_KA(cA, 1);
        PG8_STAGE(PG8_SB(0, 0), cB, voffB); PG8_STAGE(PG8_SB(0, 1), cB + hstepB, voffB); PG8_STAGE(PG8_SA(0, 0), cA, voffA); PG8_STAGE(PG8_SA(0, 1), cA + hstepA, voffA);
        if (wr == 1) PG8_BAR;
        PG8_WAIT_V(2); PG8_BAR;
        PG8_STAGE(PG8_SB(1, 0), cB + kstep, voffB); PG8_STAGE(PG8_SA(1, 0), cA1, voffA); PG8_STAGE(PG8_SB(1, 1), cB + hstepB + kstep, voffB);
        PG8_WAIT_V(6); PG8_BAR;
    }
    for (;;) {
        const bool has_next = S.next(ui + 1, nxt);
        const char* nA = has_next ? PG8_ABASE(nxt.pm) : cA; const char* nB = has_next ? (const char*)g.Bt + (size_t)nxt.pn * tstepB : cB;
        for (int t = 0; t < nt; t += 2) {
            const bool last = (t == nt - 2);
            const char* a1 = PG8_KA(cA, t + 1);
            const char* a2 = last ? nA : PG8_KA(cA, t + 2); const char* b2 = last ? nB : cB + (size_t)(t + 2) * kstep;
            const char* a3 = last ? PG8_KA(nA, 1) : PG8_KA(cA, t + 3); const char* b3 = b2 + kstep;
            PG8_LDB(B0, 0, 0); PG8_LDB(B1, 0, 1); PG8_SCHED; PG8_LDA(At, 0, 0); PG8_STAGE(PG8_SA(1, 1), a1 + hstepA, voffA);
            PG8_WAIT_V(8); PG8_WAIT_L(0); PG8_BAR; PG8_MMA(0, 0, At, B0); PG8_MMA(0, 1, At, B1); PG8_BAR; PG8_SCHED;
            PG8_LDA(At, 0, 1); PG8_STAGE(PG8_SB(0, 0), b2, voffB); PG8_STAGE(PG8_SB(0, 1), b2 + hstepB, voffB); PG8_STAGE(PG8_SA(0, 0), a2, voffA);
            PG8_WAIT_V(8); PG8_WAIT_L(0); PG8_BAR; PG8_MMA(1, 0, At, B0); PG8_MMA(1, 1, At, B1); PG8_BAR; PG8_SCHED;
            PG8_LDB(B0, 1, 0); PG8_LDB(B1, 1, 1); PG8_SCHED; PG8_LDA(At, 1, 0); PG8_STAGE(PG8_SA(0, 1), a2 + hstepA, voffA);
            PG8_WAIT_V(8); PG8_WAIT_L(0); PG8_BAR; PG8_MMA(0, 0, At, B0); PG8_MMA(0, 1, At, B1); PG8_BAR; PG8_SCHED;
            PG8_LDA(At, 1, 1); PG8_STAGE(PG8_SB(1, 0), b3, voffB); PG8_STAGE(PG8_SB(1, 1), b3 + hstepB, voffB); PG8_STAGE(PG8_SA(1, 0), a3, voffA);
            PG8_WAIT_V(8); PG8_WAIT_L(0); PG8_BAR; PG8_MMA(1, 0, At, B0); PG8_MMA(1, 1, At, B1); PG8_BAR; PG8_SCHED;
        }
        if constexpr (ALIGN_EPI) { if (wr == 0) PG8_BAR; }
        E(acc, cur, wr, wc, fr, fq);
        if (!has_next) break;
#pragma unroll
        for (int a = 0; a < 2; ++a)
#pragma unroll
            for (int b = 0; b < 2; ++b)
#pragma unroll
                for (int m = 0; m < 4; ++m)
#pragma unroll
                    for (int n = 0; n < 2; ++n) acc[a][b][m][n] = (f32x4){0.f, 0.f, 0.f, 0.f};
        cur = nxt; cA = nA; cB = nB; ++ui;
        if constexpr (ALIGN_EPI) { if (wr == 1) PG8_BAR; }
    }
    PG8_WAIT_V(0);
    if constexpr (!ALIGN_EPI) { if (wr == 0) PG8_BAR; }
    PG8_BAR;
#undef PG8_ABASE
#undef PG8_KA
#undef PG8_SA
#undef PG8_SB
#undef PG8_STAGE
#undef PG8_LDA
#undef PG8_LDB
#undef PG8_MMA
#undef PG8_WAIT_V
#undef PG8_WAIT_L
#undef PG8_BAR
#undef PG8_SCHED
}
}
using pg8::bf16_t; using pg8::f32x4; using pg8::f32x2; using pg8::u32x4; using pg8::u32x2; using pg8::Unit; using pg8::cvt_pk_bf16;
#define LAS __attribute__((address_space(3)))
constexpr int BATCH = 8, SEQ = 4096, D = 1024, M = BATCH * SEQ, FF = 2816, FF2 = 5632;
constexpr int PADR = 8, SEQP = SEQ + PADR;
constexpr float RMS_EPS = 1e-6f, GN_EPS = 64e-5f;
constexpr size_t MiB = 1u << 20;
constexpr size_t WS_WSTAT = 2 * MiB;
constexpr size_t WJ_IN = 0, WJ_OUT = 4 * MiB, WJ_RKV = 6 * MiB, WJ_L2WA = 20 * MiB, WJ_L2G = 20 * MiB + 512 * 1024, WJ_O = 21 * MiB, WJ_STRIDE = 23 * MiB;
constexpr size_t WS_WFFN = 48 * MiB;
constexpr size_t WS_WDOWN = WS_WFFN + 11 * MiB;
constexpr size_t WS_A = 67 * MiB;
constexpr size_t WS_P = 134 * MiB;
constexpr size_t P_R = WS_P, P_K = WS_P + 64 * MiB, P_V = WS_P + 128 * MiB, P_LW = WS_P + 192 * MiB, P_LA = WS_P + 256 * MiB, P_WA = WS_P + 320 * MiB, P_GL = WS_P + 328 * MiB;
constexpr size_t P_U = WS_P, P_SV = WS_P + 64 * MiB;
constexpr size_t P_Z = WS_P, P_ACT = WS_P + 176 * MiB;
constexpr size_t WS_PA = WS_P + 352 * MiB, WS_PB = WS_PA + 2 * MiB, WS_PV = WS_PB + 2 * MiB;
constexpr size_t WS_END = WS_PV + 2 * MiB;

struct Args {
    const float* in[32]; float* out; unsigned char* ws; int ph_lo, ph_hi;
};
enum { I_X = 0, I_NMIX, I_NFFN, I_NFIN, I_SWIN, I_SBIN, I_SGV, I_SWS, I_SBS, I_SWOUT, I_MU, I_WR, I_WK, I_WV, I_WO, I_W0, I_W1, I_W2, I_A0, I_A1, I_A2, I_G1, I_G2, I_KK, I_KA, I_RK, I_LNW, I_LNB, I_FUP, I_FCW, I_FCB, I_FDN };

__device__ __forceinline__ float bf2f(unsigned short b) { return __uint_as_float((unsigned)b << 16); }
__device__ __forceinline__ float bflo(unsigned w) { return __uint_as_float(w << 16); }
__device__ __forceinline__ float bfhi(unsigned w) { return __uint_as_float(w & 0xffff0000u); }
__device__ __forceinline__ float wave_sum(float v) {
#pragma unroll
    for (int o = 1; o < 64; o <<= 1) v += __shfl_xor(v, o);
    return v;
}
__device__ __forceinline__ float row_rstd(const float* P, int row) { const f32x4* p = (const f32x4*)(P + (size_t)row * 16); const f32x4 a = p[0], b = p[1], c = p[2], d = p[3];
    const float s = ((a.x + a.y) + (a.z + a.w)) + ((b.x + b.y) + (b.z + b.w)) + ((c.x + c.y) + (c.z + c.w)) + ((d.x + d.y) + (d.z + d.w)); return rsqrtf(s * (1.f / D) + RMS_EPS); }
__device__ __forceinline__ float sigmoidf_(float x) { return 1.f / (1.f + __expf(-x)); }

template <bool SCALE> struct EpiStore {
    static constexpr bool PERM = true;
    bf16_t* O; int ldc; int tsh; size_t split_stride; const float* ss;
    __device__ __forceinline__ void operator()(const f32x4 (&acc)[2][2][4][2], const Unit& u, int wr, int wc, int fr, int fq) const {
        bf16_t* base = O + (size_t)(u.pn >> tsh) * split_stride + (size_t)(u.pm * 256 + wr * 64 + fr) * ldc + (u.pn & ((1 << tsh) - 1)) * 256 + wc * 32 + 8 * fq;
        const int row0 = u.pm * 256 + wr * 64 + fr;
#pragma unroll
        for (int ai = 0; ai < 2; ++ai)
#pragma unroll
            for (int m = 0; m < 4; ++m) {
                const float rs = SCALE ? row_rstd(ss, row0 + ai * 128 + m * 16) : 1.f;
                bf16_t* rowp = base + (size_t)(ai * 128 + m * 16) * ldc;
#pragma unroll
                for (int bj = 0; bj < 2; ++bj) { const f32x4 v0 = acc[ai][bj][m][0] * rs, v1 = acc[ai][bj][m][1] * rs;
                    u32x4 w; w.x = cvt_pk_bf16(v0[0], v0[1]); w.y = cvt_pk_bf16(v0[2], v0[3]); w.z = cvt_pk_bf16(v1[0], v1[1]); w.w = cvt_pk_bf16(v1[2], v1[3]);
                    *(u32x4*)(rowp + bj * 128) = w; } }
    }
};
struct EpiSguIn {
    static constexpr bool PERM = true;
    bf16_t* U; bf16_t* V; const float* ss; const float* bias; float* ssv;
    __device__ __forceinline__ void operator()(const f32x4 (&acc)[2][2][4][2], const Unit& u, int wr, int wc, int fr, int fq) const {
        const bool isv = u.pn >= 4; bf16_t* base = isv ? V : U; const int colt = (u.pn & 3) * 256 + wc * 32 + 8 * fq, bcol = u.pn * 256 + wc * 32 + 8 * fq;
        f32x4 bv[2][2];
#pragma unroll
        for (int bj = 0; bj < 2; ++bj)
#pragma unroll
            for (int n = 0; n < 2; ++n) bv[bj][n] = *(const f32x4*)(bias + bcol + bj * 128 + 4 * n);
#pragma unroll
        for (int ai = 0; ai < 2; ++ai)
#pragma unroll
            for (int m = 0; m < 4; ++m) { const int row = u.pm * 256 + ai * 128 + wr * 64 + m * 16 + fr;
                const float rs = row_rstd(ss, row); float s = 0.f;
                bf16_t* rowp = base + (size_t)row * D + colt;
#pragma unroll
                for (int bj = 0; bj < 2; ++bj) { f32x4 v0 = acc[ai][bj][m][0] * rs + bv[bj][0], v1 = acc[ai][bj][m][1] * rs + bv[bj][1];
                    const f32x2 a = pg8::gelu_pk((f32x2){v0[0], v0[1]}), b = pg8::gelu_pk((f32x2){v0[2], v0[3]}), c = pg8::gelu_pk((f32x2){v1[0], v1[1]}), d = pg8::gelu_pk((f32x2){v1[2], v1[3]});
                    s += (a.x * a.x + a.y * a.y) + (b.x * b.x + b.y * b.y) + (c.x * c.x + c.y * c.y) + (d.x * d.x + d.y * d.y);
                    u32x4 w; w.x = cvt_pk_bf16(a.x, a.y); w.y = cvt_pk_bf16(b.x, b.y); w.z = cvt_pk_bf16(c.x, c.y); w.w = cvt_pk_bf16(d.x, d.y);
                    *(u32x4*)(rowp + bj * 128) = w; }
                if (isv) { s += __shfl_xor(s, 16); s += __shfl_xor(s, 32); if (fq == 0) ssv[(size_t)row * 16 + (u.pn - 4) * 4 + wc] = s; } }
    }
};
struct EpiResid {
    static constexpr bool PERM = true;
    float* h; bf16_t* hb; float* ssn;
    __device__ __forceinline__ void operator()(const f32x4 (&acc)[2][2][4][2], const Unit& u, int wr, int wc, int fr, int fq) const {
        const int colt = u.pn * 256 + wc * 32 + 8 * fq;
#pragma unroll
        for (int ai = 0; ai < 2; ++ai)
#pragma unroll
            for (int m = 0; m < 4; ++m) { const int row = u.pm * 256 + ai * 128 + wr * 64 + m * 16 + fr; float s = 0.f;
                float* hp = h + (size_t)row * D + colt; bf16_t* bp = hb + (size_t)row * D + colt;
#pragma unroll
                for (int bj = 0; bj < 2; ++bj) { const f32x4 v0 = *(const f32x4*)(hp + bj * 128) + acc[ai][bj][m][0], v1 = *(const f32x4*)(hp + bj * 128 + 4) + acc[ai][bj][m][1];
                    *(f32x4*)(hp + bj * 128) = v0; *(f32x4*)(hp + bj * 128 + 4) = v1;
                    s += (v0[0] * v0[0] + v0[1] * v0[1]) + (v0[2] * v0[2] + v0[3] * v0[3]) + (v1[0] * v1[0] + v1[1] * v1[1]) + (v1[2] * v1[2] + v1[3] * v1[3]);
                    u32x4 w; w.x = cvt_pk_bf16(v0[0], v0[1]); w.y = cvt_pk_bf16(v0[2], v0[3]); w.z = cvt_pk_bf16(v1[0], v1[1]); w.w = cvt_pk_bf16(v1[2], v1[3]);
                    *(u32x4*)(bp + bj * 128) = w; }
                s += __shfl_xor(s, 16); s += __shfl_xor(s, 32); if (fq == 0) ssn[(size_t)row * 16 + u.pn * 4 + wc] = s; }
    }
};
struct EpiRkv {
    static constexpr bool PERM = true;
    bf16_t* R; bf16_t* WA; bf16_t* GL;
    __device__ __forceinline__ void operator()(const f32x4 (&acc)[2][2][4][2], const Unit& u, int wr, int wc, int fr, int fq) const {
        const int mode = u.pn < 12 ? 0 : (u.pn == 12 ? 1 : 2);
        bf16_t* base; int ldc, colt;
        if (mode == 0) { base = R + (size_t)(u.pn >> 2) * ((size_t)M * D); ldc = D; colt = (u.pn & 3) * 256 + wc * 32 + 8 * fq; }
        else if (mode == 1) { base = WA; ldc = 128; colt = wc * 32 + 8 * fq; }
        else { base = GL; ldc = 256; colt = wc * 32 + 8 * fq; }
#pragma unroll
        for (int ai = 0; ai < 2; ++ai)
#pragma unroll
            for (int m = 0; m < 4; ++m) { const int row = u.pm * 256 + ai * 128 + wr * 64 + m * 16 + fr;
                bf16_t* rowp = base + (size_t)row * ldc + colt;
#pragma unroll
                for (int bj = 0; bj < 2; ++bj) { f32x4 v0 = acc[ai][bj][m][0], v1 = acc[ai][bj][m][1];
                    if (mode == 1) { if (bj == 1) continue;
                        if (wc < 2) {
#pragma unroll
                            for (int e = 0; e < 4; ++e) { v0[e] = tanhf(v0[e]); v1[e] = tanhf(v1[e]); } } }
                    else if (mode == 2) {
#pragma unroll
                        for (int e = 0; e < 4; ++e) { v0[e] = sigmoidf_(v0[e]); v1[e] = sigmoidf_(v1[e]); } }
                    u32x4 w; w.x = cvt_pk_bf16(v0[0], v0[1]); w.y = cvt_pk_bf16(v0[2], v0[3]); w.z = cvt_pk_bf16(v1[0], v1[1]); w.w = cvt_pk_bf16(v1[2], v1[3]);
                    *(u32x4*)(rowp + bj * 128) = w; } }
    }
};

typedef const __attribute__((address_space(4))) Args* CA;
struct Ctx { LAS unsigned char* lds; int tid, lane, wave, G, bid; };

__device__ __forceinline__ void conv_mat(const Ctx& c, const float* src, int ldsrc, int K, int N, int Kp, int Np, bf16_t* dst, int ldd, int n_off, int k_off, const float* sc, int mode, int rot) {
    LAS float* tile = (LAS float*)c.lds;
    const int nnb = Np / 64, nit = (Kp / 64) * nnb; const int start = (c.bid + c.G - (rot % c.G)) % c.G;
    for (int it = start; it < nit; it += c.G) {
        const int kb = it / nnb, nb = it % nnb, k0 = kb * 64, n0 = nb * 64;
#pragma unroll
        for (int j = 0; j < 8; ++j) { const int kk = (c.tid >> 6) + 8 * j, nn = c.tid & 63, k = k0 + kk, n = n0 + nn; float v = 0.f;
            if (src && k < K && n < N) { v = src[(size_t)k * ldsrc + n]; if (mode == 1) v *= sc[k]; else if (mode == 2) v *= (1.f - sc[k]); }
            tile[nn * 65 + kk] = v; }
        __syncthreads();
        { const int nn = c.tid >> 3, cc = c.tid & 7; const LAS float* s = tile + nn * 65 + 8 * cc;
            u32x4 o; o.x = cvt_pk_bf16(s[0], s[1]); o.y = cvt_pk_bf16(s[2], s[3]); o.z = cvt_pk_bf16(s[4], s[5]); o.w = cvt_pk_bf16(s[6], s[7]);
            *(u32x4*)(dst + (size_t)(n_off + n0 + nn) * ldd + k_off + k0 + 8 * cc) = o; }
        __syncthreads();
    }
}

__device__ __forceinline__ void phase_prologue(const Ctx& c, CA a) {
    float* ss = (float*)(a->ws + WS_PA);
    const int gw = c.bid * 8 + c.wave, NGW = c.G * 8;
    bf16_t* hb = (bf16_t*)(a->ws + WS_A);
    for (int m = gw; m < M; m += NGW) {
        const f32x4* xr = (const f32x4*)(a->in[I_X] + (size_t)m * D) + c.lane; f32x4* hr = (f32x4*)(a->out + (size_t)m * D) + c.lane; u32x2* br = (u32x2*)(hb + (size_t)m * D) + c.lane;
        float s = 0.f;
#pragma unroll
        for (int j = 0; j < 4; ++j) { const f32x4 v = xr[64 * j]; s += (v.x * v.x + v.y * v.y) + (v.z * v.z + v.w * v.w); hr[64 * j] = v; u32x2 w; w.x = cvt_pk_bf16(v.x, v.y); w.y = cvt_pk_bf16(v.z, v.w); br[64 * j] = w; }
        s = wave_sum(s); if (c.lane < 16) ss[(size_t)m * 16 + c.lane] = c.lane == 0 ? s : 0.f;
    }
    int rot = 0;
    for (int j = 0; j < 2; ++j) {
        unsigned char* wj = a->ws + WS_WSTAT + (size_t)j * WJ_STRIDE;
        conv_mat(c, a->in[I_SWIN] + (size_t)j * D * 2048, 2048, D, 2048, D, 2048, (bf16_t*)(wj + WJ_IN), D, 0, 0, a->in[I_NMIX] + (size_t)(2 * j) * D, 1, rot); rot += 512;
        conv_mat(c, a->in[I_SWOUT] + (size_t)j * D * D, D, D, D, D, D, (bf16_t*)(wj + WJ_OUT), D, 0, 0, nullptr, 0, rot); rot += 256;
        const float* mu = a->in[I_MU] + (size_t)j * 6 * D; bf16_t* rkv = (bf16_t*)(wj + WJ_RKV);
#define CONV_BIG(IDX, Q, MUB) do { conv_mat(c, a->in[IDX] + (size_t)j * D * D, D, D, D, D, D, rkv, 2048, (Q) * 1024, 0, mu + (MUB) * D, 2, rot); rot += 256; \
            conv_mat(c, a->in[IDX] + (size_t)j * D * D, D, D, D, D, D, rkv, 2048, (Q) * 1024, 1024, mu + (MUB) * D, 1, rot); rot += 256; } while (0)
        CONV_BIG(I_WR, 0, 0); CONV_BIG(I_WK, 1, 2); CONV_BIG(I_WV, 2, 3);
#undef CONV_BIG
        conv_mat(c, a->in[I_W1] + (size_t)j * D * 64, 64, D, 64, D, 64, rkv, 2048, 3072, 0, mu + 1 * D, 2, rot); rot += 16;
        conv_mat(c, a->in[I_W1] + (size_t)j * D * 64, 64, D, 64, D, 64, rkv, 2048, 3072, 1024, mu + 1 * D, 1, rot); rot += 16;
        conv_mat(c, a->in[I_A1] + (size_t)j * D * 64, 64, D, 64, D, 64, rkv, 2048, 3136, 0, mu + 4 * D, 2, rot); rot += 16;
        conv_mat(c, a->in[I_A1] + (size_t)j * D * 64, 64, D, 64, D, 64, rkv, 2048, 3136, 1024, mu + 4 * D, 1, rot); rot += 16;
        conv_mat(c, nullptr, 0, 0, 0, 2048, 128, rkv, 2048, 3200, 0, nullptr, 0, rot); rot += 64;
        conv_mat(c, a->in[I_G1] + (size_t)j * D * 160, 160, D, 160, D, 256, rkv, 2048, 3328, 0, mu + 5 * D, 2, rot); rot += 64;
        conv_mat(c, a->in[I_G1] + (size_t)j * D * 160, 160, D, 160, D, 256, rkv, 2048, 3328, 1024, mu + 5 * D, 1, rot); rot += 64;
        bf16_t* l2wa = (bf16_t*)(wj + WJ_L2WA);
        conv_mat(c, a->in[I_W2] + (size_t)j * 64 * D, D, 64, D, 64, D, l2wa, 128, 0, 0, nullptr, 0, rot); rot += 16;
        conv_mat(c, nullptr, 0, 0, 0, 64, D, l2wa, 128, 0, 64, nullptr, 0, rot); rot += 16;
        conv_mat(c, nullptr, 0, 0, 0, 64, D, l2wa, 128, 1024, 0, nullptr, 0, rot); rot += 16;
        conv_mat(c, a->in[I_A2] + (size_t)j * 64 * D, D, 64, D, 64, D, l2wa, 128, 1024, 64, nullptr, 0, rot); rot += 16;
        conv_mat(c, a->in[I_G2] + (size_t)j * 160 * D, D, 160, D, 256, D, (bf16_t*)(wj + WJ_L2G), 256, 0, 0, nullptr, 0, rot); rot += 64;
        conv_mat(c, a->in[I_WO] + (size_t)j * D * D, D, D, D, D, D, (bf16_t*)(wj + WJ_O), D, 0, 0, nullptr, 0, rot); rot += 256;
    }
}
__device__ __forceinline__ void phase_ffn_weights(const Ctx& c, CA a, int layer) {
    conv_mat(c, a->in[I_FUP] + (size_t)layer * D * FF2, FF2, D, FF2, D, FF2, (bf16_t*)(a->ws + WS_WFFN), D, 0, 0, a->in[I_NFFN] + (size_t)layer * D, 1, 0);
    conv_mat(c, a->in[I_FDN] + (size_t)layer * FF * D, D, FF, D, FF, D, (bf16_t*)(a->ws + WS_WDOWN), FF, 0, 0, nullptr, 0, 128);
}

__device__ __forceinline__ void phase_sgu_spatial(const Ctx& c, CA a, int j) {
    bf16_t* U = (bf16_t*)(a->ws + P_U); const bf16_t* V = (const bf16_t*)(a->ws + P_SV);
    const float* ssv = (const float*)(a->ws + WS_PV); LAS float* Lr = (LAS float*)c.lds;
    const float* Ws = a->in[I_SWS] + (size_t)j * 16 * 128 * 128; const float* bs = a->in[I_SBS] + (size_t)j * 16 * 128; const float* gv = a->in[I_SGV] + (size_t)j * D;
    for (int base = c.bid * 512; base < M * 128; base += c.G * 512) {
        const int idx = base + c.tid;
        const int m = idx >> 7, cc = (idx & 127) * 8, g = cc >> 6, tl = m & 127, m0 = m - tl;
        __syncthreads();
        if (c.tid < 128) Lr[c.tid] = row_rstd(ssv, (base >> 7 & ~127) + c.tid);
        __syncthreads();
        const float* wrow = Ws + ((size_t)g * 128 + tl) * 128;
        float acc[8];
#pragma unroll
        for (int e = 0; e < 8; ++e) acc[e] = 0.f;
        for (int s = 0; s <= tl; ++s) {
            const float w = wrow[s] * Lr[s];
            const u32x4 vv = *(const u32x4*)(V + (size_t)(m0 + s) * D + cc);
            acc[0] += w * bflo(vv.x); acc[1] += w * bfhi(vv.x); acc[2] += w * bflo(vv.y); acc[3] += w * bfhi(vv.y);
            acc[4] += w * bflo(vv.z); acc[5] += w * bfhi(vv.z); acc[6] += w * bflo(vv.w); acc[7] += w * bfhi(vv.w);
        }
        const float bb = bs[g * 128 + tl]; const f32x4 g0 = *(const f32x4*)(gv + cc), g1 = *(const f32x4*)(gv + cc + 4);
        const u32x4 uu = *(const u32x4*)(U + (size_t)m * D + cc);
        u32x4 o;
        o.x = cvt_pk_bf16(bflo(uu.x) * (acc[0] * g0.x + bb), bfhi(uu.x) * (acc[1] * g0.y + bb));
        o.y = cvt_pk_bf16(bflo(uu.y) * (acc[2] * g0.z + bb), bfhi(uu.y) * (acc[3] * g0.w + bb));
        o.z = cvt_pk_bf16(bflo(uu.z) * (acc[4] * g1.x + bb), bfhi(uu.z) * (acc[5] * g1.y + bb));
        o.w = cvt_pk_bf16(bflo(uu.w) * (acc[6] * g1.z + bb), bfhi(uu.w) * (acc[7] * g1.w + bb));
        *(u32x4*)(U + (size_t)m * D + cc) = o;
    }
}

__device__ __forceinline__ void phase_ffn_conv(const Ctx& c, CA a, int layer, int half) {
    const bf16_t* Z = (const bf16_t*)(a->ws + P_Z); bf16_t* ACT = (bf16_t*)(a->ws + P_ACT) + (size_t)half * (M / 2) * FF;
    const float* cw = a->in[I_FCW] + (size_t)layer * 3 * FF2; const float* cb = a->in[I_FCB] + (size_t)layer * FF2;
    const int gt = c.bid * 512 + c.tid, NT = c.G * 512;
    for (int idx = gt; idx < (M / 2) * (FF / 8); idx += NT) {
        const int ml = idx / (FF / 8), f = (idx % (FF / 8)) * 8, t = ml & (SEQ - 1);
        float gsum[8], vsum[8];
#pragma unroll
        for (int e = 0; e < 8; ++e) { gsum[e] = cb[f + e]; vsum[e] = cb[FF + f + e]; }
#pragma unroll
        for (int jj = 0; jj < 3; ++jj) { const int dt = 2 - jj; if (t - dt < 0) continue;
            const u32x4 zg = *(const u32x4*)(Z + (size_t)(ml - dt) * FF2 + f), zv = *(const u32x4*)(Z + (size_t)(ml - dt) * FF2 + FF + f);
            const float* wg = cw + (size_t)jj * FF2 + f; const float* wv = wg + FF;
            const unsigned zgw[4] = {zg.x, zg.y, zg.z, zg.w}, zvw[4] = {zv.x, zv.y, zv.z, zv.w};
#pragma unroll
            for (int e = 0; e < 4; ++e) { gsum[2 * e] += wg[2 * e] * bflo(zgw[e]); gsum[2 * e + 1] += wg[2 * e + 1] * bfhi(zgw[e]); vsum[2 * e] += wv[2 * e] * bflo(zvw[e]); vsum[2 * e + 1] += wv[2 * e + 1] * bfhi(zvw[e]); } }
        float o[8];
#pragma unroll
        for (int e = 0; e < 8; ++e) o[e] = gsum[e] * sigmoidf_(gsum[e]) * vsum[e];
        u32x4 w; w.x = cvt_pk_bf16(o[0], o[1]); w.y = cvt_pk_bf16(o[2], o[3]); w.z = cvt_pk_bf16(o[4], o[5]); w.w = cvt_pk_bf16(o[6], o[7]);
        *(u32x4*)(ACT + (size_t)ml * FF + f) = w;
    }
}

__device__ __forceinline__ void phase_rwkv_prep(const Ctx& c, CA a, int layer) {
    const float* ss = (const float*)(a->ws + WS_PA); const float* g = a->in[I_NMIX] + (size_t)layer * D;
    bf16_t* hn = (bf16_t*)(a->ws + WS_A);
    const int gw = c.bid * 8 + c.wave, NGW = c.G * 8;
    f32x4 gg[4];
#pragma unroll
    for (int j = 0; j < 4; ++j) gg[j] = *((const f32x4*)g + c.lane + 64 * j);
    for (int m = gw; m < M; m += NGW) {
        const float rs = row_rstd(ss, m);
        const f32x4* hr = (const f32x4*)(a->out + (size_t)m * D) + c.lane; const int prow = (m >> 12) * SEQP + PADR + (m & (SEQ - 1));
        u32x2* br = (u32x2*)(hn + (size_t)prow * D) + c.lane;
#pragma unroll
        for (int j = 0; j < 4; ++j) { const f32x4 v = hr[64 * j] * rs * gg[j]; u32x2 w; w.x = cvt_pk_bf16(v.x, v.y); w.y = cvt_pk_bf16(v.z, v.w); br[64 * j] = w; }
    }
    for (int r = gw; r < BATCH * PADR; r += NGW) { const int prow = (r / PADR) * SEQP + (r % PADR); u32x2* br = (u32x2*)(hn + (size_t)prow * D) + c.lane;
#pragma unroll
        for (int j = 0; j < 4; ++j) br[64 * j] = (u32x2){0u, 0u}; }
}

__device__ __forceinline__ void phase_scan(const Ctx& c, CA a, int j) {
    LAS float* Lw = (LAS float*)c.lds; LAS float* La = Lw + 2048; LAS float* Lb = La + 2048; LAS float* Lk = Lb + 2048; LAS float* Lr = Lk + 2048; LAS float* Lv = Lr + 2048; LAS float* Ly = Lv + 2048; LAS float* Lbon = Ly + 2048;
    bf16_t* R = (bf16_t*)(a->ws + P_R); const bf16_t* Kb = (const bf16_t*)(a->ws + P_K); const bf16_t* Vb = (const bf16_t*)(a->ws + P_V);
    const bf16_t* LWb = (const bf16_t*)(a->ws + P_LW); const bf16_t* LAb = (const bf16_t*)(a->ws + P_LA); const bf16_t* Gb = (const bf16_t*)(a->ws + WS_A);
    const int row = c.tid >> 3, q = c.tid & 7, st = c.tid >> 4, sc = (c.tid & 15) * 4;
    for (int unit = c.bid; unit < BATCH * 16; unit += c.G) {
        const int b = unit >> 4, hh = unit & 15, ch = hh * 64 + sc;
        const f32x4 w0 = *(const f32x4*)(a->in[I_W0] + (size_t)j * D + ch), a0 = *(const f32x4*)(a->in[I_A0] + (size_t)j * D + ch), kkp = *(const f32x4*)(a->in[I_KK] + (size_t)j * D + ch), kap = *(const f32x4*)(a->in[I_KA] + (size_t)j * D + ch),
                    rkp = *(const f32x4*)(a->in[I_RK] + (size_t)j * D + ch), lnw = *(const f32x4*)(a->in[I_LNW] + (size_t)j * D + ch), lnb = *(const f32x4*)(a->in[I_LNB] + (size_t)j * D + ch);
        f32x4 S0 = (f32x4){0.f, 0.f, 0.f, 0.f}, S1 = S0;
        for (int chunk = 0; chunk < SEQ / 32; ++chunk) {
            const size_t goff = ((size_t)b * SEQ + chunk * 32 + st) * D + ch;
            {
                const u32x2 r2 = *(const u32x2*)(R + goff), k2 = *(const u32x2*)(Kb + goff), v2 = *(const u32x2*)(Vb + goff), lw2 = *(const u32x2*)(LWb + goff), la2 = *(const u32x2*)(LAb + goff);
                const f32x4 r = {bflo(r2.x), bfhi(r2.x), bflo(r2.y), bfhi(r2.y)}, k = {bflo(k2.x), bfhi(k2.x), bflo(k2.y), bfhi(k2.y)}, v = {bflo(v2.x), bfhi(v2.x), bflo(v2.y), bfhi(v2.y)};
                const f32x4 lw = {bflo(lw2.x), bfhi(lw2.x), bflo(lw2.y), bfhi(lw2.y)}, la = {bflo(la2.x), bfhi(la2.x), bflo(la2.y), bfhi(la2.y)};
                f32x4 dec, av, kk, kp;
                float n2 = 0.f, bon = 0.f;
#pragma unroll
                for (int e = 0; e < 4; ++e) {
                    const float xw = -(w0[e] + lw[e]);
                    const float sp = xw > 20.f ? xw : log1pf(expf(xw));
                    dec[e] = expf(-expf(-sp - 0.5f));
                    av[e] = 1.f / (1.f + expf(-(a0[e] + la[e])));
                    kk[e] = k[e] * kkp[e]; n2 += kk[e] * kk[e];
                    kp[e] = k[e] * (1.f + (av[e] - 1.f) * kap[e]);
                    bon += r[e] * kp[e] * rkp[e];
                }
#pragma unroll
                for (int o = 1; o < 16; o <<= 1) { n2 += __shfl_xor(n2, o); bon += __shfl_xor(bon, o); }
                const float inv = rsqrtf(fmaxf(n2, 1e-24f));
                kk = kk * inv;
                const int lo = st * 64 + sc;
                *(LAS f32x4*)(Lw + lo) = dec; *(LAS f32x4*)(La + lo) = -kk; *(LAS f32x4*)(Lb + lo) = kk * av; *(LAS f32x4*)(Lk + lo) = kp; *(LAS f32x4*)(Lr + lo) = r; *(LAS f32x4*)(Lv + lo) = v;
                if ((c.tid & 15) == 0) Lbon[st] = bon;
            }
            __syncthreads();
            for (int t = 0; t < 32; ++t) {
                const LAS f32x4* pa = (const LAS f32x4*)(La + t * 64 + 8 * q); const LAS f32x4* pw = (const LAS f32x4*)(Lw + t * 64 + 8 * q); const LAS f32x4* pb = (const LAS f32x4*)(Lb + t * 64 + 8 * q);
                const LAS f32x4* pk = (const LAS f32x4*)(Lk + t * 64 + 8 * q); const LAS f32x4* pr = (const LAS f32x4*)(Lr + t * 64 + 8 * q);
                const f32x4 a0v = pa[0], a1v = pa[1], w0v = pw[0], w1v = pw[1], b0v = pb[0], b1v = pb[1], k0v = pk[0], k1v = pk[1], r0v = pr[0], r1v = pr[1];
                const float vv = Lv[t * 64 + row];
                const f32x4 p = S0 * a0v + S1 * a1v;
                float sa = (p.x + p.y) + (p.z + p.w);
                sa += __shfl_xor(sa, 1); sa += __shfl_xor(sa, 2); sa += __shfl_xor(sa, 4);
                S0 = S0 * w0v + sa * b0v + vv * k0v; S1 = S1 * w1v + sa * b1v + vv * k1v;
                const f32x4 yq = S0 * r0v + S1 * r1v;
                float y = (yq.x + yq.y) + (yq.z + yq.w);
                y += __shfl_xor(y, 1); y += __shfl_xor(y, 2); y += __shfl_xor(y, 4);
                if (q == 0) Ly[t * 64 + row] = y;
            }
            __syncthreads();
            {
                const int lo = st * 64 + sc;
                const f32x4 y = *(const LAS f32x4*)(Ly + lo), v = *(const LAS f32x4*)(Lv + lo); const float bon = Lbon[st];
                float s1 = (y.x + y.y) + (y.z + y.w);
#pragma unroll
                for (int o = 1; o < 16; o <<= 1) s1 += __shfl_xor(s1, o);
                const float mean = s1 * (1.f / 64.f); const f32x4 dlt = y - mean;
                float s2 = (dlt.x * dlt.x + dlt.y * dlt.y) + (dlt.z * dlt.z + dlt.w * dlt.w);
#pragma unroll
                for (int o = 1; o < 16; o <<= 1) s2 += __shfl_xor(s2, o);
                const float rstd = rsqrtf(s2 * (1.f / 64.f) + GN_EPS);
                const u32x2 g2 = *(const u32x2*)(Gb + goff);
                const f32x4 g = {bflo(g2.x), bfhi(g2.x), bflo(g2.y), bfhi(g2.y)};
                const f32x4 o = (dlt * rstd * lnw + lnb + bon * v) * g;
                u32x2 w; w.x = cvt_pk_bf16(o.x, o.y); w.y = cvt_pk_bf16(o.z, o.w);
                *(u32x2*)(R + goff) = w;
            }
            __syncthreads();
        }
    }
}

__device__ __forceinline__ void phase_final(const Ctx& c, CA a) {
    const float* ss = (const float*)(a->ws + WS_PA); const float* g = a->in[I_NFIN];
    const int gw = c.bid * 8 + c.wave, NGW = c.G * 8;
    f32x4 gg[4];
#pragma unroll
    for (int j = 0; j < 4; ++j) gg[j] = *((const f32x4*)g + c.lane + 64 * j);
    for (int m = gw; m < M; m += NGW) {
        const float rs = row_rstd(ss, m);
        f32x4* hr = (f32x4*)(a->out + (size_t)m * D) + c.lane;
#pragma unroll
        for (int j = 0; j < 4; ++j) hr[64 * j] = hr[64 * j] * rs * gg[j];
    }
}

constexpr int SLOTS = 11, NPH = 2 + 4 * SLOTS;
__host__ __device__ inline bool phase_active(int p) {
    if (p == 0 || p == NPH - 1) return true;
    const int i = (p - 1) / SLOTS, s = (p - 1) % SLOTS;
    if (s >= 5) return true;
    return (i & 1) ? true : (s < 3);
}

__global__ void __launch_bounds__(512, 2) mk_fwd(Args a_) {
    extern __shared__ __attribute__((aligned(16))) unsigned char lds_raw[];
    int tid_ = threadIdx.x, bid_ = blockIdx.x, G_ = gridDim.x;
    CA a = (CA)__builtin_amdgcn_kernarg_segment_ptr();
    const int ph_lo = a_.ph_lo, ph_hi = a_.ph_hi;
    for (int p = ph_lo; p < ph_hi; ++p) {
        if (!phase_active(p)) continue;
        asm volatile("" : "+s"(a), "+s"(bid_), "+s"(G_)); asm volatile("" : "+v"(tid_));
        Ctx c; c.lds = (LAS unsigned char*)lds_raw; c.tid = tid_; c.lane = c.tid & 63; c.wave = __builtin_amdgcn_readfirstlane(c.tid >> 6); c.G = G_; c.bid = bid_;
        bf16_t* regA = (bf16_t*)(a->ws + WS_A);
        if (p == 0) phase_prologue(c, a);
        else if (p == NPH - 1) phase_final(c, a);
        else {
            const int layer = (p - 1) / SLOTS, s = (p - 1) % SLOTS, j = layer >> 1;
            unsigned char* wj = a->ws + WS_WSTAT + (size_t)j * WJ_STRIDE;
            float* ss_mix = (float*)(a->ws + WS_PA); float* ss_ffn = (float*)(a->ws + WS_PB); float* ss_next = ss_mix;
            if (s < 5 && !(layer & 1)) {
                if (s == 0) {
                    pg8::Gemm g{regA, (const bf16_t*)(wj + WJ_IN), M, 2048, D, D}; pg8::StaticOrder S; S.init(M / 256, 2048, c.G, c.bid);
                    EpiSguIn E{(bf16_t*)(a->ws + P_U), (bf16_t*)(a->ws + P_SV), ss_mix, a->in[I_SBIN] + (size_t)j * 2048, (float*)(a->ws + WS_PV)};
                    pg8::gemm_phase<EpiSguIn, pg8::StaticOrder, 0, false, true>(c.lds, c.tid, g, S, E);
                } else if (s == 1) phase_sgu_spatial(c, a, j);
                else {
                    pg8::Gemm g{(const bf16_t*)(a->ws + P_U), (const bf16_t*)(wj + WJ_OUT), M, D, D, D}; pg8::StaticOrder S; S.init(M / 256, D, c.G, c.bid);
                    EpiResid E{a->out, regA, ss_ffn};
                    pg8::gemm_phase<EpiResid, pg8::StaticOrder, 0, false, true>(c.lds, c.tid, g, S, E);
                }
            } else if (s < 5) {
                if (s == 0) phase_rwkv_prep(c, a, layer);
                else if (s == 1) {
                    pg8::Gemm g{regA, (const bf16_t*)(wj + WJ_RKV), M, 3584, 2048, D}; pg8::StaticOrder S; S.init(M / 256, 3584, c.G, c.bid);
                    EpiRkv E{(bf16_t*)(a->ws + P_R), (bf16_t*)(a->ws + P_WA), (bf16_t*)(a->ws + P_GL)};
                    pg8::gemm_phase<EpiRkv, pg8::StaticOrder, 1, true, true>(c.lds, c.tid, g, S, E);
                } else if (s == 2) {
                    { int kq = 128; asm volatile("" : "+s"(kq)); pg8::Gemm g{(const bf16_t*)(a->ws + P_WA), (const bf16_t*)(wj + WJ_L2WA), M, 2048, kq, kq}; pg8::StaticOrder S; S.init(M / 256, 2048, c.G, c.bid);
                      EpiStore<false> E{(bf16_t*)(a->ws + P_LW), D, 2, (size_t)M * D, nullptr};
                      pg8::gemm_phase<EpiStore<false>, pg8::StaticOrder, 0, false, true>(c.lds, c.tid, g, S, E); }
                    asm volatile("" : "+s"(a), "+s"(c.bid), "+s"(c.G), "+s"(wj)); asm volatile("" : "+v"(c.tid));
                    { int kq = 256; asm volatile("" : "+s"(kq)); pg8::Gemm g{(const bf16_t*)(a->ws + P_GL), (const bf16_t*)(wj + WJ_L2G), M, D, kq, kq}; pg8::StaticOrder S; S.init(M / 256, D, c.G, c.bid);
                      EpiStore<false> E{regA, D, 2, 0, nullptr};
                      pg8::gemm_phase<EpiStore<false>, pg8::StaticOrder, 0, false, true>(c.lds, c.tid, g, S, E); }
                } else if (s == 3) phase_scan(c, a, j);
                else {
                    pg8::Gemm g{(const bf16_t*)(a->ws + P_R), (const bf16_t*)(wj + WJ_O), M, D, D, D}; pg8::StaticOrder S; S.init(M / 256, D, c.G, c.bid);
                    EpiResid E{a->out, regA, ss_ffn};
                    pg8::gemm_phase<EpiResid, pg8::StaticOrder, 0, false, true>(c.lds, c.tid, g, S, E);
                }
            } else if (s == 5) phase_ffn_weights(c, a, layer);
            else if (s == 6 || s == 8) {
                const int half = (s - 6) >> 1;
                pg8::Gemm g{regA + (size_t)half * (M / 2) * D, (const bf16_t*)(a->ws + WS_WFFN), M / 2, FF2, D, D}; pg8::StaticOrder S; S.init(M / 512, FF2, c.G, c.bid);
                EpiStore<true> E{(bf16_t*)(a->ws + P_Z), FF2, 8, 0, ss_ffn + (size_t)half * (M / 2) * 16};
                pg8::gemm_phase<EpiStore<true>, pg8::StaticOrder, 0, false, true>(c.lds, c.tid, g, S, E);
            } else if (s == 7 || s == 9) phase_ffn_conv(c, a, layer, (s - 7) >> 1);
            else {
                pg8::Gemm g{(const bf16_t*)(a->ws + P_ACT), (const bf16_t*)(a->ws + WS_WDOWN), M, D, FF, FF}; pg8::StaticOrder S; S.init(M / 256, D, c.G, c.bid);
                EpiResid E{a->out, regA, ss_next};
                pg8::gemm_phase<EpiResid, pg8::StaticOrder, 0, false, true>(c.lds, c.tid, g, S, E);
            }
        }
        if (p + 1 < ph_hi) cg::this_grid().sync();
    }
}

constexpr int LDS_BYTES = 147456;
#ifndef MK_ONE_LAUNCH
#define MK_ONE_LAUNCH 1
#endif
extern "C" void kernel_launch(void* const* d_in, const int* in_sizes, int n_in, void* d_out, int out_size, void* d_ws, size_t ws_size, hipStream_t stream) {
    static int grid = 0;
    if (grid == 0) {
        if (n_in != 32 || out_size != M * D || ws_size < WS_END) { fprintf(stderr, "kernel_launch: unexpected shapes (n_in %d out %d ws %zu, need %zu)\n", n_in, out_size, ws_size, (size_t)WS_END); grid = -1; return; }
        int dev = 0, cus = 0, per_cu = 0;
        (void)hipGetDevice(&dev); (void)hipDeviceGetAttribute(&cus, hipDeviceAttributeMultiprocessorCount, dev);
        if (hipFuncSetAttribute((const void*)mk_fwd, hipFuncAttributeMaxDynamicSharedMemorySize, LDS_BYTES) != hipSuccess) { fprintf(stderr, "kernel_launch: hipFuncSetAttribute failed\n"); grid = -1; return; }
        (void)hipOccupancyMaxActiveBlocksPerMultiprocessor(&per_cu, (const void*)mk_fwd, 512, LDS_BYTES);
        if (per_cu < 1) per_cu = 1;
        grid = cus * 1;
        (void)hipGetLastError();
    }
    if (grid < 0) return;
    Args a{};
    for (int i = 0; i < 32; ++i) a.in[i] = (const float*)d_in[i];
    a.out = (float*)d_out; a.ws = (unsigned char*)d_ws;
#if MK_ONE_LAUNCH
    a.ph_lo = 0; a.ph_hi = NPH;
    void* args[] = {&a};
    hipError_t e = hipLaunchCooperativeKernel((const void*)mk_fwd, dim3(grid), dim3(512), args, LDS_BYTES, stream);
    if (e != hipSuccess) fprintf(stderr, "cooperative launch failed: %s (grid %d)\n", hipGetErrorString(e), grid);
#else
    for (int p = 0; p < NPH; ++p) { if (!phase_active(p)) continue; a.ph_lo = p; a.ph_hi = p + 1; hipLaunchKernelGGL(mk_fwd, dim3(grid), dim3(512), LDS_BYTES, stream, a); }
#endif
}
```

```cpp
#include <hip/hip_runtime.h>
#include <hip/hip_cooperative_groups.h>
#include <cstdio>
#include <cstdint>
#include <cmath>
namespace cg = cooperative_groups;
#ifndef MK_PROBE
#define MK_PROBE 0
#endif
#ifndef MK_PROBE_SEL
#define MK_PROBE_SEL 0
#endif
namespace pg8 {
#define PG8_LAS __attribute__((address_space(3)))
typedef unsigned short bf16_t;
typedef short bf16x8 __attribute__((ext_vector_type(8)));
typedef float f32x4 __attribute__((ext_vector_type(4)));
typedef float f32x2 __attribute__((ext_vector_type(2)));
typedef unsigned u32x4 __attribute__((ext_vector_type(4)));
typedef unsigned u32x2 __attribute__((ext_vector_type(2)));
constexpr int BM = 256, BK = 64, HALF = 128, HTB = HALF * BK * 2  , STAGE_BYTES = 8 * HTB, NXCD = 8, WGM = 8;

__host__ __device__ __forceinline__ int lds_byte(int r, int c) { const int st = (r >> 4) * 2 + (c >> 5), rr = r & 15, cc = c & 31, ob = rr * 64 + cc * 2; return st * 1024 + (ob ^ (((ob >> 9) & 1) << 5)); }
__host__ __device__ __forceinline__ void stage_rc(int b, int& R, int& C) { const int st = b / 1024, sb = b % 1024, swz = sb ^ (((sb >> 9) & 1) << 5); R = (st >> 1) * 16 + swz / 64; C = (st & 1) * 32 + (swz % 64) / 2; }
__host__ __device__ __forceinline__ int perm32(int rho) { const int n = rho >> 4, i = rho & 15; return 8 * (i >> 2) + 4 * n + (i & 3); }

struct Unit { int pm, pn; };
struct Gemm { const bf16_t* A; const bf16_t* Bt; int M, N, K, lda; };

struct StaticOrder {
    int nM, nN, nwg, G, c;
    __host__ __device__ void init(int nM_, int N, int G_, int c_) { nM = nM_; nN = N / BM; nwg = nM * nN; G = G_; c = c_; }
    __host__ __device__ bool next(int i, Unit& u) const {
        const long L = (long)i * G + c; if (L >= nwg) return false;
        int wgid = (int)L; { const int q = nwg / NXCD, r = nwg % NXCD, xcd = wgid % NXCD, off = wgid / NXCD; wgid = (xcd < r ? xcd * (q + 1) : r * (q + 1) + (xcd - r) * q) + off; }
        const int nig = WGM * nN, gid = wgid / nig, fm = gid * WGM, gsz = (nM - fm) < WGM ? (nM - fm) : WGM;
        u.pm = fm + ((wgid % nig) % gsz); u.pn = (wgid % nig) / gsz; return true;
    }
};

__device__ __forceinline__ unsigned cvt_pk_bf16(float lo, float hi) { unsigned r; asm volatile("v_cvt_pk_bf16_f32 %0, %1, %2" : "=v"(r) : "v"(lo), "v"(hi)); return r; }
__device__ __forceinline__ f32x2 gelu_pk(f32x2 v) {
    const f32x2 av = __builtin_elementwise_abs(v), d = av * 0.2316418882f + 1.0f;
    f32x2 t; t.x = __builtin_amdgcn_rcpf(d.x); t.y = __builtin_amdgcn_rcpf(d.y);
    f32x2 q = t * 0.5307027145f + (-0.7265760135f); q = q * t + 0.7107068705f; q = q * t + (-0.142248368f); q = q * t + 0.127414796f; q = q * t;
    const f32x2 s = (v * v) * (-0.72134752044f);
    f32x2 e; e.x = __builtin_amdgcn_exp2f(s.x); e.y = __builtin_amdgcn_exp2f(s.y);
    const f32x2 m = v * (q * e), r = v - m;
    f32x2 o; o.x = v.x < 0.f ? m.x : r.x; o.y = v.y < 0.f ? m.y : r.y; return o;
}

template <class Epi, class Sched, int AMAP, bool KDBL, bool ALIGN_EPI>
__device__ __forceinline__ void gemm_phase(PG8_LAS unsigned char* lds, const int tid, const Gemm g, const Sched& S, const Epi& E) {
    const int wid = __builtin_amdgcn_readfirstlane(tid >> 6), lane = tid & 63, wr = wid >> 2, wc = wid & 3, fr = lane & 15, fq = lane >> 4;
    const int K = g.K, nt = K / BK, lda = g.lda;
    unsigned voffA[2], voffB[2];
#pragma unroll
    for (int i = 0; i < 2; ++i) { int R, C; stage_rc(tid * 16 + i * 8192, R, C); const int Rb = Epi::PERM ? ((R & ~31) + perm32(R & 31)) : R;
        const int Ra = (AMAP == 2) ? (R - 2 * (R >> 6)) : R;
        voffA[i] = (unsigned)(Ra * lda + C) * 2u; voffB[i] = (unsigned)(Rb * K + C) * 2u; }
    const size_t kstep = (size_t)(BK * 2);
    const size_t hstepA = (size_t)((AMAP == 2) ? 124 : HALF) * lda * 2;
    const size_t hstepB = (size_t)HALF * K * 2;
    const size_t tstepB = 2 * hstepB;
    const size_t rowA = (size_t)lda * 2;
    const unsigned ldsw = (unsigned)wid * 1024u;
    const int aoff = lds_byte(wr * 64 + fr, fq * 8), boff = lds_byte(wc * 32 + fr, fq * 8);
#define PG8_ABASE(pm) ((const char*)g.A + (AMAP == 1 ? (size_t)(((pm) >> 4) * 4104 + 8 + ((pm) & 15) * 256) * rowA : (AMAP == 2 ? (size_t)(pm) * 248 * rowA : (size_t)(pm) * 256 * rowA)))
#define PG8_KA(base, t) (KDBL ? ((base) + (size_t)((t) & 15) * kstep - (size_t)((t) >> 4) * rowA) : ((base) + (size_t)(t) * kstep))
#define PG8_SA(b, h) (((b) * 2 + (h)) * HTB)
#define PG8_SB(b, h) ((4 + (b) * 2 + (h)) * HTB)
#define PG8_STAGE(bufoff, gbase, voff) do { _Pragma("unroll") for (int _i = 0; _i < 2; ++_i) \
        __builtin_amdgcn_global_load_lds((const unsigned*)((const char*)(gbase) + (voff)[_i]), (PG8_LAS unsigned*)(lds + (bufoff) + ldsw + _i * 8192), 16, 0, 0); } while (0)
#define PG8_LDA(dst, b, h) do { _Pragma("unroll") for (int m = 0; m < 4; ++m) _Pragma("unroll") for (int k = 0; k < 2; ++k) dst[m][k] = *(const PG8_LAS bf16x8*)(lds + PG8_SA(b, h) + aoff + m * 2048 + k * 1024); } while (0)
#define PG8_LDB(dst, b, h) do { _Pragma("unroll") for (int n = 0; n < 2; ++n) _Pragma("unroll") for (int k = 0; k < 2; ++k) dst[n][k] = *(const PG8_LAS bf16x8*)(lds + PG8_SB(b, h) + boff + n * 2048 + k * 1024); } while (0)
#define PG8_MMA(ai, bj, At, Bt) do { __builtin_amdgcn_s_setprio(1); _Pragma("unroll") for (int m = 0; m < 4; ++m) _Pragma("unroll") for (int n = 0; n < 2; ++n) _Pragma("unroll") for (int k = 0; k < 2; ++k) \
        acc[ai][bj][m][n] = __builtin_amdgcn_mfma_f32_16x16x32_bf16(Bt[n][k], At[m][k], acc[ai][bj][m][n], 0, 0, 0); __builtin_amdgcn_s_setprio(0); } while (0)
#define PG8_WAIT_V(n) asm volatile("s_waitcnt vmcnt(" #n ")" ::: "memory")
#define PG8_WAIT_L(n) asm volatile("s_waitcnt lgkmcnt(" #n ")" ::: "memory")
#define PG8_BAR __builtin_amdgcn_s_barrier()
#define PG8_SCHED __builtin_amdgcn_sched_barrier(0)
    Unit cur, nxt; int ui = 0;
    if (!S.next(0, cur)) return;
    f32x4 acc[2][2][4][2];
#pragma unroll
    for (int a = 0; a < 2; ++a)
#pragma unroll
        for (int b = 0; b < 2; ++b)
#pragma unroll
            for (int m = 0; m < 4; ++m)
#pragma unroll
                for (int n = 0; n < 2; ++n) acc[a][b][m][n] = (f32x4){0.f, 0.f, 0.f, 0.f};
    bf16x8 At[4][2], B0[2][2], B1[2][2];
    const char* cA = PG8_ABASE(cur.pm); const char* cB = (const char*)g.Bt + (size_t)cur.pn * tstepB;
    {
        const char* cA1 = PG8_KA(cA, 1);
        PG8_STAGE(PG8_SB(0, 0), cB, voffB); PG8_STAGE(PG8_SB(0, 1), cB + hstepB, voffB); PG8_STAGE(PG8_SA(0, 0), cA, voffA); PG8_STAGE(PG8_SA(0, 1), cA + hstepA, voffA);
        if (wr == 1) PG8_BAR;
        PG8_WAIT_V(2); PG8_BAR;
        PG8_STAGE(PG8_SB(1, 0), cB + kstep, voffB); PG8_STAGE(PG8_SA(1, 0), cA1, voffA); PG8_STAGE(PG8_SB(1, 1), cB + hstepB + kstep, voffB);
        PG8_WAIT_V(6); PG8_BAR;
    }
    for (;;) {
        const bool has_next = S.next(ui + 1, nxt);
        const char* nA = has_next ? PG8_ABASE(nxt.pm) : cA; const char* nB = has_next ? (const char*)g.Bt + (size_t)nxt.pn * tstepB : cB;
        for (int t = 0; t < nt; t += 2) {
            const bool last = (t == nt - 2);
            const char* a1 = PG8_KA(cA, t + 1);
            const char* a2 = last ? nA : PG8_KA(cA, t + 2); const char* b2 = last ? nB : cB + (size_t)(t + 2) * kstep;
            const char* a3 = last ? PG8_KA(nA, 1) : PG8_KA(cA, t + 3); const char* b3 = b2 + kstep;
            PG8_LDB(B0, 0, 0); PG8_LDB(B1, 0, 1); PG8_SCHED; PG8_LDA(At, 0, 0); PG8_STAGE(PG8_SA(1, 1), a1 + hstepA, voffA);
            PG8_WAIT_V(8); PG8_WAIT_L(0); PG8_BAR; PG8_MMA(0, 0, At, B0); PG8_MMA(0, 1, At, B1); PG8_BAR; PG8_SCHED;
            PG8_LDA(At, 0, 1); PG8_STAGE(PG8_SB(0, 0), b2, voffB); PG8_STAGE(PG8_SB(0, 1), b2 + hstepB, voffB); PG8_STAGE(PG8_SA(0, 0), a2, voffA);
            PG8_WAIT_V(8); PG8_WAIT_L(0); PG8_BAR; PG8_MMA(1, 0, At, B0); PG8_MMA(1, 1, At, B1); PG8_BAR; PG8_SCHED;
            PG8_LDB(B0, 1, 0); PG8_LDB(B1, 1, 1); PG8_SCHED; PG8_LDA(At, 1, 0); PG8_STAGE(PG8_SA(0, 1), a2 + hstepA, voffA);
            PG8_WAIT_V(8); PG8_WAIT_L(0); PG8_BAR; PG8_MMA(0, 0, At, B0); PG8_MMA(0, 1, At, B1); PG8_BAR; PG8_SCHED;
            PG8_LDA(At, 1, 1); PG8_STAGE(PG8_SB(1, 0), b3, voffB); PG8_STAGE(PG8_SB(1, 1), b3 + hstepB, voffB); PG8_STAGE(PG8_SA(1, 0), a3, voffA);
            PG8_WAIT_V(8); PG8_WAIT_L(0); PG8_BAR; PG8_MMA(1, 0, At, B0); PG8_MMA(1, 1, At, B1); PG8_BAR; PG8_SCHED;
        }
        if constexpr (ALIGN_EPI) { if (wr == 0) PG8_BAR; }
        E(acc, cur, wr, wc, fr, fq);
        if (!has_next) break;
#pragma unroll
        for (int a = 0; a < 2; ++a)
#pragma unroll
            for (int b = 0; b < 2; ++b)
#pragma unroll
                for (int m = 0; m < 4; ++m)
#pragma unroll
                    for (int n = 0; n < 2; ++n) acc[a][b][m][n] = (f32x4){0.f, 0.f, 0.f, 0.f};
        cur = nxt; cA = nA; cB = nB; ++ui;
        if constexpr (ALIGN_EPI) { if (wr == 1) PG8_BAR; }
    }
    PG8_WAIT_V(0);
    if constexpr (!ALIGN_EPI) { if (wr == 0) PG8_BAR; }
    PG8_BAR;
#undef PG8_ABASE
#undef PG8_KA
#undef PG8_SA
#undef PG8_SB
#undef PG8_STAGE
#undef PG8_LDA
#undef PG8_LDB
#undef PG8_MMA
#undef PG8_WAIT_V
#undef PG8_WAIT_L
#undef PG8_BAR
#undef PG8_SCHED
}
}
using pg8::bf16_t; using pg8::f32x4; using pg8::f32x2; using pg8::u32x4; using pg8::u32x2; using pg8::Unit; using pg8::cvt_pk_bf16;
#define LAS __attribute__((address_space(3)))
constexpr int BATCH = 8, SEQ = 4096, D = 1024, M = BATCH * SEQ, FF = 2816, FF2 = 5632;
constexpr int PADR = 8, SEQP = SEQ + PADR;
constexpr float RMS_EPS = 1e-6f, GN_EPS = 64e-5f;
constexpr size_t MiB = 1u << 20;
constexpr size_t WS_WSTAT = 2 * MiB;
constexpr size_t WJ_IN = 0, WJ_OUT = 4 * MiB, WJ_RKV = 6 * MiB, WJ_L2WA = 20 * MiB, WJ_L2G = 20 * MiB + 512 * 1024, WJ_O = 21 * MiB, WJ_STRIDE = 23 * MiB;
constexpr size_t WS_WFFN = 48 * MiB;
constexpr size_t WS_WDOWN = WS_WFFN + 11 * MiB;
constexpr size_t WS_A = 67 * MiB;
constexpr size_t WS_P = 134 * MiB;
constexpr size_t P_R = WS_P, P_K = WS_P + 64 * MiB, P_V = WS_P + 128 * MiB, P_LW = WS_P + 192 * MiB, P_LA = WS_P + 256 * MiB, P_WA = WS_P + 320 * MiB, P_GL = WS_P + 328 * MiB;
constexpr size_t P_U = WS_P, P_SV = WS_P + 64 * MiB;
constexpr size_t P_Z = WS_P, P_ACT = WS_P + 176 * MiB;
constexpr size_t WS_PA = WS_P + 352 * MiB, WS_PB = WS_PA + 2 * MiB, WS_PV = WS_PB + 2 * MiB;
constexpr size_t WS_END = WS_PV + 2 * MiB;

struct Args {
    const float* in[32]; float* out; unsigned char* ws; int ph_lo, ph_hi;
};
enum { I_X = 0, I_NMIX, I_NFFN, I_NFIN, I_SWIN, I_SBIN, I_SGV, I_SWS, I_SBS, I_SWOUT, I_MU, I_WR, I_WK, I_WV, I_WO, I_W0, I_W1, I_W2, I_A0, I_A1, I_A2, I_G1, I_G2, I_KK, I_KA, I_RK, I_LNW, I_LNB, I_FUP, I_FCW, I_FCB, I_FDN };

__device__ __forceinline__ float bf2f(unsigned short b) { return __uint_as_float((unsigned)b << 16); }
__device__ __forceinline__ float bflo(unsigned w) { return __uint_as_float(w << 16); }
__device__ __forceinline__ float bfhi(unsigned w) { return __uint_as_float(w & 0xffff0000u); }
__device__ __forceinline__ float wave_sum(float v) {
#pragma unroll
    for (int o = 1; o < 64; o <<= 1) v += __shfl_xor(v, o);
    return v;
}
__device__ __forceinline__ float row_rstd(const float* P, int row) { const f32x4* p = (const f32x4*)(P + (size_t)row * 16); const f32x4 a = p[0], b = p[1], c = p[2], d = p[3];
    const float s = ((a.x + a.y) + (a.z + a.w)) + ((b.x + b.y) + (b.z + b.w)) + ((c.x + c.y) + (c.z + c.w)) + ((d.x + d.y) + (d.z + d.w)); return rsqrtf(s * (1.f / D) + RMS_EPS); }
template <int CTRL> __device__ __forceinline__ float dpp_f(float v) { return __int_as_float(__builtin_amdgcn_mov_dpp(__float_as_int(v), CTRL, 0xf, 0xf, true)); }
__device__ __forceinline__ float sum8(float v) { v += dpp_f<0x141>(v); v += dpp_f<0xB1>(v); v += dpp_f<0x4E>(v); return v; }
__device__ __forceinline__ float sigmoidf_(float x) { return 1.f / (1.f + __expf(-x)); }

template <bool SCALE> struct EpiStore {
    static constexpr bool PERM = true;
    bf16_t* O; int ldc; int tsh; size_t split_stride; const float* ss;
    __device__ __forceinline__ void operator()(const f32x4 (&acc)[2][2][4][2], const Unit& u, int wr, int wc, int fr, int fq) const {
        bf16_t* base = O + (size_t)(u.pn >> tsh) * split_stride + (size_t)(u.pm * 256 + wr * 64 + fr) * ldc + (u.pn & ((1 << tsh) - 1)) * 256 + wc * 32 + 8 * fq;
        const int row0 = u.pm * 256 + wr * 64 + fr;
#pragma unroll
        for (int ai = 0; ai < 2; ++ai)
#pragma unroll
            for (int m = 0; m < 4; ++m) {
                const float rs = SCALE ? row_rstd(ss, row0 + ai * 128 + m * 16) : 1.f;
                bf16_t* rowp = base + (size_t)(ai * 128 + m * 16) * ldc;
#pragma unroll
                for (int bj = 0; bj < 2; ++bj) { const f32x4 v0 = acc[ai][bj][m][0] * rs, v1 = acc[ai][bj][m][1] * rs;
                    u32x4 w; w.x = cvt_pk_bf16(v0[0], v0[1]); w.y = cvt_pk_bf16(v0[2], v0[3]); w.z = cvt_pk_bf16(v1[0], v1[1]); w.w = cvt_pk_bf16(v1[2], v1[3]);
                    *(u32x4*)(rowp + bj * 128) = w; } }
    }
};
struct EpiSguIn {
    static constexpr bool PERM = true;
    bf16_t* U; bf16_t* V; const float* ss; const float* bias; float* ssv;
    __device__ __forceinline__ void operator()(const f32x4 (&acc)[2][2][4][2], const Unit& u, int wr, int wc, int fr, int fq) const {
        const bool isv = u.pn >= 4; bf16_t* base = isv ? V : U; const int colt = (u.pn & 3) * 256 + wc * 32 + 8 * fq, bcol = u.pn * 256 + wc * 32 + 8 * fq;
        f32x4 bv[2][2];
#pragma unroll
        for (int bj = 0; bj < 2; ++bj)
#pragma unroll
            for (int n = 0; n < 2; ++n) bv[bj][n] = *(const f32x4*)(bias + bcol + bj * 128 + 4 * n);
#pragma unroll
        for (int ai = 0; ai < 2; ++ai)
#pragma unroll
            for (int m = 0; m < 4; ++m) { const int row = u.pm * 256 + ai * 128 + wr * 64 + m * 16 + fr;
                const float rs = row_rstd(ss, row); float s = 0.f;
                bf16_t* rowp = base + (size_t)row * D + colt;
#pragma unroll
                for (int bj = 0; bj < 2; ++bj) { f32x4 v0 = acc[ai][bj][m][0] * rs + bv[bj][0], v1 = acc[ai][bj][m][1] * rs + bv[bj][1];
                    const f32x2 a = pg8::gelu_pk((f32x2){v0[0], v0[1]}), b = pg8::gelu_pk((f32x2){v0[2], v0[3]}), c = pg8::gelu_pk((f32x2){v1[0], v1[1]}), d = pg8::gelu_pk((f32x2){v1[2], v1[3]});
                    s += (a.x * a.x + a.y * a.y) + (b.x * b.x + b.y * b.y) + (c.x * c.x + c.y * c.y) + (d.x * d.x + d.y * d.y);
                    u32x4 w; w.x = cvt_pk_bf16(a.x, a.y); w.y = cvt_pk_bf16(b.x, b.y); w.z = cvt_pk_bf16(c.x, c.y); w.w = cvt_pk_bf16(d.x, d.y);
                    *(u32x4*)(rowp + bj * 128) = w; }
                if (isv) { s += __shfl_xor(s, 16); s += __shfl_xor(s, 32); if (fq == 0) ssv[(size_t)row * 16 + (u.pn - 4) * 4 + wc] = s; } }
    }
};
struct EpiResid {
    static constexpr bool PERM = true;
    float* h; bf16_t* hb; float* ssn;
    __device__ __forceinline__ void operator()(const f32x4 (&acc)[2][2][4][2], const Unit& u, int wr, int wc, int fr, int fq) const {
        const int colt = u.pn * 256 + wc * 32 + 8 * fq;
#pragma unroll
        for (int ai = 0; ai < 2; ++ai)
#pragma unroll
            for (int m = 0; m < 4; ++m) { const int row = u.pm * 256 + ai * 128 + wr * 64 + m * 16 + fr; float s = 0.f;
                float* hp = h + (size_t)row * D + colt; bf16_t* bp = hb + (size_t)row * D + colt;
#pragma unroll
                for (int bj = 0; bj < 2; ++bj) { const f32x4 v0 = *(const f32x4*)(hp + bj * 128) + acc[ai][bj][m][0], v1 = *(const f32x4*)(hp + bj * 128 + 4) + acc[ai][bj][m][1];
                    *(f32x4*)(hp + bj * 128) = v0; *(f32x4*)(hp + bj * 128 + 4) = v1;
                    s += (v0[0] * v0[0] + v0[1] * v0[1]) + (v0[2] * v0[2] + v0[3] * v0[3]) + (v1[0] * v1[0] + v1[1] * v1[1]) + (v1[2] * v1[2] + v1[3] * v1[3]);
                    u32x4 w; w.x = cvt_pk_bf16(v0[0], v0[1]); w.y = cvt_pk_bf16(v0[2], v0[3]); w.z = cvt_pk_bf16(v1[0], v1[1]); w.w = cvt_pk_bf16(v1[2], v1[3]);
                    *(u32x4*)(bp + bj * 128) = w; }
                s += __shfl_xor(s, 16); s += __shfl_xor(s, 32); if (fq == 0) ssn[(size_t)row * 16 + u.pn * 4 + wc] = s; }
    }
};
struct EpiRkv {
    static constexpr bool PERM = true;
    bf16_t* R; bf16_t* WA; bf16_t* GL;
    __device__ __forceinline__ void operator()(const f32x4 (&acc)[2][2][4][2], const Unit& u, int wr, int wc, int fr, int fq) const {
        const int mode = u.pn < 12 ? 0 : (u.pn == 12 ? 1 : 2);
        bf16_t* base; int ldc, colt;
        if (mode == 0) { base = R + (size_t)(u.pn >> 2) * ((size_t)M * D); ldc = D; colt = (u.pn & 3) * 256 + wc * 32 + 8 * fq; }
        else if (mode == 1) { base = WA; ldc = 128; colt = wc * 32 + 8 * fq; }
        else { base = GL; ldc = 256; colt = wc * 32 + 8 * fq; }
#pragma unroll
        for (int ai = 0; ai < 2; ++ai)
#pragma unroll
            for (int m = 0; m < 4; ++m) { const int row = u.pm * 256 + ai * 128 + wr * 64 + m * 16 + fr;
                bf16_t* rowp = base + (size_t)row * ldc + colt;
#pragma unroll
                for (int bj = 0; bj < 2; ++bj) { f32x4 v0 = acc[ai][bj][m][0], v1 = acc[ai][bj][m][1];
                    if (mode == 1) { if (bj == 1) continue;
                        if (wc < 2) {
#pragma unroll
                            for (int e = 0; e < 4; ++e) { v0[e] = tanhf(v0[e]); v1[e] = tanhf(v1[e]); } } }
                    else if (mode == 2) {
#pragma unroll
                        for (int e = 0; e < 4; ++e) { v0[e] = sigmoidf_(v0[e]); v1[e] = sigmoidf_(v1[e]); } }
                    u32x4 w; w.x = cvt_pk_bf16(v0[0], v0[1]); w.y = cvt_pk_bf16(v0[2], v0[3]); w.z = cvt_pk_bf16(v1[0], v1[1]); w.w = cvt_pk_bf16(v1[2], v1[3]);
                    *(u32x4*)(rowp + bj * 128) = w; } }
    }
};

typedef const __attribute__((address_space(4))) Args* CA;
struct Ctx { LAS unsigned char* lds; int tid, lane, wave, G, bid; };

__device__ __forceinline__ void conv_mat(const Ctx& c, const float* src, int ldsrc, int K, int N, int Kp, int Np, bf16_t* dst, int ldd, int n_off, int k_off, const float* sc, int mode, int rot) {
    LAS float* tile = (LAS float*)c.lds;
    const int nnb = Np / 64, nit = (Kp / 64) * nnb; const int start = (c.bid + c.G - (rot % c.G)) % c.G;
    for (int it = start; it < nit; it += c.G) {
        const int kb = it / nnb, nb = it % nnb, k0 = kb * 64, n0 = nb * 64;
#pragma unroll
        for (int j = 0; j < 8; ++j) { const int kk = (c.tid >> 6) + 8 * j, nn = c.tid & 63, k = k0 + kk, n = n0 + nn; float v = 0.f;
            if (src && k < K && n < N) { v = src[(size_t)k * ldsrc + n]; if (mode == 1) v *= sc[k]; else if (mode == 2) v *= (1.f - sc[k]); }
            tile[nn * 65 + kk] = v; }
        __syncthreads();
        { const int nn = c.tid >> 3, cc = c.tid & 7; const LAS float* s = tile + nn * 65 + 8 * cc;
            u32x4 o; o.x = cvt_pk_bf16(s[0], s[1]); o.y = cvt_pk_bf16(s[2], s[3]); o.z = cvt_pk_bf16(s[4], s[5]); o.w = cvt_pk_bf16(s[6], s[7]);
            *(u32x4*)(dst + (size_t)(n_off + n0 + nn) * ldd + k_off + k0 + 8 * cc) = o; }
        __syncthreads();
    }
}

__device__ __forceinline__ void phase_prologue(const Ctx& c, CA a) {
    float* ss = (float*)(a->ws + WS_PA);
    const int gw = c.bid * 8 + c.wave, NGW = c.G * 8;
    bf16_t* hb = (bf16_t*)(a->ws + WS_A);
    for (int m = gw; m < M; m += NGW) {
        const f32x4* xr = (const f32x4*)(a->in[I_X] + (size_t)m * D) + c.lane; f32x4* hr = (f32x4*)(a->out + (size_t)m * D) + c.lane; u32x2* br = (u32x2*)(hb + (size_t)m * D) + c.lane;
        float s = 0.f;
#pragma unroll
        for (int j = 0; j < 4; ++j) { const f32x4 v = xr[64 * j]; s += (v.x * v.x + v.y * v.y) + (v.z * v.z + v.w * v.w); hr[64 * j] = v; u32x2 w; w.x = cvt_pk_bf16(v.x, v.y); w.y = cvt_pk_bf16(v.z, v.w); br[64 * j] = w; }
        s = wave_sum(s); if (c.lane < 16) ss[(size_t)m * 16 + c.lane] = c.lane == 0 ? s : 0.f;
    }
    int rot = 0;
    for (int j = 0; j < 2; ++j) {
        unsigned char* wj = a->ws + WS_WSTAT + (size_t)j * WJ_STRIDE;
        conv_mat(c, a->in[I_SWIN] + (size_t)j * D * 2048, 2048, D, 2048, D, 2048, (bf16_t*)(wj + WJ_IN), D, 0, 0, a->in[I_NMIX] + (size_t)(2 * j) * D, 1, rot); rot += 512;
        conv_mat(c, a->in[I_SWOUT] + (size_t)j * D * D, D, D, D, D, D, (bf16_t*)(wj + WJ_OUT), D, 0, 0, nullptr, 0, rot); rot += 256;
        const float* mu = a->in[I_MU] + (size_t)j * 6 * D; bf16_t* rkv = (bf16_t*)(wj + WJ_RKV);
#define CONV_BIG(IDX, Q, MUB) do { conv_mat(c, a->in[IDX] + (size_t)j * D * D, D, D, D, D, D, rkv, 2048, (Q) * 1024, 0, mu + (MUB) * D, 2, rot); rot += 256; \
            conv_mat(c, a->in[IDX] + (size_t)j * D * D, D, D, D, D, D, rkv, 2048, (Q) * 1024, 1024, mu + (MUB) * D, 1, rot); rot += 256; } while (0)
        CONV_BIG(I_WR, 0, 0); CONV_BIG(I_WK, 1, 2); CONV_BIG(I_WV, 2, 3);
#undef CONV_BIG
        conv_mat(c, a->in[I_W1] + (size_t)j * D * 64, 64, D, 64, D, 64, rkv, 2048, 3072, 0, mu + 1 * D, 2, rot); rot += 16;
        conv_mat(c, a->in[I_W1] + (size_t)j * D * 64, 64, D, 64, D, 64, rkv, 2048, 3072, 1024, mu + 1 * D, 1, rot); rot += 16;
        conv_mat(c, a->in[I_A1] + (size_t)j * D * 64, 64, D, 64, D, 64, rkv, 2048, 3136, 0, mu + 4 * D, 2, rot); rot += 16;
        conv_mat(c, a->in[I_A1] + (size_t)j * D * 64, 64, D, 64, D, 64, rkv, 2048, 3136, 1024, mu + 4 * D, 1, rot); rot += 16;
        conv_mat(c, nullptr, 0, 0, 0, 2048, 128, rkv, 2048, 3200, 0, nullptr, 0, rot); rot += 64;
        conv_mat(c, a->in[I_G1] + (size_t)j * D * 160, 160, D, 160, D, 256, rkv, 2048, 3328, 0, mu + 5 * D, 2, rot); rot += 64;
        conv_mat(c, a->in[I_G1] + (size_t)j * D * 160, 160, D, 160, D, 256, rkv, 2048, 3328, 1024, mu + 5 * D, 1, rot); rot += 64;
        bf16_t* l2wa = (bf16_t*)(wj + WJ_L2WA);
        conv_mat(c, a->in[I_W2] + (size_t)j * 64 * D, D, 64, D, 64, D, l2wa, 128, 0, 0, nullptr, 0, rot); rot += 16;
        conv_mat(c, nullptr, 0, 0, 0, 64, D, l2wa, 128, 0, 64, nullptr, 0, rot); rot += 16;
        conv_mat(c, nullptr, 0, 0, 0, 64, D, l2wa, 128, 1024, 0, nullptr, 0, rot); rot += 16;
        conv_mat(c, a->in[I_A2] + (size_t)j * 64 * D, D, 64, D, 64, D, l2wa, 128, 1024, 64, nullptr, 0, rot); rot += 16;
        conv_mat(c, a->in[I_G2] + (size_t)j * 160 * D, D, 160, D, 256, D, (bf16_t*)(wj + WJ_L2G), 256, 0, 0, nullptr, 0, rot); rot += 64;
        conv_mat(c, a->in[I_WO] + (size_t)j * D * D, D, D, D, D, D, (bf16_t*)(wj + WJ_O), D, 0, 0, nullptr, 0, rot); rot += 256;
    }
}
__device__ __forceinline__ void phase_ffn_weights(const Ctx& c, CA a, int layer) {
    conv_mat(c, a->in[I_FUP] + (size_t)layer * D * FF2, FF2, D, FF2, D, FF2, (bf16_t*)(a->ws + WS_WFFN), D, 0, 0, a->in[I_NFFN] + (size_t)layer * D, 1, 0);
    conv_mat(c, a->in[I_FDN] + (size_t)layer * FF * D, D, FF, D, FF, D, (bf16_t*)(a->ws + WS_WDOWN), FF, 0, 0, nullptr, 0, 128);
}

__device__ __forceinline__ void phase_sgu_spatial(const Ctx& c, CA a, int j, int rp) {
    typedef short bf16x8 __attribute__((ext_vector_type(8)));
    bf16_t* U = (bf16_t*)(a->ws + P_U); const bf16_t* V = (const bf16_t*)(a->ws + P_SV); bf16_t* UO = rp ? (bf16_t*)(a->ws + P_SV) : U;
    const float* ssv = (const float*)(a->ws + WS_PV);
    LAS bf16_t* WL = (LAS bf16_t*)c.lds; LAS bf16_t* VT = WL + 128 * 136;
    const int g = c.bid & 15;
    const float* Ws = a->in[I_SWS] + ((size_t)j * 16 + g) * 128 * 128; const float* bs = a->in[I_SBS] + ((size_t)j * 16 + g) * 128; const float* gv = a->in[I_SGV] + (size_t)j * D + g * 64;
    __syncthreads();
    { const int t = c.tid >> 2, s0 = (c.tid & 3) * 32; const float* wp = Ws + (size_t)t * 128 + s0;
#pragma unroll
      for (int q = 0; q < 4; ++q) { f32x4 x0 = *(const f32x4*)(wp + 8 * q), x1 = *(const f32x4*)(wp + 8 * q + 4);
#pragma unroll
          for (int e = 0; e < 4; ++e) { if (s0 + 8 * q + e > t) x0[e] = 0.f; if (s0 + 8 * q + 4 + e > t) x1[e] = 0.f; }
          u32x4 w; w.x = cvt_pk_bf16(x0[0], x0[1]); w.y = cvt_pk_bf16(x0[2], x0[3]); w.z = cvt_pk_bf16(x1[0], x1[1]); w.w = cvt_pk_bf16(x1[2], x1[3]);
          *(LAS u32x4*)(WL + t * 136 + s0 + 8 * q) = w; } }
    const int w8 = c.wave, fr = c.lane & 15, fq = c.lane >> 4, t0 = 16 * w8, nk = (w8 >> 1) + 1;
    const int vs = c.tid >> 2, vc = (c.tid & 3) * 16;
    f32x4 gq[4];
#pragma unroll
    for (int e = 0; e < 4; ++e) gq[e] = *(const f32x4*)(gv + vc + 4 * e);
    const float bb = bs[t0 + fr];
    for (int ub = c.bid >> 4; ub < M / 128; ub += c.G >> 4) {
        const int m0 = ub * 128;
        { const bf16_t* vp = V + (size_t)(m0 + vs) * D + g * 64 + vc; const u32x4 v0 = *(const u32x4*)vp, v1 = *(const u32x4*)(vp + 8);
          const float rs = row_rstd(ssv, m0 + vs);
          const unsigned vw[8] = {v0.x, v0.y, v0.z, v0.w, v1.x, v1.y, v1.z, v1.w};
#pragma unroll
          for (int e = 0; e < 8; ++e) { const float lo = bflo(vw[e]) * rs * gq[e >> 1][(2 * e) & 3], hi = bfhi(vw[e]) * rs * gq[e >> 1][(2 * e + 1) & 3];
              const unsigned pk = cvt_pk_bf16(lo, hi);
              VT[(vc + 2 * e) * 136 + vs] = (bf16_t)(pk & 0xffffu); VT[(vc + 2 * e + 1) * 136 + vs] = (bf16_t)(pk >> 16); } }
        __syncthreads();
        f32x4 acc[4];
#pragma unroll
        for (int ct = 0; ct < 4; ++ct) acc[ct] = (f32x4){0.f, 0.f, 0.f, 0.f};
        for (int k = 0; k < nk; ++k) {
            const bf16x8 wf = *(const LAS bf16x8*)(WL + (t0 + fr) * 136 + 32 * k + 8 * fq);
#pragma unroll
            for (int ct = 0; ct < 4; ++ct) { const bf16x8 vf = *(const LAS bf16x8*)(VT + (16 * ct + fr) * 136 + 32 * k + 8 * fq);
                acc[ct] = __builtin_amdgcn_mfma_f32_16x16x32_bf16(vf, wf, acc[ct], 0, 0, 0); }
        }
        { const size_t ro = (size_t)(m0 + t0 + fr) * D + g * 64 + 4 * fq;
#pragma unroll
          for (int ct = 0; ct < 4; ++ct) { const u32x2 uu = *(const u32x2*)(U + ro + 16 * ct); const f32x4 o = acc[ct] + bb;
              u32x2 w; w.x = cvt_pk_bf16(bflo(uu.x) * o[0], bfhi(uu.x) * o[1]); w.y = cvt_pk_bf16(bflo(uu.y) * o[2], bfhi(uu.y) * o[3]);
              *(u32x2*)(UO + ro + 16 * ct) = w; } }
        __syncthreads();
    }
}

__device__ __forceinline__ void phase_ffn_conv(const Ctx& c, CA a, int layer, int half) {
    const bf16_t* Z = (const bf16_t*)(a->ws + P_Z); bf16_t* ACT = (bf16_t*)(a->ws + P_ACT) + (size_t)half * (M / 2) * FF;
    const float* cw = a->in[I_FCW] + (size_t)layer * 3 * FF2; const float* cb = a->in[I_FCB] + (size_t)layer * FF2;
    const int gt = c.bid * 512 + c.tid, NT = c.G * 512;
    for (int idx = gt; idx < (M / 2) * (FF / 8); idx += NT) {
        const int ml = idx / (FF / 8), f = (idx % (FF / 8)) * 8, t = ml & (SEQ - 1);
        float gsum[8], vsum[8];
#pragma unroll
        for (int e = 0; e < 8; ++e) { gsum[e] = cb[f + e]; vsum[e] = cb[FF + f + e]; }
#pragma unroll
        for (int jj = 0; jj < 3; ++jj) { const int dt = 2 - jj; if (t - dt < 0) continue;
            const u32x4 zg = *(const u32x4*)(Z + (size_t)(ml - dt) * FF2 + f), zv = *(const u32x4*)(Z + (size_t)(ml - dt) * FF2 + FF + f);
            const float* wg = cw + (size_t)jj * FF2 + f; const float* wv = wg + FF;
            const unsigned zgw[4] = {zg.x, zg.y, zg.z, zg.w}, zvw[4] = {zv.x, zv.y, zv.z, zv.w};
#pragma unroll
            for (int e = 0; e < 4; ++e) { gsum[2 * e] += wg[2 * e] * bflo(zgw[e]); gsum[2 * e + 1] += wg[2 * e + 1] * bfhi(zgw[e]); vsum[2 * e] += wv[2 * e] * bflo(zvw[e]); vsum[2 * e + 1] += wv[2 * e + 1] * bfhi(zvw[e]); } }
        float o[8];
#pragma unroll
        for (int e = 0; e < 8; ++e) o[e] = gsum[e] * sigmoidf_(gsum[e]) * vsum[e];
        u32x4 w; w.x = cvt_pk_bf16(o[0], o[1]); w.y = cvt_pk_bf16(o[2], o[3]); w.z = cvt_pk_bf16(o[4], o[5]); w.w = cvt_pk_bf16(o[6], o[7]);
        *(u32x4*)(ACT + (size_t)ml * FF + f) = w;
    }
}

__device__ __forceinline__ void phase_rwkv_prep(const Ctx& c, CA a, int layer) {
    const float* ss = (const float*)(a->ws + WS_PA); const float* g = a->in[I_NMIX] + (size_t)layer * D;
    bf16_t* hn = (bf16_t*)(a->ws + WS_A);
    const int gw = c.bid * 8 + c.wave, NGW = c.G * 8;
    f32x4 gg[4];
#pragma unroll
    for (int j = 0; j < 4; ++j) gg[j] = *((const f32x4*)g + c.lane + 64 * j);
    for (int m = gw; m < M; m += NGW) {
        const float rs = row_rstd(ss, m);
        const f32x4* hr = (const f32x4*)(a->out + (size_t)m * D) + c.lane; const int prow = (m >> 12) * SEQP + PADR + (m & (SEQ - 1));
        u32x2* br = (u32x2*)(hn + (size_t)prow * D) + c.lane;
#pragma unroll
        for (int j = 0; j < 4; ++j) { const f32x4 v = hr[64 * j] * rs * gg[j]; u32x2 w; w.x = cvt_pk_bf16(v.x, v.y); w.y = cvt_pk_bf16(v.z, v.w); br[64 * j] = w; }
    }
    for (int r = gw; r < BATCH * PADR; r += NGW) { const int prow = (r / PADR) * SEQP + (r % PADR); u32x2* br = (u32x2*)(hn + (size_t)prow * D) + c.lane;
#pragma unroll
        for (int j = 0; j < 4; ++j) br[64 * j] = (u32x2){0u, 0u}; }
}

__device__ __forceinline__ void phase_scan(const Ctx& c, CA a, int j, int rp) {
    LAS float* Lw = (LAS float*)c.lds; LAS float* La = Lw + 2048; LAS float* Lb = La + 2048; LAS float* Lk = Lb + 2048; LAS float* Lr = Lk + 2048; LAS float* Lv = Lr + 2048; LAS float* Ly = Lv + 2048; LAS float* Lbon = Ly + 2048;
    bf16_t* R = (bf16_t*)(a->ws + P_R); bf16_t* RO = (bf16_t*)(a->ws + (rp ? P_LW : P_R)); const bf16_t* Kb = (const bf16_t*)(a->ws + P_K); const bf16_t* Vb = (const bf16_t*)(a->ws + P_V);
    const bf16_t* LWb = (const bf16_t*)(a->ws + P_LW); const bf16_t* LAb = (const bf16_t*)(a->ws + P_LA); const bf16_t* Gb = (const bf16_t*)(a->ws + WS_A);
    const int row = c.tid >> 3, q = c.tid & 7, st = c.tid >> 4, sc = (c.tid & 15) * 4;
    for (int unit = c.bid; unit < BATCH * 16; unit += c.G) {
        const int b = unit >> 4, hh = unit & 15, ch = hh * 64 + sc;
        const f32x4 w0 = *(const f32x4*)(a->in[I_W0] + (size_t)j * D + ch), a0 = *(const f32x4*)(a->in[I_A0] + (size_t)j * D + ch), kkp = *(const f32x4*)(a->in[I_KK] + (size_t)j * D + ch), kap = *(const f32x4*)(a->in[I_KA] + (size_t)j * D + ch),
                    rkp = *(const f32x4*)(a->in[I_RK] + (size_t)j * D + ch), lnw = *(const f32x4*)(a->in[I_LNW] + (size_t)j * D + ch), lnb = *(const f32x4*)(a->in[I_LNB] + (size_t)j * D + ch);
        f32x4 S0 = (f32x4){0.f, 0.f, 0.f, 0.f}, S1 = S0;
        for (int chunk = 0; chunk < SEQ / 32; ++chunk) {
            const size_t goff = ((size_t)b * SEQ + chunk * 32 + st) * D + ch;
            {
                const u32x2 r2 = *(const u32x2*)(R + goff), k2 = *(const u32x2*)(Kb + goff), v2 = *(const u32x2*)(Vb + goff), lw2 = *(const u32x2*)(LWb + goff), la2 = *(const u32x2*)(LAb + goff);
                const f32x4 r = {bflo(r2.x), bfhi(r2.x), bflo(r2.y), bfhi(r2.y)}, k = {bflo(k2.x), bfhi(k2.x), bflo(k2.y), bfhi(k2.y)}, v = {bflo(v2.x), bfhi(v2.x), bflo(v2.y), bfhi(v2.y)};
                const f32x4 lw = {bflo(lw2.x), bfhi(lw2.x), bflo(lw2.y), bfhi(lw2.y)}, la = {bflo(la2.x), bfhi(la2.x), bflo(la2.y), bfhi(la2.y)};
                f32x4 dec, av, kk, kp;
                float n2 = 0.f, bon = 0.f;
#pragma unroll
                for (int e = 0; e < 4; ++e) {
                    const float xw = -(w0[e] + lw[e]);
                    const float sp = xw > 20.f ? xw : log1pf(expf(xw));
                    dec[e] = expf(-expf(-sp - 0.5f));
                    av[e] = 1.f / (1.f + expf(-(a0[e] + la[e])));
                    kk[e] = k[e] * kkp[e]; n2 += kk[e] * kk[e];
                    kp[e] = k[e] * (1.f + (av[e] - 1.f) * kap[e]);
                    bon += r[e] * kp[e] * rkp[e];
                }
#pragma unroll
                for (int o = 1; o < 16; o <<= 1) { n2 += __shfl_xor(n2, o); bon += __shfl_xor(bon, o); }
                const float inv = rsqrtf(fmaxf(n2, 1e-24f));
                kk = kk * inv;
                const int lo = st * 64 + sc;
                *(LAS f32x4*)(Lw + lo) = dec; *(LAS f32x4*)(La + lo) = -kk; *(LAS f32x4*)(Lb + lo) = kk * av; *(LAS f32x4*)(Lk + lo) = kp; *(LAS f32x4*)(Lr + lo) = r; *(LAS f32x4*)(Lv + lo) = v;
                if ((c.tid & 15) == 0) Lbon[st] = bon;
            }
            __syncthreads();
            {
                const LAS f32x4* pa = (const LAS f32x4*)(La + 8 * q); const LAS f32x4* pw = (const LAS f32x4*)(Lw + 8 * q); const LAS f32x4* pb = (const LAS f32x4*)(Lb + 8 * q);
                const LAS f32x4* pk = (const LAS f32x4*)(Lk + 8 * q); const LAS f32x4* pr = (const LAS f32x4*)(Lr + 8 * q);
                f32x4 a0v = pa[0], a1v = pa[1], w0v = pw[0], w1v = pw[1], b0v = pb[0], b1v = pb[1], k0v = pk[0], k1v = pk[1], r0v = pr[0], r1v = pr[1];
                float vv = Lv[row];
#pragma unroll 2
                for (int t = 0; t < 32; ++t) {
                    const int tn = (t + 1) & 31;
                    const f32x4 na0 = pa[tn * 16], na1 = pa[tn * 16 + 1], nw0 = pw[tn * 16], nw1 = pw[tn * 16 + 1], nb0 = pb[tn * 16], nb1 = pb[tn * 16 + 1],
                                nk0 = pk[tn * 16], nk1 = pk[tn * 16 + 1], nr0 = pr[tn * 16], nr1 = pr[tn * 16 + 1];
                    const float nvv = Lv[tn * 64 + row];
                    const f32x4 p = S0 * a0v + S1 * a1v;
                    const float sa = sum8((p.x + p.y) + (p.z + p.w));
                    S0 = S0 * w0v + sa * b0v + vv * k0v; S1 = S1 * w1v + sa * b1v + vv * k1v;
                    const f32x4 yq = S0 * r0v + S1 * r1v;
                    const float y = sum8((yq.x + yq.y) + (yq.z + yq.w));
                    if (q == 0) Ly[t * 64 + row] = y;
                    a0v = na0; a1v = na1; w0v = nw0; w1v = nw1; b0v = nb0; b1v = nb1; k0v = nk0; k1v = nk1; r0v = nr0; r1v = nr1; vv = nvv;
                }
            }
            __syncthreads();
            {
                const int lo = st * 64 + sc;
                const f32x4 y = *(const LAS f32x4*)(Ly + lo), v = *(const LAS f32x4*)(Lv + lo); const float bon = Lbon[st];
                float s1 = (y.x + y.y) + (y.z + y.w);
#pragma unroll
                for (int o = 1; o < 16; o <<= 1) s1 += __shfl_xor(s1, o);
                const float mean = s1 * (1.f / 64.f); const f32x4 dlt = y - mean;
                float s2 = (dlt.x * dlt.x + dlt.y * dlt.y) + (dlt.z * dlt.z + dlt.w * dlt.w);
#pragma unroll
                for (int o = 1; o < 16; o <<= 1) s2 += __shfl_xor(s2, o);
                const float rstd = rsqrtf(s2 * (1.f / 64.f) + GN_EPS);
                const u32x2 g2 = *(const u32x2*)(Gb + goff);
                const f32x4 g = {bflo(g2.x), bfhi(g2.x), bflo(g2.y), bfhi(g2.y)};
                const f32x4 o = (dlt * rstd * lnw + lnb + bon * v) * g;
                u32x2 w; w.x = cvt_pk_bf16(o.x, o.y); w.y = cvt_pk_bf16(o.z, o.w);
                *(u32x2*)(RO + goff) = w;
            }
            __syncthreads();
        }
    }
}

__device__ __forceinline__ void phase_final(const Ctx& c, CA a) {
    const float* ss = (const float*)(a->ws + WS_PA); const float* g = a->in[I_NFIN];
    const int gw = c.bid * 8 + c.wave, NGW = c.G * 8;
    f32x4 gg[4];
#pragma unroll
    for (int j = 0; j < 4; ++j) gg[j] = *((const f32x4*)g + c.lane + 64 * j);
    for (int m = gw; m < M; m += NGW) {
        const float rs = row_rstd(ss, m);
        f32x4* hr = (f32x4*)(a->out + (size_t)m * D) + c.lane;
#pragma unroll
        for (int j = 0; j < 4; ++j) hr[64 * j] = hr[64 * j] * rs * gg[j];
    }
}

constexpr int SLOTS = 11, NPH = 2 + 4 * SLOTS;
__host__ __device__ inline bool phase_active(int p) {
    if (p == 0 || p == NPH - 1) return true;
    const int i = (p - 1) / SLOTS, s = (p - 1) % SLOTS;
    if (s >= 5) return true;
    return (i & 1) ? true : (s < 3);
}

__global__ void __launch_bounds__(512, 2) mk_fwd(Args a_) {
    extern __shared__ __attribute__((aligned(16))) unsigned char lds_raw[];
    int tid_ = threadIdx.x, bid_ = blockIdx.x, G_ = gridDim.x;
    CA a = (CA)__builtin_amdgcn_kernarg_segment_ptr();
    const int ph_lo = a_.ph_lo, ph_hi = a_.ph_hi;
    for (int p = ph_lo; p < ph_hi; ++p) {
        if (!phase_active(p)) continue;
        const int PL = (p - 1) / SLOTS, PS = (p - 1) % SLOTS; (void)PL; (void)PS;
        const int nrep = (MK_PROBE && p > 0 && p < NPH - 1 && (MK_PROBE_SEL)) ? 2 : 1;
        for (int rp = 0; rp < nrep; ++rp) {
        if (rp) cg::this_grid().sync();
        asm volatile("" : "+s"(a), "+s"(bid_), "+s"(G_)); asm volatile("" : "+v"(tid_));
        Ctx c; c.lds = (LAS unsigned char*)lds_raw; c.tid = tid_; c.lane = c.tid & 63; c.wave = __builtin_amdgcn_readfirstlane(c.tid >> 6); c.G = G_; c.bid = bid_;
        bf16_t* regA = (bf16_t*)(a->ws + WS_A);
        if (p == 0) phase_prologue(c, a);
        else if (p == NPH - 1) phase_final(c, a);
        else {
            const int layer = (p - 1) / SLOTS, s = (p - 1) % SLOTS, j = layer >> 1;
            unsigned char* wj = a->ws + WS_WSTAT + (size_t)j * WJ_STRIDE;
            float* ss_mix = (float*)(a->ws + WS_PA); float* ss_ffn = (float*)(a->ws + WS_PB); float* ss_next = ss_mix;
            if (s < 5 && !(layer & 1)) {
                if (s == 0) {
                    pg8::Gemm g{regA, (const bf16_t*)(wj + WJ_IN), M, 2048, D, D}; pg8::StaticOrder S; S.init(M / 256, 2048, c.G, c.bid);
                    EpiSguIn E{(bf16_t*)(a->ws + P_U), (bf16_t*)(a->ws + P_SV), ss_mix, a->in[I_SBIN] + (size_t)j * 2048, (float*)(a->ws + WS_PV)};
                    pg8::gemm_phase<EpiSguIn, pg8::StaticOrder, 0, false, true>(c.lds, c.tid, g, S, E);
                } else if (s == 1) phase_sgu_spatial(c, a, j, rp);
                else {
                    pg8::Gemm g{(const bf16_t*)(a->ws + P_U), (const bf16_t*)(wj + WJ_OUT), M, D, D, D}; pg8::StaticOrder S; S.init(M / 256, D, c.G, c.bid);
                    EpiResid E{a->out, regA, ss_ffn};
                    pg8::gemm_phase<EpiResid, pg8::StaticOrder, 0, false, true>(c.lds, c.tid, g, S, E);
                }
            } else if (s < 5) {
                if (s == 0) phase_rwkv_prep(c, a, layer);
                else if (s == 1) {
                    pg8::Gemm g{regA, (const bf16_t*)(wj + WJ_RKV), M, 3584, 2048, D}; pg8::StaticOrder S; S.init(M / 256, 3584, c.G, c.bid);
                    EpiRkv E{(bf16_t*)(a->ws + P_R), (bf16_t*)(a->ws + P_WA), (bf16_t*)(a->ws + P_GL)};
                    pg8::gemm_phase<EpiRkv, pg8::StaticOrder, 1, true, true>(c.lds, c.tid, g, S, E);
                } else if (s == 2) {
                    { int kq = 128; asm volatile("" : "+s"(kq)); pg8::Gemm g{(const bf16_t*)(a->ws + P_WA), (const bf16_t*)(wj + WJ_L2WA), M, 2048, kq, kq}; pg8::StaticOrder S; S.init(M / 256, 2048, c.G, c.bid);
                      EpiStore<false> E{(bf16_t*)(a->ws + P_LW), D, 2, (size_t)M * D, nullptr};
                      pg8::gemm_phase<EpiStore<false>, pg8::StaticOrder, 0, false, true>(c.lds, c.tid, g, S, E); }
                    asm volatile("" : "+s"(a), "+s"(c.bid), "+s"(c.G), "+s"(wj)); asm volatile("" : "+v"(c.tid));
                    { int kq = 256; asm volatile("" : "+s"(kq)); pg8::Gemm g{(const bf16_t*)(a->ws + P_GL), (const bf16_t*)(wj + WJ_L2G), M, D, kq, kq}; pg8::StaticOrder S; S.init(M / 256, D, c.G, c.bid);
                      EpiStore<false> E{regA, D, 2, 0, nullptr};
                      pg8::gemm_phase<EpiStore<false>, pg8::StaticOrder, 0, false, true>(c.lds, c.tid, g, S, E); }
                } else if (s == 3) phase_scan(c, a, j, rp);
                else {
                    pg8::Gemm g{(const bf16_t*)(a->ws + P_R), (const bf16_t*)(wj + WJ_O), M, D, D, D}; pg8::StaticOrder S; S.init(M / 256, D, c.G, c.bid);
                    EpiResid E{a->out, regA, ss_ffn};
                    pg8::gemm_phase<EpiResid, pg8::StaticOrder, 0, false, true>(c.lds, c.tid, g, S, E);
                }
            } else if (s == 5) phase_ffn_weights(c, a, layer);
            else if (s == 6 || s == 8) {
                const int half = (s - 6) >> 1;
                pg8::Gemm g{regA + (size_t)half * (M / 2) * D, (const bf16_t*)(a->ws + WS_WFFN), M / 2, FF2, D, D}; pg8::StaticOrder S; S.init(M / 512, FF2, c.G, c.bid);
                EpiStore<true> E{(bf16_t*)(a->ws + P_Z), FF2, 8, 0, ss_ffn + (size_t)half * (M / 2) * 16};
                pg8::gemm_phase<EpiStore<true>, pg8::StaticOrder, 0, false, true>(c.lds, c.tid, g, S, E);
            } else if (s == 7 || s == 9) phase_ffn_conv(c, a, layer, (s - 7) >> 1);
            else {
                pg8::Gemm g{(const bf16_t*)(a->ws + P_ACT), (const bf16_t*)(a->ws + WS_WDOWN), M, D, FF, FF}; pg8::StaticOrder S; S.init(M / 256, D, c.G, c.bid);
                EpiResid E{a->out, regA, ss_next};
                pg8::gemm_phase<EpiResid, pg8::StaticOrder, 0, false, true>(c.lds, c.tid, g, S, E);
            }
        }
        }
        if (p + 1 < ph_hi) cg::this_grid().sync();
    }
}

constexpr int LDS_BYTES = 147456;
#ifndef MK_ONE_LAUNCH
#define MK_ONE_LAUNCH 1
#endif
extern "C" void kernel_launch(void* const* d_in, const int* in_sizes, int n_in, void* d_out, int out_size, void* d_ws, size_t ws_size, hipStream_t stream) {
    static int grid = 0;
    if (grid == 0) {
        if (n_in != 32 || out_size != M * D || ws_size < WS_END) { fprintf(stderr, "kernel_launch: unexpected shapes (n_in %d out %d ws %zu, need %zu)\n", n_in, out_size, ws_size, (size_t)WS_END); grid = -1; return; }
        int dev = 0, cus = 0, per_cu = 0;
        (void)hipGetDevice(&dev); (void)hipDeviceGetAttribute(&cus, hipDeviceAttributeMultiprocessorCount, dev);
        if (hipFuncSetAttribute((const void*)mk_fwd, hipFuncAttributeMaxDynamicSharedMemorySize, LDS_BYTES) != hipSuccess) { fprintf(stderr, "kernel_launch: hipFuncSetAttribute failed\n"); grid = -1; return; }
        (void)hipOccupancyMaxActiveBlocksPerMultiprocessor(&per_cu, (const void*)mk_fwd, 512, LDS_BYTES);
        if (per_cu < 1) per_cu = 1;
        grid = cus * 1;
        (void)hipGetLastError();
    }
    if (grid < 0) return;
    Args a{};
    for (int i = 0; i < 32; ++i) a.in[i] = (const float*)d_in[i];
    a.out = (float*)d_out; a.ws = (unsigned char*)d_ws;
#if MK_ONE_LAUNCH
    a.ph_lo = 0; a.ph_hi = NPH;
    void* args[] = {&a};
    hipError_t e = hipLaunchCooperativeKernel((const void*)mk_fwd, dim3(grid), dim3(512), args, LDS_BYTES, stream);
    if (e != hipSuccess) fprintf(stderr, "cooperative launch failed: %s (grid %d)\n", hipGetErrorString(e), grid);
#else
    for (int p = 0; p < NPH; ++p) { if (!phase_active(p)) continue; a.ph_lo = p; a.ph_hi = p + 1; hipLaunchKernelGGL(mk_fwd, dim3(grid), dim3(512), LDS_BYTES, stream, a); }
#endif
}
```

```cpp
#include <hip/hip_runtime.h>
#include <hip/hip_cooperative_groups.h>
#include <cstdio>
#include <cstdint>
#include <cmath>
namespace cg = cooperative_groups;
#ifndef MK_PROBE
#define MK_PROBE 0
#endif
#ifndef MK_PROBE_SEL
#define MK_PROBE_SEL 0
#endif
namespace pg8 {
#define PG8_LAS __attribute__((address_space(3)))
typedef unsigned short bf16_t;
typedef short bf16x8 __attribute__((ext_vector_type(8)));
typedef float f32x4 __attribute__((ext_vector_type(4)));
typedef float f32x2 __attribute__((ext_vector_type(2)));
typedef unsigned u32x4 __attribute__((ext_vector_type(4)));
typedef unsigned u32x2 __attribute__((ext_vector_type(2)));
constexpr int BM = 256, BK = 64, HALF = 128, HTB = HALF * BK * 2  , STAGE_BYTES = 8 * HTB, NXCD = 8, WGM = 8;

__host__ __device__ __forceinline__ int lds_byte(int r, int c) { const int st = (r >> 4) * 2 + (c >> 5), rr = r & 15, cc = c & 31, ob = rr * 64 + cc * 2; return st * 1024 + (ob ^ (((ob >> 9) & 1) << 5)); }
__host__ __device__ __forceinline__ void stage_rc(int b, int& R, int& C) { const int st = b / 1024, sb = b % 1024, swz = sb ^ (((sb >> 9) & 1) << 5); R = (st >> 1) * 16 + swz / 64; C = (st & 1) * 32 + (swz % 64) / 2; }
__host__ __device__ __forceinline__ int perm32(int rho) { const int n = rho >> 4, i = rho & 15; return 8 * (i >> 2) + 4 * n + (i & 3); }

struct Unit { int pm, pn; };
struct Gemm { const bf16_t* A; const bf16_t* Bt; int M, N, K, lda; };

struct StaticOrder {
    int nM, nN, nwg, G, c;
    __host__ __device__ void init(int nM_, int N, int G_, int c_) { nM = nM_; nN = N / BM; nwg = nM * nN; G = G_; c = c_; }
    __host__ __device__ bool next(int i, Unit& u) const {
        const long L = (long)i * G + c; if (L >= nwg) return false;
        int wgid = (int)L; { const int q = nwg / NXCD, r = nwg % NXCD, xcd = wgid % NXCD, off = wgid / NXCD; wgid = (xcd < r ? xcd * (q + 1) : r * (q + 1) + (xcd - r) * q) + off; }
        const int nig = WGM * nN, gid = wgid / nig, fm = gid * WGM, gsz = (nM - fm) < WGM ? (nM - fm) : WGM;
        u.pm = fm + ((wgid % nig) % gsz); u.pn = (wgid % nig) / gsz; return true;
    }
};

__device__ __forceinline__ unsigned cvt_pk_bf16(float lo, float hi) { unsigned r; asm volatile("v_cvt_pk_bf16_f32 %0, %1, %2" : "=v"(r) : "v"(lo), "v"(hi)); return r; }
__device__ __forceinline__ f32x2 gelu_pk(f32x2 v) {
    const f32x2 av = __builtin_elementwise_abs(v), d = av * 0.2316418882f + 1.0f;
    f32x2 t; t.x = __builtin_amdgcn_rcpf(d.x); t.y = __builtin_amdgcn_rcpf(d.y);
    f32x2 q = t * 0.5307027145f + (-0.7265760135f); q = q * t + 0.7107068705f; q = q * t + (-0.142248368f); q = q * t + 0.127414796f; q = q * t;
    const f32x2 s = (v * v) * (-0.72134752044f);
    f32x2 e; e.x = __builtin_amdgcn_exp2f(s.x); e.y = __builtin_amdgcn_exp2f(s.y);
    const f32x2 m = v * (q * e), r = v - m;
    f32x2 o; o.x = v.x < 0.f ? m.x : r.x; o.y = v.y < 0.f ? m.y : r.y; return o;
}

template <class Epi, class Sched, int AMAP, bool KDBL, bool ALIGN_EPI>
__device__ __forceinline__ void gemm_phase(PG8_LAS unsigned char* lds, const int tid, const Gemm g, const Sched& S, const Epi& E) {
    const int wid = __builtin_amdgcn_readfirstlane(tid >> 6), lane = tid & 63, wr = wid >> 2, wc = wid & 3, fr = lane & 15, fq = lane >> 4;
    const int K = g.K, nt = K / BK, lda = g.lda;
    unsigned voffA[2], voffB[2];
#pragma unroll
    for (int i = 0; i < 2; ++i) { int R, C; stage_rc(tid * 16 + i * 8192, R, C); const int Rb = Epi::PERM ? ((R & ~31) + perm32(R & 31)) : R;
        const int Ra = (AMAP == 2) ? (R - 2 * (R >> 6)) : R;
        voffA[i] = (unsigned)(Ra * lda + C) * 2u; voffB[i] = (unsigned)(Rb * K + C) * 2u; }
    const size_t kstep = (size_t)(BK * 2);
    const size_t hstepA = (size_t)((AMAP == 2) ? 124 : HALF) * lda * 2;
    const size_t hstepB = (size_t)HALF * K * 2;
    const size_t tstepB = 2 * hstepB;
    const size_t rowA = (size_t)lda * 2;
    const unsigned ldsw = (unsigned)wid * 1024u;
    const int aoff = lds_byte(wr * 64 + fr, fq * 8), boff = lds_byte(wc * 32 + fr, fq * 8);
#define PG8_ABASE(pm) ((const char*)g.A + (AMAP == 1 ? (size_t)(((pm) >> 4) * 4104 + 8 + ((pm) & 15) * 256) * rowA : (AMAP == 2 ? (size_t)(pm) * 248 * rowA : (size_t)(pm) * 256 * rowA)))
#define PG8_KA(base, t) (KDBL ? ((base) + (size_t)((t) & 15) * kstep - (size_t)((t) >> 4) * rowA) : ((base) + (size_t)(t) * kstep))
#define PG8_SA(b, h) (((b) * 2 + (h)) * HTB)
#define PG8_SB(b, h) ((4 + (b) * 2 + (h)) * HTB)
#define PG8_STAGE(bufoff, gbase, voff) do { _Pragma("unroll") for (int _i = 0; _i < 2; ++_i) \
        __builtin_amdgcn_global_load_lds((const unsigned*)((const char*)(gbase) + (voff)[_i]), (PG8_LAS unsigned*)(lds + (bufoff) + ldsw + _i * 8192), 16, 0, 0); } while (0)
#define PG8_LDA(dst, b, h) do { _Pragma("unroll") for (int m = 0; m < 4; ++m) _Pragma("unroll") for (int k = 0; k < 2; ++k) dst[m][k] = *(const PG8_LAS bf16x8*)(lds + PG8_SA(b, h) + aoff + m * 2048 + k * 1024); } while (0)
#define PG8_LDB(dst, b, h) do { _Pragma("unroll") for (int n = 0; n < 2; ++n) _Pragma("unroll") for (int k = 0; k < 2; ++k) dst[n][k] = *(const PG8_LAS bf16x8*)(lds + PG8_SB(b, h) + boff + n * 2048 + k * 1024); } while (0)
#define PG8_MMA(ai, bj, At, Bt) do { __builtin_amdgcn_s_setprio(1); _Pragma("unroll") for (int m = 0; m < 4; ++m) _Pragma("unroll") for (int n = 0; n < 2; ++n) _Pragma("unroll") for (int k = 0; k < 2; ++k) \
        acc[ai][bj][m][n] = __builtin_amdgcn_mfma_f32_16x16x32_bf16(Bt[n][k], At[m][k], acc[ai][bj][m][n], 0, 0, 0); __builtin_amdgcn_s_setprio(0); } while (0)
#define PG8_WAIT_V(n) asm volatile("s_waitcnt vmcnt(" #n ")" ::: "memory")
#define PG8_WAIT_L(n) asm volatile("s_waitcnt lgkmcnt(" #n ")" ::: "memory")
#define PG8_BAR __builtin_amdgcn_s_barrier()
#define PG8_SCHED __builtin_amdgcn_sched_barrier(0)
    Unit cur, nxt; int ui = 0;
    if (!S.next(0, cur)) return;
    f32x4 acc[2][2][4][2];
#pragma unroll
    for (int a = 0; a < 2; ++a)
#pragma unroll
        for (int b = 0; b < 2; ++b)
#pragma unroll
            for (int m = 0; m < 4; ++m)
#pragma unroll
                for (int n = 0; n < 2; ++n) acc[a][b][m][n] = (f32x4){0.f, 0.f, 0.f, 0.f};
    bf16x8 At[4][2], B0[2][2], B1[2][2];
    const char* cA = PG8_ABASE(cur.pm); const char* cB = (const char*)g.Bt + (size_t)cur.pn * tstepB;
    {
        const char* cA1 = PG8_KA(cA, 1);
        PG8_STAGE(PG8_SB(0, 0), cB, voffB); PG8_STAGE(PG8_SB(0, 1), cB + hstepB, voffB); PG8_STAGE(PG8_SA(0, 0), cA, voffA); PG8_STAGE(PG8_SA(0, 1), cA + hstepA, voffA);
        if (wr == 1) PG8_BAR;
        PG8_WAIT_V(2); PG8_BAR;
        PG8_STAGE(PG8_SB(1, 0), cB + kstep, voffB); PG8_STAGE(PG8_SA(1, 0), cA1, voffA); PG8_STAGE(PG8_SB(1, 1), cB + hstepB + kstep, voffB);
        PG8_WAIT_V(6); PG8_BAR;
    }
    for (;;) {
        const bool has_next = S.next(ui + 1, nxt);
        const char* nA = has_next ? PG8_ABASE(nxt.pm) : cA; const char* nB = has_next ? (const char*)g.Bt + (size_t)nxt.pn * tstepB : cB;
        for (int t = 0; t < nt; t += 2) {
            const bool last = (t == nt - 2);
            const char* a1 = PG8_KA(cA, t + 1);
            const char* a2 = last ? nA : PG8_KA(cA, t + 2); const char* b2 = last ? nB : cB + (size_t)(t + 2) * kstep;
            const char* a3 = last ? PG8_KA(nA, 1) : PG8_KA(cA, t + 3); const char* b3 = b2 + kstep;
            PG8_LDB(B0, 0, 0); PG8_LDB(B1, 0, 1); PG8_SCHED; PG8_LDA(At, 0, 0); PG8_STAGE(PG8_SA(1, 1), a1 + hstepA, voffA);
            PG8_WAIT_V(8); PG8_WAIT_L(0); PG8_BAR; PG8_MMA(0, 0, At, B0); PG8_MMA(0, 1, At, B1); PG8_BAR; PG8_SCHED;
            PG8_LDA(At, 0, 1); PG8_STAGE(PG8_SB(0, 0), b2, voffB); PG8_STAGE(PG8_SB(0, 1), b2 + hstepB, voffB); PG8_STAGE(PG8_SA(0, 0), a2, voffA);
            PG8_WAIT_V(8); PG8_WAIT_L(0); PG8_BAR; PG8_MMA(1, 0, At, B0); PG8_MMA(1, 1, At, B1); PG8_BAR; PG8_SCHED;
            PG8_LDB(B0, 1, 0); PG8_LDB(B1, 1, 1); PG8_SCHED; PG8_LDA(At, 1, 0); PG8_STAGE(PG8_SA(0, 1), a2 + hstepA, voffA);
            PG8_WAIT_V(8); PG8_WAIT_L(0); PG8_BAR; PG8_MMA(0, 0, At, B0); PG8_MMA(0, 1, At, B1); PG8_BAR; PG8_SCHED;
            PG8_LDA(At, 1, 1); PG8_STAGE(PG8_SB(1, 0), b3, voffB); PG8_STAGE(PG8_SB(1, 1), b3 + hstepB, voffB); PG8_STAGE(PG8_SA(1, 0), a3, voffA);
            PG8_WAIT_V(8); PG8_WAIT_L(0); PG8_BAR; PG8_MMA(1, 0, At, B0); PG8_MMA(1, 1, At, B1); PG8_BAR; PG8_SCHED;
        }
        if constexpr (ALIGN_EPI) { if (wr == 0) PG8_BAR; }
        E(acc, cur, wr, wc, fr, fq);
        if (!has_next) break;
#pragma unroll
        for (int a = 0; a < 2; ++a)
#pragma unroll
            for (int b = 0; b < 2; ++b)
#pragma unroll
                for (int m = 0; m < 4; ++m)
#pragma unroll
                    for (int n = 0; n < 2; ++n) acc[a][b][m][n] = (f32x4){0.f, 0.f, 0.f, 0.f};
        cur = nxt; cA = nA; cB = nB; ++ui;
        if constexpr (ALIGN_EPI) { if (wr == 1) PG8_BAR; }
    }
    PG8_WAIT_V(0);
    if constexpr (!ALIGN_EPI) { if (wr == 0) PG8_BAR; }
    PG8_BAR;
#undef PG8_ABASE
#undef PG8_KA
#undef PG8_SA
#undef PG8_SB
#undef PG8_STAGE
#undef PG8_LDA
#undef PG8_LDB
#undef PG8_MMA
#undef PG8_WAIT_V
#undef PG8_WAIT_L
#undef PG8_BAR
#undef PG8_SCHED
}
}
using pg8::bf16_t; using pg8::f32x4; using pg8::f32x2; using pg8::u32x4; using pg8::u32x2; using pg8::Unit; using pg8::cvt_pk_bf16;
#define LAS __attribute__((address_space(3)))
constexpr int BATCH = 8, SEQ = 4096, D = 1024, M = BATCH * SEQ, FF = 2816, FF2 = 5632;
constexpr int PADR = 8, SEQP = SEQ + PADR;
constexpr float RMS_EPS = 1e-6f, GN_EPS = 64e-5f;
constexpr size_t MiB = 1u << 20;
constexpr size_t WS_WSTAT = 2 * MiB;
constexpr size_t WJ_IN = 0, WJ_OUT = 4 * MiB, WJ_RKV = 6 * MiB, WJ_L2WA = 20 * MiB, WJ_L2G = 20 * MiB + 512 * 1024, WJ_O = 21 * MiB, WJ_STRIDE = 23 * MiB;
constexpr size_t WS_WFFN = 48 * MiB;
constexpr size_t WS_WDOWN = WS_WFFN + 11 * MiB;
constexpr size_t WS_A = 67 * MiB;
constexpr size_t WS_P = 134 * MiB;
constexpr size_t P_R = WS_P, P_K = WS_P + 64 * MiB, P_V = WS_P + 128 * MiB, P_LW = WS_P + 192 * MiB, P_LA = WS_P + 256 * MiB, P_WA = WS_P + 320 * MiB, P_GL = WS_P + 328 * MiB;
constexpr size_t P_U = WS_P, P_SV = WS_P + 64 * MiB;
constexpr size_t P_Z = WS_P, P_ACT = WS_P + 176 * MiB;
constexpr size_t WS_PA = WS_P + 352 * MiB, WS_PB = WS_PA + 2 * MiB, WS_PV = WS_PB + 2 * MiB;
constexpr size_t WS_END = WS_PV + 2 * MiB;

struct Args {
    const float* in[32]; float* out; unsigned char* ws; int ph_lo, ph_hi;
};
enum { I_X = 0, I_NMIX, I_NFFN, I_NFIN, I_SWIN, I_SBIN, I_SGV, I_SWS, I_SBS, I_SWOUT, I_MU, I_WR, I_WK, I_WV, I_WO, I_W0, I_W1, I_W2, I_A0, I_A1, I_A2, I_G1, I_G2, I_KK, I_KA, I_RK, I_LNW, I_LNB, I_FUP, I_FCW, I_FCB, I_FDN };

__device__ __forceinline__ float bf2f(unsigned short b) { return __uint_as_float((unsigned)b << 16); }
__device__ __forceinline__ float bflo(unsigned w) { return __uint_as_float(w << 16); }
__device__ __forceinline__ float bfhi(unsigned w) { return __uint_as_float(w & 0xffff0000u); }
__device__ __forceinline__ float wave_sum(float v) {
#pragma unroll
    for (int o = 1; o < 64; o <<= 1) v += __shfl_xor(v, o);
    return v;
}
__device__ __forceinline__ float row_rstd(const float* P, int row) { const f32x4* p = (const f32x4*)(P + (size_t)row * 16); const f32x4 a = p[0], b = p[1], c = p[2], d = p[3];
    const float s = ((a.x + a.y) + (a.z + a.w)) + ((b.x + b.y) + (b.z + b.w)) + ((c.x + c.y) + (c.z + c.w)) + ((d.x + d.y) + (d.z + d.w)); return rsqrtf(s * (1.f / D) + RMS_EPS); }
template <int CTRL> __device__ __forceinline__ float dpp_f(float v) { return __int_as_float(__builtin_amdgcn_mov_dpp(__float_as_int(v), CTRL, 0xf, 0xf, true)); }
__device__ __forceinline__ float sum8(float v) { v += dpp_f<0x141>(v); v += dpp_f<0xB1>(v); v += dpp_f<0x4E>(v); return v; }
__device__ __forceinline__ float sigmoidf_(float x) { return 1.f / (1.f + __expf(-x)); }

template <bool SCALE> struct EpiStore {
    static constexpr bool PERM = true;
    bf16_t* O; int ldc; int tsh; size_t split_stride; const float* ss;
    __device__ __forceinline__ void operator()(const f32x4 (&acc)[2][2][4][2], const Unit& u, int wr, int wc, int fr, int fq) const {
        bf16_t* base = O + (size_t)(u.pn >> tsh) * split_stride + (size_t)(u.pm * 256 + wr * 64 + fr) * ldc + (u.pn & ((1 << tsh) - 1)) * 256 + wc * 32 + 8 * fq;
        const int row0 = u.pm * 256 + wr * 64 + fr;
#pragma unroll
        for (int ai = 0; ai < 2; ++ai)
#pragma unroll
            for (int m = 0; m < 4; ++m) {
                const float rs = SCALE ? row_rstd(ss, row0 + ai * 128 + m * 16) : 1.f;
                bf16_t* rowp = base + (size_t)(ai * 128 + m * 16) * ldc;
#pragma unroll
                for (int bj = 0; bj < 2; ++bj) { const f32x4 v0 = acc[ai][bj][m][0] * rs, v1 = acc[ai][bj][m][1] * rs;
                    u32x4 w; w.x = cvt_pk_bf16(v0[0], v0[1]); w.y = cvt_pk_bf16(v0[2], v0[3]); w.z = cvt_pk_bf16(v1[0], v1[1]); w.w = cvt_pk_bf16(v1[2], v1[3]);
                    *(u32x4*)(rowp + bj * 128) = w; } }
    }
};
struct EpiSguIn {
    static constexpr bool PERM = true;
    bf16_t* U; bf16_t* V; const float* ss; const float* bias; float* ssv;
    __device__ __forceinline__ void operator()(const f32x4 (&acc)[2][2][4][2], const Unit& u, int wr, int wc, int fr, int fq) const {
        const bool isv = u.pn >= 4; bf16_t* base = isv ? V : U; const int colt = (u.pn & 3) * 256 + wc * 32 + 8 * fq, bcol = u.pn * 256 + wc * 32 + 8 * fq;
        f32x4 bv[2][2];
#pragma unroll
        for (int bj = 0; bj < 2; ++bj)
#pragma unroll
            for (int n = 0; n < 2; ++n) bv[bj][n] = *(const f32x4*)(bias + bcol + bj * 128 + 4 * n);
#pragma unroll
        for (int ai = 0; ai < 2; ++ai)
#pragma unroll
            for (int m = 0; m < 4; ++m) { const int row = u.pm * 256 + ai * 128 + wr * 64 + m * 16 + fr;
                const float rs = row_rstd(ss, row); float s = 0.f;
                bf16_t* rowp = base + (size_t)row * D + colt;
#pragma unroll
                for (int bj = 0; bj < 2; ++bj) { f32x4 v0 = acc[ai][bj][m][0] * rs + bv[bj][0], v1 = acc[ai][bj][m][1] * rs + bv[bj][1];
                    const f32x2 a = pg8::gelu_pk((f32x2){v0[0], v0[1]}), b = pg8::gelu_pk((f32x2){v0[2], v0[3]}), c = pg8::gelu_pk((f32x2){v1[0], v1[1]}), d = pg8::gelu_pk((f32x2){v1[2], v1[3]});
                    s += (a.x * a.x + a.y * a.y) + (b.x * b.x + b.y * b.y) + (c.x * c.x + c.y * c.y) + (d.x * d.x + d.y * d.y);
                    u32x4 w; w.x = cvt_pk_bf16(a.x, a.y); w.y = cvt_pk_bf16(b.x, b.y); w.z = cvt_pk_bf16(c.x, c.y); w.w = cvt_pk_bf16(d.x, d.y);
                    *(u32x4*)(rowp + bj * 128) = w; }
                if (isv) { s += __shfl_xor(s, 16); s += __shfl_xor(s, 32); if (fq == 0) ssv[(size_t)row * 16 + (u.pn - 4) * 4 + wc] = s; } }
    }
};
struct EpiResid {
    static constexpr bool PERM = true;
    float* h; bf16_t* hb; float* ssn;
    __device__ __forceinline__ void operator()(const f32x4 (&acc)[2][2][4][2], const Unit& u, int wr, int wc, int fr, int fq) const {
        const int colt = u.pn * 256 + wc * 32 + 8 * fq;
#pragma unroll
        for (int ai = 0; ai < 2; ++ai)
#pragma unroll
            for (int m = 0; m < 4; ++m) { const int row = u.pm * 256 + ai * 128 + wr * 64 + m * 16 + fr; float s = 0.f;
                float* hp = h + (size_t)row * D + colt; bf16_t* bp = hb + (size_t)row * D + colt;
#pragma unroll
                for (int bj = 0; bj < 2; ++bj) { const f32x4 v0 = *(const f32x4*)(hp + bj * 128) + acc[ai][bj][m][0], v1 = *(const f32x4*)(hp + bj * 128 + 4) + acc[ai][bj][m][1];
                    *(f32x4*)(hp + bj * 128) = v0; *(f32x4*)(hp + bj * 128 + 4) = v1;
                    s += (v0[0] * v0[0] + v0[1] * v0[1]) + (v0[2] * v0[2] + v0[3] * v0[3]) + (v1[0] * v1[0] + v1[1] * v1[1]) + (v1[2] * v1[2] + v1[3] * v1[3]);
                    u32x4 w; w.x = cvt_pk_bf16(v0[0], v0[1]); w.y = cvt_pk_bf16(v0[2], v0[3]); w.z = cvt_pk_bf16(v1[0], v1[1]); w.w = cvt_pk_bf16(v1[2], v1[3]);
                    *(u32x4*)(bp + bj * 128) = w; }
                s += __shfl_xor(s, 16); s += __shfl_xor(s, 32); if (fq == 0) ssn[(size_t)row * 16 + u.pn * 4 + wc] = s; }
    }
};
template <int CTRL> __device__ __forceinline__ f32x4 dpp4(f32x4 v) { f32x4 r; r.x = dpp_f<CTRL>(v.x); r.y = dpp_f<CTRL>(v.y); r.z = dpp_f<CTRL>(v.z); r.w = dpp_f<CTRL>(v.w); return r; }
struct EpiFfnUp {
    static constexpr bool PERM = true;
    bf16_t* ACT; const float* ss; const float* cw; const float* cb;
    __device__ __forceinline__ void conv4(f32x4& z0, f32x4& z1, f32x4& z2, f32x4& z3, const float (&rs)[4], const int (&tt)[4], const float* wcol, const float* bcol, int fr) const {
        const f32x4 w0 = *(const f32x4*)wcol, w1 = *(const f32x4*)(wcol + FF2), w2 = *(const f32x4*)(wcol + 2 * FF2), bb = *(const f32x4*)bcol;
#pragma unroll
        for (int e = 0; e < 4; ++e) {
            float cur = z3[e] * rs[3], c1 = dpp_f<0x121>(cur), c2 = dpp_f<0x122>(cur);
#define CONV_STEP(ZM, ZP, MI, HASP) { float prv = cur, p1 = c1, p2 = c2; if (HASP) { prv = ZP[e] * rs[MI - (HASP)]; p1 = dpp_f<0x121>(prv); p2 = dpp_f<0x122>(prv); } \
            float y1 = (fr == 0) ? p1 : c1, y2 = (fr < 2) ? p2 : c2; if (tt[MI] < 1) y1 = 0.f; if (tt[MI] < 2) y2 = 0.f; \
            ZM[e] = w0[e] * y2 + w1[e] * y1 + w2[e] * cur + bb[e]; cur = prv; c1 = p1; c2 = p2; }
            CONV_STEP(z3, z2, 3, 1) CONV_STEP(z2, z1, 2, 1) CONV_STEP(z1, z0, 1, 1) CONV_STEP(z0, z0, 0, 0)
#undef CONV_STEP
            asm volatile("" : "+v"(z0[e]), "+v"(z1[e]), "+v"(z2[e]), "+v"(z3[e]));
        }
    }
    __device__ __forceinline__ void operator()(f32x4 (&acc)[2][2][4][2], const Unit& u, int wr, int wc, int fr, int fq) const {
        const int f0 = u.pn * 128 + wc * 32 + 8 * fq;
#pragma unroll
        for (int ai = 0; ai < 2; ++ai) {
            const int gbase = u.pm * 248 - 2 + 62 * (2 * ai + wr) + fr;
            float rs[4]; int tt[4];
#pragma unroll
            for (int m = 0; m < 4; ++m) { const int g = gbase + 16 * m; const int gc = g < 0 ? 0 : (g >= M ? M - 1 : g); rs[m] = row_rstd(ss, gc); tt[m] = g & (SEQ - 1); asm volatile("" : "+v"(rs[m]) :: "memory"); }
#pragma unroll
            for (int n = 0; n < 2; ++n) {
                conv4(acc[ai][0][0][n], acc[ai][0][1][n], acc[ai][0][2][n], acc[ai][0][3][n], rs, tt, cw + f0 + 4 * n, cb + f0 + 4 * n, fr);
                asm volatile("" ::: "memory");
                conv4(acc[ai][1][0][n], acc[ai][1][1][n], acc[ai][1][2][n], acc[ai][1][3][n], rs, tt, cw + FF + f0 + 4 * n, cb + FF + f0 + 4 * n, fr);
                asm volatile("" ::: "memory");
#pragma unroll
                for (int m = 0; m < 4; ++m) { const int g = gbase + 16 * m;
                    if ((m > 0 || fr >= 2) && g < M) { const f32x4 gt = acc[ai][0][m][n], vl = acc[ai][1][m][n]; f32x4 o;
#pragma unroll
                        for (int e = 0; e < 4; ++e) o[e] = gt[e] * sigmoidf_(gt[e]) * vl[e];
                        u32x2 w; w.x = cvt_pk_bf16(o[0], o[1]); w.y = cvt_pk_bf16(o[2], o[3]);
                        *(u32x2*)(ACT + (size_t)g * FF + f0 + 4 * n) = w; } }
            }
        }
    }
};
struct EpiRkv {
    static constexpr bool PERM = true;
    bf16_t* R; bf16_t* WA; bf16_t* GL;
    __device__ __forceinline__ void operator()(const f32x4 (&acc)[2][2][4][2], const Unit& u, int wr, int wc, int fr, int fq) const {
        const int mode = u.pn < 12 ? 0 : (u.pn == 12 ? 1 : 2);
        bf16_t* base; int ldc, colt;
        if (mode == 0) { base = R + (size_t)(u.pn >> 2) * ((size_t)M * D); ldc = D; colt = (u.pn & 3) * 256 + wc * 32 + 8 * fq; }
        else if (mode == 1) { base = WA; ldc = 128; colt = wc * 32 + 8 * fq; }
        else { base = GL; ldc = 256; colt = wc * 32 + 8 * fq; }
#pragma unroll
        for (int ai = 0; ai < 2; ++ai)
#pragma unroll
            for (int m = 0; m < 4; ++m) { const int row = u.pm * 256 + ai * 128 + wr * 64 + m * 16 + fr;
                bf16_t* rowp = base + (size_t)row * ldc + colt;
#pragma unroll
                for (int bj = 0; bj < 2; ++bj) { f32x4 v0 = acc[ai][bj][m][0], v1 = acc[ai][bj][m][1];
                    if (mode == 1) { if (bj == 1) continue;
                        if (wc < 2) {
#pragma unroll
                            for (int e = 0; e < 4; ++e) { v0[e] = tanhf(v0[e]); v1[e] = tanhf(v1[e]); } } }
                    else if (mode == 2) {
#pragma unroll
                        for (int e = 0; e < 4; ++e) { v0[e] = sigmoidf_(v0[e]); v1[e] = sigmoidf_(v1[e]); } }
                    u32x4 w; w.x = cvt_pk_bf16(v0[0], v0[1]); w.y = cvt_pk_bf16(v0[2], v0[3]); w.z = cvt_pk_bf16(v1[0], v1[1]); w.w = cvt_pk_bf16(v1[2], v1[3]);
                    *(u32x4*)(rowp + bj * 128) = w; } }
    }
};

typedef const __attribute__((address_space(4))) Args* CA;
struct Ctx { LAS unsigned char* lds; int tid, lane, wave, G, bid; };

__device__ __forceinline__ void conv_mat(const Ctx& c, const float* src, int ldsrc, int K, int N, int Kp, int Np, bf16_t* dst, int ldd, int n_off, int k_off, const float* sc, int mode, int rot) {
    LAS float* tile = (LAS float*)c.lds;
    const int nnb = Np / 64, nit = (Kp / 64) * nnb; const int start = (c.bid + c.G - (rot % c.G)) % c.G;
    for (int it = start; it < nit; it += c.G) {
        const int kb = it / nnb, nb = it % nnb, k0 = kb * 64, n0 = nb * 64;
#pragma unroll
        for (int j = 0; j < 8; ++j) { const int kk = (c.tid >> 6) + 8 * j, nn = c.tid & 63, k = k0 + kk, n = n0 + nn; float v = 0.f;
            if (src && k < K && n < N) { v = src[(size_t)k * ldsrc + n]; if (mode == 1) v *= sc[k]; else if (mode == 2) v *= (1.f - sc[k]); }
            tile[nn * 65 + kk] = v; }
        __syncthreads();
        { const int nn = c.tid >> 3, cc = c.tid & 7; const LAS float* s = tile + nn * 65 + 8 * cc;
            u32x4 o; o.x = cvt_pk_bf16(s[0], s[1]); o.y = cvt_pk_bf16(s[2], s[3]); o.z = cvt_pk_bf16(s[4], s[5]); o.w = cvt_pk_bf16(s[6], s[7]);
            *(u32x4*)(dst + (size_t)(n_off + n0 + nn) * ldd + k_off + k0 + 8 * cc) = o; }
        __syncthreads();
    }
}

__device__ __forceinline__ void phase_prologue(const Ctx& c, CA a) {
    float* ss = (float*)(a->ws + WS_PA);
    const int gw = c.bid * 8 + c.wave, NGW = c.G * 8;
    bf16_t* hb = (bf16_t*)(a->ws + WS_A);
    for (int m = gw; m < M; m += NGW) {
        const f32x4* xr = (const f32x4*)(a->in[I_X] + (size_t)m * D) + c.lane; f32x4* hr = (f32x4*)(a->out + (size_t)m * D) + c.lane; u32x2* br = (u32x2*)(hb + (size_t)m * D) + c.lane;
        float s = 0.f;
#pragma unroll
        for (int j = 0; j < 4; ++j) { const f32x4 v = xr[64 * j]; s += (v.x * v.x + v.y * v.y) + (v.z * v.z + v.w * v.w); hr[64 * j] = v; u32x2 w; w.x = cvt_pk_bf16(v.x, v.y); w.y = cvt_pk_bf16(v.z, v.w); br[64 * j] = w; }
        s = wave_sum(s); if (c.lane < 16) ss[(size_t)m * 16 + c.lane] = c.lane == 0 ? s : 0.f;
    }
    int rot = 0;
    for (int j = 0; j < 2; ++j) {
        unsigned char* wj = a->ws + WS_WSTAT + (size_t)j * WJ_STRIDE;
        conv_mat(c, a->in[I_SWIN] + (size_t)j * D * 2048, 2048, D, 2048, D, 2048, (bf16_t*)(wj + WJ_IN), D, 0, 0, a->in[I_NMIX] + (size_t)(2 * j) * D, 1, rot); rot += 512;
        conv_mat(c, a->in[I_SWOUT] + (size_t)j * D * D, D, D, D, D, D, (bf16_t*)(wj + WJ_OUT), D, 0, 0, nullptr, 0, rot); rot += 256;
        const float* mu = a->in[I_MU] + (size_t)j * 6 * D; bf16_t* rkv = (bf16_t*)(wj + WJ_RKV);
#define CONV_BIG(IDX, Q, MUB) do { conv_mat(c, a->in[IDX] + (size_t)j * D * D, D, D, D, D, D, rkv, 2048, (Q) * 1024, 0, mu + (MUB) * D, 2, rot); rot += 256; \
            conv_mat(c, a->in[IDX] + (size_t)j * D * D, D, D, D, D, D, rkv, 2048, (Q) * 1024, 1024, mu + (MUB) * D, 1, rot); rot += 256; } while (0)
        CONV_BIG(I_WR, 0, 0); CONV_BIG(I_WK, 1, 2); CONV_BIG(I_WV, 2, 3);
#undef CONV_BIG
        conv_mat(c, a->in[I_W1] + (size_t)j * D * 64, 64, D, 64, D, 64, rkv, 2048, 3072, 0, mu + 1 * D, 2, rot); rot += 16;
        conv_mat(c, a->in[I_W1] + (size_t)j * D * 64, 64, D, 64, D, 64, rkv, 2048, 3072, 1024, mu + 1 * D, 1, rot); rot += 16;
        conv_mat(c, a->in[I_A1] + (size_t)j * D * 64, 64, D, 64, D, 64, rkv, 2048, 3136, 0, mu + 4 * D, 2, rot); rot += 16;
        conv_mat(c, a->in[I_A1] + (size_t)j * D * 64, 64, D, 64, D, 64, rkv, 2048, 3136, 1024, mu + 4 * D, 1, rot); rot += 16;
        conv_mat(c, nullptr, 0, 0, 0, 2048, 128, rkv, 2048, 3200, 0, nullptr, 0, rot); rot += 64;
        conv_mat(c, a->in[I_G1] + (size_t)j * D * 160, 160, D, 160, D, 256, rkv, 2048, 3328, 0, mu + 5 * D, 2, rot); rot += 64;
        conv_mat(c, a->in[I_G1] + (size_t)j * D * 160, 160, D, 160, D, 256, rkv, 2048, 3328, 1024, mu + 5 * D, 1, rot); rot += 64;
        bf16_t* l2wa = (bf16_t*)(wj + WJ_L2WA);
        conv_mat(c, a->in[I_W2] + (size_t)j * 64 * D, D, 64, D, 64, D, l2wa, 128, 0, 0, nullptr, 0, rot); rot += 16;
        conv_mat(c, nullptr, 0, 0, 0, 64, D, l2wa, 128, 0, 64, nullptr, 0, rot); rot += 16;
        conv_mat(c, nullptr, 0, 0, 0, 64, D, l2wa, 128, 1024, 0, nullptr, 0, rot); rot += 16;
        conv_mat(c, a->in[I_A2] + (size_t)j * 64 * D, D, 64, D, 64, D, l2wa, 128, 1024, 64, nullptr, 0, rot); rot += 16;
        conv_mat(c, a->in[I_G2] + (size_t)j * 160 * D, D, 160, D, 256, D, (bf16_t*)(wj + WJ_L2G), 256, 0, 0, nullptr, 0, rot); rot += 64;
        conv_mat(c, a->in[I_WO] + (size_t)j * D * D, D, D, D, D, D, (bf16_t*)(wj + WJ_O), D, 0, 0, nullptr, 0, rot); rot += 256;
    }
}
__device__ __forceinline__ void phase_ffn_weights(const Ctx& c, CA a, int layer) {
    for (int pn = 0; pn < FF / 128; ++pn) {
        conv_mat(c, a->in[I_FUP] + (size_t)layer * D * FF2 + pn * 128, FF2, D, 128, D, 128, (bf16_t*)(a->ws + WS_WFFN), D, pn * 256, 0, a->in[I_NFFN] + (size_t)layer * D, 1, pn * 64);
        conv_mat(c, a->in[I_FUP] + (size_t)layer * D * FF2 + FF + pn * 128, FF2, D, 128, D, 128, (bf16_t*)(a->ws + WS_WFFN), D, pn * 256 + 128, 0, a->in[I_NFFN] + (size_t)layer * D, 1, pn * 64 + 32);
    }
    conv_mat(c, a->in[I_FDN] + (size_t)layer * FF * D, D, FF, D, FF, D, (bf16_t*)(a->ws + WS_WDOWN), FF, 0, 0, nullptr, 0, 128);
}

__device__ __forceinline__ void phase_sgu_spatial(const Ctx& c, CA a, int j, int rp) {
    typedef short bf16x8 __attribute__((ext_vector_type(8)));
    bf16_t* U = (bf16_t*)(a->ws + P_U); const bf16_t* V = (const bf16_t*)(a->ws + P_SV); bf16_t* UO = rp ? (bf16_t*)(a->ws + P_SV) : U;
    const float* ssv = (const float*)(a->ws + WS_PV);
    LAS bf16_t* WL = (LAS bf16_t*)c.lds; LAS bf16_t* VT = WL + 128 * 136;
    const int g = c.bid & 15;
    const float* Ws = a->in[I_SWS] + ((size_t)j * 16 + g) * 128 * 128; const float* bs = a->in[I_SBS] + ((size_t)j * 16 + g) * 128; const float* gv = a->in[I_SGV] + (size_t)j * D + g * 64;
    __syncthreads();
    { const int t = c.tid >> 2, s0 = (c.tid & 3) * 32; const float* wp = Ws + (size_t)t * 128 + s0;
#pragma unroll
      for (int q = 0; q < 4; ++q) { f32x4 x0 = *(const f32x4*)(wp + 8 * q), x1 = *(const f32x4*)(wp + 8 * q + 4);
#pragma unroll
          for (int e = 0; e < 4; ++e) { if (s0 + 8 * q + e > t) x0[e] = 0.f; if (s0 + 8 * q + 4 + e > t) x1[e] = 0.f; }
          u32x4 w; w.x = cvt_pk_bf16(x0[0], x0[1]); w.y = cvt_pk_bf16(x0[2], x0[3]); w.z = cvt_pk_bf16(x1[0], x1[1]); w.w = cvt_pk_bf16(x1[2], x1[3]);
          *(LAS u32x4*)(WL + t * 136 + s0 + 8 * q) = w; } }
    const int w8 = c.wave, fr = c.lane & 15, fq = c.lane >> 4, t0 = 16 * w8, nk = (w8 >> 1) + 1;
    const int vs = c.tid >> 2, vc = (c.tid & 3) * 16;
    f32x4 gq[4];
#pragma unroll
    for (int e = 0; e < 4; ++e) gq[e] = *(const f32x4*)(gv + vc + 4 * e);
    const float bb = bs[t0 + fr];
    for (int ub = c.bid >> 4; ub < M / 128; ub += c.G >> 4) {
        const int m0 = ub * 128;
        { const bf16_t* vp = V + (size_t)(m0 + vs) * D + g * 64 + vc; const u32x4 v0 = *(const u32x4*)vp, v1 = *(const u32x4*)(vp + 8);
          const float rs = row_rstd(ssv, m0 + vs);
          const unsigned vw[8] = {v0.x, v0.y, v0.z, v0.w, v1.x, v1.y, v1.z, v1.w};
#pragma unroll
          for (int e = 0; e < 8; ++e) { const float lo = bflo(vw[e]) * rs * gq[e >> 1][(2 * e) & 3], hi = bfhi(vw[e]) * rs * gq[e >> 1][(2 * e + 1) & 3];
              const unsigned pk = cvt_pk_bf16(lo, hi);
              VT[(vc + 2 * e) * 136 + vs] = (bf16_t)(pk & 0xffffu); VT[(vc + 2 * e + 1) * 136 + vs] = (bf16_t)(pk >> 16); } }
        __syncthreads();
        f32x4 acc[4];
#pragma unroll
        for (int ct = 0; ct < 4; ++ct) acc[ct] = (f32x4){0.f, 0.f, 0.f, 0.f};
        for (int k = 0; k < nk; ++k) {
            const bf16x8 wf = *(const LAS bf16x8*)(WL + (t0 + fr) * 136 + 32 * k + 8 * fq);
#pragma unroll
            for (int ct = 0; ct < 4; ++ct) { const bf16x8 vf = *(const LAS bf16x8*)(VT + (16 * ct + fr) * 136 + 32 * k + 8 * fq);
                acc[ct] = __builtin_amdgcn_mfma_f32_16x16x32_bf16(vf, wf, acc[ct], 0, 0, 0); }
        }
        { const size_t ro = (size_t)(m0 + t0 + fr) * D + g * 64 + 4 * fq;
#pragma unroll
          for (int ct = 0; ct < 4; ++ct) { const u32x2 uu = *(const u32x2*)(U + ro + 16 * ct); const f32x4 o = acc[ct] + bb;
              u32x2 w; w.x = cvt_pk_bf16(bflo(uu.x) * o[0], bfhi(uu.x) * o[1]); w.y = cvt_pk_bf16(bflo(uu.y) * o[2], bfhi(uu.y) * o[3]);
              *(u32x2*)(UO + ro + 16 * ct) = w; } }
        __syncthreads();
    }
}

__device__ __forceinline__ void phase_ffn_conv(const Ctx& c, CA a, int layer, int half) {
    const bf16_t* Z = (const bf16_t*)(a->ws + P_Z); bf16_t* ACT = (bf16_t*)(a->ws + P_ACT) + (size_t)half * (M / 2) * FF;
    const float* cw = a->in[I_FCW] + (size_t)layer * 3 * FF2; const float* cb = a->in[I_FCB] + (size_t)layer * FF2;
    const int gt = c.bid * 512 + c.tid, NT = c.G * 512;
    for (int idx = gt; idx < (M / 2) * (FF / 8); idx += NT) {
        const int ml = idx / (FF / 8), f = (idx % (FF / 8)) * 8, t = ml & (SEQ - 1);
        float gsum[8], vsum[8];
#pragma unroll
        for (int e = 0; e < 8; ++e) { gsum[e] = cb[f + e]; vsum[e] = cb[FF + f + e]; }
#pragma unroll
        for (int jj = 0; jj < 3; ++jj) { const int dt = 2 - jj; if (t - dt < 0) continue;
            const u32x4 zg = *(const u32x4*)(Z + (size_t)(ml - dt) * FF2 + f), zv = *(const u32x4*)(Z + (size_t)(ml - dt) * FF2 + FF + f);
            const float* wg = cw + (size_t)jj * FF2 + f; const float* wv = wg + FF;
            const unsigned zgw[4] = {zg.x, zg.y, zg.z, zg.w}, zvw[4] = {zv.x, zv.y, zv.z, zv.w};
#pragma unroll
            for (int e = 0; e < 4; ++e) { gsum[2 * e] += wg[2 * e] * bflo(zgw[e]); gsum[2 * e + 1] += wg[2 * e + 1] * bfhi(zgw[e]); vsum[2 * e] += wv[2 * e] * bflo(zvw[e]); vsum[2 * e + 1] += wv[2 * e + 1] * bfhi(zvw[e]); } }
        float o[8];
#pragma unroll
        for (int e = 0; e < 8; ++e) o[e] = gsum[e] * sigmoidf_(gsum[e]) * vsum[e];
        u32x4 w; w.x = cvt_pk_bf16(o[0], o[1]); w.y = cvt_pk_bf16(o[2], o[3]); w.z = cvt_pk_bf16(o[4], o[5]); w.w = cvt_pk_bf16(o[6], o[7]);
        *(u32x4*)(ACT + (size_t)ml * FF + f) = w;
    }
}

__device__ __forceinline__ void phase_rwkv_prep(const Ctx& c, CA a, int layer) {
    const float* ss = (const float*)(a->ws + WS_PA); const float* g = a->in[I_NMIX] + (size_t)layer * D;
    bf16_t* hn = (bf16_t*)(a->ws + WS_A);
    const int gw = c.bid * 8 + c.wave, NGW = c.G * 8;
    f32x4 gg[4];
#pragma unroll
    for (int j = 0; j < 4; ++j) gg[j] = *((const f32x4*)g + c.lane + 64 * j);
    for (int m = gw; m < M; m += NGW) {
        const float rs = row_rstd(ss, m);
        const f32x4* hr = (const f32x4*)(a->out + (size_t)m * D) + c.lane; const int prow = (m >> 12) * SEQP + PADR + (m & (SEQ - 1));
        u32x2* br = (u32x2*)(hn + (size_t)prow * D) + c.lane;
#pragma unroll
        for (int j = 0; j < 4; ++j) { const f32x4 v = hr[64 * j] * rs * gg[j]; u32x2 w; w.x = cvt_pk_bf16(v.x, v.y); w.y = cvt_pk_bf16(v.z, v.w); br[64 * j] = w; }
    }
    for (int r = gw; r < BATCH * PADR; r += NGW) { const int prow = (r / PADR) * SEQP + (r % PADR); u32x2* br = (u32x2*)(hn + (size_t)prow * D) + c.lane;
#pragma unroll
        for (int j = 0; j < 4; ++j) br[64 * j] = (u32x2){0u, 0u}; }
}

__device__ __forceinline__ void phase_scan(const Ctx& c, CA a, int j, int rp) {
    LAS float* Lw = (LAS float*)c.lds; LAS float* La = Lw + 2048; LAS float* Lb = La + 2048; LAS float* Lk = Lb + 2048; LAS float* Lr = Lk + 2048; LAS float* Lv = Lr + 2048; LAS float* Ly = Lv + 2048; LAS float* Lbon = Ly + 2048;
    bf16_t* R = (bf16_t*)(a->ws + P_R); bf16_t* RO = (bf16_t*)(a->ws + (rp ? P_LW : P_R)); const bf16_t* Kb = (const bf16_t*)(a->ws + P_K); const bf16_t* Vb = (const bf16_t*)(a->ws + P_V);
    const bf16_t* LWb = (const bf16_t*)(a->ws + P_LW); const bf16_t* LAb = (const bf16_t*)(a->ws + P_LA); const bf16_t* Gb = (const bf16_t*)(a->ws + WS_A);
    const int row = c.tid >> 3, q = c.tid & 7, st = c.tid >> 4, sc = (c.tid & 15) * 4;
    for (int unit = c.bid; unit < BATCH * 16; unit += c.G) {
        const int b = unit >> 4, hh = unit & 15, ch = hh * 64 + sc;
        const f32x4 w0 = *(const f32x4*)(a->in[I_W0] + (size_t)j * D + ch), a0 = *(const f32x4*)(a->in[I_A0] + (size_t)j * D + ch), kkp = *(const f32x4*)(a->in[I_KK] + (size_t)j * D + ch), kap = *(const f32x4*)(a->in[I_KA] + (size_t)j * D + ch),
                    rkp = *(const f32x4*)(a->in[I_RK] + (size_t)j * D + ch), lnw = *(const f32x4*)(a->in[I_LNW] + (size_t)j * D + ch), lnb = *(const f32x4*)(a->in[I_LNB] + (size_t)j * D + ch);
        f32x4 S0 = (f32x4){0.f, 0.f, 0.f, 0.f}, S1 = S0;
        for (int chunk = 0; chunk < SEQ / 32; ++chunk) {
            const size_t goff = ((size_t)b * SEQ + chunk * 32 + st) * D + ch;
            {
                const u32x2 r2 = *(const u32x2*)(R + goff), k2 = *(const u32x2*)(Kb + goff), v2 = *(const u32x2*)(Vb + goff), lw2 = *(const u32x2*)(LWb + goff), la2 = *(const u32x2*)(LAb + goff);
                const f32x4 r = {bflo(r2.x), bfhi(r2.x), bflo(r2.y), bfhi(r2.y)}, k = {bflo(k2.x), bfhi(k2.x), bflo(k2.y), bfhi(k2.y)}, v = {bflo(v2.x), bfhi(v2.x), bflo(v2.y), bfhi(v2.y)};
                const f32x4 lw = {bflo(lw2.x), bfhi(lw2.x), bflo(lw2.y), bfhi(lw2.y)}, la = {bflo(la2.x), bfhi(la2.x), bflo(la2.y), bfhi(la2.y)};
                f32x4 dec, av, kk, kp;
                float n2 = 0.f, bon = 0.f;
#pragma unroll
                for (int e = 0; e < 4; ++e) {
                    const float xw = -(w0[e] + lw[e]);
                    const float sp = xw > 20.f ? xw : log1pf(expf(xw));
                    dec[e] = expf(-expf(-sp - 0.5f));
                    av[e] = 1.f / (1.f + expf(-(a0[e] + la[e])));
                    kk[e] = k[e] * kkp[e]; n2 += kk[e] * kk[e];
                    kp[e] = k[e] * (1.f + (av[e] - 1.f) * kap[e]);
                    bon += r[e] * kp[e] * rkp[e];
                }
#pragma unroll
                for (int o = 1; o < 16; o <<= 1) { n2 += __shfl_xor(n2, o); bon += __shfl_xor(bon, o); }
                const float inv = rsqrtf(fmaxf(n2, 1e-24f));
                kk = kk * inv;
                const int lo = st * 64 + sc;
                *(LAS f32x4*)(Lw + lo) = dec; *(LAS f32x4*)(La + lo) = -kk; *(LAS f32x4*)(Lb + lo) = kk * av; *(LAS f32x4*)(Lk + lo) = kp; *(LAS f32x4*)(Lr + lo) = r; *(LAS f32x4*)(Lv + lo) = v;
                if ((c.tid & 15) == 0) Lbon[st] = bon;
            }
            __syncthreads();
            {
                const LAS f32x4* pa = (const LAS f32x4*)(La + 8 * q); const LAS f32x4* pw = (const LAS f32x4*)(Lw + 8 * q); const LAS f32x4* pb = (const LAS f32x4*)(Lb + 8 * q);
                const LAS f32x4* pk = (const LAS f32x4*)(Lk + 8 * q); const LAS f32x4* pr = (const LAS f32x4*)(Lr + 8 * q);
                f32x4 a0v = pa[0], a1v = pa[1], w0v = pw[0], w1v = pw[1], b0v = pb[0], b1v = pb[1], k0v = pk[0], k1v = pk[1], r0v = pr[0], r1v = pr[1];
                float vv = Lv[row];
#pragma unroll 2
                for (int t = 0; t < 32; ++t) {
                    const int tn = (t + 1) & 31;
                    const f32x4 na0 = pa[tn * 16], na1 = pa[tn * 16 + 1], nw0 = pw[tn * 16], nw1 = pw[tn * 16 + 1], nb0 = pb[tn * 16], nb1 = pb[tn * 16 + 1],
                                nk0 = pk[tn * 16], nk1 = pk[tn * 16 + 1], nr0 = pr[tn * 16], nr1 = pr[tn * 16 + 1];
                    const float nvv = Lv[tn * 64 + row];
                    const f32x4 p = S0 * a0v + S1 * a1v;
                    const float sa = sum8((p.x + p.y) + (p.z + p.w));
                    S0 = S0 * w0v + sa * b0v + vv * k0v; S1 = S1 * w1v + sa * b1v + vv * k1v;
                    const f32x4 yq = S0 * r0v + S1 * r1v;
                    const float y = sum8((yq.x + yq.y) + (yq.z + yq.w));
                    if (q == 0) Ly[t * 64 + row] = y;
                    a0v = na0; a1v = na1; w0v = nw0; w1v = nw1; b0v = nb0; b1v = nb1; k0v = nk0; k1v = nk1; r0v = nr0; r1v = nr1; vv = nvv;
                }
            }
            __syncthreads();
            {
                const int lo = st * 64 + sc;
                const f32x4 y = *(const LAS f32x4*)(Ly + lo), v = *(const LAS f32x4*)(Lv + lo); const float bon = Lbon[st];
                float s1 = (y.x + y.y) + (y.z + y.w);
#pragma unroll
                for (int o = 1; o < 16; o <<= 1) s1 += __shfl_xor(s1, o);
                const float mean = s1 * (1.f / 64.f); const f32x4 dlt = y - mean;
                float s2 = (dlt.x * dlt.x + dlt.y * dlt.y) + (dlt.z * dlt.z + dlt.w * dlt.w);
#pragma unroll
                for (int o = 1; o < 16; o <<= 1) s2 += __shfl_xor(s2, o);
                const float rstd = rsqrtf(s2 * (1.f / 64.f) + GN_EPS);
                const u32x2 g2 = *(const u32x2*)(Gb + goff);
                const f32x4 g = {bflo(g2.x), bfhi(g2.x), bflo(g2.y), bfhi(g2.y)};
                const f32x4 o = (dlt * rstd * lnw + lnb + bon * v) * g;
                u32x2 w; w.x = cvt_pk_bf16(o.x, o.y); w.y = cvt_pk_bf16(o.z, o.w);
                *(u32x2*)(RO + goff) = w;
            }
            __syncthreads();
        }
    }
}

__device__ __forceinline__ void phase_final(const Ctx& c, CA a) {
    const float* ss = (const float*)(a->ws + WS_PA); const float* g = a->in[I_NFIN];
    const int gw = c.bid * 8 + c.wave, NGW = c.G * 8;
    f32x4 gg[4];
#pragma unroll
    for (int j = 0; j < 4; ++j) gg[j] = *((const f32x4*)g + c.lane + 64 * j);
    for (int m = gw; m < M; m += NGW) {
        const float rs = row_rstd(ss, m);
        f32x4* hr = (f32x4*)(a->out + (size_t)m * D) + c.lane;
#pragma unroll
        for (int j = 0; j < 4; ++j) hr[64 * j] = hr[64 * j] * rs * gg[j];
    }
}

constexpr int SLOTS = 11, NPH = 2 + 4 * SLOTS;
__host__ __device__ inline bool phase_active(int p) {
    if (p == 0 || p == NPH - 1) return true;
    const int i = (p - 1) / SLOTS, s = (p - 1) % SLOTS;
    if (s >= 5) return s == 5 || s == 6 || s == 10;
    return (i & 1) ? true : (s < 3);
}

__global__ void __launch_bounds__(512, 2) mk_fwd(Args a_) {
    extern __shared__ __attribute__((aligned(16))) unsigned char lds_raw[];
    int tid_ = threadIdx.x, bid_ = blockIdx.x, G_ = gridDim.x;
    CA a = (CA)__builtin_amdgcn_kernarg_segment_ptr();
    const int ph_lo = a_.ph_lo, ph_hi = a_.ph_hi;
    for (int p = ph_lo; p < ph_hi; ++p) {
        if (!phase_active(p)) continue;
        const int PL = (p - 1) / SLOTS, PS = (p - 1) % SLOTS; (void)PL; (void)PS;
        const int nrep = (MK_PROBE && p > 0 && p < NPH - 1 && (MK_PROBE_SEL)) ? 2 : 1;
        for (int rp = 0; rp < nrep; ++rp) {
        if (rp) cg::this_grid().sync();
        asm volatile("" : "+s"(a), "+s"(bid_), "+s"(G_)); asm volatile("" : "+v"(tid_));
        Ctx c; c.lds = (LAS unsigned char*)lds_raw; c.tid = tid_; c.lane = c.tid & 63; c.wave = __builtin_amdgcn_readfirstlane(c.tid >> 6); c.G = G_; c.bid = bid_;
        bf16_t* regA = (bf16_t*)(a->ws + WS_A);
        if (p == 0) phase_prologue(c, a);
        else if (p == NPH - 1) phase_final(c, a);
        else {
            const int layer = (p - 1) / SLOTS, s = (p - 1) % SLOTS, j = layer >> 1;
            unsigned char* wj = a->ws + WS_WSTAT + (size_t)j * WJ_STRIDE;
            float* ss_mix = (float*)(a->ws + WS_PA); float* ss_ffn = (float*)(a->ws + WS_PB); float* ss_next = ss_mix;
            if (s < 5 && !(layer & 1)) {
                if (s == 0) {
                    pg8::Gemm g{regA, (const bf16_t*)(wj + WJ_IN), M, 2048, D, D}; pg8::StaticOrder S; S.init(M / 256, 2048, c.G, c.bid);
                    EpiSguIn E{(bf16_t*)(a->ws + P_U), (bf16_t*)(a->ws + P_SV), ss_mix, a->in[I_SBIN] + (size_t)j * 2048, (float*)(a->ws + WS_PV)};
                    pg8::gemm_phase<EpiSguIn, pg8::StaticOrder, 0, false, true>(c.lds, c.tid, g, S, E);
                } else if (s == 1) phase_sgu_spatial(c, a, j, rp);
                else {
                    pg8::Gemm g{(const bf16_t*)(a->ws + P_U), (const bf16_t*)(wj + WJ_OUT), M, D, D, D}; pg8::StaticOrder S; S.init(M / 256, D, c.G, c.bid);
                    EpiResid E{a->out, regA, ss_ffn};
                    pg8::gemm_phase<EpiResid, pg8::StaticOrder, 0, false, true>(c.lds, c.tid, g, S, E);
                }
            } else if (s < 5) {
                if (s == 0) phase_rwkv_prep(c, a, layer);
                else if (s == 1) {
                    pg8::Gemm g{regA, (const bf16_t*)(wj + WJ_RKV), M, 3584, 2048, D}; pg8::StaticOrder S; S.init(M / 256, 3584, c.G, c.bid);
                    EpiRkv E{(bf16_t*)(a->ws + P_R), (bf16_t*)(a->ws + P_WA), (bf16_t*)(a->ws + P_GL)};
                    pg8::gemm_phase<EpiRkv, pg8::StaticOrder, 1, true, true>(c.lds, c.tid, g, S, E);
                } else if (s == 2) {
                    { int kq = 128; asm volatile("" : "+s"(kq)); pg8::Gemm g{(const bf16_t*)(a->ws + P_WA), (const bf16_t*)(wj + WJ_L2WA), M, 2048, kq, kq}; pg8::StaticOrder S; S.init(M / 256, 2048, c.G, c.bid);
                      EpiStore<false> E{(bf16_t*)(a->ws + P_LW), D, 2, (size_t)M * D, nullptr};
                      pg8::gemm_phase<EpiStore<false>, pg8::StaticOrder, 0, false, true>(c.lds, c.tid, g, S, E); }
                    asm volatile("" : "+s"(a), "+s"(c.bid), "+s"(c.G), "+s"(wj)); asm volatile("" : "+v"(c.tid));
                    { int kq = 256; asm volatile("" : "+s"(kq)); pg8::Gemm g{(const bf16_t*)(a->ws + P_GL), (const bf16_t*)(wj + WJ_L2G), M, D, kq, kq}; pg8::StaticOrder S; S.init(M / 256, D, c.G, c.bid);
                      EpiStore<false> E{regA, D, 2, 0, nullptr};
                      pg8::gemm_phase<EpiStore<false>, pg8::StaticOrder, 0, false, true>(c.lds, c.tid, g, S, E); }
                } else if (s == 3) phase_scan(c, a, j, rp);
                else {
                    pg8::Gemm g{(const bf16_t*)(a->ws + P_R), (const bf16_t*)(wj + WJ_O), M, D, D, D}; pg8::StaticOrder S; S.init(M / 256, D, c.G, c.bid);
                    EpiResid E{a->out, regA, ss_ffn};
                    pg8::gemm_phase<EpiResid, pg8::StaticOrder, 0, false, true>(c.lds, c.tid, g, S, E);
                }
            } else if (s == 5) phase_ffn_weights(c, a, layer);
            else if (s == 6) {
                pg8::Gemm g{regA - 2 * D, (const bf16_t*)(a->ws + WS_WFFN), M, FF2, D, D}; pg8::StaticOrder S; S.init(133, FF2, c.G, c.bid);
                EpiFfnUp E{(bf16_t*)(a->ws + P_ACT), ss_ffn, a->in[I_FCW] + (size_t)layer * 3 * FF2, a->in[I_FCB] + (size_t)layer * FF2};
                pg8::gemm_phase<EpiFfnUp, pg8::StaticOrder, 2, false, true>(c.lds, c.tid, g, S, E);
            }
            else {
                pg8::Gemm g{(const bf16_t*)(a->ws + P_ACT), (const bf16_t*)(a->ws + WS_WDOWN), M, D, FF, FF}; pg8::StaticOrder S; S.init(M / 256, D, c.G, c.bid);
                EpiResid E{a->out, regA, ss_next};
                pg8::gemm_phase<EpiResid, pg8::StaticOrder, 0, false, true>(c.lds, c.tid, g, S, E);
            }
        }
        }
        if (p + 1 < ph_hi) cg::this_grid().sync();
    }
}

constexpr int LDS_BYTES = 147456;
#ifndef MK_ONE_LAUNCH
#define MK_ONE_LAUNCH 1
#endif
extern "C" void kernel_launch(void* const* d_in, const int* in_sizes, int n_in, void* d_out, int out_size, void* d_ws, size_t ws_size, hipStream_t stream) {
    static int grid = 0;
    if (grid == 0) {
        if (n_in != 32 || out_size != M * D || ws_size < WS_END) { fprintf(stderr, "kernel_launch: unexpected shapes (n_in %d out %d ws %zu, need %zu)\n", n_in, out_size, ws_size, (size_t)WS_END); grid = -1; return; }
        int dev = 0, cus = 0, per_cu = 0;
        (void)hipGetDevice(&dev); (void)hipDeviceGetAttribute(&cus, hipDeviceAttributeMultiprocessorCount, dev);
        if (hipFuncSetAttribute((const void*)mk_fwd, hipFuncAttributeMaxDynamicSharedMemorySize, LDS_BYTES) != hipSuccess) { fprintf(stderr, "kernel_launch: hipFuncSetAttribute failed\n"); grid = -1; return; }
        (void)hipOccupancyMaxActiveBlocksPerMultiprocessor(&per_cu, (const void*)mk_fwd, 512, LDS_BYTES);
        if (per_cu < 1) per_cu = 1;
        grid = cus * 1;
        (void)hipGetLastError();
    }
    if (grid < 0) return;
    Args a{};
    for (int i = 0; i < 32; ++i) a.in[i] = (const float*)d_in[i];
    a.out = (float*)d_out; a.ws = (unsigned char*)d_ws;
#if MK_ONE_LAUNCH
    a.ph_lo = 0; a.ph_hi = NPH;
    void* args[] = {&a};
    hipError_t e = hipLaunchCooperativeKernel((const void*)mk_fwd, dim3(grid), dim3(512), args, LDS_BYTES, stream);
    if (e != hipSuccess) fprintf(stderr, "cooperative launch failed: %s (grid %d)\n", hipGetErrorString(e), grid);
#else
    for (int p = 0; p < NPH; ++p) { if (!phase_active(p)) continue; a.ph_lo = p; a.ph_hi = p + 1; hipLaunchKernelGGL(mk_fwd, dim3(grid), dim3(512), LDS_BYTES, stream, a); }
#endif
}
```

```cpp
#include <hip/hip_runtime.h>
#include <hip/hip_cooperative_groups.h>
#include <cstdio>
#include <cstdint>
#include <cmath>
namespace cg = cooperative_groups;
#ifndef MK_PROBE
#define MK_PROBE 0
#endif
#ifndef MK_PROBE_SEL
#define MK_PROBE_SEL 0
#endif
namespace pg8 {
#define PG8_LAS __attribute__((address_space(3)))
typedef unsigned short bf16_t;
typedef short bf16x8 __attribute__((ext_vector_type(8)));
typedef float f32x4 __attribute__((ext_vector_type(4)));
typedef float f32x2 __attribute__((ext_vector_type(2)));
typedef unsigned u32x4 __attribute__((ext_vector_type(4)));
typedef unsigned u32x2 __attribute__((ext_vector_type(2)));
constexpr int BM = 256, BK = 64, HALF = 128, HTB = HALF * BK * 2  , STAGE_BYTES = 8 * HTB, NXCD = 8, WGM = 8;

__host__ __device__ __forceinline__ int lds_byte(int r, int c) { const int st = (r >> 4) * 2 + (c >> 5), rr = r & 15, cc = c & 31, ob = rr * 64 + cc * 2; return st * 1024 + (ob ^ (((ob >> 9) & 1) << 5)); }
__host__ __device__ __forceinline__ void stage_rc(int b, int& R, int& C) { const int st = b / 1024, sb = b % 1024, swz = sb ^ (((sb >> 9) & 1) << 5); R = (st >> 1) * 16 + swz / 64; C = (st & 1) * 32 + (swz % 64) / 2; }
__host__ __device__ __forceinline__ int perm32(int rho) { const int n = rho >> 4, i = rho & 15; return 8 * (i >> 2) + 4 * n + (i & 3); }

struct Unit { int pm, pn; };
struct Gemm { const bf16_t* A; const bf16_t* Bt; int M, N, K, lda; };

struct StaticOrder {
    int nM, nN, nwg, G, c;
    __host__ __device__ void init(int nM_, int N, int G_, int c_) { nM = nM_; nN = N / BM; nwg = nM * nN; G = G_; c = c_; }
    __host__ __device__ bool next(int i, Unit& u) const {
        const long L = (long)i * G + c; if (L >= nwg) return false;
        int wgid = (int)L; { const int q = nwg / NXCD, r = nwg % NXCD, xcd = wgid % NXCD, off = wgid / NXCD; wgid = (xcd < r ? xcd * (q + 1) : r * (q + 1) + (xcd - r) * q) + off; }
        const int nig = WGM * nN, gid = wgid / nig, fm = gid * WGM, gsz = (nM - fm) < WGM ? (nM - fm) : WGM;
        u.pm = fm + ((wgid % nig) % gsz); u.pn = (wgid % nig) / gsz; return true;
    }
};

__device__ __forceinline__ unsigned cvt_pk_bf16(float lo, float hi) { unsigned r; asm volatile("v_cvt_pk_bf16_f32 %0, %1, %2" : "=v"(r) : "v"(lo), "v"(hi)); return r; }
__device__ __forceinline__ f32x2 gelu_pk(f32x2 v) {
    const f32x2 av = __builtin_elementwise_abs(v), d = av * 0.2316418882f + 1.0f;
    f32x2 t; t.x = __builtin_amdgcn_rcpf(d.x); t.y = __builtin_amdgcn_rcpf(d.y);
    f32x2 q = t * 0.5307027145f + (-0.7265760135f); q = q * t + 0.7107068705f; q = q * t + (-0.142248368f); q = q * t + 0.127414796f; q = q * t;
    const f32x2 s = (v * v) * (-0.72134752044f);
    f32x2 e; e.x = __builtin_amdgcn_exp2f(s.x); e.y = __builtin_amdgcn_exp2f(s.y);
    const f32x2 m = v * (q * e), r = v - m;
    f32x2 o; o.x = v.x < 0.f ? m.x : r.x; o.y = v.y < 0.f ? m.y : r.y; return o;
}

template <class Epi, class Sched, int AMAP, bool KDBL, bool ALIGN_EPI>
__device__ __forceinline__ void gemm_phase(PG8_LAS unsigned char* lds, const int tid, const Gemm g, const Sched& S, const Epi& E) {
    const int wid = __builtin_amdgcn_readfirstlane(tid >> 6), lane = tid & 63, wr = wid >> 2, wc = wid & 3, fr = lane & 15, fq = lane >> 4;
    const int K = g.K, nt = K / BK, lda = g.lda;
    unsigned voffA[2], voffB[2];
#pragma unroll
    for (int i = 0; i < 2; ++i) { int R, C; stage_rc(tid * 16 + i * 8192, R, C); const int Rb = Epi::PERM ? ((R & ~31) + perm32(R & 31)) : R;
        const int Ra = (AMAP == 2) ? (R - 2 * (R >> 6)) : R;
        voffA[i] = (unsigned)(Ra * lda + C) * 2u; voffB[i] = (unsigned)(Rb * K + C) * 2u; }
    const size_t kstep = (size_t)(BK * 2);
    const size_t hstepA = (size_t)((AMAP == 2) ? 124 : HALF) * lda * 2;
    const size_t hstepB = (size_t)HALF * K * 2;
    const size_t tstepB = 2 * hstepB;
    const size_t rowA = (size_t)lda * 2;
    const unsigned ldsw = (unsigned)wid * 1024u;
    const int aoff = lds_byte(wr * 64 + fr, fq * 8), boff = lds_byte(wc * 32 + fr, fq * 8);
#define PG8_ABASE(pm) ((const char*)g.A + (AMAP == 1 ? (size_t)(((pm) >> 4) * 4104 + 8 + ((pm) & 15) * 256) * rowA : (AMAP == 2 ? (size_t)(pm) * 248 * rowA : (size_t)(pm) * 256 * rowA)))
#define PG8_KA(base, t) (KDBL ? ((base) + (size_t)((t) & 15) * kstep - (size_t)((t) >> 4) * rowA) : ((base) + (size_t)(t) * kstep))
#define PG8_SA(b, h) (((b) * 2 + (h)) * HTB)
#define PG8_SB(b, h) ((4 + (b) * 2 + (h)) * HTB)
#define PG8_STAGE(bufoff, gbase, voff) do { _Pragma("unroll") for (int _i = 0; _i < 2; ++_i) \
        __builtin_amdgcn_global_load_lds((const unsigned*)((const char*)(gbase) + (voff)[_i]), (PG8_LAS unsigned*)(lds + (bufoff) + ldsw + _i * 8192), 16, 0, 0); } while (0)
#define PG8_LDA(dst, b, h) do { _Pragma("unroll") for (int m = 0; m < 4; ++m) _Pragma("unroll") for (int k = 0; k < 2; ++k) dst[m][k] = *(const PG8_LAS bf16x8*)(lds + PG8_SA(b, h) + aoff + m * 2048 + k * 1024); } while (0)
#define PG8_LDB(dst, b, h) do { _Pragma("unroll") for (int n = 0; n < 2; ++n) _Pragma("unroll") for (int k = 0; k < 2; ++k) dst[n][k] = *(const PG8_LAS bf16x8*)(lds + PG8_SB(b, h) + boff + n * 2048 + k * 1024); } while (0)
#define PG8_MMA(ai, bj, At, Bt) do { __builtin_amdgcn_s_setprio(1); _Pragma("unroll") for (int m = 0; m < 4; ++m) _Pragma("unroll") for (int n = 0; n < 2; ++n) _Pragma("unroll") for (int k = 0; k < 2; ++k) \
        acc[ai][bj][m][n] = __builtin_amdgcn_mfma_f32_16x16x32_bf16(Bt[n][k], At[m][k], acc[ai][bj][m][n], 0, 0, 0); __builtin_amdgcn_s_setprio(0); } while (0)
#define PG8_WAIT_V(n) asm volatile("s_waitcnt vmcnt(" #n ")" ::: "memory")
#define PG8_WAIT_L(n) asm volatile("s_waitcnt lgkmcnt(" #n ")" ::: "memory")
#define PG8_BAR __builtin_amdgcn_s_barrier()
#define PG8_SCHED __builtin_amdgcn_sched_barrier(0)
    Unit cur, nxt; int ui = 0;
    if (!S.next(0, cur)) return;
    f32x4 acc[2][2][4][2];
#pragma unroll
    for (int a = 0; a < 2; ++a)
#pragma unroll
        for (int b = 0; b < 2; ++b)
#pragma unroll
            for (int m = 0; m < 4; ++m)
#pragma unroll
                for (int n = 0; n < 2; ++n) acc[a][b][m][n] = (f32x4){0.f, 0.f, 0.f, 0.f};
    bf16x8 At[4][2], B0[2][2], B1[2][2];
    const char* cA = PG8_ABASE(cur.pm); const char* cB = (const char*)g.Bt + (size_t)cur.pn * tstepB;
    {
        const char* cA1 = PG8_KA(cA, 1);
        PG8_STAGE(PG8_SB(0, 0), cB, voffB); PG8_STAGE(PG8_SB(0, 1), cB + hstepB, voffB); PG8_STAGE(PG8_SA(0, 0), cA, voffA); PG8_STAGE(PG8_SA(0, 1), cA + hstepA, voffA);
        if (wr == 1) PG8_BAR;
        PG8_WAIT_V(2); PG8_BAR;
        PG8_STAGE(PG8_SB(1, 0), cB + kstep, voffB); PG8_STAGE(PG8_SA(1, 0), cA1, voffA); PG8_STAGE(PG8_SB(1, 1), cB + hstepB + kstep, voffB);
        PG8_WAIT_V(6); PG8_BAR;
    }
    for (;;) {
        const bool has_next = S.next(ui + 1, nxt);
        const char* nA = has_next ? PG8_ABASE(nxt.pm) : cA; const char* nB = has_next ? (const char*)g.Bt + (size_t)nxt.pn * tstepB : cB;
        for (int t = 0; t < nt; t += 2) {
            const bool last = (t == nt - 2);
            const char* a1 = PG8_KA(cA, t + 1);
            const char* a2 = last ? nA : PG8_KA(cA, t + 2); const char* b2 = last ? nB : cB + (size_t)(t + 2) * kstep;
            const char* a3 = last ? PG8_KA(nA, 1) : PG8_KA(cA, t + 3); const char* b3 = b2 + kstep;
            PG8_LDB(B0, 0, 0); PG8_LDB(B1, 0, 1); PG8_SCHED; PG8_LDA(At, 0, 0); PG8_STAGE(PG8_SA(1, 1), a1 + hstepA, voffA);
            PG8_WAIT_V(8); PG8_WAIT_L(0); PG8_BAR; PG8_MMA(0, 0, At, B0); PG8_MMA(0, 1, At, B1); PG8_BAR; PG8_SCHED;
            PG8_LDA(At, 0, 1); PG8_STAGE(PG8_SB(0, 0), b2, voffB); PG8_STAGE(PG8_SB(0, 1), b2 + hstepB, voffB); PG8_STAGE(PG8_SA(0, 0), a2, voffA);
            PG8_WAIT_V(8); PG8_WAIT_L(0); PG8_BAR; PG8_MMA(1, 0, At, B0); PG8_MMA(1, 1, At, B1); PG8_BAR; PG8_SCHED;
            PG8_LDB(B0, 1, 0); PG8_LDB(B1, 1, 1); PG8_SCHED; PG8_LDA(At, 1, 0); PG8_STAGE(PG8_SA(0, 1), a2 + hstepA, voffA);
            PG8_WAIT_V(8); PG8_WAIT_L(0); PG8_BAR; PG8_MMA(0, 0, At, B0); PG8_MMA(0, 1, At, B1); PG8_BAR; PG8_SCHED;
            PG8_LDA(At, 1, 1); PG8_STAGE(PG8_SB(1, 0), b3, voffB); PG8_STAGE(PG8_SB(1, 1), b3 + hstepB, voffB); PG8_STAGE(PG8_SA(1, 0), a3, voffA);
            PG8_WAIT_V(8); PG8_WAIT_L(0); PG8_BAR; PG8_MMA(1, 0, At, B0); PG8_MMA(1, 1, At, B1); PG8_BAR; PG8_SCHED;
        }
        if constexpr (ALIGN_EPI) { if (wr == 0) PG8_BAR; }
        E(acc, cur, wr, wc, fr, fq);
        if (!has_next) break;
#pragma unroll
        for (int a = 0; a < 2; ++a)
#pragma unroll
            for (int b = 0; b < 2; ++b)
#pragma unroll
                for (int m = 0; m < 4; ++m)
#pragma unroll
                    for (int n = 0; n < 2; ++n) acc[a][b][m][n] = (f32x4){0.f, 0.f, 0.f, 0.f};
        cur = nxt; cA = nA; cB = nB; ++ui;
        if constexpr (ALIGN_EPI) { if (wr == 1) PG8_BAR; }
    }
    PG8_WAIT_V(0);
    if constexpr (!ALIGN_EPI) { if (wr == 0) PG8_BAR; }
    PG8_BAR;
#undef PG8_ABASE
#undef PG8_KA
#undef PG8_SA
#undef PG8_SB
#undef PG8_STAGE
#undef PG8_LDA
#undef PG8_LDB
#undef PG8_MMA
#undef PG8_WAIT_V
#undef PG8_WAIT_L
#undef PG8_BAR
#undef PG8_SCHED
}
}
using pg8::bf16_t; using pg8::f32x4; using pg8::f32x2; using pg8::u32x4; using pg8::u32x2; using pg8::Unit; using pg8::cvt_pk_bf16;
#define LAS __attribute__((address_space(3)))
constexpr int BATCH = 8, SEQ = 4096, D = 1024, M = BATCH * SEQ, FF = 2816, FF2 = 5632;
constexpr int PADR = 8, SEQP = SEQ + PADR;
constexpr float RMS_EPS = 1e-6f, GN_EPS = 64e-5f;
constexpr size_t MiB = 1u << 20;
constexpr size_t WS_WSTAT = 2 * MiB;
constexpr size_t WJ_IN = 0, WJ_OUT = 4 * MiB, WJ_RKV = 6 * MiB, WJ_L2WA = 20 * MiB, WJ_L2G = 20 * MiB + 512 * 1024, WJ_O = 21 * MiB, WJ_STRIDE = 23 * MiB;
constexpr size_t WS_WFFN = 48 * MiB;
constexpr size_t WS_WDOWN = WS_WFFN + 11 * MiB;
constexpr size_t WS_A = 67 * MiB;
constexpr size_t WS_P = 134 * MiB;
constexpr size_t P_R = WS_P, P_K = WS_P + 64 * MiB, P_V = WS_P + 128 * MiB, P_LW = WS_P + 192 * MiB, P_LA = WS_P + 256 * MiB, P_WA = WS_P + 320 * MiB, P_GL = WS_P + 328 * MiB;
constexpr size_t P_U = WS_P, P_SV = WS_P + 64 * MiB;
constexpr size_t P_Z = WS_P, P_ACT = WS_P + 176 * MiB;
constexpr size_t WS_PA = WS_P + 352 * MiB, WS_PB = WS_PA + 2 * MiB, WS_PV = WS_PB + 2 * MiB;
constexpr size_t WS_END = WS_PV + 2 * MiB;

struct Args {
    const float* in[32]; float* out; unsigned char* ws; int ph_lo, ph_hi;
};
enum { I_X = 0, I_NMIX, I_NFFN, I_NFIN, I_SWIN, I_SBIN, I_SGV, I_SWS, I_SBS, I_SWOUT, I_MU, I_WR, I_WK, I_WV, I_WO, I_W0, I_W1, I_W2, I_A0, I_A1, I_A2, I_G1, I_G2, I_KK, I_KA, I_RK, I_LNW, I_LNB, I_FUP, I_FCW, I_FCB, I_FDN };

__device__ __forceinline__ float bf2f(unsigned short b) { return __uint_as_float((unsigned)b << 16); }
__device__ __forceinline__ float bflo(unsigned w) { return __uint_as_float(w << 16); }
__device__ __forceinline__ float bfhi(unsigned w) { return __uint_as_float(w & 0xffff0000u); }
__device__ __forceinline__ float wave_sum(float v) {
#pragma unroll
    for (int o = 1; o < 64; o <<= 1) v += __shfl_xor(v, o);
    return v;
}
__device__ __forceinline__ float row_rstd(const float* P, int row) { const f32x4* p = (const f32x4*)(P + (size_t)row * 16); const f32x4 a = p[0], b = p[1], c = p[2], d = p[3];
    const float s = ((a.x + a.y) + (a.z + a.w)) + ((b.x + b.y) + (b.z + b.w)) + ((c.x + c.y) + (c.z + c.w)) + ((d.x + d.y) + (d.z + d.w)); return rsqrtf(s * (1.f / D) + RMS_EPS); }
template <int CTRL> __device__ __forceinline__ float dpp_f(float v) { return __int_as_float(__builtin_amdgcn_mov_dpp(__float_as_int(v), CTRL, 0xf, 0xf, true)); }
__device__ __forceinline__ float sum8(float v) { v += dpp_f<0x141>(v); v += dpp_f<0xB1>(v); v += dpp_f<0x4E>(v); return v; }
__device__ __forceinline__ float sigmoidf_(float x) { return 1.f / (1.f + __expf(-x)); }

template <bool SCALE> struct EpiStore {
    static constexpr bool PERM = true;
    bf16_t* O; int ldc; int tsh; size_t split_stride; const float* ss;
    __device__ __forceinline__ void operator()(const f32x4 (&acc)[2][2][4][2], const Unit& u, int wr, int wc, int fr, int fq) const {
        bf16_t* base = O + (size_t)(u.pn >> tsh) * split_stride + (size_t)(u.pm * 256 + wr * 64 + fr) * ldc + (u.pn & ((1 << tsh) - 1)) * 256 + wc * 32 + 8 * fq;
        const int row0 = u.pm * 256 + wr * 64 + fr;
#pragma unroll
        for (int ai = 0; ai < 2; ++ai)
#pragma unroll
            for (int m = 0; m < 4; ++m) {
                const float rs = SCALE ? row_rstd(ss, row0 + ai * 128 + m * 16) : 1.f;
                bf16_t* rowp = base + (size_t)(ai * 128 + m * 16) * ldc;
#pragma unroll
                for (int bj = 0; bj < 2; ++bj) { const f32x4 v0 = acc[ai][bj][m][0] * rs, v1 = acc[ai][bj][m][1] * rs;
                    u32x4 w; w.x = cvt_pk_bf16(v0[0], v0[1]); w.y = cvt_pk_bf16(v0[2], v0[3]); w.z = cvt_pk_bf16(v1[0], v1[1]); w.w = cvt_pk_bf16(v1[2], v1[3]);
                    *(u32x4*)(rowp + bj * 128) = w; } }
    }
};
struct EpiSguIn {
    static constexpr bool PERM = true;
    bf16_t* U; bf16_t* V; const float* ss; const float* bias; float* ssv;
    __device__ __forceinline__ void operator()(const f32x4 (&acc)[2][2][4][2], const Unit& u, int wr, int wc, int fr, int fq) const {
        const bool isv = u.pn >= 4; bf16_t* base = isv ? V : U; const int colt = (u.pn & 3) * 256 + wc * 32 + 8 * fq, bcol = u.pn * 256 + wc * 32 + 8 * fq;
        f32x4 bv[2][2];
#pragma unroll
        for (int bj = 0; bj < 2; ++bj)
#pragma unroll
            for (int n = 0; n < 2; ++n) bv[bj][n] = *(const f32x4*)(bias + bcol + bj * 128 + 4 * n);
#pragma unroll
        for (int ai = 0; ai < 2; ++ai)
#pragma unroll
            for (int m = 0; m < 4; ++m) { const int row = u.pm * 256 + ai * 128 + wr * 64 + m * 16 + fr;
                const float rs = row_rstd(ss, row); float s = 0.f;
                bf16_t* rowp = base + (size_t)row * D + colt;
#pragma unroll
                for (int bj = 0; bj < 2; ++bj) { f32x4 v0 = acc[ai][bj][m][0] * rs + bv[bj][0], v1 = acc[ai][bj][m][1] * rs + bv[bj][1];
                    const f32x2 a = pg8::gelu_pk((f32x2){v0[0], v0[1]}), b = pg8::gelu_pk((f32x2){v0[2], v0[3]}), c = pg8::gelu_pk((f32x2){v1[0], v1[1]}), d = pg8::gelu_pk((f32x2){v1[2], v1[3]});
                    s += (a.x * a.x + a.y * a.y) + (b.x * b.x + b.y * b.y) + (c.x * c.x + c.y * c.y) + (d.x * d.x + d.y * d.y);
                    u32x4 w; w.x = cvt_pk_bf16(a.x, a.y); w.y = cvt_pk_bf16(b.x, b.y); w.z = cvt_pk_bf16(c.x, c.y); w.w = cvt_pk_bf16(d.x, d.y);
                    *(u32x4*)(rowp + bj * 128) = w; }
                if (isv) { s += __shfl_xor(s, 16); s += __shfl_xor(s, 32); if (fq == 0) ssv[(size_t)row * 16 + (u.pn - 4) * 4 + wc] = s; } }
    }
};
struct EpiResid {
    static constexpr bool PERM = true;
    float* h; bf16_t* hb; float* ssn;
    __device__ __forceinline__ void operator()(const f32x4 (&acc)[2][2][4][2], const Unit& u, int wr, int wc, int fr, int fq) const {
        const int colt = u.pn * 256 + wc * 32 + 8 * fq;
#pragma unroll
        for (int ai = 0; ai < 2; ++ai)
#pragma unroll
            for (int m = 0; m < 4; ++m) { const int row = u.pm * 256 + ai * 128 + wr * 64 + m * 16 + fr; float s = 0.f;
                float* hp = h + (size_t)row * D + colt; bf16_t* bp = hb + (size_t)row * D + colt;
#pragma unroll
                for (int bj = 0; bj < 2; ++bj) { const f32x4 v0 = *(const f32x4*)(hp + bj * 128) + acc[ai][bj][m][0], v1 = *(const f32x4*)(hp + bj * 128 + 4) + acc[ai][bj][m][1];
                    *(f32x4*)(hp + bj * 128) = v0; *(f32x4*)(hp + bj * 128 + 4) = v1;
                    s += (v0[0] * v0[0] + v0[1] * v0[1]) + (v0[2] * v0[2] + v0[3] * v0[3]) + (v1[0] * v1[0] + v1[1] * v1[1]) + (v1[2] * v1[2] + v1[3] * v1[3]);
                    u32x4 w; w.x = cvt_pk_bf16(v0[0], v0[1]); w.y = cvt_pk_bf16(v0[2], v0[3]); w.z = cvt_pk_bf16(v1[0], v1[1]); w.w = cvt_pk_bf16(v1[2], v1[3]);
                    *(u32x4*)(bp + bj * 128) = w; }
                s += __shfl_xor(s, 16); s += __shfl_xor(s, 32); if (fq == 0) ssn[(size_t)row * 16 + u.pn * 4 + wc] = s; }
    }
};
template <int CTRL> __device__ __forceinline__ f32x4 dpp4(f32x4 v) { f32x4 r; r.x = dpp_f<CTRL>(v.x); r.y = dpp_f<CTRL>(v.y); r.z = dpp_f<CTRL>(v.z); r.w = dpp_f<CTRL>(v.w); return r; }
struct EpiFfnUp {
    static constexpr bool PERM = true;
    bf16_t* ACT; const float* ss; const float* cw; const float* cb;
    __device__ __forceinline__ void conv4(f32x4& z0, f32x4& z1, f32x4& z2, f32x4& z3, const float (&rs)[4], const int (&tt)[4], const float* wcol, const float* bcol, int fr) const {
        const f32x4 w0 = *(const f32x4*)wcol, w1 = *(const f32x4*)(wcol + FF2), w2 = *(const f32x4*)(wcol + 2 * FF2), bb = *(const f32x4*)bcol;
#pragma unroll
        for (int e = 0; e < 4; ++e) {
            float cur = z3[e] * rs[3], c1 = dpp_f<0x121>(cur), c2 = dpp_f<0x122>(cur);
#define CONV_STEP(ZM, ZP, MI, HASP) { float prv = cur, p1 = c1, p2 = c2; if (HASP) { prv = ZP[e] * rs[MI - (HASP)]; p1 = dpp_f<0x121>(prv); p2 = dpp_f<0x122>(prv); } \
            float y1 = (fr == 0) ? p1 : c1, y2 = (fr < 2) ? p2 : c2; if (tt[MI] < 1) y1 = 0.f; if (tt[MI] < 2) y2 = 0.f; \
            ZM[e] = w0[e] * y2 + w1[e] * y1 + w2[e] * cur + bb[e]; cur = prv; c1 = p1; c2 = p2; }
            CONV_STEP(z3, z2, 3, 1) CONV_STEP(z2, z1, 2, 1) CONV_STEP(z1, z0, 1, 1) CONV_STEP(z0, z0, 0, 0)
#undef CONV_STEP
            asm volatile("" : "+v"(z0[e]), "+v"(z1[e]), "+v"(z2[e]), "+v"(z3[e]));
        }
    }
    __device__ __forceinline__ void operator()(f32x4 (&acc)[2][2][4][2], const Unit& u, int wr, int wc, int fr, int fq) const {
        const int f0 = u.pn * 128 + wc * 32 + 8 * fq;
#pragma unroll
        for (int ai = 0; ai < 2; ++ai) {
            const int gbase = u.pm * 248 - 2 + 62 * (2 * ai + wr) + fr;
            float rs[4]; int tt[4];
#pragma unroll
            for (int m = 0; m < 4; ++m) { const int g = gbase + 16 * m; const int gc = g < 0 ? 0 : (g >= M ? M - 1 : g); rs[m] = row_rstd(ss, gc); tt[m] = g & (SEQ - 1); asm volatile("" : "+v"(rs[m]) :: "memory"); }
#pragma unroll
            for (int n = 0; n < 2; ++n) {
                conv4(acc[ai][0][0][n], acc[ai][0][1][n], acc[ai][0][2][n], acc[ai][0][3][n], rs, tt, cw + f0 + 4 * n, cb + f0 + 4 * n, fr);
                asm volatile("" ::: "memory");
                conv4(acc[ai][1][0][n], acc[ai][1][1][n], acc[ai][1][2][n], acc[ai][1][3][n], rs, tt, cw + FF + f0 + 4 * n, cb + FF + f0 + 4 * n, fr);
                asm volatile("" ::: "memory");
#pragma unroll
                for (int m = 0; m < 4; ++m) { const int g = gbase + 16 * m;
                    if ((m > 0 || fr >= 2) && g < M) { const f32x4 gt = acc[ai][0][m][n], vl = acc[ai][1][m][n]; f32x4 o;
#pragma unroll
                        for (int e = 0; e < 4; ++e) o[e] = gt[e] * sigmoidf_(gt[e]) * vl[e];
                        u32x2 w; w.x = cvt_pk_bf16(o[0], o[1]); w.y = cvt_pk_bf16(o[2], o[3]);
                        *(u32x2*)(ACT + (size_t)g * FF + f0 + 4 * n) = w; } }
            }
        }
    }
};
struct EpiRkv {
    static constexpr bool PERM = true;
    bf16_t* R; bf16_t* WA; bf16_t* GL;
    __device__ __forceinline__ void operator()(const f32x4 (&acc)[2][2][4][2], const Unit& u, int wr, int wc, int fr, int fq) const {
        const int mode = u.pn < 12 ? 0 : (u.pn == 12 ? 1 : 2);
        bf16_t* base; int ldc, colt;
        if (mode == 0) { base = R + (size_t)(u.pn >> 2) * ((size_t)M * D); ldc = D; colt = (u.pn & 3) * 256 + wc * 32 + 8 * fq; }
        else if (mode == 1) { base = WA; ldc = 128; colt = wc * 32 + 8 * fq; }
        else { base = GL; ldc = 256; colt = wc * 32 + 8 * fq; }
#pragma unroll
        for (int ai = 0; ai < 2; ++ai)
#pragma unroll
            for (int m = 0; m < 4; ++m) { const int row = u.pm * 256 + ai * 128 + wr * 64 + m * 16 + fr;
                bf16_t* rowp = base + (size_t)row * ldc + colt;
#pragma unroll
                for (int bj = 0; bj < 2; ++bj) { f32x4 v0 = acc[ai][bj][m][0], v1 = acc[ai][bj][m][1];
                    if (mode == 1) { if (bj == 1) continue;
                        if (wc < 2) {
#pragma unroll
                            for (int e = 0; e < 4; ++e) { v0[e] = tanhf(v0[e]); v1[e] = tanhf(v1[e]); } } }
                    else if (mode == 2) {
#pragma unroll
                        for (int e = 0; e < 4; ++e) { v0[e] = sigmoidf_(v0[e]); v1[e] = sigmoidf_(v1[e]); } }
                    u32x4 w; w.x = cvt_pk_bf16(v0[0], v0[1]); w.y = cvt_pk_bf16(v0[2], v0[3]); w.z = cvt_pk_bf16(v1[0], v1[1]); w.w = cvt_pk_bf16(v1[2], v1[3]);
                    *(u32x4*)(rowp + bj * 128) = w; } }
    }
};

typedef const __attribute__((address_space(4))) Args* CA;
struct Ctx { LAS unsigned char* lds; int tid, lane, wave, G, bid; };

__device__ __forceinline__ void conv_mat(const Ctx& c, const float* src, int ldsrc, int K, int N, int Kp, int Np, bf16_t* dst, int ldd, int n_off, int k_off, const float* sc, int mode, int rot) {
    LAS float* tile = (LAS float*)c.lds;
    const int nnb = Np / 64, nit = (Kp / 64) * nnb; const int start = (c.bid + c.G - (rot % c.G)) % c.G;
    for (int it = start; it < nit; it += c.G) {
        const int kb = it / nnb, nb = it % nnb, k0 = kb * 64, n0 = nb * 64;
#pragma unroll
        for (int j = 0; j < 8; ++j) { const int kk = (c.tid >> 6) + 8 * j, nn = c.tid & 63, k = k0 + kk, n = n0 + nn; float v = 0.f;
            if (src && k < K && n < N) { v = src[(size_t)k * ldsrc + n]; if (mode == 1) v *= sc[k]; else if (mode == 2) v *= (1.f - sc[k]); }
            tile[nn * 65 + kk] = v; }
        __syncthreads();
        { const int nn = c.tid >> 3, cc = c.tid & 7; const LAS float* s = tile + nn * 65 + 8 * cc;
            u32x4 o; o.x = cvt_pk_bf16(s[0], s[1]); o.y = cvt_pk_bf16(s[2], s[3]); o.z = cvt_pk_bf16(s[4], s[5]); o.w = cvt_pk_bf16(s[6], s[7]);
            *(u32x4*)(dst + (size_t)(n_off + n0 + nn) * ldd + k_off + k0 + 8 * cc) = o; }
        __syncthreads();
    }
}

__device__ __forceinline__ void phase_prologue(const Ctx& c, CA a) {
    float* ss = (float*)(a->ws + WS_PA);
    const int gw = c.bid * 8 + c.wave, NGW = c.G * 8;
    bf16_t* hb = (bf16_t*)(a->ws + WS_A);
    for (int m = gw; m < M; m += NGW) {
        const f32x4* xr = (const f32x4*)(a->in[I_X] + (size_t)m * D) + c.lane; f32x4* hr = (f32x4*)(a->out + (size_t)m * D) + c.lane; u32x2* br = (u32x2*)(hb + (size_t)m * D) + c.lane;
        float s = 0.f;
#pragma unroll
        for (int j = 0; j < 4; ++j) { const f32x4 v = xr[64 * j]; s += (v.x * v.x + v.y * v.y) + (v.z * v.z + v.w * v.w); hr[64 * j] = v; u32x2 w; w.x = cvt_pk_bf16(v.x, v.y); w.y = cvt_pk_bf16(v.z, v.w); br[64 * j] = w; }
        s = wave_sum(s); if (c.lane < 16) ss[(size_t)m * 16 + c.lane] = c.lane == 0 ? s : 0.f;
    }
    int rot = 0;
    for (int j = 0; j < 2; ++j) {
        unsigned char* wj = a->ws + WS_WSTAT + (size_t)j * WJ_STRIDE;
        conv_mat(c, a->in[I_SWIN] + (size_t)j * D * 2048, 2048, D, 2048, D, 2048, (bf16_t*)(wj + WJ_IN), D, 0, 0, a->in[I_NMIX] + (size_t)(2 * j) * D, 1, rot); rot += 512;
        conv_mat(c, a->in[I_SWOUT] + (size_t)j * D * D, D, D, D, D, D, (bf16_t*)(wj + WJ_OUT), D, 0, 0, nullptr, 0, rot); rot += 256;
        const float* mu = a->in[I_MU] + (size_t)j * 6 * D; bf16_t* rkv = (bf16_t*)(wj + WJ_RKV);
#define CONV_BIG(IDX, Q, MUB) do { conv_mat(c, a->in[IDX] + (size_t)j * D * D, D, D, D, D, D, rkv, 2048, (Q) * 1024, 0, mu + (MUB) * D, 2, rot); rot += 256; \
            conv_mat(c, a->in[IDX] + (size_t)j * D * D, D, D, D, D, D, rkv, 2048, (Q) * 1024, 1024, mu + (MUB) * D, 1, rot); rot += 256; } while (0)
        CONV_BIG(I_WR, 0, 0); CONV_BIG(I_WK, 1, 2); CONV_BIG(I_WV, 2, 3);
#undef CONV_BIG
        conv_mat(c, a->in[I_W1] + (size_t)j * D * 64, 64, D, 64, D, 64, rkv, 2048, 3072, 0, mu + 1 * D, 2, rot); rot += 16;
        conv_mat(c, a->in[I_W1] + (size_t)j * D * 64, 64, D, 64, D, 64, rkv, 2048, 3072, 1024, mu + 1 * D, 1, rot); rot += 16;
        conv_mat(c, a->in[I_A1] + (size_t)j * D * 64, 64, D, 64, D, 64, rkv, 2048, 3136, 0, mu + 4 * D, 2, rot); rot += 16;
        conv_mat(c, a->in[I_A1] + (size_t)j * D * 64, 64, D, 64, D, 64, rkv, 2048, 3136, 1024, mu + 4 * D, 1, rot); rot += 16;
        conv_mat(c, nullptr, 0, 0, 0, 2048, 128, rkv, 2048, 3200, 0, nullptr, 0, rot); rot += 64;
        conv_mat(c, a->in[I_G1] + (size_t)j * D * 160, 160, D, 160, D, 256, rkv, 2048, 3328, 0, mu + 5 * D, 2, rot); rot += 64;
        conv_mat(c, a->in[I_G1] + (size_t)j * D * 160, 160, D, 160, D, 256, rkv, 2048, 3328, 1024, mu + 5 * D, 1, rot); rot += 64;
        bf16_t* l2wa = (bf16_t*)(wj + WJ_L2WA);
        conv_mat(c, a->in[I_W2] + (size_t)j * 64 * D, D, 64, D, 64, D, l2wa, 128, 0, 0, nullptr, 0, rot); rot += 16;
        conv_mat(c, nullptr, 0, 0, 0, 64, D, l2wa, 128, 0, 64, nullptr, 0, rot); rot += 16;
        conv_mat(c, nullptr, 0, 0, 0, 64, D, l2wa, 128, 1024, 0, nullptr, 0, rot); rot += 16;
        conv_mat(c, a->in[I_A2] + (size_t)j * 64 * D, D, 64, D, 64, D, l2wa, 128, 1024, 64, nullptr, 0, rot); rot += 16;
        conv_mat(c, a->in[I_G2] + (size_t)j * 160 * D, D, 160, D, 256, D, (bf16_t*)(wj + WJ_L2G), 256, 0, 0, nullptr, 0, rot); rot += 64;
        conv_mat(c, a->in[I_WO] + (size_t)j * D * D, D, D, D, D, D, (bf16_t*)(wj + WJ_O), D, 0, 0, nullptr, 0, rot); rot += 256;
    }
}
__device__ __forceinline__ void phase_ffn_weights(const Ctx& c, CA a, int layer) {
    for (int pn = 0; pn < FF / 128; ++pn) {
        conv_mat(c, a->in[I_FUP] + (size_t)layer * D * FF2 + pn * 128, FF2, D, 128, D, 128, (bf16_t*)(a->ws + WS_WFFN), D, pn * 256, 0, a->in[I_NFFN] + (size_t)layer * D, 1, pn * 64);
        conv_mat(c, a->in[I_FUP] + (size_t)layer * D * FF2 + FF + pn * 128, FF2, D, 128, D, 128, (bf16_t*)(a->ws + WS_WFFN), D, pn * 256 + 128, 0, a->in[I_NFFN] + (size_t)layer * D, 1, pn * 64 + 32);
    }
    conv_mat(c, a->in[I_FDN] + (size_t)layer * FF * D, D, FF, D, FF, D, (bf16_t*)(a->ws + WS_WDOWN), FF, 0, 0, nullptr, 0, 128);
}

__device__ __forceinline__ void phase_sgu_spatial(const Ctx& c, CA a, int j, int rp) {
    typedef short bf16x8 __attribute__((ext_vector_type(8)));
    bf16_t* U = (bf16_t*)(a->ws + P_U); const bf16_t* V = (const bf16_t*)(a->ws + P_SV); bf16_t* UO = rp ? (bf16_t*)(a->ws + P_SV) : U;
    const float* ssv = (const float*)(a->ws + WS_PV);
    LAS bf16_t* WL = (LAS bf16_t*)c.lds; LAS bf16_t* VT = WL + 128 * 136;
    const int g = c.bid & 15;
    const float* Ws = a->in[I_SWS] + ((size_t)j * 16 + g) * 128 * 128; const float* bs = a->in[I_SBS] + ((size_t)j * 16 + g) * 128; const float* gv = a->in[I_SGV] + (size_t)j * D + g * 64;
    __syncthreads();
    { const int t = c.tid >> 2, s0 = (c.tid & 3) * 32; const float* wp = Ws + (size_t)t * 128 + s0;
#pragma unroll
      for (int q = 0; q < 4; ++q) { f32x4 x0 = *(const f32x4*)(wp + 8 * q), x1 = *(const f32x4*)(wp + 8 * q + 4);
#pragma unroll
          for (int e = 0; e < 4; ++e) { if (s0 + 8 * q + e > t) x0[e] = 0.f; if (s0 + 8 * q + 4 + e > t) x1[e] = 0.f; }
          u32x4 w; w.x = cvt_pk_bf16(x0[0], x0[1]); w.y = cvt_pk_bf16(x0[2], x0[3]); w.z = cvt_pk_bf16(x1[0], x1[1]); w.w = cvt_pk_bf16(x1[2], x1[3]);
          *(LAS u32x4*)(WL + t * 136 + s0 + 8 * q) = w; } }
    const int w8 = c.wave, fr = c.lane & 15, fq = c.lane >> 4, t0 = 16 * w8, nk = (w8 >> 1) + 1;
    const int vs = c.tid >> 2, vc = (c.tid & 3) * 16;
    f32x4 gq[4];
#pragma unroll
    for (int e = 0; e < 4; ++e) gq[e] = *(const f32x4*)(gv + vc + 4 * e);
    const float bb = bs[t0 + fr];
    for (int ub = c.bid >> 4; ub < M / 128; ub += c.G >> 4) {
        const int m0 = ub * 128;
        { const bf16_t* vp = V + (size_t)(m0 + vs) * D + g * 64 + vc; const u32x4 v0 = *(const u32x4*)vp, v1 = *(const u32x4*)(vp + 8);
          const float rs = row_rstd(ssv, m0 + vs);
          const unsigned vw[8] = {v0.x, v0.y, v0.z, v0.w, v1.x, v1.y, v1.z, v1.w};
#pragma unroll
          for (int e = 0; e < 8; ++e) { const float lo = bflo(vw[e]) * rs * gq[e >> 1][(2 * e) & 3], hi = bfhi(vw[e]) * rs * gq[e >> 1][(2 * e + 1) & 3];
              const unsigned pk = cvt_pk_bf16(lo, hi);
              VT[(vc + 2 * e) * 136 + vs] = (bf16_t)(pk & 0xffffu); VT[(vc + 2 * e + 1) * 136 + vs] = (bf16_t)(pk >> 16); } }
        __syncthreads();
        f32x4 acc[4];
#pragma unroll
        for (int ct = 0; ct < 4; ++ct) acc[ct] = (f32x4){0.f, 0.f, 0.f, 0.f};
        for (int k = 0; k < nk; ++k) {
            const bf16x8 wf = *(const LAS bf16x8*)(WL + (t0 + fr) * 136 + 32 * k + 8 * fq);
#pragma unroll
            for (int ct = 0; ct < 4; ++ct) { const bf16x8 vf = *(const LAS bf16x8*)(VT + (16 * ct + fr) * 136 + 32 * k + 8 * fq);
                acc[ct] = __builtin_amdgcn_mfma_f32_16x16x32_bf16(vf, wf, acc[ct], 0, 0, 0); }
        }
        { const size_t ro = (size_t)(m0 + t0 + fr) * D + g * 64 + 4 * fq;
#pragma unroll
          for (int ct = 0; ct < 4; ++ct) { const u32x2 uu = *(const u32x2*)(U + ro + 16 * ct); const f32x4 o = acc[ct] + bb;
              u32x2 w; w.x = cvt_pk_bf16(bflo(uu.x) * o[0], bfhi(uu.x) * o[1]); w.y = cvt_pk_bf16(bflo(uu.y) * o[2], bfhi(uu.y) * o[3]);
              *(u32x2*)(UO + ro + 16 * ct) = w; } }
        __syncthreads();
    }
}

__device__ __forceinline__ void phase_ffn_conv(const Ctx& c, CA a, int layer, int half) {
    const bf16_t* Z = (const bf16_t*)(a->ws + P_Z); bf16_t* ACT = (bf16_t*)(a->ws + P_ACT) + (size_t)half * (M / 2) * FF;
    const float* cw = a->in[I_FCW] + (size_t)layer * 3 * FF2; const float* cb = a->in[I_FCB] + (size_t)layer * FF2;
    const int gt = c.bid * 512 + c.tid, NT = c.G * 512;
    for (int idx = gt; idx < (M / 2) * (FF / 8); idx += NT) {
        const int ml = idx / (FF / 8), f = (idx % (FF / 8)) * 8, t = ml & (SEQ - 1);
        float gsum[8], vsum[8];
#pragma unroll
        for (int e = 0; e < 8; ++e) { gsum[e] = cb[f + e]; vsum[e] = cb[FF + f + e]; }
#pragma unroll
        for (int jj = 0; jj < 3; ++jj) { const int dt = 2 - jj; if (t - dt < 0) continue;
            const u32x4 zg = *(const u32x4*)(Z + (size_t)(ml - dt) * FF2 + f), zv = *(const u32x4*)(Z + (size_t)(ml - dt) * FF2 + FF + f);
            const float* wg = cw + (size_t)jj * FF2 + f; const float* wv = wg + FF;
            const unsigned zgw[4] = {zg.x, zg.y, zg.z, zg.w}, zvw[4] = {zv.x, zv.y, zv.z, zv.w};
#pragma unroll
            for (int e = 0; e < 4; ++e) { gsum[2 * e] += wg[2 * e] * bflo(zgw[e]); gsum[2 * e + 1] += wg[2 * e + 1] * bfhi(zgw[e]); vsum[2 * e] += wv[2 * e] * bflo(zvw[e]); vsum[2 * e + 1] += wv[2 * e + 1] * bfhi(zvw[e]); } }
        float o[8];
#pragma unroll
        for (int e = 0; e < 8; ++e) o[e] = gsum[e] * sigmoidf_(gsum[e]) * vsum[e];
        u32x4 w; w.x = cvt_pk_bf16(o[0], o[1]); w.y = cvt_pk_bf16(o[2], o[3]); w.z = cvt_pk_bf16(o[4], o[5]); w.w = cvt_pk_bf16(o[6], o[7]);
        *(u32x4*)(ACT + (size_t)ml * FF + f) = w;
    }
}

__device__ __forceinline__ void phase_rwkv_prep(const Ctx& c, CA a, int layer) {
    const float* ss = (const float*)(a->ws + WS_PA); const float* g = a->in[I_NMIX] + (size_t)layer * D;
    bf16_t* hn = (bf16_t*)(a->ws + WS_A);
    const int gw = c.bid * 8 + c.wave, NGW = c.G * 8;
    f32x4 gg[4];
#pragma unroll
    for (int j = 0; j < 4; ++j) gg[j] = *((const f32x4*)g + c.lane + 64 * j);
    for (int m = gw; m < M; m += NGW) {
        const float rs = row_rstd(ss, m);
        const f32x4* hr = (const f32x4*)(a->out + (size_t)m * D) + c.lane; const int prow = (m >> 12) * SEQP + PADR + (m & (SEQ - 1));
        u32x2* br = (u32x2*)(hn + (size_t)prow * D) + c.lane;
#pragma unroll
        for (int j = 0; j < 4; ++j) { const f32x4 v = hr[64 * j] * rs * gg[j]; u32x2 w; w.x = cvt_pk_bf16(v.x, v.y); w.y = cvt_pk_bf16(v.z, v.w); br[64 * j] = w; }
    }
    for (int r = gw; r < BATCH * PADR; r += NGW) { const int prow = (r / PADR) * SEQP + (r % PADR); u32x2* br = (u32x2*)(hn + (size_t)prow * D) + c.lane;
#pragma unroll
        for (int j = 0; j < 4; ++j) br[64 * j] = (u32x2){0u, 0u}; }
}

__device__ __forceinline__ f32x4 bf4lo(u32x4 w) { return (f32x4){bflo(w.x), bfhi(w.x), bflo(w.y), bfhi(w.y)}; }
__device__ __forceinline__ f32x4 bf4hi(u32x4 w) { return (f32x4){bflo(w.z), bfhi(w.z), bflo(w.w), bfhi(w.w)}; }
__device__ __forceinline__ float hsum4(f32x4 p) { return (p.x + p.y) + (p.z + p.w); }
__device__ __forceinline__ void phase_scan(const Ctx& c, CA a, int j, int rp_unused) {
    LAS float* BIG = (LAS float*)c.lds; LAS float* VB = BIG + 2 * 5 * 2048; LAS float* YB = VB + 3 * 2048; LAS float* BON = YB + 2 * 2048;
    bf16_t* R = (bf16_t*)(a->ws + P_R); const bf16_t* Kb = (const bf16_t*)(a->ws + P_K); const bf16_t* Vb = (const bf16_t*)(a->ws + P_V);
    const bf16_t* LWb = (const bf16_t*)(a->ws + P_LW); const bf16_t* LAb = (const bf16_t*)(a->ws + P_LA); const bf16_t* Gb = (const bf16_t*)(a->ws + WS_A);
    const bool cons = c.tid < 256;
    constexpr int NCH = SEQ / 32;
    for (int unit = c.bid; unit < BATCH * 16; unit += c.G) {
        const int b = unit >> 4, hh = unit & 15;
        __syncthreads();
        if (cons) {
            const int rp = c.tid >> 3, q = c.tid & 7;
            f32x4 S00 = (f32x4){0.f, 0.f, 0.f, 0.f}, S01 = S00, S10 = S00, S11 = S00;
            __syncthreads();
            for (int i = 0; i <= NCH; ++i) {
                if (i < NCH) {
                    const LAS float* bg = BIG + (i & 1) * 5 * 2048 + 8 * q;
                    const LAS f32x4* pw = (const LAS f32x4*)bg; const LAS f32x4* pa = (const LAS f32x4*)(bg + 2048); const LAS f32x4* pb = (const LAS f32x4*)(bg + 2 * 2048);
                    const LAS f32x4* pk = (const LAS f32x4*)(bg + 3 * 2048); const LAS f32x4* pr = (const LAS f32x4*)(bg + 4 * 2048);
                    const LAS float* pv = VB + (i % 3) * 2048 + 2 * rp; LAS float* py = YB + (i & 1) * 2048 + 2 * rp;
                    f32x4 a0v = pa[0], a1v = pa[1], w0v = pw[0], w1v = pw[1], b0v = pb[0], b1v = pb[1], k0v = pk[0], k1v = pk[1], r0v = pr[0], r1v = pr[1];
                    f32x2 vv = *(const LAS f32x2*)pv;
#pragma unroll 2
                    for (int t = 0; t < 32; ++t) {
                        const int tn = (t + 1) & 31;
                        const f32x4 na0 = pa[tn * 16], na1 = pa[tn * 16 + 1], nw0 = pw[tn * 16], nw1 = pw[tn * 16 + 1], nb0 = pb[tn * 16], nb1 = pb[tn * 16 + 1],
                                    nk0 = pk[tn * 16], nk1 = pk[tn * 16 + 1], nr0 = pr[tn * 16], nr1 = pr[tn * 16 + 1];
                        const f32x2 nvv = *(const LAS f32x2*)(pv + tn * 64);
                        const float sa0 = sum8(hsum4(S00 * a0v + S01 * a1v)), sa1 = sum8(hsum4(S10 * a0v + S11 * a1v));
                        S00 = S00 * w0v + sa0 * b0v + vv.x * k0v; S01 = S01 * w1v + sa0 * b1v + vv.x * k1v;
                        S10 = S10 * w0v + sa1 * b0v + vv.y * k0v; S11 = S11 * w1v + sa1 * b1v + vv.y * k1v;
                        const float y0 = sum8(hsum4(S00 * r0v + S01 * r1v)), y1 = sum8(hsum4(S10 * r0v + S11 * r1v));
                        if (q == 0) *(LAS f32x2*)(py + t * 64) = (f32x2){y0, y1};
                        a0v = na0; a1v = na1; w0v = nw0; w1v = nw1; b0v = nb0; b1v = nb1; k0v = nk0; k1v = nk1; r0v = nr0; r1v = nr1; vv = nvv;
                    }
                }
                __syncthreads();
            }
        } else {
            const int pt = c.tid - 256, st = pt >> 3, sc = (pt & 7) * 8, ch = hh * 64 + sc;
            const float* pp = a->in[I_W0] + (size_t)j * D + ch; const f32x4 w0a = *(const f32x4*)pp, w0b = *(const f32x4*)(pp + 4);
            pp = a->in[I_A0] + (size_t)j * D + ch; const f32x4 a0a = *(const f32x4*)pp, a0b = *(const f32x4*)(pp + 4);
            pp = a->in[I_KK] + (size_t)j * D + ch; const f32x4 kka = *(const f32x4*)pp, kkb = *(const f32x4*)(pp + 4);
            pp = a->in[I_KA] + (size_t)j * D + ch; const f32x4 kaa = *(const f32x4*)pp, kab = *(const f32x4*)(pp + 4);
            pp = a->in[I_RK] + (size_t)j * D + ch; const f32x4 rka = *(const f32x4*)pp, rkb = *(const f32x4*)(pp + 4);
            pp = a->in[I_LNW] + (size_t)j * D + ch; const f32x4 lwa = *(const f32x4*)pp, lwb = *(const f32x4*)(pp + 4);
            pp = a->in[I_LNB] + (size_t)j * D + ch; const f32x4 lba = *(const f32x4*)pp, lbb = *(const f32x4*)(pp + 4);
            const size_t gbase = ((size_t)b * SEQ + st) * D + ch;
            u32x4 qr = *(const u32x4*)(R + gbase), qk = *(const u32x4*)(Kb + gbase), qv = *(const u32x4*)(Vb + gbase), qlw = *(const u32x4*)(LWb + gbase), qla = *(const u32x4*)(LAb + gbase), qg = qr;
#define SCAN_STAGE(n) { \
                f32x4 rr[2] = {bf4lo(qr), bf4hi(qr)}, kk_[2] = {bf4lo(qk), bf4hi(qk)}, vv_[2] = {bf4lo(qv), bf4hi(qv)}, lw_[2] = {bf4lo(qlw), bf4hi(qlw)}, la_[2] = {bf4lo(qla), bf4hi(qla)}; \
                const f32x4 w0_[2] = {w0a, w0b}, a0_[2] = {a0a, a0b}, kkp_[2] = {kka, kkb}, kap_[2] = {kaa, kab}, rkp_[2] = {rka, rkb}; \
                f32x4 dec[2], av[2], kn[2], kp[2]; float n2 = 0.f, bon = 0.f; \
                _Pragma("unroll") for (int h2 = 0; h2 < 2; ++h2) _Pragma("unroll") for (int e = 0; e < 4; ++e) { \
                    const float xw = -(w0_[h2][e] + lw_[h2][e]); const float sp = xw > 20.f ? xw : log1pf(expf(xw)); \
                    dec[h2][e] = expf(-expf(-sp - 0.5f)); av[h2][e] = 1.f / (1.f + expf(-(a0_[h2][e] + la_[h2][e]))); \
                    kn[h2][e] = kk_[h2][e] * kkp_[h2][e]; n2 += kn[h2][e] * kn[h2][e]; \
                    kp[h2][e] = kk_[h2][e] * (1.f + (av[h2][e] - 1.f) * kap_[h2][e]); bon += rr[h2][e] * kp[h2][e] * rkp_[h2][e]; } \
                n2 = sum8(n2); bon = sum8(bon); const float inv = rsqrtf(fmaxf(n2, 1e-24f)); \
                LAS float* bg = BIG + ((n) & 1) * 5 * 2048 + st * 64 + sc; \
                _Pragma("unroll") for (int h2 = 0; h2 < 2; ++h2) { const f32x4 kq = kn[h2] * inv; \
                    *(LAS f32x4*)(bg + 4 * h2) = dec[h2]; *(LAS f32x4*)(bg + 2048 + 4 * h2) = -kq; *(LAS f32x4*)(bg + 2 * 2048 + 4 * h2) = kq * av[h2]; \
                    *(LAS f32x4*)(bg + 3 * 2048 + 4 * h2) = kp[h2]; *(LAS f32x4*)(bg + 4 * 2048 + 4 * h2) = rr[h2]; \
                    *(LAS f32x4*)(VB + ((n) % 3) * 2048 + st * 64 + sc + 4 * h2) = vv_[h2]; } \
                if ((pt & 7) == 0) BON[((n) % 3) * 32 + st] = bon; }
#define SCAN_LOAD(n) { const size_t go = gbase + (size_t)(n) * 32 * D; qr = *(const u32x4*)(R + go); qk = *(const u32x4*)(Kb + go); qv = *(const u32x4*)(Vb + go); qlw = *(const u32x4*)(LWb + go); qla = *(const u32x4*)(LAb + go); }
            SCAN_STAGE(0)
            SCAN_LOAD(1)
            __syncthreads();
            for (int i = 0; i <= NCH; ++i) {
                u32x4 nr = qr, nk = qk, nv = qv, nlw = qlw, nla = qla, ng = qg;
                if (i + 2 < NCH) { const size_t go = gbase + (size_t)(i + 2) * 32 * D; nr = *(const u32x4*)(R + go); nk = *(const u32x4*)(Kb + go); nv = *(const u32x4*)(Vb + go); nlw = *(const u32x4*)(LWb + go); nla = *(const u32x4*)(LAb + go); }
                if (i < NCH) ng = *(const u32x4*)(Gb + gbase + (size_t)i * 32 * D);
                if (i >= 1) {
                    const int n = i - 1; const LAS float* yp = YB + (n & 1) * 2048 + st * 64 + sc; const LAS float* vp = VB + (n % 3) * 2048 + st * 64 + sc;
                    const f32x4 y0 = *(const LAS f32x4*)yp, y1 = *(const LAS f32x4*)(yp + 4), v0 = *(const LAS f32x4*)vp, v1 = *(const LAS f32x4*)(vp + 4); const float bon = BON[(n % 3) * 32 + st];
                    const float mean = sum8(hsum4(y0) + hsum4(y1)) * (1.f / 64.f); const f32x4 d0 = y0 - mean, d1 = y1 - mean;
                    const float rstd = rsqrtf(sum8(hsum4(d0 * d0) + hsum4(d1 * d1)) * (1.f / 64.f) + GN_EPS);
                    const f32x4 o0 = (d0 * rstd * lwa + lba + bon * v0) * bf4lo(qg), o1 = (d1 * rstd * lwb + lbb + bon * v1) * bf4hi(qg);
                    u32x4 w; w.x = cvt_pk_bf16(o0.x, o0.y); w.y = cvt_pk_bf16(o0.z, o0.w); w.z = cvt_pk_bf16(o1.x, o1.y); w.w = cvt_pk_bf16(o1.z, o1.w);
                    *(u32x4*)(R + gbase + (size_t)n * 32 * D) = w;
                }
                qg = ng;
                if (i + 1 < NCH) { SCAN_STAGE(i + 1) qr = nr; qk = nk; qv = nv; qlw = nlw; qla = nla; }
                __syncthreads();
            }
#undef SCAN_STAGE
#undef SCAN_LOAD
        }
    }
}

__device__ __forceinline__ void phase_final(const Ctx& c, CA a) {
    const float* ss = (const float*)(a->ws + WS_PA); const float* g = a->in[I_NFIN];
    const int gw = c.bid * 8 + c.wave, NGW = c.G * 8;
    f32x4 gg[4];
#pragma unroll
    for (int j = 0; j < 4; ++j) gg[j] = *((const f32x4*)g + c.lane + 64 * j);
    for (int m = gw; m < M; m += NGW) {
        const float rs = row_rstd(ss, m);
        f32x4* hr = (f32x4*)(a->out + (size_t)m * D) + c.lane;
#pragma unroll
        for (int j = 0; j < 4; ++j) hr[64 * j] = hr[64 * j] * rs * gg[j];
    }
}

constexpr int SLOTS = 11, NPH = 2 + 4 * SLOTS;
__host__ __device__ inline bool phase_active(int p) {
    if (p == 0 || p == NPH - 1) return true;
    const int i = (p - 1) / SLOTS, s = (p - 1) % SLOTS;
    if (s >= 5) return s == 6 || s == 10;
    return (i & 1) ? true : (s < 3);
}

__global__ void __launch_bounds__(512, 2) mk_fwd(Args a_) {
    extern __shared__ __attribute__((aligned(16))) unsigned char lds_raw[];
    int tid_ = threadIdx.x, bid_ = blockIdx.x, G_ = gridDim.x;
    CA a = (CA)__builtin_amdgcn_kernarg_segment_ptr();
    const int ph_lo = a_.ph_lo, ph_hi = a_.ph_hi;
    for (int p = ph_lo; p < ph_hi; ++p) {
        if (!phase_active(p)) continue;
        const int PL = (p - 1) / SLOTS, PS = (p - 1) % SLOTS; (void)PL; (void)PS;
        const int nrep = (MK_PROBE && p > 0 && p < NPH - 1 && (MK_PROBE_SEL)) ? 2 : 1;
        for (int rp = 0; rp < nrep; ++rp) {
        if (rp) cg::this_grid().sync();
        asm volatile("" : "+s"(a), "+s"(bid_), "+s"(G_)); asm volatile("" : "+v"(tid_));
        Ctx c; c.lds = (LAS unsigned char*)lds_raw; c.tid = tid_; c.lane = c.tid & 63; c.wave = __builtin_amdgcn_readfirstlane(c.tid >> 6); c.G = G_; c.bid = bid_;
        bf16_t* regA = (bf16_t*)(a->ws + WS_A);
        if (p == 0) phase_prologue(c, a);
        else if (p == NPH - 1) phase_final(c, a);
        else {
            const int layer = (p - 1) / SLOTS, s = (p - 1) % SLOTS, j = layer >> 1;
            unsigned char* wj = a->ws + WS_WSTAT + (size_t)j * WJ_STRIDE;
            float* ss_mix = (float*)(a->ws + WS_PA); float* ss_ffn = (float*)(a->ws + WS_PB); float* ss_next = ss_mix;
            if (s < 5 && !(layer & 1)) {
                if (s == 0) {
                    pg8::Gemm g{regA, (const bf16_t*)(wj + WJ_IN), M, 2048, D, D}; pg8::StaticOrder S; S.init(M / 256, 2048, c.G, c.bid);
                    EpiSguIn E{(bf16_t*)(a->ws + P_U), (bf16_t*)(a->ws + P_SV), ss_mix, a->in[I_SBIN] + (size_t)j * 2048, (float*)(a->ws + WS_PV)};
                    pg8::gemm_phase<EpiSguIn, pg8::StaticOrder, 0, false, true>(c.lds, c.tid, g, S, E);
                } else if (s == 1) { phase_ffn_weights(c, a, layer); phase_sgu_spatial(c, a, j, rp); }
                else {
                    pg8::Gemm g{(const bf16_t*)(a->ws + P_U), (const bf16_t*)(wj + WJ_OUT), M, D, D, D}; pg8::StaticOrder S; S.init(M / 256, D, c.G, c.bid);
                    EpiResid E{a->out, regA, ss_ffn};
                    pg8::gemm_phase<EpiResid, pg8::StaticOrder, 0, false, true>(c.lds, c.tid, g, S, E);
                }
            } else if (s < 5) {
                if (s == 0) phase_rwkv_prep(c, a, layer);
                else if (s == 1) {
                    pg8::Gemm g{regA, (const bf16_t*)(wj + WJ_RKV), M, 3584, 2048, D}; pg8::StaticOrder S; S.init(M / 256, 3584, c.G, c.bid);
                    EpiRkv E{(bf16_t*)(a->ws + P_R), (bf16_t*)(a->ws + P_WA), (bf16_t*)(a->ws + P_GL)};
                    pg8::gemm_phase<EpiRkv, pg8::StaticOrder, 1, true, true>(c.lds, c.tid, g, S, E);
                } else if (s == 2) {
                    { int kq = 128; asm volatile("" : "+s"(kq)); pg8::Gemm g{(const bf16_t*)(a->ws + P_WA), (const bf16_t*)(wj + WJ_L2WA), M, 2048, kq, kq}; pg8::StaticOrder S; S.init(M / 256, 2048, c.G, c.bid);
                      EpiStore<false> E{(bf16_t*)(a->ws + P_LW), D, 2, (size_t)M * D, nullptr};
                      pg8::gemm_phase<EpiStore<false>, pg8::StaticOrder, 0, false, true>(c.lds, c.tid, g, S, E); }
                    asm volatile("" : "+s"(a), "+s"(c.bid), "+s"(c.G), "+s"(wj)); asm volatile("" : "+v"(c.tid));
                    { int kq = 256; asm volatile("" : "+s"(kq)); pg8::Gemm g{(const bf16_t*)(a->ws + P_GL), (const bf16_t*)(wj + WJ_L2G), M, D, kq, kq}; pg8::StaticOrder S; S.init(M / 256, D, c.G, c.bid);
                      EpiStore<false> E{regA, D, 2, 0, nullptr};
                      pg8::gemm_phase<EpiStore<false>, pg8::StaticOrder, 0, false, true>(c.lds, c.tid, g, S, E); }
                } else if (s == 3) { if (c.bid >= 128) { Ctx c2 = c; c2.bid = c.bid - 128; c2.G = c.G - 128; phase_ffn_weights(c2, a, layer); } else phase_scan(c, a, j, rp); }
                else {
                    pg8::Gemm g{(const bf16_t*)(a->ws + P_R), (const bf16_t*)(wj + WJ_O), M, D, D, D}; pg8::StaticOrder S; S.init(M / 256, D, c.G, c.bid);
                    EpiResid E{a->out, regA, ss_ffn};
                    pg8::gemm_phase<EpiResid, pg8::StaticOrder, 0, false, true>(c.lds, c.tid, g, S, E);
                }
            }
            else if (s == 6) {
                pg8::Gemm g{regA - 2 * D, (const bf16_t*)(a->ws + WS_WFFN), M, FF2, D, D}; pg8::StaticOrder S; S.init(133, FF2, c.G, c.bid);
                EpiFfnUp E{(bf16_t*)(a->ws + P_ACT), ss_ffn, a->in[I_FCW] + (size_t)layer * 3 * FF2, a->in[I_FCB] + (size_t)layer * FF2};
                pg8::gemm_phase<EpiFfnUp, pg8::StaticOrder, 2, false, true>(c.lds, c.tid, g, S, E);
            }
            else {
                pg8::Gemm g{(const bf16_t*)(a->ws + P_ACT), (const bf16_t*)(a->ws + WS_WDOWN), M, D, FF, FF}; pg8::StaticOrder S; S.init(M / 256, D, c.G, c.bid);
                EpiResid E{a->out, regA, ss_next};
                pg8::gemm_phase<EpiResid, pg8::StaticOrder, 0, false, true>(c.lds, c.tid, g, S, E);
            }
        }
        }
        if (p + 1 < ph_hi) cg::this_grid().sync();
    }
}

constexpr int LDS_BYTES = 147456;
#ifndef MK_ONE_LAUNCH
#define MK_ONE_LAUNCH 1
#endif
extern "C" void kernel_launch(void* const* d_in, const int* in_sizes, int n_in, void* d_out, int out_size, void* d_ws, size_t ws_size, hipStream_t stream) {
    static int grid = 0;
    if (grid == 0) {
        if (n_in != 32 || out_size != M * D || ws_size < WS_END) { fprintf(stderr, "kernel_launch: unexpected shapes (n_in %d out %d ws %zu, need %zu)\n", n_in, out_size, ws_size, (size_t)WS_END); grid = -1; return; }
        int dev = 0, cus = 0, per_cu = 0;
        (void)hipGetDevice(&dev); (void)hipDeviceGetAttribute(&cus, hipDeviceAttributeMultiprocessorCount, dev);
        if (hipFuncSetAttribute((const void*)mk_fwd, hipFuncAttributeMaxDynamicSharedMemorySize, LDS_BYTES) != hipSuccess) { fprintf(stderr, "kernel_launch: hipFuncSetAttribute failed\n"); grid = -1; return; }
        (void)hipOccupancyMaxActiveBlocksPerMultiprocessor(&per_cu, (const void*)mk_fwd, 512, LDS_BYTES);
        if (per_cu < 1) per_cu = 1;
        grid = cus * 1;
        (void)hipGetLastError();
    }
    if (grid < 0) return;
    Args a{};
    for (int i = 0; i < 32; ++i) a.in[i] = (const float*)d_in[i];
    a.out = (float*)d_out; a.ws = (unsigned char*)d_ws;
#if MK_ONE_LAUNCH
    a.ph_lo = 0; a.ph_hi = NPH;
    void* args[] = {&a};
    hipError_t e = hipLaunchCooperativeKernel((const void*)mk_fwd, dim3(grid), dim3(512), args, LDS_BYTES, stream);
    if (e != hipSuccess) fprintf(stderr, "cooperative launch failed: %s (grid %d)\n", hipGetErrorString(e), grid);
#else
    for (int p = 0; p < NPH; ++p) { if (!phase_active(p)) continue; a.ph_lo = p; a.ph_hi = p + 1; hipLaunchKernelGGL(mk_fwd, dim3(grid), dim3(512), LDS_BYTES, stream, a); }
#endif
}
```

```cpp
#include <hip/hip_runtime.h>
#include <hip/hip_cooperative_groups.h>
#include <cstdio>
#include <cstdint>
#include <cmath>
namespace cg = cooperative_groups;
#ifndef MK_PROBE
#define MK_PROBE 0
#endif
#ifndef MK_PROBE_SEL
#define MK_PROBE_SEL 0
#endif
namespace pg8 {
#define PG8_LAS __attribute__((address_space(3)))
typedef unsigned short bf16_t;
typedef short bf16x8 __attribute__((ext_vector_type(8)));
typedef float f32x4 __attribute__((ext_vector_type(4)));
typedef float f32x2 __attribute__((ext_vector_type(2)));
typedef unsigned u32x4 __attribute__((ext_vector_type(4)));
typedef unsigned u32x2 __attribute__((ext_vector_type(2)));
constexpr int BM = 256, BK = 64, HALF = 128, HTB = HALF * BK * 2  , STAGE_BYTES = 8 * HTB, NXCD = 8, WGM = 8;

__host__ __device__ __forceinline__ int lds_byte(int r, int c) { const int st = (r >> 4) * 2 + (c >> 5), rr = r & 15, cc = c & 31, ob = rr * 64 + cc * 2; return st * 1024 + (ob ^ (((ob >> 9) & 1) << 5)); }
__host__ __device__ __forceinline__ void stage_rc(int b, int& R, int& C) { const int st = b / 1024, sb = b % 1024, swz = sb ^ (((sb >> 9) & 1) << 5); R = (st >> 1) * 16 + swz / 64; C = (st & 1) * 32 + (swz % 64) / 2; }
__host__ __device__ __forceinline__ int perm32(int rho) { const int n = rho >> 4, i = rho & 15; return 8 * (i >> 2) + 4 * n + (i & 3); }

struct Unit { int pm, pn; };
struct Gemm { const bf16_t* A; const bf16_t* Bt; int M, N, K, lda; };

struct StaticOrder {
    int nM, nN, nwg, G, c;
    __host__ __device__ void init(int nM_, int N, int G_, int c_) { nM = nM_; nN = N / BM; nwg = nM * nN; G = G_; c = c_; }
    __host__ __device__ bool next(int i, Unit& u) const {
        const long L = (long)i * G + c; if (L >= nwg) return false;
        int wgid = (int)L; { const int q = nwg / NXCD, r = nwg % NXCD, xcd = wgid % NXCD, off = wgid / NXCD; wgid = (xcd < r ? xcd * (q + 1) : r * (q + 1) + (xcd - r) * q) + off; }
        const int nig = WGM * nN, gid = wgid / nig, fm = gid * WGM, gsz = (nM - fm) < WGM ? (nM - fm) : WGM;
        u.pm = fm + ((wgid % nig) % gsz); u.pn = (wgid % nig) / gsz; return true;
    }
};

__device__ __forceinline__ unsigned cvt_pk_bf16(float lo, float hi) { unsigned r; asm volatile("v_cvt_pk_bf16_f32 %0, %1, %2" : "=v"(r) : "v"(lo), "v"(hi)); return r; }
__device__ __forceinline__ f32x2 gelu_pk(f32x2 v) {
    const f32x2 av = __builtin_elementwise_abs(v), d = av * 0.2316418882f + 1.0f;
    f32x2 t; t.x = __builtin_amdgcn_rcpf(d.x); t.y = __builtin_amdgcn_rcpf(d.y);
    f32x2 q = t * 0.5307027145f + (-0.7265760135f); q = q * t + 0.7107068705f; q = q * t + (-0.142248368f); q = q * t + 0.127414796f; q = q * t;
    const f32x2 s = (v * v) * (-0.72134752044f);
    f32x2 e; e.x = __builtin_amdgcn_exp2f(s.x); e.y = __builtin_amdgcn_exp2f(s.y);
    const f32x2 m = v * (q * e), r = v - m;
    f32x2 o; o.x = v.x < 0.f ? m.x : r.x; o.y = v.y < 0.f ? m.y : r.y; return o;
}

template <class Epi, class Sched, int AMAP, bool KDBL, bool ALIGN_EPI>
__device__ __forceinline__ void gemm_phase(PG8_LAS unsigned char* lds, const int tid, const Gemm g, const Sched& S, const Epi& E) {
    const int wid = __builtin_amdgcn_readfirstlane(tid >> 6), lane = tid & 63, wr = wid >> 2, wc = wid & 3, fr = lane & 15, fq = lane >> 4;
    const int K = g.K, nt = K / BK, lda = g.lda;
    unsigned voffA[2], voffB[2];
#pragma unroll
    for (int i = 0; i < 2; ++i) { int R, C; stage_rc(tid * 16 + i * 8192, R, C); const int Rb = Epi::PERM ? ((R & ~31) + perm32(R & 31)) : R;
        const int Ra = (AMAP == 2) ? (R - 2 * (R >> 6)) : R;
        voffA[i] = (unsigned)(Ra * lda + C) * 2u; voffB[i] = (unsigned)(Rb * K + C) * 2u; }
    const size_t kstep = (size_t)(BK * 2);
    const size_t hstepA = (size_t)((AMAP == 2) ? 124 : HALF) * lda * 2;
    const size_t hstepB = (size_t)HALF * K * 2;
    const size_t tstepB = 2 * hstepB;
    const size_t rowA = (size_t)lda * 2;
    const unsigned ldsw = (unsigned)wid * 1024u;
    const int aoff = lds_byte(wr * 64 + fr, fq * 8), boff = lds_byte(wc * 32 + fr, fq * 8);
#define PG8_ABASE(pm) ((const char*)g.A + (AMAP == 1 ? (size_t)(((pm) >> 4) * 4104 + 8 + ((pm) & 15) * 256) * rowA : (AMAP == 2 ? (size_t)(pm) * 248 * rowA : (size_t)(pm) * 256 * rowA)))
#define PG8_KA(base, t) (KDBL ? ((base) + (size_t)((t) & 15) * kstep - (size_t)((t) >> 4) * rowA) : ((base) + (size_t)(t) * kstep))
#define PG8_SA(b, h) (((b) * 2 + (h)) * HTB)
#define PG8_SB(b, h) ((4 + (b) * 2 + (h)) * HTB)
#define PG8_STAGE(bufoff, gbase, voff) do { _Pragma("unroll") for (int _i = 0; _i < 2; ++_i) \
        __builtin_amdgcn_global_load_lds((const unsigned*)((const char*)(gbase) + (voff)[_i]), (PG8_LAS unsigned*)(lds + (bufoff) + ldsw + _i * 8192), 16, 0, 0); } while (0)
#define PG8_LDA(dst, b, h) do { _Pragma("unroll") for (int m = 0; m < 4; ++m) _Pragma("unroll") for (int k = 0; k < 2; ++k) dst[m][k] = *(const PG8_LAS bf16x8*)(lds + PG8_SA(b, h) + aoff + m * 2048 + k * 1024); } while (0)
#define PG8_LDB(dst, b, h) do { _Pragma("unroll") for (int n = 0; n < 2; ++n) _Pragma("unroll") for (int k = 0; k < 2; ++k) dst[n][k] = *(const PG8_LAS bf16x8*)(lds + PG8_SB(b, h) + boff + n * 2048 + k * 1024); } while (0)
#define PG8_MMA(ai, bj, At, Bt) do { __builtin_amdgcn_s_setprio(1); _Pragma("unroll") for (int m = 0; m < 4; ++m) _Pragma("unroll") for (int n = 0; n < 2; ++n) _Pragma("unroll") for (int k = 0; k < 2; ++k) \
        acc[ai][bj][m][n] = __builtin_amdgcn_mfma_f32_16x16x32_bf16(Bt[n][k], At[m][k], acc[ai][bj][m][n], 0, 0, 0); __builtin_amdgcn_s_setprio(0); } while (0)
#define PG8_WAIT_V(n) asm volatile("s_waitcnt vmcnt(" #n ")" ::: "memory")
#define PG8_WAIT_L(n) asm volatile("s_waitcnt lgkmcnt(" #n ")" ::: "memory")
#define PG8_BAR __builtin_amdgcn_s_barrier()
#define PG8_SCHED __builtin_amdgcn_sched_barrier(0)
    Unit cur, nxt; int ui = 0;
    if (!S.next(0, cur)) return;
    f32x4 acc[2][2][4][2];
#pragma unroll
    for (int a = 0; a < 2; ++a)
#pragma unroll
        for (int b = 0; b < 2; ++b)
#pragma unroll
            for (int m = 0; m < 4; ++m)
#pragma unroll
                for (int n = 0; n < 2; ++n) acc[a][b][m][n] = (f32x4){0.f, 0.f, 0.f, 0.f};
    bf16x8 At[4][2], B0[2][2], B1[2][2];
    const char* cA = PG8_ABASE(cur.pm); const char* cB = (const char*)g.Bt + (size_t)cur.pn * tstepB;
    {
        const char* cA1 = PG8_KA(cA, 1);
        PG8_STAGE(PG8_SB(0, 0), cB, voffB); PG8_STAGE(PG8_SB(0, 1), cB + hstepB, voffB); PG8_STAGE(PG8_SA(0, 0), cA, voffA); PG8_STAGE(PG8_SA(0, 1), cA + hstepA, voffA);
        if (wr == 1) PG8_BAR;
        PG8_WAIT_V(2); PG8_BAR;
        PG8_STAGE(PG8_SB(1, 0), cB + kstep, voffB); PG8_STAGE(PG8_SA(1, 0), cA1, voffA); PG8_STAGE(PG8_SB(1, 1), cB + hstepB + kstep, voffB);
        PG8_WAIT_V(6); PG8_BAR;
    }
    for (;;) {
        const bool has_next = S.next(ui + 1, nxt);
        const char* nA = has_next ? PG8_ABASE(nxt.pm) : cA; const char* nB = has_next ? (const char*)g.Bt + (size_t)nxt.pn * tstepB : cB;
        for (int t = 0; t < nt; t += 2) {
            const bool last = (t == nt - 2);
            const char* a1 = PG8_KA(cA, t + 1);
            const char* a2 = last ? nA : PG8_KA(cA, t + 2); const char* b2 = last ? nB : cB + (size_t)(t + 2) * kstep;
            const char* a3 = last ? PG8_KA(nA, 1) : PG8_KA(cA, t + 3); const char* b3 = b2 + kstep;
            PG8_LDB(B0, 0, 0); PG8_LDB(B1, 0, 1); PG8_SCHED; PG8_LDA(At, 0, 0); PG8_STAGE(PG8_SA(1, 1), a1 + hstepA, voffA);
            PG8_WAIT_V(8); PG8_WAIT_L(0); PG8_BAR; PG8_MMA(0, 0, At, B0); PG8_MMA(0, 1, At, B1); PG8_BAR; PG8_SCHED;
            PG8_LDA(At, 0, 1); PG8_STAGE(PG8_SB(0, 0), b2, voffB); PG8_STAGE(PG8_SB(0, 1), b2 + hstepB, voffB); PG8_STAGE(PG8_SA(0, 0), a2, voffA);
            PG8_WAIT_V(8); PG8_WAIT_L(0); PG8_BAR; PG8_MMA(1, 0, At, B0); PG8_MMA(1, 1, At, B1); PG8_BAR; PG8_SCHED;
            PG8_LDB(B0, 1, 0); PG8_LDB(B1, 1, 1); PG8_SCHED; PG8_LDA(At, 1, 0); PG8_STAGE(PG8_SA(0, 1), a2 + hstepA, voffA);
            PG8_WAIT_V(8); PG8_WAIT_L(0); PG8_BAR; PG8_MMA(0, 0, At, B0); PG8_MMA(0, 1, At, B1); PG8_BAR; PG8_SCHED;
            PG8_LDA(At, 1, 1); PG8_STAGE(PG8_SB(1, 0), b3, voffB); PG8_STAGE(PG8_SB(1, 1), b3 + hstepB, voffB); PG8_STAGE(PG8_SA(1, 0), a3, voffA);
            PG8_WAIT_V(8); PG8_WAIT_L(0); PG8_BAR; PG8_MMA(1, 0, At, B0); PG8_MMA(1, 1, At, B1); PG8_BAR; PG8_SCHED;
        }
        if constexpr (ALIGN_EPI) { if (wr == 0) PG8_BAR; }
        E(acc, cur, wr, wc, fr, fq);
        if (!has_next) break;
#pragma unroll
        for (int a = 0; a < 2; ++a)
#pragma unroll
            for (int b = 0; b < 2; ++b)
#pragma unroll
                for (int m = 0; m < 4; ++m)
#pragma unroll
                    for (int n = 0; n < 2; ++n) acc[a][b][m][n] = (f32x4){0.f, 0.f, 0.f, 0.f};
        cur = nxt; cA = nA; cB = nB; ++ui;
        if constexpr (ALIGN_EPI) { if (wr == 1) PG8_BAR; }
    }
    PG8_WAIT_V(0);
    if constexpr (!ALIGN_EPI) { if (wr == 0) PG8_BAR; }
    PG8_BAR;
#undef PG8_ABASE
#undef PG8_KA
#undef PG8_SA
#undef PG8_SB
#undef PG8_STAGE
#undef PG8_LDA
#undef PG8_LDB
#undef PG8_MMA
#undef PG8_WAIT_V
#undef PG8_WAIT_L
#undef PG8_BAR
#undef PG8_SCHED
}
}
using pg8::bf16_t; using pg8::f32x4; using pg8::f32x2; using pg8::u32x4; using pg8::u32x2; using pg8::Unit; using pg8::cvt_pk_bf16;
#define LAS __attribute__((address_space(3)))
constexpr int BATCH = 8, SEQ = 4096, D = 1024, M = BATCH * SEQ, FF = 2816, FF2 = 5632;
constexpr int PADR = 8, SEQP = SEQ + PADR;
constexpr float RMS_EPS = 1e-6f, GN_EPS = 64e-5f;
constexpr size_t MiB = 1u << 20;
constexpr size_t WS_CTL = 0, CTL_BYTES = 16384;
constexpr size_t WS_WSTAT = 2 * MiB;
constexpr size_t WJ_IN = 0, WJ_OUT = 4 * MiB, WJ_RKV = 6 * MiB, WJ_L2WA = 20 * MiB, WJ_L2G = 20 * MiB + 512 * 1024, WJ_O = 21 * MiB, WJ_STRIDE = 23 * MiB;
constexpr size_t WS_WFFN = 48 * MiB;
constexpr size_t WS_WDOWN = WS_WFFN + 11 * MiB;
constexpr size_t WS_A = 67 * MiB;
constexpr size_t WS_P = 134 * MiB;
constexpr size_t P_R = WS_P, P_K = WS_P + 64 * MiB, P_V = WS_P + 128 * MiB, P_LW = WS_P + 192 * MiB, P_LA = WS_P + 256 * MiB, P_WA = WS_P + 320 * MiB, P_GL = WS_P + 328 * MiB;
constexpr size_t P_U = WS_P, P_SV = WS_P + 64 * MiB;
constexpr size_t P_Z = WS_P, P_ACT = WS_P + 176 * MiB;
constexpr size_t WS_PA = WS_P + 352 * MiB, WS_PB = WS_PA + 2 * MiB, WS_PV = WS_PB + 2 * MiB;
constexpr size_t WS_END = WS_PV + 2 * MiB;

struct Args {
    const float* in[32]; float* out; unsigned char* ws; int ph_lo, ph_hi;
};
enum { I_X = 0, I_NMIX, I_NFFN, I_NFIN, I_SWIN, I_SBIN, I_SGV, I_SWS, I_SBS, I_SWOUT, I_MU, I_WR, I_WK, I_WV, I_WO, I_W0, I_W1, I_W2, I_A0, I_A1, I_A2, I_G1, I_G2, I_KK, I_KA, I_RK, I_LNW, I_LNB, I_FUP, I_FCW, I_FCB, I_FDN };

__device__ __forceinline__ float bf2f(unsigned short b) { return __uint_as_float((unsigned)b << 16); }
__device__ __forceinline__ float bflo(unsigned w) { return __uint_as_float(w << 16); }
__device__ __forceinline__ float bfhi(unsigned w) { return __uint_as_float(w & 0xffff0000u); }
__device__ __forceinline__ float wave_sum(float v) {
#pragma unroll
    for (int o = 1; o < 64; o <<= 1) v += __shfl_xor(v, o);
    return v;
}
__device__ __forceinline__ float row_rstd(const float* P, int row) { const f32x4* p = (const f32x4*)(P + (size_t)row * 16); const f32x4 a = p[0], b = p[1], c = p[2], d = p[3];
    const float s = ((a.x + a.y) + (a.z + a.w)) + ((b.x + b.y) + (b.z + b.w)) + ((c.x + c.y) + (c.z + c.w)) + ((d.x + d.y) + (d.z + d.w)); return rsqrtf(s * (1.f / D) + RMS_EPS); }
template <int CTRL> __device__ __forceinline__ float dpp_f(float v) { return __int_as_float(__builtin_amdgcn_mov_dpp(__float_as_int(v), CTRL, 0xf, 0xf, true)); }
__device__ __forceinline__ float sum8(float v) { v += dpp_f<0x141>(v); v += dpp_f<0xB1>(v); v += dpp_f<0x4E>(v); return v; }
__device__ __forceinline__ float sigmoidf_(float x) { return 1.f / (1.f + __expf(-x)); }

template <bool SCALE> struct EpiStore {
    static constexpr bool PERM = true;
    bf16_t* O; int ldc; int tsh; size_t split_stride; const float* ss;
    __device__ __forceinline__ void operator()(const f32x4 (&acc)[2][2][4][2], const Unit& u, int wr, int wc, int fr, int fq) const {
        bf16_t* base = O + (size_t)(u.pn >> tsh) * split_stride + (size_t)(u.pm * 256 + wr * 64 + fr) * ldc + (u.pn & ((1 << tsh) - 1)) * 256 + wc * 32 + 8 * fq;
        const int row0 = u.pm * 256 + wr * 64 + fr;
#pragma unroll
        for (int ai = 0; ai < 2; ++ai)
#pragma unroll
            for (int m = 0; m < 4; ++m) {
                const float rs = SCALE ? row_rstd(ss, row0 + ai * 128 + m * 16) : 1.f;
                bf16_t* rowp = base + (size_t)(ai * 128 + m * 16) * ldc;
#pragma unroll
                for (int bj = 0; bj < 2; ++bj) { const f32x4 v0 = acc[ai][bj][m][0] * rs, v1 = acc[ai][bj][m][1] * rs;
                    u32x4 w; w.x = cvt_pk_bf16(v0[0], v0[1]); w.y = cvt_pk_bf16(v0[2], v0[3]); w.z = cvt_pk_bf16(v1[0], v1[1]); w.w = cvt_pk_bf16(v1[2], v1[3]);
                    *(u32x4*)(rowp + bj * 128) = w; } }
    }
};
struct EpiSguIn {
    static constexpr bool PERM = true;
    bf16_t* U; bf16_t* V; const float* ss; const float* bias; float* ssv;
    __device__ __forceinline__ void operator()(const f32x4 (&acc)[2][2][4][2], const Unit& u, int wr, int wc, int fr, int fq) const {
        const bool isv = u.pn >= 4; bf16_t* base = isv ? V : U; const int colt = (u.pn & 3) * 256 + wc * 32 + 8 * fq, bcol = u.pn * 256 + wc * 32 + 8 * fq;
        f32x4 bv[2][2];
#pragma unroll
        for (int bj = 0; bj < 2; ++bj)
#pragma unroll
            for (int n = 0; n < 2; ++n) bv[bj][n] = *(const f32x4*)(bias + bcol + bj * 128 + 4 * n);
#pragma unroll
        for (int ai = 0; ai < 2; ++ai)
#pragma unroll
            for (int m = 0; m < 4; ++m) { const int row = u.pm * 256 + ai * 128 + wr * 64 + m * 16 + fr;
                const float rs = row_rstd(ss, row); float s = 0.f;
                bf16_t* rowp = base + (size_t)row * D + colt;
#pragma unroll
                for (int bj = 0; bj < 2; ++bj) { f32x4 v0 = acc[ai][bj][m][0] * rs + bv[bj][0], v1 = acc[ai][bj][m][1] * rs + bv[bj][1];
                    const f32x2 a = pg8::gelu_pk((f32x2){v0[0], v0[1]}), b = pg8::gelu_pk((f32x2){v0[2], v0[3]}), c = pg8::gelu_pk((f32x2){v1[0], v1[1]}), d = pg8::gelu_pk((f32x2){v1[2], v1[3]});
                    s += (a.x * a.x + a.y * a.y) + (b.x * b.x + b.y * b.y) + (c.x * c.x + c.y * c.y) + (d.x * d.x + d.y * d.y);
                    u32x4 w; w.x = cvt_pk_bf16(a.x, a.y); w.y = cvt_pk_bf16(b.x, b.y); w.z = cvt_pk_bf16(c.x, c.y); w.w = cvt_pk_bf16(d.x, d.y);
                    *(u32x4*)(rowp + bj * 128) = w; }
                if (isv) { s += __shfl_xor(s, 16); s += __shfl_xor(s, 32); if (fq == 0) ssv[(size_t)row * 16 + (u.pn - 4) * 4 + wc] = s; } }
    }
};
struct EpiResid {
    static constexpr bool PERM = true;
    float* h; bf16_t* hb; float* ssn;
    __device__ __forceinline__ void operator()(const f32x4 (&acc)[2][2][4][2], const Unit& u, int wr, int wc, int fr, int fq) const {
        const int colt = u.pn * 256 + wc * 32 + 8 * fq;
#pragma unroll
        for (int ai = 0; ai < 2; ++ai)
#pragma unroll
            for (int m = 0; m < 4; ++m) { const int row = u.pm * 256 + ai * 128 + wr * 64 + m * 16 + fr; float s = 0.f;
                float* hp = h + (size_t)row * D + colt; bf16_t* bp = hb + (size_t)row * D + colt;
#pragma unroll
                for (int bj = 0; bj < 2; ++bj) { const f32x4 v0 = *(const f32x4*)(hp + bj * 128) + acc[ai][bj][m][0], v1 = *(const f32x4*)(hp + bj * 128 + 4) + acc[ai][bj][m][1];
                    *(f32x4*)(hp + bj * 128) = v0; *(f32x4*)(hp + bj * 128 + 4) = v1;
                    s += (v0[0] * v0[0] + v0[1] * v0[1]) + (v0[2] * v0[2] + v0[3] * v0[3]) + (v1[0] * v1[0] + v1[1] * v1[1]) + (v1[2] * v1[2] + v1[3] * v1[3]);
                    u32x4 w; w.x = cvt_pk_bf16(v0[0], v0[1]); w.y = cvt_pk_bf16(v0[2], v0[3]); w.z = cvt_pk_bf16(v1[0], v1[1]); w.w = cvt_pk_bf16(v1[2], v1[3]);
                    *(u32x4*)(bp + bj * 128) = w; }
                s += __shfl_xor(s, 16); s += __shfl_xor(s, 32); if (fq == 0) ssn[(size_t)row * 16 + u.pn * 4 + wc] = s; }
    }
};
template <int CTRL> __device__ __forceinline__ f32x4 dpp4(f32x4 v) { f32x4 r; r.x = dpp_f<CTRL>(v.x); r.y = dpp_f<CTRL>(v.y); r.z = dpp_f<CTRL>(v.z); r.w = dpp_f<CTRL>(v.w); return r; }
struct EpiFfnUp {
    static constexpr bool PERM = true;
    bf16_t* ACT; const float* ss; const float* cw; const float* cb;
    __device__ __forceinline__ void conv4(f32x4& z0, f32x4& z1, f32x4& z2, f32x4& z3, const float (&rs)[4], const int (&tt)[4], const float* wcol, const float* bcol, int fr) const {
        const f32x4 w0 = *(const f32x4*)wcol, w1 = *(const f32x4*)(wcol + FF2), w2 = *(const f32x4*)(wcol + 2 * FF2), bb = *(const f32x4*)bcol;
#pragma unroll
        for (int e = 0; e < 4; ++e) {
            float cur = z3[e] * rs[3], c1 = dpp_f<0x121>(cur), c2 = dpp_f<0x122>(cur);
#define CONV_STEP(ZM, ZP, MI, HASP) { float prv = cur, p1 = c1, p2 = c2; if (HASP) { prv = ZP[e] * rs[MI - (HASP)]; p1 = dpp_f<0x121>(prv); p2 = dpp_f<0x122>(prv); } \
            float y1 = (fr == 0) ? p1 : c1, y2 = (fr < 2) ? p2 : c2; if (tt[MI] < 1) y1 = 0.f; if (tt[MI] < 2) y2 = 0.f; \
            ZM[e] = w0[e] * y2 + w1[e] * y1 + w2[e] * cur + bb[e]; cur = prv; c1 = p1; c2 = p2; }
            CONV_STEP(z3, z2, 3, 1) CONV_STEP(z2, z1, 2, 1) CONV_STEP(z1, z0, 1, 1) CONV_STEP(z0, z0, 0, 0)
#undef CONV_STEP
            asm volatile("" : "+v"(z0[e]), "+v"(z1[e]), "+v"(z2[e]), "+v"(z3[e]));
        }
    }
    __device__ __forceinline__ void operator()(f32x4 (&acc)[2][2][4][2], const Unit& u, int wr, int wc, int fr, int fq) const {
        const int f0 = u.pn * 128 + wc * 32 + 8 * fq;
#pragma unroll
        for (int ai = 0; ai < 2; ++ai) {
            const int gbase = u.pm * 248 - 2 + 62 * (2 * ai + wr) + fr;
            float rs[4]; int tt[4];
#pragma unroll
            for (int m = 0; m < 4; ++m) { const int g = gbase + 16 * m; const int gc = g < 0 ? 0 : (g >= M ? M - 1 : g); rs[m] = row_rstd(ss, gc); tt[m] = g & (SEQ - 1); asm volatile("" : "+v"(rs[m]) :: "memory"); }
#pragma unroll
            for (int n = 0; n < 2; ++n) {
                conv4(acc[ai][0][0][n], acc[ai][0][1][n], acc[ai][0][2][n], acc[ai][0][3][n], rs, tt, cw + f0 + 4 * n, cb + f0 + 4 * n, fr);
                asm volatile("" ::: "memory");
                conv4(acc[ai][1][0][n], acc[ai][1][1][n], acc[ai][1][2][n], acc[ai][1][3][n], rs, tt, cw + FF + f0 + 4 * n, cb + FF + f0 + 4 * n, fr);
                asm volatile("" ::: "memory");
#pragma unroll
                for (int m = 0; m < 4; ++m) { const int g = gbase + 16 * m;
                    if ((m > 0 || fr >= 2) && g < M) { const f32x4 gt = acc[ai][0][m][n], vl = acc[ai][1][m][n]; f32x4 o;
#pragma unroll
                        for (int e = 0; e < 4; ++e) o[e] = gt[e] * sigmoidf_(gt[e]) * vl[e];
                        u32x2 w; w.x = cvt_pk_bf16(o[0], o[1]); w.y = cvt_pk_bf16(o[2], o[3]);
                        *(u32x2*)(ACT + (size_t)g * FF + f0 + 4 * n) = w; } }
            }
        }
    }
};
struct EpiRkv {
    static constexpr bool PERM = true;
    bf16_t* R; bf16_t* WA; bf16_t* GL;
    __device__ __forceinline__ void operator()(const f32x4 (&acc)[2][2][4][2], const Unit& u, int wr, int wc, int fr, int fq) const {
        const int mode = u.pn < 12 ? 0 : (u.pn == 12 ? 1 : 2);
        bf16_t* base; int ldc, colt;
        if (mode == 0) { base = R + (size_t)(u.pn >> 2) * ((size_t)M * D); ldc = D; colt = (u.pn & 3) * 256 + wc * 32 + 8 * fq; }
        else if (mode == 1) { base = WA; ldc = 128; colt = wc * 32 + 8 * fq; }
        else { base = GL; ldc = 256; colt = wc * 32 + 8 * fq; }
#pragma unroll
        for (int ai = 0; ai < 2; ++ai)
#pragma unroll
            for (int m = 0; m < 4; ++m) { const int row = u.pm * 256 + ai * 128 + wr * 64 + m * 16 + fr;
                bf16_t* rowp = base + (size_t)row * ldc + colt;
#pragma unroll
                for (int bj = 0; bj < 2; ++bj) { f32x4 v0 = acc[ai][bj][m][0], v1 = acc[ai][bj][m][1];
                    if (mode == 1) { if (bj == 1) continue;
                        if (wc < 2) {
#pragma unroll
                            for (int e = 0; e < 4; ++e) { v0[e] = tanhf(v0[e]); v1[e] = tanhf(v1[e]); } } }
                    else if (mode == 2) {
#pragma unroll
                        for (int e = 0; e < 4; ++e) { v0[e] = sigmoidf_(v0[e]); v1[e] = sigmoidf_(v1[e]); } }
                    u32x4 w; w.x = cvt_pk_bf16(v0[0], v0[1]); w.y = cvt_pk_bf16(v0[2], v0[3]); w.z = cvt_pk_bf16(v1[0], v1[1]); w.w = cvt_pk_bf16(v1[2], v1[3]);
                    *(u32x4*)(rowp + bj * 128) = w; } }
    }
};

typedef const __attribute__((address_space(4))) Args* CA;
struct Ctx { LAS unsigned char* lds; int tid, lane, wave, G, bid; };

__device__ __forceinline__ void conv_mat(const Ctx& c, const float* src, int ldsrc, int K, int N, int Kp, int Np, bf16_t* dst, int ldd, int n_off, int k_off, const float* sc, int mode, int rot) {
    LAS float* tile = (LAS float*)c.lds;
    const int nnb = Np / 64, nit = (Kp / 64) * nnb; const int start = (c.bid + c.G - (rot % c.G)) % c.G;
    for (int it = start; it < nit; it += c.G) {
        const int kb = it / nnb, nb = it % nnb, k0 = kb * 64, n0 = nb * 64;
#pragma unroll
        for (int j = 0; j < 8; ++j) { const int kk = (c.tid >> 6) + 8 * j, nn = c.tid & 63, k = k0 + kk, n = n0 + nn; float v = 0.f;
            if (src && k < K && n < N) { v = src[(size_t)k * ldsrc + n]; if (mode == 1) v *= sc[k]; else if (mode == 2) v *= (1.f - sc[k]); }
            tile[nn * 65 + kk] = v; }
        __syncthreads();
        { const int nn = c.tid >> 3, cc = c.tid & 7; const LAS float* s = tile + nn * 65 + 8 * cc;
            u32x4 o; o.x = cvt_pk_bf16(s[0], s[1]); o.y = cvt_pk_bf16(s[2], s[3]); o.z = cvt_pk_bf16(s[4], s[5]); o.w = cvt_pk_bf16(s[6], s[7]);
            *(u32x4*)(dst + (size_t)(n_off + n0 + nn) * ldd + k_off + k0 + 8 * cc) = o; }
        __syncthreads();
    }
}

__device__ __forceinline__ void phase_prologue(const Ctx& c, CA a) {
    float* ss = (float*)(a->ws + WS_PA);
    const int gw = c.bid * 8 + c.wave, NGW = c.G * 8;
    bf16_t* hb = (bf16_t*)(a->ws + WS_A);
    for (int m = gw; m < M; m += NGW) {
        const f32x4* xr = (const f32x4*)(a->in[I_X] + (size_t)m * D) + c.lane; f32x4* hr = (f32x4*)(a->out + (size_t)m * D) + c.lane; u32x2* br = (u32x2*)(hb + (size_t)m * D) + c.lane;
        float s = 0.f;
#pragma unroll
        for (int j = 0; j < 4; ++j) { const f32x4 v = xr[64 * j]; s += (v.x * v.x + v.y * v.y) + (v.z * v.z + v.w * v.w); hr[64 * j] = v; u32x2 w; w.x = cvt_pk_bf16(v.x, v.y); w.y = cvt_pk_bf16(v.z, v.w); br[64 * j] = w; }
        s = wave_sum(s); if (c.lane < 16) ss[(size_t)m * 16 + c.lane] = c.lane == 0 ? s : 0.f;
    }
    int rot = 0;
    for (int j = 0; j < 2; ++j) {
        unsigned char* wj = a->ws + WS_WSTAT + (size_t)j * WJ_STRIDE;
        conv_mat(c, a->in[I_SWIN] + (size_t)j * D * 2048, 2048, D, 2048, D, 2048, (bf16_t*)(wj + WJ_IN), D, 0, 0, a->in[I_NMIX] + (size_t)(2 * j) * D, 1, rot); rot += 512;
        conv_mat(c, a->in[I_SWOUT] + (size_t)j * D * D, D, D, D, D, D, (bf16_t*)(wj + WJ_OUT), D, 0, 0, nullptr, 0, rot); rot += 256;
        const float* mu = a->in[I_MU] + (size_t)j * 6 * D; bf16_t* rkv = (bf16_t*)(wj + WJ_RKV);
#define CONV_BIG(IDX, Q, MUB) do { conv_mat(c, a->in[IDX] + (size_t)j * D * D, D, D, D, D, D, rkv, 2048, (Q) * 1024, 0, mu + (MUB) * D, 2, rot); rot += 256; \
            conv_mat(c, a->in[IDX] + (size_t)j * D * D, D, D, D, D, D, rkv, 2048, (Q) * 1024, 1024, mu + (MUB) * D, 1, rot); rot += 256; } while (0)
        CONV_BIG(I_WR, 0, 0); CONV_BIG(I_WK, 1, 2); CONV_BIG(I_WV, 2, 3);
#undef CONV_BIG
        conv_mat(c, a->in[I_W1] + (size_t)j * D * 64, 64, D, 64, D, 64, rkv, 2048, 3072, 0, mu + 1 * D, 2, rot); rot += 16;
        conv_mat(c, a->in[I_W1] + (size_t)j * D * 64, 64, D, 64, D, 64, rkv, 2048, 3072, 1024, mu + 1 * D, 1, rot); rot += 16;
        conv_mat(c, a->in[I_A1] + (size_t)j * D * 64, 64, D, 64, D, 64, rkv, 2048, 3136, 0, mu + 4 * D, 2, rot); rot += 16;
        conv_mat(c, a->in[I_A1] + (size_t)j * D * 64, 64, D, 64, D, 64, rkv, 2048, 3136, 1024, mu + 4 * D, 1, rot); rot += 16;
        conv_mat(c, nullptr, 0, 0, 0, 2048, 128, rkv, 2048, 3200, 0, nullptr, 0, rot); rot += 64;
        conv_mat(c, a->in[I_G1] + (size_t)j * D * 160, 160, D, 160, D, 256, rkv, 2048, 3328, 0, mu + 5 * D, 2, rot); rot += 64;
        conv_mat(c, a->in[I_G1] + (size_t)j * D * 160, 160, D, 160, D, 256, rkv, 2048, 3328, 1024, mu + 5 * D, 1, rot); rot += 64;
        bf16_t* l2wa = (bf16_t*)(wj + WJ_L2WA);
        conv_mat(c, a->in[I_W2] + (size_t)j * 64 * D, D, 64, D, 64, D, l2wa, 128, 0, 0, nullptr, 0, rot); rot += 16;
        conv_mat(c, nullptr, 0, 0, 0, 64, D, l2wa, 128, 0, 64, nullptr, 0, rot); rot += 16;
        conv_mat(c, nullptr, 0, 0, 0, 64, D, l2wa, 128, 1024, 0, nullptr, 0, rot); rot += 16;
        conv_mat(c, a->in[I_A2] + (size_t)j * 64 * D, D, 64, D, 64, D, l2wa, 128, 1024, 64, nullptr, 0, rot); rot += 16;
        conv_mat(c, a->in[I_G2] + (size_t)j * 160 * D, D, 160, D, 256, D, (bf16_t*)(wj + WJ_L2G), 256, 0, 0, nullptr, 0, rot); rot += 64;
        conv_mat(c, a->in[I_WO] + (size_t)j * D * D, D, D, D, D, D, (bf16_t*)(wj + WJ_O), D, 0, 0, nullptr, 0, rot); rot += 256;
    }
}
__device__ __forceinline__ void phase_ffn_weights(const Ctx& c, CA a, int layer) {
    for (int pn = 0; pn < FF / 128; ++pn) {
        conv_mat(c, a->in[I_FUP] + (size_t)layer * D * FF2 + pn * 128, FF2, D, 128, D, 128, (bf16_t*)(a->ws + WS_WFFN), D, pn * 256, 0, a->in[I_NFFN] + (size_t)layer * D, 1, pn * 64);
        conv_mat(c, a->in[I_FUP] + (size_t)layer * D * FF2 + FF + pn * 128, FF2, D, 128, D, 128, (bf16_t*)(a->ws + WS_WFFN), D, pn * 256 + 128, 0, a->in[I_NFFN] + (size_t)layer * D, 1, pn * 64 + 32);
    }
    conv_mat(c, a->in[I_FDN] + (size_t)layer * FF * D, D, FF, D, FF, D, (bf16_t*)(a->ws + WS_WDOWN), FF, 0, 0, nullptr, 0, 128);
}

__device__ __forceinline__ void phase_sgu_spatial(const Ctx& c, CA a, int j, int rp) {
    typedef short bf16x8 __attribute__((ext_vector_type(8)));
    bf16_t* U = (bf16_t*)(a->ws + P_U); const bf16_t* V = (const bf16_t*)(a->ws + P_SV); bf16_t* UO = rp ? (bf16_t*)(a->ws + P_SV) : U;
    const float* ssv = (const float*)(a->ws + WS_PV);
    LAS bf16_t* WL = (LAS bf16_t*)c.lds; LAS bf16_t* VT = WL + 128 * 136;
    const int g = c.bid & 15;
    const float* Ws = a->in[I_SWS] + ((size_t)j * 16 + g) * 128 * 128; const float* bs = a->in[I_SBS] + ((size_t)j * 16 + g) * 128; const float* gv = a->in[I_SGV] + (size_t)j * D + g * 64;
    __syncthreads();
    { const int t = c.tid >> 2, s0 = (c.tid & 3) * 32; const float* wp = Ws + (size_t)t * 128 + s0;
#pragma unroll
      for (int q = 0; q < 4; ++q) { f32x4 x0 = *(const f32x4*)(wp + 8 * q), x1 = *(const f32x4*)(wp + 8 * q + 4);
#pragma unroll
          for (int e = 0; e < 4; ++e) { if (s0 + 8 * q + e > t) x0[e] = 0.f; if (s0 + 8 * q + 4 + e > t) x1[e] = 0.f; }
          u32x4 w; w.x = cvt_pk_bf16(x0[0], x0[1]); w.y = cvt_pk_bf16(x0[2], x0[3]); w.z = cvt_pk_bf16(x1[0], x1[1]); w.w = cvt_pk_bf16(x1[2], x1[3]);
          *(LAS u32x4*)(WL + t * 136 + s0 + 8 * q) = w; } }
    const int w8 = c.wave, fr = c.lane & 15, fq = c.lane >> 4, t0 = 16 * w8, nk = (w8 >> 1) + 1;
    const int vs = c.tid >> 2, vc = (c.tid & 3) * 16;
    f32x4 gq[4];
#pragma unroll
    for (int e = 0; e < 4; ++e) gq[e] = *(const f32x4*)(gv + vc + 4 * e);
    const float bb = bs[t0 + fr];
    for (int ub = c.bid >> 4; ub < M / 128; ub += c.G >> 4) {
        const int m0 = ub * 128;
        { const bf16_t* vp = V + (size_t)(m0 + vs) * D + g * 64 + vc; const u32x4 v0 = *(const u32x4*)vp, v1 = *(const u32x4*)(vp + 8);
          const float rs = row_rstd(ssv, m0 + vs);
          const unsigned vw[8] = {v0.x, v0.y, v0.z, v0.w, v1.x, v1.y, v1.z, v1.w};
#pragma unroll
          for (int e = 0; e < 8; ++e) { const float lo = bflo(vw[e]) * rs * gq[e >> 1][(2 * e) & 3], hi = bfhi(vw[e]) * rs * gq[e >> 1][(2 * e + 1) & 3];
              const unsigned pk = cvt_pk_bf16(lo, hi);
              VT[(vc + 2 * e) * 136 + vs] = (bf16_t)(pk & 0xffffu); VT[(vc + 2 * e + 1) * 136 + vs] = (bf16_t)(pk >> 16); } }
        __syncthreads();
        f32x4 acc[4];
#pragma unroll
        for (int ct = 0; ct < 4; ++ct) acc[ct] = (f32x4){0.f, 0.f, 0.f, 0.f};
        for (int k = 0; k < nk; ++k) {
            const bf16x8 wf = *(const LAS bf16x8*)(WL + (t0 + fr) * 136 + 32 * k + 8 * fq);
#pragma unroll
            for (int ct = 0; ct < 4; ++ct) { const bf16x8 vf = *(const LAS bf16x8*)(VT + (16 * ct + fr) * 136 + 32 * k + 8 * fq);
                acc[ct] = __builtin_amdgcn_mfma_f32_16x16x32_bf16(vf, wf, acc[ct], 0, 0, 0); }
        }
        { const size_t ro = (size_t)(m0 + t0 + fr) * D + g * 64 + 4 * fq;
#pragma unroll
          for (int ct = 0; ct < 4; ++ct) { const u32x2 uu = *(const u32x2*)(U + ro + 16 * ct); const f32x4 o = acc[ct] + bb;
              u32x2 w; w.x = cvt_pk_bf16(bflo(uu.x) * o[0], bfhi(uu.x) * o[1]); w.y = cvt_pk_bf16(bflo(uu.y) * o[2], bfhi(uu.y) * o[3]);
              *(u32x2*)(UO + ro + 16 * ct) = w; } }
        __syncthreads();
    }
}

__device__ __forceinline__ void phase_ffn_conv(const Ctx& c, CA a, int layer, int half) {
    const bf16_t* Z = (const bf16_t*)(a->ws + P_Z); bf16_t* ACT = (bf16_t*)(a->ws + P_ACT) + (size_t)half * (M / 2) * FF;
    const float* cw = a->in[I_FCW] + (size_t)layer * 3 * FF2; const float* cb = a->in[I_FCB] + (size_t)layer * FF2;
    const int gt = c.bid * 512 + c.tid, NT = c.G * 512;
    for (int idx = gt; idx < (M / 2) * (FF / 8); idx += NT) {
        const int ml = idx / (FF / 8), f = (idx % (FF / 8)) * 8, t = ml & (SEQ - 1);
        float gsum[8], vsum[8];
#pragma unroll
        for (int e = 0; e < 8; ++e) { gsum[e] = cb[f + e]; vsum[e] = cb[FF + f + e]; }
#pragma unroll
        for (int jj = 0; jj < 3; ++jj) { const int dt = 2 - jj; if (t - dt < 0) continue;
            const u32x4 zg = *(const u32x4*)(Z + (size_t)(ml - dt) * FF2 + f), zv = *(const u32x4*)(Z + (size_t)(ml - dt) * FF2 + FF + f);
            const float* wg = cw + (size_t)jj * FF2 + f; const float* wv = wg + FF;
            const unsigned zgw[4] = {zg.x, zg.y, zg.z, zg.w}, zvw[4] = {zv.x, zv.y, zv.z, zv.w};
#pragma unroll
            for (int e = 0; e < 4; ++e) { gsum[2 * e] += wg[2 * e] * bflo(zgw[e]); gsum[2 * e + 1] += wg[2 * e + 1] * bfhi(zgw[e]); vsum[2 * e] += wv[2 * e] * bflo(zvw[e]); vsum[2 * e + 1] += wv[2 * e + 1] * bfhi(zvw[e]); } }
        float o[8];
#pragma unroll
        for (int e = 0; e < 8; ++e) o[e] = gsum[e] * sigmoidf_(gsum[e]) * vsum[e];
        u32x4 w; w.x = cvt_pk_bf16(o[0], o[1]); w.y = cvt_pk_bf16(o[2], o[3]); w.z = cvt_pk_bf16(o[4], o[5]); w.w = cvt_pk_bf16(o[6], o[7]);
        *(u32x4*)(ACT + (size_t)ml * FF + f) = w;
    }
}

__device__ __forceinline__ void phase_rwkv_prep(const Ctx& c, CA a, int layer) {
    const float* ss = (const float*)(a->ws + WS_PA); const float* g = a->in[I_NMIX] + (size_t)layer * D;
    bf16_t* hn = (bf16_t*)(a->ws + WS_A);
    const int gw = c.bid * 8 + c.wave, NGW = c.G * 8;
    f32x4 gg[4];
#pragma unroll
    for (int j = 0; j < 4; ++j) gg[j] = *((const f32x4*)g + c.lane + 64 * j);
    for (int m = gw; m < M; m += NGW) {
        const float rs = row_rstd(ss, m);
        const f32x4* hr = (const f32x4*)(a->out + (size_t)m * D) + c.lane; const int prow = (m >> 12) * SEQP + PADR + (m & (SEQ - 1));
        u32x2* br = (u32x2*)(hn + (size_t)prow * D) + c.lane;
#pragma unroll
        for (int j = 0; j < 4; ++j) { const f32x4 v = hr[64 * j] * rs * gg[j]; u32x2 w; w.x = cvt_pk_bf16(v.x, v.y); w.y = cvt_pk_bf16(v.z, v.w); br[64 * j] = w; }
    }
    for (int r = gw; r < BATCH * PADR; r += NGW) { const int prow = (r / PADR) * SEQP + (r % PADR); u32x2* br = (u32x2*)(hn + (size_t)prow * D) + c.lane;
#pragma unroll
        for (int j = 0; j < 4; ++j) br[64 * j] = (u32x2){0u, 0u}; }
}

__device__ __forceinline__ f32x4 bf4lo(u32x4 w) { return (f32x4){bflo(w.x), bfhi(w.x), bflo(w.y), bfhi(w.y)}; }
__device__ __forceinline__ f32x4 bf4hi(u32x4 w) { return (f32x4){bflo(w.z), bfhi(w.z), bflo(w.w), bfhi(w.w)}; }
__device__ __forceinline__ float hsum4(f32x4 p) { return (p.x + p.y) + (p.z + p.w); }
__device__ __forceinline__ void phase_scan(const Ctx& c, CA a, int j, int rp_unused) {
    LAS float* BIG = (LAS float*)c.lds; LAS float* VB = BIG + 2 * 5 * 2048; LAS float* YB = VB + 3 * 2048; LAS float* BON = YB + 2 * 2048;
    bf16_t* R = (bf16_t*)(a->ws + P_R); const bf16_t* Kb = (const bf16_t*)(a->ws + P_K); const bf16_t* Vb = (const bf16_t*)(a->ws + P_V);
    const bf16_t* LWb = (const bf16_t*)(a->ws + P_LW); const bf16_t* LAb = (const bf16_t*)(a->ws + P_LA); const bf16_t* Gb = (const bf16_t*)(a->ws + WS_A);
    const bool cons = c.tid < 256;
    constexpr int NCH = SEQ / 32;
    for (int unit = c.bid; unit < BATCH * 16; unit += c.G) {
        const int b = unit >> 4, hh = unit & 15;
        __syncthreads();
        if (cons) {
            const int rp = c.tid >> 3, q = c.tid & 7;
            f32x4 S00 = (f32x4){0.f, 0.f, 0.f, 0.f}, S01 = S00, S10 = S00, S11 = S00;
            __syncthreads();
            for (int i = 0; i <= NCH; ++i) {
                if (i < NCH) {
                    const LAS float* bg = BIG + (i & 1) * 5 * 2048 + 8 * q;
                    const LAS f32x4* pw = (const LAS f32x4*)bg; const LAS f32x4* pa = (const LAS f32x4*)(bg + 2048); const LAS f32x4* pb = (const LAS f32x4*)(bg + 2 * 2048);
                    const LAS f32x4* pk = (const LAS f32x4*)(bg + 3 * 2048); const LAS f32x4* pr = (const LAS f32x4*)(bg + 4 * 2048);
                    const LAS float* pv = VB + (i % 3) * 2048 + 2 * rp; LAS float* py = YB + (i & 1) * 2048 + 2 * rp;
                    f32x4 a0v = pa[0], a1v = pa[1], w0v = pw[0], w1v = pw[1], b0v = pb[0], b1v = pb[1], k0v = pk[0], k1v = pk[1], r0v = pr[0], r1v = pr[1];
                    f32x2 vv = *(const LAS f32x2*)pv;
#pragma unroll 2
                    for (int t = 0; t < 32; ++t) {
                        const int tn = (t + 1) & 31;
                        const f32x4 na0 = pa[tn * 16], na1 = pa[tn * 16 + 1], nw0 = pw[tn * 16], nw1 = pw[tn * 16 + 1], nb0 = pb[tn * 16], nb1 = pb[tn * 16 + 1],
                                    nk0 = pk[tn * 16], nk1 = pk[tn * 16 + 1], nr0 = pr[tn * 16], nr1 = pr[tn * 16 + 1];
                        const f32x2 nvv = *(const LAS f32x2*)(pv + tn * 64);
                        const float sa0 = sum8(hsum4(S00 * a0v + S01 * a1v)), sa1 = sum8(hsum4(S10 * a0v + S11 * a1v));
                        S00 = S00 * w0v + sa0 * b0v + vv.x * k0v; S01 = S01 * w1v + sa0 * b1v + vv.x * k1v;
                        S10 = S10 * w0v + sa1 * b0v + vv.y * k0v; S11 = S11 * w1v + sa1 * b1v + vv.y * k1v;
                        const float y0 = sum8(hsum4(S00 * r0v + S01 * r1v)), y1 = sum8(hsum4(S10 * r0v + S11 * r1v));
                        if (q == 0) *(LAS f32x2*)(py + t * 64) = (f32x2){y0, y1};
                        a0v = na0; a1v = na1; w0v = nw0; w1v = nw1; b0v = nb0; b1v = nb1; k0v = nk0; k1v = nk1; r0v = nr0; r1v = nr1; vv = nvv;
                    }
                }
                __syncthreads();
            }
        } else {
            const int pt = c.tid - 256, st = pt >> 3, sc = (pt & 7) * 8, ch = hh * 64 + sc;
            const float* pp = a->in[I_W0] + (size_t)j * D + ch; const f32x4 w0a = *(const f32x4*)pp, w0b = *(const f32x4*)(pp + 4);
            pp = a->in[I_A0] + (size_t)j * D + ch; const f32x4 a0a = *(const f32x4*)pp, a0b = *(const f32x4*)(pp + 4);
            pp = a->in[I_KK] + (size_t)j * D + ch; const f32x4 kka = *(const f32x4*)pp, kkb = *(const f32x4*)(pp + 4);
            pp = a->in[I_KA] + (size_t)j * D + ch; const f32x4 kaa = *(const f32x4*)pp, kab = *(const f32x4*)(pp + 4);
            pp = a->in[I_RK] + (size_t)j * D + ch; const f32x4 rka = *(const f32x4*)pp, rkb = *(const f32x4*)(pp + 4);
            pp = a->in[I_LNW] + (size_t)j * D + ch; const f32x4 lwa = *(const f32x4*)pp, lwb = *(const f32x4*)(pp + 4);
            pp = a->in[I_LNB] + (size_t)j * D + ch; const f32x4 lba = *(const f32x4*)pp, lbb = *(const f32x4*)(pp + 4);
            const size_t gbase = ((size_t)b * SEQ + st) * D + ch;
            u32x4 qr = *(const u32x4*)(R + gbase), qk = *(const u32x4*)(Kb + gbase), qv = *(const u32x4*)(Vb + gbase), qlw = *(const u32x4*)(LWb + gbase), qla = *(const u32x4*)(LAb + gbase), qg = qr;
#define SCAN_STAGE(n) { \
                f32x4 rr[2] = {bf4lo(qr), bf4hi(qr)}, kk_[2] = {bf4lo(qk), bf4hi(qk)}, vv_[2] = {bf4lo(qv), bf4hi(qv)}, lw_[2] = {bf4lo(qlw), bf4hi(qlw)}, la_[2] = {bf4lo(qla), bf4hi(qla)}; \
                const f32x4 w0_[2] = {w0a, w0b}, a0_[2] = {a0a, a0b}, kkp_[2] = {kka, kkb}, kap_[2] = {kaa, kab}, rkp_[2] = {rka, rkb}; \
                f32x4 dec[2], av[2], kn[2], kp[2]; float n2 = 0.f, bon = 0.f; \
                _Pragma("unroll") for (int h2 = 0; h2 < 2; ++h2) _Pragma("unroll") for (int e = 0; e < 4; ++e) { \
                    const float xw = -(w0_[h2][e] + lw_[h2][e]); const float sp = xw > 20.f ? xw : log1pf(expf(xw)); \
                    dec[h2][e] = expf(-expf(-sp - 0.5f)); av[h2][e] = 1.f / (1.f + expf(-(a0_[h2][e] + la_[h2][e]))); \
                    kn[h2][e] = kk_[h2][e] * kkp_[h2][e]; n2 += kn[h2][e] * kn[h2][e]; \
                    kp[h2][e] = kk_[h2][e] * (1.f + (av[h2][e] - 1.f) * kap_[h2][e]); bon += rr[h2][e] * kp[h2][e] * rkp_[h2][e]; } \
                n2 = sum8(n2); bon = sum8(bon); const float inv = rsqrtf(fmaxf(n2, 1e-24f)); \
                LAS float* bg = BIG + ((n) & 1) * 5 * 2048 + st * 64 + sc; \
                _Pragma("unroll") for (int h2 = 0; h2 < 2; ++h2) { const f32x4 kq = kn[h2] * inv; \
                    *(LAS f32x4*)(bg + 4 * h2) = dec[h2]; *(LAS f32x4*)(bg + 2048 + 4 * h2) = -kq; *(LAS f32x4*)(bg + 2 * 2048 + 4 * h2) = kq * av[h2]; \
                    *(LAS f32x4*)(bg + 3 * 2048 + 4 * h2) = kp[h2]; *(LAS f32x4*)(bg + 4 * 2048 + 4 * h2) = rr[h2]; \
                    *(LAS f32x4*)(VB + ((n) % 3) * 2048 + st * 64 + sc + 4 * h2) = vv_[h2]; } \
                if ((pt & 7) == 0) BON[((n) % 3) * 32 + st] = bon; }
#define SCAN_LOAD(n) { const size_t go = gbase + (size_t)(n) * 32 * D; qr = *(const u32x4*)(R + go); qk = *(const u32x4*)(Kb + go); qv = *(const u32x4*)(Vb + go); qlw = *(const u32x4*)(LWb + go); qla = *(const u32x4*)(LAb + go); }
            SCAN_STAGE(0)
            SCAN_LOAD(1)
            __syncthreads();
            for (int i = 0; i <= NCH; ++i) {
                u32x4 nr = qr, nk = qk, nv = qv, nlw = qlw, nla = qla, ng = qg;
                if (i + 2 < NCH) { const size_t go = gbase + (size_t)(i + 2) * 32 * D; nr = *(const u32x4*)(R + go); nk = *(const u32x4*)(Kb + go); nv = *(const u32x4*)(Vb + go); nlw = *(const u32x4*)(LWb + go); nla = *(const u32x4*)(LAb + go); }
                if (i < NCH) ng = *(const u32x4*)(Gb + gbase + (size_t)i * 32 * D);
                if (i >= 1) {
                    const int n = i - 1; const LAS float* yp = YB + (n & 1) * 2048 + st * 64 + sc; const LAS float* vp = VB + (n % 3) * 2048 + st * 64 + sc;
                    const f32x4 y0 = *(const LAS f32x4*)yp, y1 = *(const LAS f32x4*)(yp + 4), v0 = *(const LAS f32x4*)vp, v1 = *(const LAS f32x4*)(vp + 4); const float bon = BON[(n % 3) * 32 + st];
                    const float mean = sum8(hsum4(y0) + hsum4(y1)) * (1.f / 64.f); const f32x4 d0 = y0 - mean, d1 = y1 - mean;
                    const float rstd = rsqrtf(sum8(hsum4(d0 * d0) + hsum4(d1 * d1)) * (1.f / 64.f) + GN_EPS);
                    const f32x4 o0 = (d0 * rstd * lwa + lba + bon * v0) * bf4lo(qg), o1 = (d1 * rstd * lwb + lbb + bon * v1) * bf4hi(qg);
                    u32x4 w; w.x = cvt_pk_bf16(o0.x, o0.y); w.y = cvt_pk_bf16(o0.z, o0.w); w.z = cvt_pk_bf16(o1.x, o1.y); w.w = cvt_pk_bf16(o1.z, o1.w);
                    *(u32x4*)(R + gbase + (size_t)n * 32 * D) = w;
                }
                qg = ng;
                if (i + 1 < NCH) { SCAN_STAGE(i + 1) qr = nr; qk = nk; qv = nv; qlw = nlw; qla = nla; }
                __syncthreads();
            }
#undef SCAN_STAGE
#undef SCAN_LOAD
        }
    }
}

__device__ __forceinline__ void phase_final(const Ctx& c, CA a) {
    const float* ss = (const float*)(a->ws + WS_PA); const float* g = a->in[I_NFIN];
    const int gw = c.bid * 8 + c.wave, NGW = c.G * 8;
    f32x4 gg[4];
#pragma unroll
    for (int j = 0; j < 4; ++j) gg[j] = *((const f32x4*)g + c.lane + 64 * j);
    for (int m = gw; m < M; m += NGW) {
        const float rs = row_rstd(ss, m);
        f32x4* hr = (f32x4*)(a->out + (size_t)m * D) + c.lane;
#pragma unroll
        for (int j = 0; j < 4; ++j) hr[64 * j] = hr[64 * j] * rs * gg[j];
    }
}

#define XB_TMO      128
#define XB_XCNT(j)  (256  + 64 * (j))
#define XB_XSUB(j)  (1280 + 64 * (j))
#define XB_XGEN(j)  (2304 + 64 * (j))
#define XB_TOP      3328
#define XB_TOPGEN   3392
#define XCD_BAR_WORDS 3456
#define XB_SPIN_CAP (1u << 18)

__device__ __forceinline__ unsigned xb_ld(unsigned* p)              { return __hip_atomic_load(p, __ATOMIC_RELAXED, __HIP_MEMORY_SCOPE_AGENT); }
__device__ __forceinline__ unsigned xb_add(unsigned* p, unsigned v) { return __hip_atomic_fetch_add(p, v, __ATOMIC_RELAXED, __HIP_MEMORY_SCOPE_AGENT); }
__device__ __forceinline__ unsigned xb_xcc_id() { return (unsigned)__builtin_amdgcn_s_getreg((3 << 11) | 20) & 0xFu; }
#define XB_SPIN(cond, bar) do { unsigned _sp = 0; while (cond) { __builtin_amdgcn_s_sleep(1); \
    if ((++_sp & 255u) == 0u) { if (xb_ld(&(bar)[XB_TMO])) break; if (_sp > XB_SPIN_CAP) { atomicAdd(&(bar)[XB_TMO], 1u); break; } } } } while (0)

struct XcdBarrier {
    unsigned* bar; unsigned x;
    volatile LAS unsigned* st;
};

__device__ __forceinline__ XcdBarrier xcd_barrier_post(unsigned* bar, volatile LAS unsigned* st) {
    XcdBarrier b; b.bar = bar; b.x = xb_xcc_id(); b.st = st;
    if (threadIdx.x == 0) (void)xb_add(&bar[XB_XCNT(b.x)], 1u);
    return b;
}
__device__ __forceinline__ void xcd_barrier_complete(unsigned* bar, unsigned x, unsigned& nloc, unsigned& nx) {
    const unsigned G = gridDim.x * gridDim.y * gridDim.z;
    unsigned sum, cnt, mine, sp = 0u;
    for (;;) {
        sum = 0u; cnt = 0u; mine = 0u;
#pragma unroll
        for (unsigned j = 0; j < 16; ++j) { const unsigned c = xb_ld(&bar[XB_XCNT(j)]); sum += c; cnt += (c > 0u) ? 1u : 0u; mine = (j == x) ? c : mine; }
        if (sum == G) break;
        __builtin_amdgcn_s_sleep(1);
        if ((++sp & 255u) == 0u) { if (xb_ld(&bar[XB_TMO])) break; if (sp > XB_SPIN_CAP) { atomicAdd(&bar[XB_TMO], 1u); break; } }
    }
    nloc = mine > 0u ? mine : 1u; nx = cnt > 0u ? cnt : 1u;
}

__device__ __forceinline__ void xcd_barrier(const XcdBarrier& b) {
    asm volatile("s_waitcnt vmcnt(0)" ::: "memory");
    __syncthreads();
    if (threadIdx.x == 0) {
        unsigned* bar = b.bar;
        __builtin_amdgcn_s_waitcnt(0);
        unsigned nloc = b.st[0], nx = b.st[1];
        if (nloc == 0u) { xcd_barrier_complete(bar, b.x, nloc, nx); b.st[0] = nloc; b.st[1] = nx; }
        const unsigned old = xb_add(&bar[XB_XSUB(b.x)], 1u);
        const unsigned gen = old / nloc;
        if (old + 1u == (gen + 1u) * nloc) {
            __builtin_amdgcn_fence(__ATOMIC_RELEASE, "agent");
            asm volatile("s_waitcnt vmcnt(0)" ::: "memory");
            const unsigned og = xb_add(&bar[XB_TOP], 1u);
            const unsigned tg = og / nx;
            if (og + 1u == (tg + 1u) * nx) xb_add(&bar[XB_TOPGEN], 1u);
            else XB_SPIN(xb_ld(&bar[XB_TOPGEN]) == tg, bar);
            __builtin_amdgcn_fence(__ATOMIC_ACQUIRE, "agent");
            xb_add(&bar[XB_XGEN(b.x)], 1u);
            asm volatile("s_waitcnt vmcnt(0)" ::: "memory");
        } else {
            XB_SPIN(xb_ld(&bar[XB_XGEN(b.x)]) == gen, bar);
            __builtin_amdgcn_fence(__ATOMIC_ACQUIRE, "agent");
            asm volatile("s_waitcnt vmcnt(0)" ::: "memory");
        }
    }
    __syncthreads();
}

constexpr int SLOTS = 11, NPH = 2 + 4 * SLOTS;
__host__ __device__ inline bool phase_active(int p) {
    if (p == 0 || p == NPH - 1) return true;
    const int i = (p - 1) / SLOTS, s = (p - 1) % SLOTS;
    if (s >= 5) return s == 6 || s == 10;
    return (i & 1) ? true : (s < 3);
}

__global__ void __launch_bounds__(512, 2) mk_fwd(Args a_) {
    extern __shared__ __attribute__((aligned(16))) unsigned char lds_raw[];
    int tid_ = threadIdx.x, bid_ = blockIdx.x, G_ = gridDim.x;
    volatile LAS unsigned* xst = (volatile LAS unsigned*)((LAS unsigned char*)lds_raw + 131072 + 64);
    if (tid_ < 2) xst[tid_] = 0u;
    __syncthreads();
    const XcdBarrier xbar = xcd_barrier_post((unsigned*)(a_.ws + WS_CTL), xst);
    CA a = (CA)__builtin_amdgcn_kernarg_segment_ptr();
    const int ph_lo = a_.ph_lo, ph_hi = a_.ph_hi;
    for (int p = ph_lo; p < ph_hi; ++p) {
        if (!phase_active(p)) continue;
        const int PL = (p - 1) / SLOTS, PS = (p - 1) % SLOTS; (void)PL; (void)PS;
        const int nrep = (MK_PROBE && p > 0 && p < NPH - 1 && (MK_PROBE_SEL)) ? 2 : 1;
        for (int rp = 0; rp < nrep; ++rp) {
        if (rp) cg::this_grid().sync();
        asm volatile("" : "+s"(a), "+s"(bid_), "+s"(G_)); asm volatile("" : "+v"(tid_));
        Ctx c; c.lds = (LAS unsigned char*)lds_raw; c.tid = tid_; c.lane = c.tid & 63; c.wave = __builtin_amdgcn_readfirstlane(c.tid >> 6); c.G = G_; c.bid = bid_;
        bf16_t* regA = (bf16_t*)(a->ws + WS_A);
        if (p == 0) phase_prologue(c, a);
        else if (p == NPH - 1) phase_final(c, a);
        else {
            const int layer = (p - 1) / SLOTS, s = (p - 1) % SLOTS, j = layer >> 1;
            unsigned char* wj = a->ws + WS_WSTAT + (size_t)j * WJ_STRIDE;
            float* ss_mix = (float*)(a->ws + WS_PA); float* ss_ffn = (float*)(a->ws + WS_PB); float* ss_next = ss_mix;
            if (s < 5 && !(layer & 1)) {
                if (s == 0) {
                    pg8::Gemm g{regA, (const bf16_t*)(wj + WJ_IN), M, 2048, D, D}; pg8::StaticOrder S; S.init(M / 256, 2048, c.G, c.bid);
                    EpiSguIn E{(bf16_t*)(a->ws + P_U), (bf16_t*)(a->ws + P_SV), ss_mix, a->in[I_SBIN] + (size_t)j * 2048, (float*)(a->ws + WS_PV)};
                    pg8::gemm_phase<EpiSguIn, pg8::StaticOrder, 0, false, true>(c.lds, c.tid, g, S, E);
                } else if (s == 1) { phase_ffn_weights(c, a, layer); phase_sgu_spatial(c, a, j, rp); }
                else {
                    pg8::Gemm g{(const bf16_t*)(a->ws + P_U), (const bf16_t*)(wj + WJ_OUT), M, D, D, D}; pg8::StaticOrder S; S.init(M / 256, D, c.G, c.bid);
                    EpiResid E{a->out, regA, ss_ffn};
                    pg8::gemm_phase<EpiResid, pg8::StaticOrder, 0, false, true>(c.lds, c.tid, g, S, E);
                }
            } else if (s < 5) {
                if (s == 0) phase_rwkv_prep(c, a, layer);
                else if (s == 1) {
                    pg8::Gemm g{regA, (const bf16_t*)(wj + WJ_RKV), M, 3584, 2048, D}; pg8::StaticOrder S; S.init(M / 256, 3584, c.G, c.bid);
                    EpiRkv E{(bf16_t*)(a->ws + P_R), (bf16_t*)(a->ws + P_WA), (bf16_t*)(a->ws + P_GL)};
                    pg8::gemm_phase<EpiRkv, pg8::StaticOrder, 1, true, true>(c.lds, c.tid, g, S, E);
                } else if (s == 2) {
                    { int kq = 128; asm volatile("" : "+s"(kq)); pg8::Gemm g{(const bf16_t*)(a->ws + P_WA), (const bf16_t*)(wj + WJ_L2WA), M, 2048, kq, kq}; pg8::StaticOrder S; S.init(M / 256, 2048, c.G, c.bid);
                      EpiStore<false> E{(bf16_t*)(a->ws + P_LW), D, 2, (size_t)M * D, nullptr};
                      pg8::gemm_phase<EpiStore<false>, pg8::StaticOrder, 0, false, true>(c.lds, c.tid, g, S, E); }
                    asm volatile("" : "+s"(a), "+s"(c.bid), "+s"(c.G), "+s"(wj)); asm volatile("" : "+v"(c.tid));
                    { int kq = 256; asm volatile("" : "+s"(kq)); pg8::Gemm g{(const bf16_t*)(a->ws + P_GL), (const bf16_t*)(wj + WJ_L2G), M, D, kq, kq}; pg8::StaticOrder S; S.init(M / 256, D, c.G, c.bid);
                      EpiStore<false> E{regA, D, 2, 0, nullptr};
                      pg8::gemm_phase<EpiStore<false>, pg8::StaticOrder, 0, false, true>(c.lds, c.tid, g, S, E); }
                } else if (s == 3) { if (c.bid >= 128) { Ctx c2 = c; c2.bid = c.bid - 128; c2.G = c.G - 128; phase_ffn_weights(c2, a, layer); } else phase_scan(c, a, j, rp); }
                else {
                    pg8::Gemm g{(const bf16_t*)(a->ws + P_R), (const bf16_t*)(wj + WJ_O), M, D, D, D}; pg8::StaticOrder S; S.init(M / 256, D, c.G, c.bid);
                    EpiResid E{a->out, regA, ss_ffn};
                    pg8::gemm_phase<EpiResid, pg8::StaticOrder, 0, false, true>(c.lds, c.tid, g, S, E);
                }
            }
            else if (s == 6) {
                pg8::Gemm g{regA - 2 * D, (const bf16_t*)(a->ws + WS_WFFN), M, FF2, D, D}; pg8::StaticOrder S; S.init(133, FF2, c.G, c.bid);
                EpiFfnUp E{(bf16_t*)(a->ws + P_ACT), ss_ffn, a->in[I_FCW] + (size_t)layer * 3 * FF2, a->in[I_FCB] + (size_t)layer * FF2};
                pg8::gemm_phase<EpiFfnUp, pg8::StaticOrder, 2, false, true>(c.lds, c.tid, g, S, E);
            }
            else {
                pg8::Gemm g{(const bf16_t*)(a->ws + P_ACT), (const bf16_t*)(a->ws + WS_WDOWN), M, D, FF, FF}; pg8::StaticOrder S; S.init(M / 256, D, c.G, c.bid);
                EpiResid E{a->out, regA, ss_next};
                pg8::gemm_phase<EpiResid, pg8::StaticOrder, 0, false, true>(c.lds, c.tid, g, S, E);
            }
        }
        }
        if (p + 1 < ph_hi) { if (p == 0) cg::this_grid().sync(); else xcd_barrier(xbar); }
    }
}

constexpr int LDS_BYTES = 147456;
#ifndef MK_ONE_LAUNCH
#define MK_ONE_LAUNCH 1
#endif
extern "C" void kernel_launch(void* const* d_in, const int* in_sizes, int n_in, void* d_out, int out_size, void* d_ws, size_t ws_size, hipStream_t stream) {
    static int grid = 0;
    if (grid == 0) {
        if (n_in != 32 || out_size != M * D || ws_size < WS_END) { fprintf(stderr, "kernel_launch: unexpected shapes (n_in %d out %d ws %zu, need %zu)\n", n_in, out_size, ws_size, (size_t)WS_END); grid = -1; return; }
        int dev = 0, cus = 0, per_cu = 0;
        (void)hipGetDevice(&dev); (void)hipDeviceGetAttribute(&cus, hipDeviceAttributeMultiprocessorCount, dev);
        if (hipFuncSetAttribute((const void*)mk_fwd, hipFuncAttributeMaxDynamicSharedMemorySize, LDS_BYTES) != hipSuccess) { fprintf(stderr, "kernel_launch: hipFuncSetAttribute failed\n"); grid = -1; return; }
        (void)hipOccupancyMaxActiveBlocksPerMultiprocessor(&per_cu, (const void*)mk_fwd, 512, LDS_BYTES);
        if (per_cu < 1) per_cu = 1;
        grid = cus * 1;
        (void)hipGetLastError();
    }
    if (grid < 0) return;
    if (hipMemsetAsync((char*)d_ws + WS_CTL, 0, CTL_BYTES, stream) != hipSuccess) { fprintf(stderr, "kernel_launch: memset failed\n"); return; }
    Args a{};
    for (int i = 0; i < 32; ++i) a.in[i] = (const float*)d_in[i];
    a.out = (float*)d_out; a.ws = (unsigned char*)d_ws;
#if MK_ONE_LAUNCH
    a.ph_lo = 0; a.ph_hi = NPH;
    void* args[] = {&a};
    hipError_t e = hipLaunchCooperativeKernel((const void*)mk_fwd, dim3(grid), dim3(512), args, LDS_BYTES, stream);
    if (e != hipSuccess) fprintf(stderr, "cooperative launch failed: %s (grid %d)\n", hipGetErrorString(e), grid);
#else
    for (int p = 0; p < NPH; ++p) { if (!phase_active(p)) continue; a.ph_lo = p; a.ph_hi = p + 1; hipLaunchKernelGGL(mk_fwd, dim3(grid), dim3(512), LDS_BYTES, stream, a); }
#endif
}
```

```cpp
#include <hip/hip_runtime.h>
#include <hip/hip_cooperative_groups.h>
#include <cstdio>
#include <cstdint>
#include <cmath>
namespace cg = cooperative_groups;
#ifndef MK_PROBE
#define MK_PROBE 0
#endif
#ifndef MK_PROBE_SEL
#define MK_PROBE_SEL 0
#endif
namespace pg8 {
#define PG8_LAS __attribute__((address_space(3)))
typedef unsigned short bf16_t;
typedef short bf16x8 __attribute__((ext_vector_type(8)));
typedef float f32x4 __attribute__((ext_vector_type(4)));
typedef float f32x2 __attribute__((ext_vector_type(2)));
typedef unsigned u32x4 __attribute__((ext_vector_type(4)));
typedef unsigned u32x2 __attribute__((ext_vector_type(2)));
constexpr int BM = 256, BK = 64, HALF = 128, HTB = HALF * BK * 2  , STAGE_BYTES = 8 * HTB, NXCD = 8, WGM = 8;

__host__ __device__ __forceinline__ int lds_byte(int r, int c) { const int st = (r >> 4) * 2 + (c >> 5), rr = r & 15, cc = c & 31, ob = rr * 64 + cc * 2; return st * 1024 + (ob ^ (((ob >> 9) & 1) << 5)); }
__host__ __device__ __forceinline__ void stage_rc(int b, int& R, int& C) { const int st = b / 1024, sb = b % 1024, swz = sb ^ (((sb >> 9) & 1) << 5); R = (st >> 1) * 16 + swz / 64; C = (st & 1) * 32 + (swz % 64) / 2; }
__host__ __device__ __forceinline__ int perm32(int rho) { const int n = rho >> 4, i = rho & 15; return 8 * (i >> 2) + 4 * n + (i & 3); }

struct Unit { int pm, pn; };
struct Gemm { const bf16_t* A; const bf16_t* Bt; int M, N, K, lda; };

struct StaticOrder {
    int nM, nN, nwg, G, c;
    __host__ __device__ void init(int nM_, int N, int G_, int c_) { nM = nM_; nN = N / BM; nwg = nM * nN; G = G_; c = c_; }
    __host__ __device__ bool next(int i, Unit& u) const {
        const long L = (long)i * G + c; if (L >= nwg) return false;
        int wgid = (int)L; { const int q = nwg / NXCD, r = nwg % NXCD, xcd = wgid % NXCD, off = wgid / NXCD; wgid = (xcd < r ? xcd * (q + 1) : r * (q + 1) + (xcd - r) * q) + off; }
        const int nig = WGM * nN, gid = wgid / nig, fm = gid * WGM, gsz = (nM - fm) < WGM ? (nM - fm) : WGM;
        u.pm = fm + ((wgid % nig) % gsz); u.pn = (wgid % nig) / gsz; return true;
    }
};

__device__ __forceinline__ unsigned cvt_pk_bf16(float lo, float hi) { unsigned r; asm volatile("v_cvt_pk_bf16_f32 %0, %1, %2" : "=v"(r) : "v"(lo), "v"(hi)); return r; }
__device__ __forceinline__ f32x2 gelu_pk(f32x2 v) {
    const f32x2 av = __builtin_elementwise_abs(v), d = av * 0.2316418882f + 1.0f;
    f32x2 t; t.x = __builtin_amdgcn_rcpf(d.x); t.y = __builtin_amdgcn_rcpf(d.y);
    f32x2 q = t * 0.5307027145f + (-0.7265760135f); q = q * t + 0.7107068705f; q = q * t + (-0.142248368f); q = q * t + 0.127414796f; q = q * t;
    const f32x2 s = (v * v) * (-0.72134752044f);
    f32x2 e; e.x = __builtin_amdgcn_exp2f(s.x); e.y = __builtin_amdgcn_exp2f(s.y);
    const f32x2 m = v * (q * e), r = v - m;
    f32x2 o; o.x = v.x < 0.f ? m.x : r.x; o.y = v.y < 0.f ? m.y : r.y; return o;
}

template <class Epi, class Sched, int AMAP, bool KDBL, bool ALIGN_EPI>
__device__ __forceinline__ void gemm_phase(PG8_LAS unsigned char* lds, const int tid, const Gemm g, const Sched& S, const Epi& E) {
    const int wid = __builtin_amdgcn_readfirstlane(tid >> 6), lane = tid & 63, wr = wid >> 2, wc = wid & 3, fr = lane & 15, fq = lane >> 4;
    const int K = g.K, nt = K / BK, lda = g.lda;
    unsigned voffA[2], voffB[2];
#pragma unroll
    for (int i = 0; i < 2; ++i) { int R, C; stage_rc(tid * 16 + i * 8192, R, C); const int Rb = Epi::PERM ? ((R & ~31) + perm32(R & 31)) : R;
        const int Ra = (AMAP == 2) ? (R - 2 * (R >> 6)) : R;
        voffA[i] = (unsigned)(Ra * lda + C) * 2u; voffB[i] = (unsigned)(Rb * K + C) * 2u; }
    const size_t kstep = (size_t)(BK * 2);
    const size_t hstepA = (size_t)((AMAP == 2) ? 124 : HALF) * lda * 2;
    const size_t hstepB = (size_t)HALF * K * 2;
    const size_t tstepB = 2 * hstepB;
    const size_t rowA = (size_t)lda * 2;
    const unsigned ldsw = (unsigned)wid * 1024u;
    const int aoff = lds_byte(wr * 64 + fr, fq * 8), boff = lds_byte(wc * 32 + fr, fq * 8);
#define PG8_ABASE(pm) ((const char*)g.A + (AMAP == 1 ? (size_t)(((pm) >> 4) * 4104 + 8 + ((pm) & 15) * 256) * rowA : (AMAP == 2 ? (size_t)(pm) * 248 * rowA : (size_t)(pm) * 256 * rowA)))
#define PG8_KA(base, t) (KDBL ? ((base) + (size_t)((t) & 15) * kstep - (size_t)((t) >> 4) * rowA) : ((base) + (size_t)(t) * kstep))
#define PG8_SA(b, h) (((b) * 2 + (h)) * HTB)
#define PG8_SB(b, h) ((4 + (b) * 2 + (h)) * HTB)
#define PG8_STAGE(bufoff, gbase, voff) do { _Pragma("unroll") for (int _i = 0; _i < 2; ++_i) \
        __builtin_amdgcn_global_load_lds((const unsigned*)((const char*)(gbase) + (voff)[_i]), (PG8_LAS unsigned*)(lds + (bufoff) + ldsw + _i * 8192), 16, 0, 0); } while (0)
#define PG8_LDA(dst, b, h) do { _Pragma("unroll") for (int m = 0; m < 4; ++m) _Pragma("unroll") for (int k = 0; k < 2; ++k) dst[m][k] = *(const PG8_LAS bf16x8*)(lds + PG8_SA(b, h) + aoff + m * 2048 + k * 1024); } while (0)
#define PG8_LDB(dst, b, h) do { _Pragma("unroll") for (int n = 0; n < 2; ++n) _Pragma("unroll") for (int k = 0; k < 2; ++k) dst[n][k] = *(const PG8_LAS bf16x8*)(lds + PG8_SB(b, h) + boff + n * 2048 + k * 1024); } while (0)
#define PG8_MMA(ai, bj, At, Bt) do { __builtin_amdgcn_s_setprio(1); _Pragma("unroll") for (int m = 0; m < 4; ++m) _Pragma("unroll") for (int n = 0; n < 2; ++n) _Pragma("unroll") for (int k = 0; k < 2; ++k) \
        acc[ai][bj][m][n] = __builtin_amdgcn_mfma_f32_16x16x32_bf16(Bt[n][k], At[m][k], acc[ai][bj][m][n], 0, 0, 0); __builtin_amdgcn_s_setprio(0); } while (0)
#define PG8_WAIT_V(n) asm volatile("s_waitcnt vmcnt(" #n ")" ::: "memory")
#define PG8_WAIT_L(n) asm volatile("s_waitcnt lgkmcnt(" #n ")" ::: "memory")
#define PG8_BAR __builtin_amdgcn_s_barrier()
#define PG8_SCHED __builtin_amdgcn_sched_barrier(0)
    Unit cur, nxt; int ui = 0;
    if (!S.next(0, cur)) return;
    f32x4 acc[2][2][4][2];
#pragma unroll
    for (int a = 0; a < 2; ++a)
#pragma unroll
        for (int b = 0; b < 2; ++b)
#pragma unroll
            for (int m = 0; m < 4; ++m)
#pragma unroll
                for (int n = 0; n < 2; ++n) acc[a][b][m][n] = (f32x4){0.f, 0.f, 0.f, 0.f};
    bf16x8 At[4][2], B0[2][2], B1[2][2];
    const char* cA = PG8_ABASE(cur.pm); const char* cB = (const char*)g.Bt + (size_t)cur.pn * tstepB;
    {
        const char* cA1 = PG8_KA(cA, 1);
        PG8_STAGE(PG8_SB(0, 0), cB, voffB); PG8_STAGE(PG8_SB(0, 1), cB + hstepB, voffB); PG8_STAGE(PG8_SA(0, 0), cA, voffA); PG8_STAGE(PG8_SA(0, 1), cA + hstepA, voffA);
        if (wr == 1) PG8_BAR;
        PG8_WAIT_V(2); PG8_BAR;
        PG8_STAGE(PG8_SB(1, 0), cB + kstep, voffB); PG8_STAGE(PG8_SA(1, 0), cA1, voffA); PG8_STAGE(PG8_SB(1, 1), cB + hstepB + kstep, voffB);
        PG8_WAIT_V(6); PG8_BAR;
    }
    for (;;) {
        const bool has_next = S.next(ui + 1, nxt);
        const char* nA = has_next ? PG8_ABASE(nxt.pm) : cA; const char* nB = has_next ? (const char*)g.Bt + (size_t)nxt.pn * tstepB : cB;
        for (int t = 0; t < nt; t += 2) {
            const bool last = (t == nt - 2);
            const char* a1 = PG8_KA(cA, t + 1);
            const char* a2 = last ? nA : PG8_KA(cA, t + 2); const char* b2 = last ? nB : cB + (size_t)(t + 2) * kstep;
            const char* a3 = last ? PG8_KA(nA, 1) : PG8_KA(cA, t + 3); const char* b3 = b2 + kstep;
            PG8_LDB(B0, 0, 0); PG8_LDB(B1, 0, 1); PG8_SCHED; PG8_LDA(At, 0, 0); PG8_STAGE(PG8_SA(1, 1), a1 + hstepA, voffA);
            PG8_WAIT_V(8); PG8_WAIT_L(0); PG8_BAR; PG8_MMA(0, 0, At, B0); PG8_MMA(0, 1, At, B1); PG8_BAR; PG8_SCHED;
            PG8_LDA(At, 0, 1); PG8_STAGE(PG8_SB(0, 0), b2, voffB); PG8_STAGE(PG8_SB(0, 1), b2 + hstepB, voffB); PG8_STAGE(PG8_SA(0, 0), a2, voffA);
            PG8_WAIT_V(8); PG8_WAIT_L(0); PG8_BAR; PG8_MMA(1, 0, At, B0); PG8_MMA(1, 1, At, B1); PG8_BAR; PG8_SCHED;
            PG8_LDB(B0, 1, 0); PG8_LDB(B1, 1, 1); PG8_SCHED; PG8_LDA(At, 1, 0); PG8_STAGE(PG8_SA(0, 1), a2 + hstepA, voffA);
            PG8_WAIT_V(8); PG8_WAIT_L(0); PG8_BAR; PG8_MMA(0, 0, At, B0); PG8_MMA(0, 1, At, B1); PG8_BAR; PG8_SCHED;
            PG8_LDA(At, 1, 1); PG8_STAGE(PG8_SB(1, 0), b3, voffB); PG8_STAGE(PG8_SB(1, 1), b3 + hstepB, voffB); PG8_STAGE(PG8_SA(1, 0), a3, voffA);
            PG8_WAIT_V(8); PG8_WAIT_L(0); PG8_BAR; PG8_MMA(1, 0, At, B0); PG8_MMA(1, 1, At, B1); PG8_BAR; PG8_SCHED;
        }
        if constexpr (ALIGN_EPI) { if (wr == 0) PG8_BAR; }
        E(acc, cur, wr, wc, fr, fq);
        if (!has_next) break;
#pragma unroll
        for (int a = 0; a < 2; ++a)
#pragma unroll
            for (int b = 0; b < 2; ++b)
#pragma unroll
                for (int m = 0; m < 4; ++m)
#pragma unroll
                    for (int n = 0; n < 2; ++n) acc[a][b][m][n] = (f32x4){0.f, 0.f, 0.f, 0.f};
        cur = nxt; cA = nA; cB = nB; ++ui;
        if constexpr (ALIGN_EPI) { if (wr == 1) PG8_BAR; }
    }
    PG8_WAIT_V(0);
    if constexpr (!ALIGN_EPI) { if (wr == 0) PG8_BAR; }
    PG8_BAR;
#undef PG8_ABASE
#undef PG8_KA
#undef PG8_SA
#undef PG8_SB
#undef PG8_STAGE
#undef PG8_LDA
#undef PG8_LDB
#undef PG8_MMA
#undef PG8_WAIT_V
#undef PG8_WAIT_L
#undef PG8_BAR
#undef PG8_SCHED
}
}
using pg8::bf16_t; using pg8::f32x4; using pg8::f32x2; using pg8::u32x4; using pg8::u32x2; using pg8::Unit; using pg8::cvt_pk_bf16;
#define LAS __attribute__((address_space(3)))
constexpr int BATCH = 8, SEQ = 4096, D = 1024, M = BATCH * SEQ, FF = 2816, FF2 = 5632;
constexpr int PADR = 8, SEQP = SEQ + PADR;
constexpr float RMS_EPS = 1e-6f, GN_EPS = 64e-5f;
constexpr size_t MiB = 1u << 20;
constexpr size_t WS_CTL = 0, CTL_BYTES = 16384;
constexpr size_t WS_WSTAT = 2 * MiB;
constexpr size_t WJ_IN = 0, WJ_OUT = 4 * MiB, WJ_RKV = 6 * MiB, WJ_L2WA = 20 * MiB, WJ_L2G = 20 * MiB + 512 * 1024, WJ_O = 21 * MiB, WJ_STRIDE = 23 * MiB;
constexpr size_t WS_WFFN = 48 * MiB;
constexpr size_t WS_WDOWN = WS_WFFN + 11 * MiB;
constexpr size_t WS_A = 67 * MiB;
constexpr size_t WS_P = 134 * MiB;
constexpr size_t P_R = WS_P, P_K = WS_P + 64 * MiB, P_V = WS_P + 128 * MiB, P_LW = WS_P + 192 * MiB, P_LA = WS_P + 256 * MiB, P_WA = WS_P + 320 * MiB, P_GL = WS_P + 328 * MiB;
constexpr size_t P_U = WS_P, P_SV = WS_P + 64 * MiB;
constexpr size_t P_Z = WS_P, P_ACT = WS_P + 176 * MiB;
constexpr size_t WS_PA = WS_P + 352 * MiB, WS_PB = WS_PA + 2 * MiB, WS_PV = WS_PB + 2 * MiB;
constexpr size_t WS_END = WS_PV + 2 * MiB;

struct Args {
    const float* in[32]; float* out; unsigned char* ws; int ph_lo, ph_hi;
};
enum { I_X = 0, I_NMIX, I_NFFN, I_NFIN, I_SWIN, I_SBIN, I_SGV, I_SWS, I_SBS, I_SWOUT, I_MU, I_WR, I_WK, I_WV, I_WO, I_W0, I_W1, I_W2, I_A0, I_A1, I_A2, I_G1, I_G2, I_KK, I_KA, I_RK, I_LNW, I_LNB, I_FUP, I_FCW, I_FCB, I_FDN };

__device__ __forceinline__ float bf2f(unsigned short b) { return __uint_as_float((unsigned)b << 16); }
__device__ __forceinline__ float bflo(unsigned w) { return __uint_as_float(w << 16); }
__device__ __forceinline__ float bfhi(unsigned w) { return __uint_as_float(w & 0xffff0000u); }
__device__ __forceinline__ float wave_sum(float v) {
#pragma unroll
    for (int o = 1; o < 64; o <<= 1) v += __shfl_xor(v, o);
    return v;
}
__device__ __forceinline__ float row_rstd(const float* P, int row) { const f32x4* p = (const f32x4*)(P + (size_t)row * 16); const f32x4 a = p[0], b = p[1], c = p[2], d = p[3];
    const float s = ((a.x + a.y) + (a.z + a.w)) + ((b.x + b.y) + (b.z + b.w)) + ((c.x + c.y) + (c.z + c.w)) + ((d.x + d.y) + (d.z + d.w)); return rsqrtf(s * (1.f / D) + RMS_EPS); }
__device__ __forceinline__ void row_rstd4(const float* P, int row0, int rstride, int lo, int hi, float (&rs)[4]) {
    f32x4 p[4][4];
#pragma unroll
    for (int m = 0; m < 4; ++m) { int r = row0 + m * rstride; r = r < lo ? lo : (r > hi ? hi : r); const f32x4* q = (const f32x4*)(P + (size_t)r * 16);
#pragma unroll
        for (int k = 0; k < 4; ++k) p[m][k] = q[k]; }
#pragma unroll
    for (int m = 0; m < 4; ++m) { const f32x4 a = p[m][0], b = p[m][1], c = p[m][2], d = p[m][3];
        const float s = ((a.x + a.y) + (a.z + a.w)) + ((b.x + b.y) + (b.z + b.w)) + ((c.x + c.y) + (c.z + c.w)) + ((d.x + d.y) + (d.z + d.w)); rs[m] = rsqrtf(s * (1.f / D) + RMS_EPS); }
}
template <int CTRL> __device__ __forceinline__ float dpp_f(float v) { return __int_as_float(__builtin_amdgcn_mov_dpp(__float_as_int(v), CTRL, 0xf, 0xf, true)); }
__device__ __forceinline__ float sum8(float v) { v += dpp_f<0x141>(v); v += dpp_f<0xB1>(v); v += dpp_f<0x4E>(v); return v; }
__device__ __forceinline__ float sigmoidf_(float x) { return 1.f / (1.f + __expf(-x)); }

template <bool SCALE> struct EpiStore {
    static constexpr bool PERM = true;
    bf16_t* O; int ldc; int tsh; size_t split_stride; const float* ss;
    __device__ __forceinline__ void operator()(const f32x4 (&acc)[2][2][4][2], const Unit& u, int wr, int wc, int fr, int fq) const {
        bf16_t* base = O + (size_t)(u.pn >> tsh) * split_stride + (size_t)(u.pm * 256 + wr * 64 + fr) * ldc + (u.pn & ((1 << tsh) - 1)) * 256 + wc * 32 + 8 * fq;
        const int row0 = u.pm * 256 + wr * 64 + fr;
#pragma unroll
        for (int ai = 0; ai < 2; ++ai)
#pragma unroll
            for (int m = 0; m < 4; ++m) {
                const float rs = SCALE ? row_rstd(ss, row0 + ai * 128 + m * 16) : 1.f;
                bf16_t* rowp = base + (size_t)(ai * 128 + m * 16) * ldc;
#pragma unroll
                for (int bj = 0; bj < 2; ++bj) { const f32x4 v0 = acc[ai][bj][m][0] * rs, v1 = acc[ai][bj][m][1] * rs;
                    u32x4 w; w.x = cvt_pk_bf16(v0[0], v0[1]); w.y = cvt_pk_bf16(v0[2], v0[3]); w.z = cvt_pk_bf16(v1[0], v1[1]); w.w = cvt_pk_bf16(v1[2], v1[3]);
                    *(u32x4*)(rowp + bj * 128) = w; } }
    }
};
struct EpiSguIn {
    static constexpr bool PERM = true;
    bf16_t* U; bf16_t* V; const float* ss; const float* bias; float* ssv;
    __device__ __forceinline__ void operator()(const f32x4 (&acc)[2][2][4][2], const Unit& u, int wr, int wc, int fr, int fq) const {
        const bool isv = u.pn >= 4; bf16_t* base = isv ? V : U; const int colt = (u.pn & 3) * 256 + wc * 32 + 8 * fq, bcol = u.pn * 256 + wc * 32 + 8 * fq;
        f32x4 bv[2][2];
#pragma unroll
        for (int bj = 0; bj < 2; ++bj)
#pragma unroll
            for (int n = 0; n < 2; ++n) bv[bj][n] = *(const f32x4*)(bias + bcol + bj * 128 + 4 * n);
#pragma unroll
        for (int ai = 0; ai < 2; ++ai) {
            float rs4[4]; row_rstd4(ss, u.pm * 256 + ai * 128 + wr * 64 + fr, 16, 0, M - 1, rs4);
#pragma unroll
            for (int m = 0; m < 4; ++m) { const int row = u.pm * 256 + ai * 128 + wr * 64 + m * 16 + fr;
                const float rs = rs4[m]; float s = 0.f;
                bf16_t* rowp = base + (size_t)row * D + colt;
#pragma unroll
                for (int bj = 0; bj < 2; ++bj) { f32x4 v0 = acc[ai][bj][m][0] * rs + bv[bj][0], v1 = acc[ai][bj][m][1] * rs + bv[bj][1];
                    const f32x2 a = pg8::gelu_pk((f32x2){v0[0], v0[1]}), b = pg8::gelu_pk((f32x2){v0[2], v0[3]}), c = pg8::gelu_pk((f32x2){v1[0], v1[1]}), d = pg8::gelu_pk((f32x2){v1[2], v1[3]});
                    s += (a.x * a.x + a.y * a.y) + (b.x * b.x + b.y * b.y) + (c.x * c.x + c.y * c.y) + (d.x * d.x + d.y * d.y);
                    u32x4 w; w.x = cvt_pk_bf16(a.x, a.y); w.y = cvt_pk_bf16(b.x, b.y); w.z = cvt_pk_bf16(c.x, c.y); w.w = cvt_pk_bf16(d.x, d.y);
                    *(u32x4*)(rowp + bj * 128) = w; }
                if (isv) { s += __shfl_xor(s, 16); s += __shfl_xor(s, 32); if (fq == 0) ssv[(size_t)row * 16 + (u.pn - 4) * 4 + wc] = s; } } }
    }
};
struct EpiResid {
    static constexpr bool PERM = true;
    float* h; bf16_t* hb; float* ssn;
    __device__ __forceinline__ void operator()(const f32x4 (&acc)[2][2][4][2], const Unit& u, int wr, int wc, int fr, int fq) const {
        const int colt = u.pn * 256 + wc * 32 + 8 * fq;
#pragma unroll
        for (int ai = 0; ai < 2; ++ai) {
            const int rowb = u.pm * 256 + ai * 128 + wr * 64 + fr;
            f32x4 pre[4][2][2];
#pragma unroll
            for (int m = 0; m < 4; ++m)
#pragma unroll
                for (int bj = 0; bj < 2; ++bj) { const float* hp = h + (size_t)(rowb + m * 16) * D + colt + bj * 128; pre[m][bj][0] = *(const f32x4*)hp; pre[m][bj][1] = *(const f32x4*)(hp + 4); }
#pragma unroll
            for (int m = 0; m < 4; ++m) { const int row = rowb + m * 16; float s = 0.f;
                float* hp = h + (size_t)row * D + colt; bf16_t* bp = hb + (size_t)row * D + colt;
#pragma unroll
                for (int bj = 0; bj < 2; ++bj) { const f32x4 v0 = pre[m][bj][0] + acc[ai][bj][m][0], v1 = pre[m][bj][1] + acc[ai][bj][m][1];
                    *(f32x4*)(hp + bj * 128) = v0; *(f32x4*)(hp + bj * 128 + 4) = v1;
                    s += (v0[0] * v0[0] + v0[1] * v0[1]) + (v0[2] * v0[2] + v0[3] * v0[3]) + (v1[0] * v1[0] + v1[1] * v1[1]) + (v1[2] * v1[2] + v1[3] * v1[3]);
                    u32x4 w; w.x = cvt_pk_bf16(v0[0], v0[1]); w.y = cvt_pk_bf16(v0[2], v0[3]); w.z = cvt_pk_bf16(v1[0], v1[1]); w.w = cvt_pk_bf16(v1[2], v1[3]);
                    *(u32x4*)(bp + bj * 128) = w; }
                s += __shfl_xor(s, 16); s += __shfl_xor(s, 32); if (fq == 0) ssn[(size_t)row * 16 + u.pn * 4 + wc] = s; }
            asm volatile("" ::: "memory");
        }
    }
};
template <int CTRL> __device__ __forceinline__ f32x4 dpp4(f32x4 v) { f32x4 r; r.x = dpp_f<CTRL>(v.x); r.y = dpp_f<CTRL>(v.y); r.z = dpp_f<CTRL>(v.z); r.w = dpp_f<CTRL>(v.w); return r; }
struct EpiFfnUp {
    static constexpr bool PERM = true;
    bf16_t* ACT; const float* ss; const float* cw; const float* cb;
    __device__ __forceinline__ void conv4(f32x4& z0, f32x4& z1, f32x4& z2, f32x4& z3, const float (&rs)[4], const int (&tt)[4], const float* wcol, const float* bcol, int fr) const {
        const f32x4 w0 = *(const f32x4*)wcol, w1 = *(const f32x4*)(wcol + FF2), w2 = *(const f32x4*)(wcol + 2 * FF2), bb = *(const f32x4*)bcol;
#pragma unroll
        for (int e = 0; e < 4; e += 2) {
            const f32x2 w0p = {w0[e], w0[e + 1]}, w1p = {w1[e], w1[e + 1]}, w2p = {w2[e], w2[e + 1]}, bp = {bb[e], bb[e + 1]};
            f32x2 cur = (f32x2){z3[e], z3[e + 1]} * rs[3];
            f32x2 c1 = {dpp_f<0x121>(cur.x), dpp_f<0x121>(cur.y)}, c2 = {dpp_f<0x122>(cur.x), dpp_f<0x122>(cur.y)};
#define CONV_STEP(ZM, ZP, MI, HASP) { f32x2 prv = cur, p1 = c1, p2 = c2; if (HASP) { prv = (f32x2){ZP[e], ZP[e + 1]} * rs[MI - (HASP)]; p1 = (f32x2){dpp_f<0x121>(prv.x), dpp_f<0x121>(prv.y)}; p2 = (f32x2){dpp_f<0x122>(prv.x), dpp_f<0x122>(prv.y)}; } \
            f32x2 y1 = (fr == 0) ? p1 : c1, y2 = (fr < 2) ? p2 : c2; if (tt[MI] < 1) y1 = (f32x2){0.f, 0.f}; if (tt[MI] < 2) y2 = (f32x2){0.f, 0.f}; \
            const f32x2 o = w0p * y2 + (w1p * y1 + (w2p * cur + bp)); ZM[e] = o.x; ZM[e + 1] = o.y; cur = prv; c1 = p1; c2 = p2; }
            CONV_STEP(z3, z2, 3, 1) CONV_STEP(z2, z1, 2, 1) CONV_STEP(z1, z0, 1, 1) CONV_STEP(z0, z0, 0, 0)
#undef CONV_STEP
            asm volatile("" : "+v"(z0[e]), "+v"(z1[e]), "+v"(z2[e]), "+v"(z3[e]), "+v"(z0[e + 1]), "+v"(z1[e + 1]), "+v"(z2[e + 1]), "+v"(z3[e + 1]));
        }
    }
    __device__ __forceinline__ void operator()(f32x4 (&acc)[2][2][4][2], const Unit& u, int wr, int wc, int fr, int fq) const {
        const int f0 = u.pn * 128 + wc * 32 + 8 * fq;
#pragma unroll
        for (int ai = 0; ai < 2; ++ai) {
            const int gbase = u.pm * 248 - 2 + 62 * (2 * ai + wr) + fr;
            float rs[4]; int tt[4];
            row_rstd4(ss, gbase, 16, 0, M - 1, rs);
            asm volatile("" : "+v"(rs[0]), "+v"(rs[1]), "+v"(rs[2]), "+v"(rs[3]) :: "memory");
            { const int g0 = u.pm * 248 - 2 + 62 * (2 * ai + wr);
              const bool seqstart = ((g0 + 63) & (SEQ - 1)) < 65 || g0 < 0;
#pragma unroll
              for (int m = 0; m < 4; ++m) tt[m] = seqstart ? ((gbase + 16 * m) & (SEQ - 1)) : 2; }
#pragma unroll
            for (int n = 0; n < 2; ++n) {
                conv4(acc[ai][0][0][n], acc[ai][0][1][n], acc[ai][0][2][n], acc[ai][0][3][n], rs, tt, cw + f0 + 4 * n, cb + f0 + 4 * n, fr);
                asm volatile("" ::: "memory");
                conv4(acc[ai][1][0][n], acc[ai][1][1][n], acc[ai][1][2][n], acc[ai][1][3][n], rs, tt, cw + FF + f0 + 4 * n, cb + FF + f0 + 4 * n, fr);
                asm volatile("" ::: "memory");
#pragma unroll
                for (int m = 0; m < 4; ++m) { const int g = gbase + 16 * m;
                    if ((m > 0 || fr >= 2) && g < M) { const f32x4 gt = acc[ai][0][m][n], vl = acc[ai][1][m][n]; f32x4 o;
#pragma unroll
                        for (int e = 0; e < 4; ++e) o[e] = gt[e] * sigmoidf_(gt[e]) * vl[e];
                        u32x2 w; w.x = cvt_pk_bf16(o[0], o[1]); w.y = cvt_pk_bf16(o[2], o[3]);
                        *(u32x2*)(ACT + (size_t)g * FF + f0 + 4 * n) = w; } }
            }
        }
    }
};
struct EpiRkv {
    static constexpr bool PERM = true;
    bf16_t* R; bf16_t* WA; bf16_t* GL;
    __device__ __forceinline__ void operator()(const f32x4 (&acc)[2][2][4][2], const Unit& u, int wr, int wc, int fr, int fq) const {
        const int mode = u.pn < 12 ? 0 : (u.pn == 12 ? 1 : 2);
        bf16_t* base; int ldc, colt;
        if (mode == 0) { base = R + (size_t)(u.pn >> 2) * ((size_t)M * D); ldc = D; colt = (u.pn & 3) * 256 + wc * 32 + 8 * fq; }
        else if (mode == 1) { base = WA; ldc = 128; colt = wc * 32 + 8 * fq; }
        else { base = GL; ldc = 256; colt = wc * 32 + 8 * fq; }
#pragma unroll
        for (int ai = 0; ai < 2; ++ai)
#pragma unroll
            for (int m = 0; m < 4; ++m) { const int row = u.pm * 256 + ai * 128 + wr * 64 + m * 16 + fr;
                bf16_t* rowp = base + (size_t)row * ldc + colt;
#pragma unroll
                for (int bj = 0; bj < 2; ++bj) { f32x4 v0 = acc[ai][bj][m][0], v1 = acc[ai][bj][m][1];
                    if (mode == 1) { if (bj == 1) continue;
                        if (wc < 2) {
#pragma unroll
                            for (int e = 0; e < 4; ++e) { v0[e] = tanhf(v0[e]); v1[e] = tanhf(v1[e]); } } }
                    else if (mode == 2) {
#pragma unroll
                        for (int e = 0; e < 4; ++e) { v0[e] = sigmoidf_(v0[e]); v1[e] = sigmoidf_(v1[e]); } }
                    u32x4 w; w.x = cvt_pk_bf16(v0[0], v0[1]); w.y = cvt_pk_bf16(v0[2], v0[3]); w.z = cvt_pk_bf16(v1[0], v1[1]); w.w = cvt_pk_bf16(v1[2], v1[3]);
                    *(u32x4*)(rowp + bj * 128) = w; } }
    }
};

typedef const __attribute__((address_space(4))) Args* CA;
struct Ctx { LAS unsigned char* lds; int tid, lane, wave, G, bid; };

__device__ __forceinline__ void conv_mat(const Ctx& c, const float* src, int ldsrc, int K, int N, int Kp, int Np, bf16_t* dst, int ldd, int n_off, int k_off, const float* sc, int mode, int rot) {
    LAS float* tile = (LAS float*)c.lds;
    const int nnb = Np / 64, nit = (Kp / 64) * nnb; const int start = (c.bid + c.G - (rot % c.G)) % c.G;
    for (int it = start; it < nit; it += c.G) {
        const int kb = it / nnb, nb = it % nnb, k0 = kb * 64, n0 = nb * 64;
#pragma unroll
        for (int j = 0; j < 8; ++j) { const int kk = (c.tid >> 6) + 8 * j, nn = c.tid & 63, k = k0 + kk, n = n0 + nn; float v = 0.f;
            if (src && k < K && n < N) { v = src[(size_t)k * ldsrc + n]; if (mode == 1) v *= sc[k]; else if (mode == 2) v *= (1.f - sc[k]); }
            tile[nn * 65 + kk] = v; }
        __syncthreads();
        { const int nn = c.tid >> 3, cc = c.tid & 7; const LAS float* s = tile + nn * 65 + 8 * cc;
            u32x4 o; o.x = cvt_pk_bf16(s[0], s[1]); o.y = cvt_pk_bf16(s[2], s[3]); o.z = cvt_pk_bf16(s[4], s[5]); o.w = cvt_pk_bf16(s[6], s[7]);
            *(u32x4*)(dst + (size_t)(n_off + n0 + nn) * ldd + k_off + k0 + 8 * cc) = o; }
        __syncthreads();
    }
}

__device__ __forceinline__ void phase_static_weights(const Ctx& c, CA a, int j);
__device__ __forceinline__ void phase_prologue(const Ctx& c, CA a) {
    float* ss = (float*)(a->ws + WS_PA);
    const int gw = c.bid * 8 + c.wave, NGW = c.G * 8;
    bf16_t* hb = (bf16_t*)(a->ws + WS_A);
    for (int m = gw; m < M; m += NGW) {
        const f32x4* xr = (const f32x4*)(a->in[I_X] + (size_t)m * D) + c.lane; f32x4* hr = (f32x4*)(a->out + (size_t)m * D) + c.lane; u32x2* br = (u32x2*)(hb + (size_t)m * D) + c.lane;
        float s = 0.f;
#pragma unroll
        for (int j = 0; j < 4; ++j) { const f32x4 v = xr[64 * j]; s += (v.x * v.x + v.y * v.y) + (v.z * v.z + v.w * v.w); hr[64 * j] = v; u32x2 w; w.x = cvt_pk_bf16(v.x, v.y); w.y = cvt_pk_bf16(v.z, v.w); br[64 * j] = w; }
        s = wave_sum(s); if (c.lane < 16) ss[(size_t)m * 16 + c.lane] = c.lane == 0 ? s : 0.f;
    }
    phase_static_weights(c, a, 0);
}
__device__ __forceinline__ void phase_static_weights(const Ctx& c, CA a, int j) {
    int rot = 0;
    {
        unsigned char* wj = a->ws + WS_WSTAT + (size_t)j * WJ_STRIDE;
        conv_mat(c, a->in[I_SWIN] + (size_t)j * D * 2048, 2048, D, 2048, D, 2048, (bf16_t*)(wj + WJ_IN), D, 0, 0, a->in[I_NMIX] + (size_t)(2 * j) * D, 1, rot); rot += 512;
        conv_mat(c, a->in[I_SWOUT] + (size_t)j * D * D, D, D, D, D, D, (bf16_t*)(wj + WJ_OUT), D, 0, 0, nullptr, 0, rot); rot += 256;
        const float* mu = a->in[I_MU] + (size_t)j * 6 * D; bf16_t* rkv = (bf16_t*)(wj + WJ_RKV);
#define CONV_BIG(IDX, Q, MUB) do { conv_mat(c, a->in[IDX] + (size_t)j * D * D, D, D, D, D, D, rkv, 2048, (Q) * 1024, 0, mu + (MUB) * D, 2, rot); rot += 256; \
            conv_mat(c, a->in[IDX] + (size_t)j * D * D, D, D, D, D, D, rkv, 2048, (Q) * 1024, 1024, mu + (MUB) * D, 1, rot); rot += 256; } while (0)
        CONV_BIG(I_WR, 0, 0); CONV_BIG(I_WK, 1, 2); CONV_BIG(I_WV, 2, 3);
#undef CONV_BIG
        conv_mat(c, a->in[I_W1] + (size_t)j * D * 64, 64, D, 64, D, 64, rkv, 2048, 3072, 0, mu + 1 * D, 2, rot); rot += 16;
        conv_mat(c, a->in[I_W1] + (size_t)j * D * 64, 64, D, 64, D, 64, rkv, 2048, 3072, 1024, mu + 1 * D, 1, rot); rot += 16;
        conv_mat(c, a->in[I_A1] + (size_t)j * D * 64, 64, D, 64, D, 64, rkv, 2048, 3136, 0, mu + 4 * D, 2, rot); rot += 16;
        conv_mat(c, a->in[I_A1] + (size_t)j * D * 64, 64, D, 64, D, 64, rkv, 2048, 3136, 1024, mu + 4 * D, 1, rot); rot += 16;
        conv_mat(c, nullptr, 0, 0, 0, 2048, 128, rkv, 2048, 3200, 0, nullptr, 0, rot); rot += 64;
        conv_mat(c, a->in[I_G1] + (size_t)j * D * 160, 160, D, 160, D, 256, rkv, 2048, 3328, 0, mu + 5 * D, 2, rot); rot += 64;
        conv_mat(c, a->in[I_G1] + (size_t)j * D * 160, 160, D, 160, D, 256, rkv, 2048, 3328, 1024, mu + 5 * D, 1, rot); rot += 64;
        bf16_t* l2wa = (bf16_t*)(wj + WJ_L2WA);
        conv_mat(c, a->in[I_W2] + (size_t)j * 64 * D, D, 64, D, 64, D, l2wa, 128, 0, 0, nullptr, 0, rot); rot += 16;
        conv_mat(c, nullptr, 0, 0, 0, 64, D, l2wa, 128, 0, 64, nullptr, 0, rot); rot += 16;
        conv_mat(c, nullptr, 0, 0, 0, 64, D, l2wa, 128, 1024, 0, nullptr, 0, rot); rot += 16;
        conv_mat(c, a->in[I_A2] + (size_t)j * 64 * D, D, 64, D, 64, D, l2wa, 128, 1024, 64, nullptr, 0, rot); rot += 16;
        conv_mat(c, a->in[I_G2] + (size_t)j * 160 * D, D, 160, D, 256, D, (bf16_t*)(wj + WJ_L2G), 256, 0, 0, nullptr, 0, rot); rot += 64;
        conv_mat(c, a->in[I_WO] + (size_t)j * D * D, D, D, D, D, D, (bf16_t*)(wj + WJ_O), D, 0, 0, nullptr, 0, rot); rot += 256;
    }
}
__device__ __forceinline__ void phase_ffn_weights(const Ctx& c, CA a, int layer) {
    for (int pn = 0; pn < FF / 128; ++pn) {
        conv_mat(c, a->in[I_FUP] + (size_t)layer * D * FF2 + pn * 128, FF2, D, 128, D, 128, (bf16_t*)(a->ws + WS_WFFN), D, pn * 256, 0, a->in[I_NFFN] + (size_t)layer * D, 1, pn * 64);
        conv_mat(c, a->in[I_FUP] + (size_t)layer * D * FF2 + FF + pn * 128, FF2, D, 128, D, 128, (bf16_t*)(a->ws + WS_WFFN), D, pn * 256 + 128, 0, a->in[I_NFFN] + (size_t)layer * D, 1, pn * 64 + 32);
    }
    conv_mat(c, a->in[I_FDN] + (size_t)layer * FF * D, D, FF, D, FF, D, (bf16_t*)(a->ws + WS_WDOWN), FF, 0, 0, nullptr, 0, 128);
}

__device__ __forceinline__ void phase_sgu_spatial(const Ctx& c, CA a, int j, int rp) {
    typedef short bf16x8 __attribute__((ext_vector_type(8)));
    bf16_t* U = (bf16_t*)(a->ws + P_U); const bf16_t* V = (const bf16_t*)(a->ws + P_SV); bf16_t* UO = rp ? (bf16_t*)(a->ws + P_SV) : U;
    const float* ssv = (const float*)(a->ws + WS_PV);
    LAS bf16_t* WL = (LAS bf16_t*)c.lds; LAS bf16_t* VT = WL + 128 * 136;
    const int g = c.bid & 15;
    const float* Ws = a->in[I_SWS] + ((size_t)j * 16 + g) * 128 * 128; const float* bs = a->in[I_SBS] + ((size_t)j * 16 + g) * 128; const float* gv = a->in[I_SGV] + (size_t)j * D + g * 64;
    __syncthreads();
    { const int t = c.tid >> 2, s0 = (c.tid & 3) * 32; const float* wp = Ws + (size_t)t * 128 + s0;
#pragma unroll
      for (int q = 0; q < 4; ++q) { f32x4 x0 = *(const f32x4*)(wp + 8 * q), x1 = *(const f32x4*)(wp + 8 * q + 4);
#pragma unroll
          for (int e = 0; e < 4; ++e) { if (s0 + 8 * q + e > t) x0[e] = 0.f; if (s0 + 8 * q + 4 + e > t) x1[e] = 0.f; }
          u32x4 w; w.x = cvt_pk_bf16(x0[0], x0[1]); w.y = cvt_pk_bf16(x0[2], x0[3]); w.z = cvt_pk_bf16(x1[0], x1[1]); w.w = cvt_pk_bf16(x1[2], x1[3]);
          *(LAS u32x4*)(WL + t * 136 + s0 + 8 * q) = w; } }
    const int w8 = c.wave, fr = c.lane & 15, fq = c.lane >> 4, t0 = 16 * w8, nk = (w8 >> 1) + 1;
    const int vs = c.tid >> 2, vc = (c.tid & 3) * 16;
    f32x4 gq[4];
#pragma unroll
    for (int e = 0; e < 4; ++e) gq[e] = *(const f32x4*)(gv + vc + 4 * e);
    const float bb = bs[t0 + fr];
    for (int ub = c.bid >> 4; ub < M / 128; ub += c.G >> 4) {
        const int m0 = ub * 128;
        { const bf16_t* vp = V + (size_t)(m0 + vs) * D + g * 64 + vc; const u32x4 v0 = *(const u32x4*)vp, v1 = *(const u32x4*)(vp + 8);
          const float rs = row_rstd(ssv, m0 + vs);
          const unsigned vw[8] = {v0.x, v0.y, v0.z, v0.w, v1.x, v1.y, v1.z, v1.w};
#pragma unroll
          for (int e = 0; e < 8; ++e) { const float lo = bflo(vw[e]) * rs * gq[e >> 1][(2 * e) & 3], hi = bfhi(vw[e]) * rs * gq[e >> 1][(2 * e + 1) & 3];
              const unsigned pk = cvt_pk_bf16(lo, hi);
              VT[(vc + 2 * e) * 136 + vs] = (bf16_t)(pk & 0xffffu); VT[(vc + 2 * e + 1) * 136 + vs] = (bf16_t)(pk >> 16); } }
        __syncthreads();
        f32x4 acc[4];
#pragma unroll
        for (int ct = 0; ct < 4; ++ct) acc[ct] = (f32x4){0.f, 0.f, 0.f, 0.f};
        for (int k = 0; k < nk; ++k) {
            const bf16x8 wf = *(const LAS bf16x8*)(WL + (t0 + fr) * 136 + 32 * k + 8 * fq);
#pragma unroll
            for (int ct = 0; ct < 4; ++ct) { const bf16x8 vf = *(const LAS bf16x8*)(VT + (16 * ct + fr) * 136 + 32 * k + 8 * fq);
                acc[ct] = __builtin_amdgcn_mfma_f32_16x16x32_bf16(vf, wf, acc[ct], 0, 0, 0); }
        }
        { const size_t ro = (size_t)(m0 + t0 + fr) * D + g * 64 + 4 * fq;
#pragma unroll
          for (int ct = 0; ct < 4; ++ct) { const u32x2 uu = *(const u32x2*)(U + ro + 16 * ct); const f32x4 o = acc[ct] + bb;
              u32x2 w; w.x = cvt_pk_bf16(bflo(uu.x) * o[0], bfhi(uu.x) * o[1]); w.y = cvt_pk_bf16(bflo(uu.y) * o[2], bfhi(uu.y) * o[3]);
              *(u32x2*)(UO + ro + 16 * ct) = w; } }
        __syncthreads();
    }
}

__device__ __forceinline__ void phase_ffn_conv(const Ctx& c, CA a, int layer, int half) {
    const bf16_t* Z = (const bf16_t*)(a->ws + P_Z); bf16_t* ACT = (bf16_t*)(a->ws + P_ACT) + (size_t)half * (M / 2) * FF;
    const float* cw = a->in[I_FCW] + (size_t)layer * 3 * FF2; const float* cb = a->in[I_FCB] + (size_t)layer * FF2;
    const int gt = c.bid * 512 + c.tid, NT = c.G * 512;
    for (int idx = gt; idx < (M / 2) * (FF / 8); idx += NT) {
        const int ml = idx / (FF / 8), f = (idx % (FF / 8)) * 8, t = ml & (SEQ - 1);
        float gsum[8], vsum[8];
#pragma unroll
        for (int e = 0; e < 8; ++e) { gsum[e] = cb[f + e]; vsum[e] = cb[FF + f + e]; }
#pragma unroll
        for (int jj = 0; jj < 3; ++jj) { const int dt = 2 - jj; if (t - dt < 0) continue;
            const u32x4 zg = *(const u32x4*)(Z + (size_t)(ml - dt) * FF2 + f), zv = *(const u32x4*)(Z + (size_t)(ml - dt) * FF2 + FF + f);
            const float* wg = cw + (size_t)jj * FF2 + f; const float* wv = wg + FF;
            const unsigned zgw[4] = {zg.x, zg.y, zg.z, zg.w}, zvw[4] = {zv.x, zv.y, zv.z, zv.w};
#pragma unroll
            for (int e = 0; e < 4; ++e) { gsum[2 * e] += wg[2 * e] * bflo(zgw[e]); gsum[2 * e + 1] += wg[2 * e + 1] * bfhi(zgw[e]); vsum[2 * e] += wv[2 * e] * bflo(zvw[e]); vsum[2 * e + 1] += wv[2 * e + 1] * bfhi(zvw[e]); } }
        float o[8];
#pragma unroll
        for (int e = 0; e < 8; ++e) o[e] = gsum[e] * sigmoidf_(gsum[e]) * vsum[e];
        u32x4 w; w.x = cvt_pk_bf16(o[0], o[1]); w.y = cvt_pk_bf16(o[2], o[3]); w.z = cvt_pk_bf16(o[4], o[5]); w.w = cvt_pk_bf16(o[6], o[7]);
        *(u32x4*)(ACT + (size_t)ml * FF + f) = w;
    }
}

__device__ __forceinline__ void phase_rwkv_prep(const Ctx& c, CA a, int layer) {
    const float* ss = (const float*)(a->ws + WS_PA); const float* g = a->in[I_NMIX] + (size_t)layer * D;
    bf16_t* hn = (bf16_t*)(a->ws + WS_A);
    const int gw = c.bid * 8 + c.wave, NGW = c.G * 8;
    f32x4 gg[4];
#pragma unroll
    for (int j = 0; j < 4; ++j) gg[j] = *((const f32x4*)g + c.lane + 64 * j);
    for (int m = gw; m < M; m += NGW) {
        const float rs = row_rstd(ss, m);
        const f32x4* hr = (const f32x4*)(a->out + (size_t)m * D) + c.lane; const int prow = (m >> 12) * SEQP + PADR + (m & (SEQ - 1));
        u32x2* br = (u32x2*)(hn + (size_t)prow * D) + c.lane;
#pragma unroll
        for (int j = 0; j < 4; ++j) { const f32x4 v = hr[64 * j] * rs * gg[j]; u32x2 w; w.x = cvt_pk_bf16(v.x, v.y); w.y = cvt_pk_bf16(v.z, v.w); br[64 * j] = w; }
    }
    for (int r = gw; r < BATCH * PADR; r += NGW) { const int prow = (r / PADR) * SEQP + (r % PADR); u32x2* br = (u32x2*)(hn + (size_t)prow * D) + c.lane;
#pragma unroll
        for (int j = 0; j < 4; ++j) br[64 * j] = (u32x2){0u, 0u}; }
}

__device__ __forceinline__ f32x4 bf4lo(u32x4 w) { return (f32x4){bflo(w.x), bfhi(w.x), bflo(w.y), bfhi(w.y)}; }
__device__ __forceinline__ f32x4 bf4hi(u32x4 w) { return (f32x4){bflo(w.z), bfhi(w.z), bflo(w.w), bfhi(w.w)}; }
__device__ __forceinline__ float hsum4(f32x4 p) { return (p.x + p.y) + (p.z + p.w); }
__device__ __forceinline__ void phase_scan(const Ctx& c, CA a, int j, int rp_out) {
    LAS float* BIG = (LAS float*)c.lds; LAS float* VB = BIG + 2 * 5 * 2048; LAS float* YB = VB + 3 * 2048; LAS float* BON = YB + 2 * 2048;
    bf16_t* R = (bf16_t*)(a->ws + P_R); const bf16_t* Kb = (const bf16_t*)(a->ws + P_K); const bf16_t* Vb = (const bf16_t*)(a->ws + P_V);
    const bf16_t* LWb = (const bf16_t*)(a->ws + P_LW); const bf16_t* LAb = (const bf16_t*)(a->ws + P_LA); const bf16_t* Gb = (const bf16_t*)(a->ws + WS_A);
    const bool cons = c.tid < 256;
    constexpr int NCH = SEQ / 32;
    for (int unit = c.bid; unit < BATCH * 16; unit += c.G) {
        const int b = unit >> 4, hh = unit & 15;
        __syncthreads();
        if (cons) {
            const int rp = c.tid >> 3, q = c.tid & 7;
            f32x4 S00 = (f32x4){0.f, 0.f, 0.f, 0.f}, S01 = S00, S10 = S00, S11 = S00;
            __builtin_amdgcn_s_setprio(2);
            __syncthreads();
            for (int i = 0; i <= NCH; ++i) {
                if (i < NCH) {
                    const LAS float* bg = BIG + (i & 1) * 5 * 2048 + 8 * q;
                    const LAS f32x4* pw = (const LAS f32x4*)bg; const LAS f32x4* pa = (const LAS f32x4*)(bg + 2048); const LAS f32x4* pb = (const LAS f32x4*)(bg + 2 * 2048);
                    const LAS f32x4* pk = (const LAS f32x4*)(bg + 3 * 2048); const LAS f32x4* pr = (const LAS f32x4*)(bg + 4 * 2048);
                    const LAS float* pv = VB + (i % 3) * 2048 + 2 * rp; LAS float* py = YB + (i & 1) * 2048 + 2 * rp;
                    f32x4 a0v = pa[0], a1v = pa[1], w0v = pw[0], w1v = pw[1], b0v = pb[0], b1v = pb[1], k0v = pk[0], k1v = pk[1], r0v = pr[0], r1v = pr[1];
                    f32x2 vv = *(const LAS f32x2*)pv;
#pragma unroll 2
                    for (int t = 0; t < 32; ++t) {
                        const int tn = (t + 1) & 31;
                        const f32x4 na0 = pa[tn * 16], na1 = pa[tn * 16 + 1], nw0 = pw[tn * 16], nw1 = pw[tn * 16 + 1], nb0 = pb[tn * 16], nb1 = pb[tn * 16 + 1],
                                    nk0 = pk[tn * 16], nk1 = pk[tn * 16 + 1], nr0 = pr[tn * 16], nr1 = pr[tn * 16 + 1];
                        const f32x2 nvv = *(const LAS f32x2*)(pv + tn * 64);
                        const float sa0 = sum8(hsum4(S00 * a0v + S01 * a1v)), sa1 = sum8(hsum4(S10 * a0v + S11 * a1v));
                        S00 = S00 * w0v + sa0 * b0v + vv.x * k0v; S01 = S01 * w1v + sa0 * b1v + vv.x * k1v;
                        S10 = S10 * w0v + sa1 * b0v + vv.y * k0v; S11 = S11 * w1v + sa1 * b1v + vv.y * k1v;
                        const float y0 = sum8(hsum4(S00 * r0v + S01 * r1v)), y1 = sum8(hsum4(S10 * r0v + S11 * r1v));
                        if (q == 0) *(LAS f32x2*)(py + t * 64) = (f32x2){y0, y1};
                        a0v = na0; a1v = na1; w0v = nw0; w1v = nw1; b0v = nb0; b1v = nb1; k0v = nk0; k1v = nk1; r0v = nr0; r1v = nr1; vv = nvv;
                    }
                }
                __syncthreads();
            }
            __builtin_amdgcn_s_setprio(0);
        } else {
            const int pt = c.tid - 256, st = pt >> 3, sc = (pt & 7) * 8, ch = hh * 64 + sc;
            const float* pp = a->in[I_W0] + (size_t)j * D + ch; const f32x4 w0a = *(const f32x4*)pp, w0b = *(const f32x4*)(pp + 4);
            pp = a->in[I_A0] + (size_t)j * D + ch; const f32x4 a0a = *(const f32x4*)pp, a0b = *(const f32x4*)(pp + 4);
            pp = a->in[I_KK] + (size_t)j * D + ch; const f32x4 kka = *(const f32x4*)pp, kkb = *(const f32x4*)(pp + 4);
            pp = a->in[I_KA] + (size_t)j * D + ch; const f32x4 kaa = *(const f32x4*)pp, kab = *(const f32x4*)(pp + 4);
            pp = a->in[I_RK] + (size_t)j * D + ch; const f32x4 rka = *(const f32x4*)pp, rkb = *(const f32x4*)(pp + 4);
            pp = a->in[I_LNW] + (size_t)j * D + ch; const f32x4 lwa = *(const f32x4*)pp, lwb = *(const f32x4*)(pp + 4);
            pp = a->in[I_LNB] + (size_t)j * D + ch; const f32x4 lba = *(const f32x4*)pp, lbb = *(const f32x4*)(pp + 4);
            const size_t gbase = ((size_t)b * SEQ + st) * D + ch;
            u32x4 qr = *(const u32x4*)(R + gbase), qk = *(const u32x4*)(Kb + gbase), qv = *(const u32x4*)(Vb + gbase), qlw = *(const u32x4*)(LWb + gbase), qla = *(const u32x4*)(LAb + gbase), qg = qr;
#define SCAN_STAGE(n) { \
                f32x4 rr[2] = {bf4lo(qr), bf4hi(qr)}, kk_[2] = {bf4lo(qk), bf4hi(qk)}, vv_[2] = {bf4lo(qv), bf4hi(qv)}, lw_[2] = {bf4lo(qlw), bf4hi(qlw)}, la_[2] = {bf4lo(qla), bf4hi(qla)}; \
                const f32x4 w0_[2] = {w0a, w0b}, a0_[2] = {a0a, a0b}, kkp_[2] = {kka, kkb}, kap_[2] = {kaa, kab}, rkp_[2] = {rka, rkb}; \
                f32x4 dec[2], av[2], kn[2], kp[2]; float n2 = 0.f, bon = 0.f; \
                _Pragma("unroll") for (int h2 = 0; h2 < 2; ++h2) _Pragma("unroll") for (int e = 0; e < 4; ++e) { \
                    const float xw = -(w0_[h2][e] + lw_[h2][e]); const float sp = xw > 20.f ? xw : __logf(1.f + __expf(xw)); \
                    dec[h2][e] = __expf(-__expf(-sp - 0.5f)); av[h2][e] = __builtin_amdgcn_rcpf(1.f + __expf(-(a0_[h2][e] + la_[h2][e]))); \
                    kn[h2][e] = kk_[h2][e] * kkp_[h2][e]; n2 += kn[h2][e] * kn[h2][e]; \
                    kp[h2][e] = kk_[h2][e] * (1.f + (av[h2][e] - 1.f) * kap_[h2][e]); bon += rr[h2][e] * kp[h2][e] * rkp_[h2][e]; } \
                n2 = sum8(n2); bon = sum8(bon); const float inv = rsqrtf(fmaxf(n2, 1e-24f)); \
                LAS float* bg = BIG + ((n) & 1) * 5 * 2048 + st * 64 + sc; \
                _Pragma("unroll") for (int h2 = 0; h2 < 2; ++h2) { const f32x4 kq = kn[h2] * inv; \
                    *(LAS f32x4*)(bg + 4 * h2) = dec[h2]; *(LAS f32x4*)(bg + 2048 + 4 * h2) = -kq; *(LAS f32x4*)(bg + 2 * 2048 + 4 * h2) = kq * av[h2]; \
                    *(LAS f32x4*)(bg + 3 * 2048 + 4 * h2) = kp[h2]; *(LAS f32x4*)(bg + 4 * 2048 + 4 * h2) = rr[h2]; \
                    *(LAS f32x4*)(VB + ((n) % 3) * 2048 + st * 64 + sc + 4 * h2) = vv_[h2]; } \
                if ((pt & 7) == 0) BON[((n) % 3) * 32 + st] = bon; }
#define SCAN_LOAD(n) { const size_t go = gbase + (size_t)(n) * 32 * D; qr = *(const u32x4*)(R + go); qk = *(const u32x4*)(Kb + go); qv = *(const u32x4*)(Vb + go); qlw = *(const u32x4*)(LWb + go); qla = *(const u32x4*)(LAb + go); }
            SCAN_STAGE(0)
            SCAN_LOAD(1)
            __syncthreads();
            for (int i = 0; i <= NCH; ++i) {
                u32x4 nr = qr, nk = qk, nv = qv, nlw = qlw, nla = qla, ng = qg;
                if (i + 2 < NCH) { const size_t go = gbase + (size_t)(i + 2) * 32 * D; nr = *(const u32x4*)(R + go); nk = *(const u32x4*)(Kb + go); nv = *(const u32x4*)(Vb + go); nlw = *(const u32x4*)(LWb + go); nla = *(const u32x4*)(LAb + go); }
                if (i < NCH) ng = *(const u32x4*)(Gb + gbase + (size_t)i * 32 * D);
                if (i >= 1) {
                    const int n = i - 1; const LAS float* yp = YB + (n & 1) * 2048 + st * 64 + sc; const LAS float* vp = VB + (n % 3) * 2048 + st * 64 + sc;
                    const f32x4 y0 = *(const LAS f32x4*)yp, y1 = *(const LAS f32x4*)(yp + 4), v0 = *(const LAS f32x4*)vp, v1 = *(const LAS f32x4*)(vp + 4); const float bon = BON[(n % 3) * 32 + st];
                    const float mean = sum8(hsum4(y0) + hsum4(y1)) * (1.f / 64.f); const f32x4 d0 = y0 - mean, d1 = y1 - mean;
                    const float rstd = rsqrtf(sum8(hsum4(d0 * d0) + hsum4(d1 * d1)) * (1.f / 64.f) + GN_EPS);
                    const f32x4 o0 = (d0 * rstd * lwa + lba + bon * v0) * bf4lo(qg), o1 = (d1 * rstd * lwb + lbb + bon * v1) * bf4hi(qg);
                    u32x4 w; w.x = cvt_pk_bf16(o0.x, o0.y); w.y = cvt_pk_bf16(o0.z, o0.w); w.z = cvt_pk_bf16(o1.x, o1.y); w.w = cvt_pk_bf16(o1.z, o1.w);
                    *(u32x4*)((rp_out ? (bf16_t*)(a->ws + P_LW) : R) + gbase + (size_t)n * 32 * D) = w;
                }
                qg = ng;
                if (i + 1 < NCH) { SCAN_STAGE(i + 1) qr = nr; qk = nk; qv = nv; qlw = nlw; qla = nla; }
                __syncthreads();
            }
#undef SCAN_STAGE
#undef SCAN_LOAD
        }
    }
}

__device__ __forceinline__ void phase_final(const Ctx& c, CA a) {
    const float* ss = (const float*)(a->ws + WS_PA); const float* g = a->in[I_NFIN];
    const int gw = c.bid * 8 + c.wave, NGW = c.G * 8;
    f32x4 gg[4];
#pragma unroll
    for (int j = 0; j < 4; ++j) gg[j] = *((const f32x4*)g + c.lane + 64 * j);
    for (int m = gw; m < M; m += NGW) {
        const float rs = row_rstd(ss, m);
        f32x4* hr = (f32x4*)(a->out + (size_t)m * D) + c.lane;
#pragma unroll
        for (int j = 0; j < 4; ++j) hr[64 * j] = hr[64 * j] * rs * gg[j];
    }
}

#define XB_TMO      128
#define XB_XCNT(j)  (256  + 64 * (j))
#define XB_XSUB(j)  (1280 + 64 * (j))
#define XB_XGEN(j)  (2304 + 64 * (j))
#define XB_TOP      3328
#define XB_TOPGEN   3392
#define XCD_BAR_WORDS 3456
#define XB_SPIN_CAP (1u << 18)

__device__ __forceinline__ unsigned xb_ld(unsigned* p)              { return __hip_atomic_load(p, __ATOMIC_RELAXED, __HIP_MEMORY_SCOPE_AGENT); }
__device__ __forceinline__ unsigned xb_add(unsigned* p, unsigned v) { return __hip_atomic_fetch_add(p, v, __ATOMIC_RELAXED, __HIP_MEMORY_SCOPE_AGENT); }
__device__ __forceinline__ unsigned xb_xcc_id() { return (unsigned)__builtin_amdgcn_s_getreg((3 << 11) | 20) & 0xFu; }
#define XB_SPIN(cond, bar) do { unsigned _sp = 0; while (cond) { __builtin_amdgcn_s_sleep(1); \
    if ((++_sp & 255u) == 0u) { if (xb_ld(&(bar)[XB_TMO])) break; if (_sp > XB_SPIN_CAP) { atomicAdd(&(bar)[XB_TMO], 1u); break; } } } } while (0)

struct XcdBarrier {
    unsigned* bar; unsigned x;
    volatile LAS unsigned* st;
};

__device__ __forceinline__ XcdBarrier xcd_barrier_post(unsigned* bar, volatile LAS unsigned* st) {
    XcdBarrier b; b.bar = bar; b.x = xb_xcc_id(); b.st = st;
    if (threadIdx.x == 0) (void)xb_add(&bar[XB_XCNT(b.x)], 1u);
    return b;
}
__device__ __forceinline__ void xcd_barrier_complete(unsigned* bar, unsigned x, unsigned& nloc, unsigned& nx) {
    const unsigned G = gridDim.x * gridDim.y * gridDim.z;
    unsigned sum, cnt, mine, sp = 0u;
    for (;;) {
        sum = 0u; cnt = 0u; mine = 0u;
#pragma unroll
        for (unsigned j = 0; j < 16; ++j) { const unsigned c = xb_ld(&bar[XB_XCNT(j)]); sum += c; cnt += (c > 0u) ? 1u : 0u; mine = (j == x) ? c : mine; }
        if (sum == G) break;
        __builtin_amdgcn_s_sleep(1);
        if ((++sp & 255u) == 0u) { if (xb_ld(&bar[XB_TMO])) break; if (sp > XB_SPIN_CAP) { atomicAdd(&bar[XB_TMO], 1u); break; } }
    }
    nloc = mine > 0u ? mine : 1u; nx = cnt > 0u ? cnt : 1u;
}

__device__ __forceinline__ void xcd_barrier(const XcdBarrier& b) {
    asm volatile("s_waitcnt vmcnt(0)" ::: "memory");
    __syncthreads();
    if (threadIdx.x == 0) {
        unsigned* bar = b.bar;
        __builtin_amdgcn_s_waitcnt(0);
        unsigned nloc = b.st[0], nx = b.st[1];
        if (nloc == 0u) { xcd_barrier_complete(bar, b.x, nloc, nx); b.st[0] = nloc; b.st[1] = nx; }
        const unsigned old = xb_add(&bar[XB_XSUB(b.x)], 1u);
        const unsigned gen = old / nloc;
        if (old + 1u == (gen + 1u) * nloc) {
            __builtin_amdgcn_fence(__ATOMIC_RELEASE, "agent");
            asm volatile("s_waitcnt vmcnt(0)" ::: "memory");
            const unsigned og = xb_add(&bar[XB_TOP], 1u);
            const unsigned tg = og / nx;
            if (og + 1u == (tg + 1u) * nx) xb_add(&bar[XB_TOPGEN], 1u);
            else XB_SPIN(xb_ld(&bar[XB_TOPGEN]) == tg, bar);
            __builtin_amdgcn_fence(__ATOMIC_ACQUIRE, "agent");
            xb_add(&bar[XB_XGEN(b.x)], 1u);
            asm volatile("s_waitcnt vmcnt(0)" ::: "memory");
        } else {
            XB_SPIN(xb_ld(&bar[XB_XGEN(b.x)]) == gen, bar);
            __builtin_amdgcn_fence(__ATOMIC_ACQUIRE, "agent");
            asm volatile("s_waitcnt vmcnt(0)" ::: "memory");
        }
    }
    __syncthreads();
}

constexpr int SLOTS = 11, NPH = 2 + 4 * SLOTS;
__host__ __device__ inline bool phase_active(int p) {
    if (p == 0 || p == NPH - 1) return true;
    const int i = (p - 1) / SLOTS, s = (p - 1) % SLOTS;
    if (s >= 5) return s == 6 || s == 10;
    return (i & 1) ? true : (s < 3);
}

__global__ void __launch_bounds__(512, 2) mk_fwd(Args a_) {
    extern __shared__ __attribute__((aligned(16))) unsigned char lds_raw[];
    int tid_ = threadIdx.x, bid_ = blockIdx.x, G_ = gridDim.x;
    volatile LAS unsigned* xst = (volatile LAS unsigned*)((LAS unsigned char*)lds_raw + 131072 + 64);
    if (tid_ < 2) xst[tid_] = 0u;
    __syncthreads();
    const XcdBarrier xbar = xcd_barrier_post((unsigned*)(a_.ws + WS_CTL), xst);
    CA a = (CA)__builtin_amdgcn_kernarg_segment_ptr();
    const int ph_lo = a_.ph_lo, ph_hi = a_.ph_hi;
    for (int p = ph_lo; p < ph_hi; ++p) {
        if (!phase_active(p)) continue;
        const int PL = (p - 1) / SLOTS, PS = (p - 1) % SLOTS; (void)PL; (void)PS;
        const int nrep = (MK_PROBE && p < NPH - 1 && (MK_PROBE_SEL)) ? 2 : 1;
        for (int rp = 0; rp < nrep; ++rp) {
        if (rp) cg::this_grid().sync();
        asm volatile("" : "+s"(a), "+s"(bid_), "+s"(G_)); asm volatile("" : "+v"(tid_));
        Ctx c; c.lds = (LAS unsigned char*)lds_raw; c.tid = tid_; c.lane = c.tid & 63; c.wave = __builtin_amdgcn_readfirstlane(c.tid >> 6); c.G = G_; c.bid = bid_;
        bf16_t* regA = (bf16_t*)(a->ws + WS_A);
        if (p == 0) phase_prologue(c, a);
        else if (p == NPH - 1) phase_final(c, a);
        else {
            const int layer = (p - 1) / SLOTS, s = (p - 1) % SLOTS, j = layer >> 1;
            unsigned char* wj = a->ws + WS_WSTAT + (size_t)j * WJ_STRIDE;
            float* ss_mix = (float*)(a->ws + WS_PA); float* ss_ffn = (float*)(a->ws + WS_PB); float* ss_next = ss_mix;
            if (s < 5 && !(layer & 1)) {
                if (s == 0) {
                    pg8::Gemm g{regA, (const bf16_t*)(wj + WJ_IN), M, 2048, D, D}; pg8::StaticOrder S; S.init(M / 256, 2048, c.G, c.bid);
                    EpiSguIn E{(bf16_t*)(a->ws + P_U), (bf16_t*)(a->ws + P_SV), ss_mix, a->in[I_SBIN] + (size_t)j * 2048, (float*)(a->ws + WS_PV)};
                    pg8::gemm_phase<EpiSguIn, pg8::StaticOrder, 0, false, true>(c.lds, c.tid, g, S, E);
                } else if (s == 1) { phase_ffn_weights(c, a, layer); phase_sgu_spatial(c, a, j, rp); }
                else {
                    pg8::Gemm g{(const bf16_t*)(a->ws + P_U), (const bf16_t*)(wj + WJ_OUT), M, D, D, D}; pg8::StaticOrder S; S.init(M / 256, D, c.G, c.bid);
                    EpiResid E{a->out, regA, ss_ffn};
                    pg8::gemm_phase<EpiResid, pg8::StaticOrder, 0, false, true>(c.lds, c.tid, g, S, E);
                }
            } else if (s < 5) {
                if (s == 0) phase_rwkv_prep(c, a, layer);
                else if (s == 1) {
                    pg8::Gemm g{regA, (const bf16_t*)(wj + WJ_RKV), M, 3584, 2048, D}; pg8::StaticOrder S; S.init(M / 256, 3584, c.G, c.bid);
                    EpiRkv E{(bf16_t*)(a->ws + P_R), (bf16_t*)(a->ws + P_WA), (bf16_t*)(a->ws + P_GL)};
                    pg8::gemm_phase<EpiRkv, pg8::StaticOrder, 1, true, true>(c.lds, c.tid, g, S, E);
                } else if (s == 2) {
                    { int kq = 128; asm volatile("" : "+s"(kq)); pg8::Gemm g{(const bf16_t*)(a->ws + P_WA), (const bf16_t*)(wj + WJ_L2WA), M, 2048, kq, kq}; pg8::StaticOrder S; S.init(M / 256, 2048, c.G, c.bid);
                      EpiStore<false> E{(bf16_t*)(a->ws + P_LW), D, 2, (size_t)M * D, nullptr};
                      pg8::gemm_phase<EpiStore<false>, pg8::StaticOrder, 0, false, true>(c.lds, c.tid, g, S, E); }
                    asm volatile("" : "+s"(a), "+s"(c.bid), "+s"(c.G), "+s"(wj)); asm volatile("" : "+v"(c.tid));
                    { int kq = 256; asm volatile("" : "+s"(kq)); pg8::Gemm g{(const bf16_t*)(a->ws + P_GL), (const bf16_t*)(wj + WJ_L2G), M, D, kq, kq}; pg8::StaticOrder S; S.init(M / 256, D, c.G, c.bid);
                      EpiStore<false> E{regA, D, 2, 0, nullptr};
                      pg8::gemm_phase<EpiStore<false>, pg8::StaticOrder, 0, false, true>(c.lds, c.tid, g, S, E); }
                } else if (s == 3) { if (c.bid >= 128) { Ctx c2 = c; c2.bid = c.bid - 128; c2.G = c.G - 128; phase_ffn_weights(c2, a, layer); if (layer == 1) phase_static_weights(c2, a, 1); } else phase_scan(c, a, j, rp); }
                else {
                    pg8::Gemm g{(const bf16_t*)(a->ws + P_R), (const bf16_t*)(wj + WJ_O), M, D, D, D}; pg8::StaticOrder S; S.init(M / 256, D, c.G, c.bid);
                    EpiResid E{a->out, regA, ss_ffn};
                    pg8::gemm_phase<EpiResid, pg8::StaticOrder, 0, false, true>(c.lds, c.tid, g, S, E);
                }
            }
            else if (s == 6) {
                pg8::Gemm g{regA - 2 * D, (const bf16_t*)(a->ws + WS_WFFN), M, FF2, D, D}; pg8::StaticOrder S; S.init(133, FF2, c.G, c.bid);
                EpiFfnUp E{(bf16_t*)(a->ws + P_ACT), ss_ffn, a->in[I_FCW] + (size_t)layer * 3 * FF2, a->in[I_FCB] + (size_t)layer * FF2};
                pg8::gemm_phase<EpiFfnUp, pg8::StaticOrder, 2, false, true>(c.lds, c.tid, g, S, E);
            }
            else {
                pg8::Gemm g{(const bf16_t*)(a->ws + P_ACT), (const bf16_t*)(a->ws + WS_WDOWN), M, D, FF, FF}; pg8::StaticOrder S; S.init(M / 256, D, c.G, c.bid);
                EpiResid E{a->out, regA, ss_next};
                pg8::gemm_phase<EpiResid, pg8::StaticOrder, 0, false, true>(c.lds, c.tid, g, S, E);
            }
        }
        }
        if (p + 1 < ph_hi) { if (p == 0) cg::this_grid().sync(); else xcd_barrier(xbar); }
    }
}

constexpr int LDS_BYTES = 147456;
#ifndef MK_ONE_LAUNCH
#define MK_ONE_LAUNCH 1
#endif
extern "C" void kernel_launch(void* const* d_in, const int* in_sizes, int n_in, void* d_out, int out_size, void* d_ws, size_t ws_size, hipStream_t stream) {
    static int grid = 0;
    if (grid == 0) {
        if (n_in != 32 || out_size != M * D || ws_size < WS_END) { fprintf(stderr, "kernel_launch: unexpected shapes (n_in %d out %d ws %zu, need %zu)\n", n_in, out_size, ws_size, (size_t)WS_END); grid = -1; return; }
        int dev = 0, cus = 0, per_cu = 0;
        (void)hipGetDevice(&dev); (void)hipDeviceGetAttribute(&cus, hipDeviceAttributeMultiprocessorCount, dev);
        if (hipFuncSetAttribute((const void*)mk_fwd, hipFuncAttributeMaxDynamicSharedMemorySize, LDS_BYTES) != hipSuccess) { fprintf(stderr, "kernel_launch: hipFuncSetAttribute failed\n"); grid = -1; return; }
        (void)hipOccupancyMaxActiveBlocksPerMultiprocessor(&per_cu, (const void*)mk_fwd, 512, LDS_BYTES);
        if (per_cu < 1) per_cu = 1;
        grid = cus * 1;
        (void)hipGetLastError();
    }
    if (grid < 0) return;
    if (hipMemsetAsync((char*)d_ws + WS_CTL, 0, CTL_BYTES, stream) != hipSuccess) { fprintf(stderr, "kernel_launch: memset failed\n"); return; }
    Args a{};
    for (int i = 0; i < 32; ++i) a.in[i] = (const float*)d_in[i];
    a.out = (float*)d_out; a.ws = (unsigned char*)d_ws;
#if MK_ONE_LAUNCH
    a.ph_lo = 0; a.ph_hi = NPH;
    void* args[] = {&a};
    hipError_t e = hipLaunchCooperativeKernel((const void*)mk_fwd, dim3(grid), dim3(512), args, LDS_BYTES, stream);
    if (e != hipSuccess) fprintf(stderr, "cooperative launch failed: %s (grid %d)\n", hipGetErrorString(e), grid);
#else
    for (int p = 0; p < NPH; ++p) { if (!phase_active(p)) continue; a.ph_lo = p; a.ph_hi = p + 1; hipLaunchKernelGGL(mk_fwd, dim3(grid), dim3(512), LDS_BYTES, stream, a); }
#endif
}
```

```cpp
#include <hip/hip_runtime.h>
#include <hip/hip_cooperative_groups.h>
#include <cstdio>
#include <cstdint>
#include <cmath>
namespace cg = cooperative_groups;
#ifndef MK_PROBE
#define MK_PROBE 0
#endif
#ifndef MK_PROBE_SEL
#define MK_PROBE_SEL 0
#endif
#ifndef MK_PROBE_MODE
#define MK_PROBE_MODE 1
#endif
namespace pg8 {
#define PG8_LAS __attribute__((address_space(3)))
typedef unsigned short bf16_t;
typedef short bf16x8 __attribute__((ext_vector_type(8)));
typedef float f32x4 __attribute__((ext_vector_type(4)));
typedef float f32x2 __attribute__((ext_vector_type(2)));
typedef unsigned u32x4 __attribute__((ext_vector_type(4)));
typedef unsigned u32x2 __attribute__((ext_vector_type(2)));
constexpr int BM = 256, BK = 64, HALF = 128, HTB = HALF * BK * 2  , STAGE_BYTES = 8 * HTB, NXCD = 8, WGM = 8;

__host__ __device__ __forceinline__ int lds_byte(int r, int c) { const int st = (r >> 4) * 2 + (c >> 5), rr = r & 15, cc = c & 31, ob = rr * 64 + cc * 2; return st * 1024 + (ob ^ (((ob >> 9) & 1) << 5)); }
__host__ __device__ __forceinline__ void stage_rc(int b, int& R, int& C) { const int st = b / 1024, sb = b % 1024, swz = sb ^ (((sb >> 9) & 1) << 5); R = (st >> 1) * 16 + swz / 64; C = (st & 1) * 32 + (swz % 64) / 2; }
__host__ __device__ __forceinline__ int perm32(int rho) { const int n = rho >> 4, i = rho & 15; return 8 * (i >> 2) + 4 * n + (i & 3); }

struct Unit { int pm, pn; };
struct Gemm { const bf16_t* A; const bf16_t* Bt; int M, N, K, lda; };

struct StaticOrder {
    int nM, nN, nwg, G, c;
    __host__ __device__ void init(int nM_, int N, int G_, int c_) { nM = nM_; nN = N / BM; nwg = nM * nN; G = G_; c = c_; }
    __host__ __device__ bool next(int i, Unit& u) const {
        const long L = (long)i * G + c; if (L >= nwg) return false;
        int wgid = (int)L; { const int q = nwg / NXCD, r = nwg % NXCD, xcd = wgid % NXCD, off = wgid / NXCD; wgid = (xcd < r ? xcd * (q + 1) : r * (q + 1) + (xcd - r) * q) + off; }
        const int nig = WGM * nN, gid = wgid / nig, fm = gid * WGM, gsz = (nM - fm) < WGM ? (nM - fm) : WGM;
        u.pm = fm + ((wgid % nig) % gsz); u.pn = (wgid % nig) / gsz; return true;
    }
};

__device__ __forceinline__ unsigned cvt_pk_bf16(float lo, float hi) { unsigned r; asm volatile("v_cvt_pk_bf16_f32 %0, %1, %2" : "=v"(r) : "v"(lo), "v"(hi)); return r; }
__device__ __forceinline__ f32x2 gelu_pk(f32x2 v) {
    const f32x2 av = __builtin_elementwise_abs(v), d = av * 0.2316418882f + 1.0f;
    f32x2 t; t.x = __builtin_amdgcn_rcpf(d.x); t.y = __builtin_amdgcn_rcpf(d.y);
    f32x2 q = t * 0.5307027145f + (-0.7265760135f); q = q * t + 0.7107068705f; q = q * t + (-0.142248368f); q = q * t + 0.127414796f; q = q * t;
    const f32x2 s = (v * v) * (-0.72134752044f);
    f32x2 e; e.x = __builtin_amdgcn_exp2f(s.x); e.y = __builtin_amdgcn_exp2f(s.y);
    const f32x2 m = v * (q * e), r = v - m;
    f32x2 o; o.x = v.x < 0.f ? m.x : r.x; o.y = v.y < 0.f ? m.y : r.y; return o;
}

template <class Epi, class Sched, int AMAP, bool KDBL, bool ALIGN_EPI>
__device__ __forceinline__ void gemm_phase(PG8_LAS unsigned char* lds, const int tid, const Gemm g, const Sched& S, const Epi& E) {
    const int wid = __builtin_amdgcn_readfirstlane(tid >> 6), lane = tid & 63, wr = wid >> 2, wc = wid & 3, fr = lane & 15, fq = lane >> 4;
    const int K = g.K, nt = K / BK, lda = g.lda;
    unsigned voffA[2], voffB[2];
#pragma unroll
    for (int i = 0; i < 2; ++i) { int R, C; stage_rc(tid * 16 + i * 8192, R, C); const int Rb = Epi::PERM ? ((R & ~31) + perm32(R & 31)) : R;
        const int Ra = (AMAP == 2) ? (R - 2 * (R >> 6)) : R;
        voffA[i] = (unsigned)(Ra * lda + C) * 2u; voffB[i] = (unsigned)(Rb * K + C) * 2u; }
    const size_t kstep = (size_t)(BK * 2);
    const size_t hstepA = (size_t)((AMAP == 2) ? 124 : HALF) * lda * 2;
    const size_t hstepB = (size_t)HALF * K * 2;
    const size_t tstepB = 2 * hstepB;
    const size_t rowA = (size_t)lda * 2;
    const unsigned ldsw = (unsigned)wid * 1024u;
    const int aoff = lds_byte(wr * 64 + fr, fq * 8), boff = lds_byte(wc * 32 + fr, fq * 8);
#define PG8_ABASE(pm) ((const char*)g.A + (AMAP == 1 ? (size_t)(((pm) >> 4) * 4104 + 8 + ((pm) & 15) * 256) * rowA : (AMAP == 2 ? (size_t)(pm) * 248 * rowA : (size_t)(pm) * 256 * rowA)))
#define PG8_KA(base, t) (KDBL ? ((base) + (size_t)((t) & 15) * kstep - (size_t)((t) >> 4) * rowA) : ((base) + (size_t)(t) * kstep))
#define PG8_SA(b, h) (((b) * 2 + (h)) * HTB)
#define PG8_SB(b, h) ((4 + (b) * 2 + (h)) * HTB)
#define PG8_STAGE(bufoff, gbase, voff) do { _Pragma("unroll") for (int _i = 0; _i < 2; ++_i) \
        __builtin_amdgcn_global_load_lds((const unsigned*)((const char*)(gbase) + (voff)[_i]), (PG8_LAS unsigned*)(lds + (bufoff) + ldsw + _i * 8192), 16, 0, 0); } while (0)
#define PG8_LDA(dst, b, h) do { _Pragma("unroll") for (int m = 0; m < 4; ++m) _Pragma("unroll") for (int k = 0; k < 2; ++k) dst[m][k] = *(const PG8_LAS bf16x8*)(lds + PG8_SA(b, h) + aoff + m * 2048 + k * 1024); } while (0)
#define PG8_LDB(dst, b, h) do { _Pragma("unroll") for (int n = 0; n < 2; ++n) _Pragma("unroll") for (int k = 0; k < 2; ++k) dst[n][k] = *(const PG8_LAS bf16x8*)(lds + PG8_SB(b, h) + boff + n * 2048 + k * 1024); } while (0)
#define PG8_MMA(ai, bj, At, Bt) do { __builtin_amdgcn_s_setprio(1); _Pragma("unroll") for (int m = 0; m < 4; ++m) _Pragma("unroll") for (int n = 0; n < 2; ++n) _Pragma("unroll") for (int k = 0; k < 2; ++k) \
        acc[ai][bj][m][n] = __builtin_amdgcn_mfma_f32_16x16x32_bf16(Bt[n][k], At[m][k], acc[ai][bj][m][n], 0, 0, 0); __builtin_amdgcn_s_setprio(0); } while (0)
#define PG8_WAIT_V(n) asm volatile("s_waitcnt vmcnt(" #n ")" ::: "memory")
#define PG8_WAIT_L(n) asm volatile("s_waitcnt lgkmcnt(" #n ")" ::: "memory")
#define PG8_BAR __builtin_amdgcn_s_barrier()
#define PG8_SCHED __builtin_amdgcn_sched_barrier(0)
    Unit cur, nxt; int ui = 0;
    if (!S.next(0, cur)) return;
    f32x4 acc[2][2][4][2];
#pragma unroll
    for (int a = 0; a < 2; ++a)
#pragma unroll
        for (int b = 0; b < 2; ++b)
#pragma unroll
            for (int m = 0; m < 4; ++m)
#pragma unroll
                for (int n = 0; n < 2; ++n) acc[a][b][m][n] = (f32x4){0.f, 0.f, 0.f, 0.f};
    bf16x8 At[4][2], B0[2][2], B1[2][2];
    const char* cA = PG8_ABASE(cur.pm); const char* cB = (const char*)g.Bt + (size_t)cur.pn * tstepB;
    {
        const char* cA1 = PG8_KA(cA, 1);
        PG8_STAGE(PG8_SB(0, 0), cB, voffB); PG8_STAGE(PG8_SB(0, 1), cB + hstepB, voffB); PG8_STAGE(PG8_SA(0, 0), cA, voffA); PG8_STAGE(PG8_SA(0, 1), cA + hstepA, voffA);
        if (wr == 1) PG8_BAR;
        PG8_WAIT_V(2); PG8_BAR;
        PG8_STAGE(PG8_SB(1, 0), cB + kstep, voffB); PG8_STAGE(PG8_SA(1, 0), cA1, voffA); PG8_STAGE(PG8_SB(1, 1), cB + hstepB + kstep, voffB);
        PG8_WAIT_V(6); PG8_BAR;
    }
    for (;;) {
        const bool has_next = S.next(ui + 1, nxt);
        const char* nA = has_next ? PG8_ABASE(nxt.pm) : cA; const char* nB = has_next ? (const char*)g.Bt + (size_t)nxt.pn * tstepB : cB;
        for (int t = 0; t < nt; t += 2) {
            const bool last = (t == nt - 2);
            const char* a1 = PG8_KA(cA, t + 1);
            const char* a2 = last ? nA : PG8_KA(cA, t + 2); const char* b2 = last ? nB : cB + (size_t)(t + 2) * kstep;
            const char* a3 = last ? PG8_KA(nA, 1) : PG8_KA(cA, t + 3); const char* b3 = b2 + kstep;
            PG8_LDB(B0, 0, 0); PG8_LDB(B1, 0, 1); PG8_SCHED; PG8_LDA(At, 0, 0); PG8_STAGE(PG8_SA(1, 1), a1 + hstepA, voffA);
            PG8_WAIT_V(8); PG8_WAIT_L(0); PG8_BAR; PG8_MMA(0, 0, At, B0); PG8_MMA(0, 1, At, B1); PG8_BAR; PG8_SCHED;
            PG8_LDA(At, 0, 1); PG8_STAGE(PG8_SB(0, 0), b2, voffB); PG8_STAGE(PG8_SB(0, 1), b2 + hstepB, voffB); PG8_STAGE(PG8_SA(0, 0), a2, voffA);
            PG8_WAIT_V(8); PG8_WAIT_L(0); PG8_BAR; PG8_MMA(1, 0, At, B0); PG8_MMA(1, 1, At, B1); PG8_BAR; PG8_SCHED;
            PG8_LDB(B0, 1, 0); PG8_LDB(B1, 1, 1); PG8_SCHED; PG8_LDA(At, 1, 0); PG8_STAGE(PG8_SA(0, 1), a2 + hstepA, voffA);
            PG8_WAIT_V(8); PG8_WAIT_L(0); PG8_BAR; PG8_MMA(0, 0, At, B0); PG8_MMA(0, 1, At, B1); PG8_BAR; PG8_SCHED;
            PG8_LDA(At, 1, 1); PG8_STAGE(PG8_SB(1, 0), b3, voffB); PG8_STAGE(PG8_SB(1, 1), b3 + hstepB, voffB); PG8_STAGE(PG8_SA(1, 0), a3, voffA);
            PG8_WAIT_V(8); PG8_WAIT_L(0); PG8_BAR; PG8_MMA(1, 0, At, B0); PG8_MMA(1, 1, At, B1); PG8_BAR; PG8_SCHED;
        }
        if constexpr (ALIGN_EPI) { if (wr == 0) PG8_BAR; }
        E(acc, cur, wr, wc, fr, fq);
        if (!has_next) break;
#pragma unroll
        for (int a = 0; a < 2; ++a)
#pragma unroll
            for (int b = 0; b < 2; ++b)
#pragma unroll
                for (int m = 0; m < 4; ++m)
#pragma unroll
                    for (int n = 0; n < 2; ++n) acc[a][b][m][n] = (f32x4){0.f, 0.f, 0.f, 0.f};
        cur = nxt; cA = nA; cB = nB; ++ui;
        if constexpr (ALIGN_EPI) { if (wr == 1) PG8_BAR; }
    }
    PG8_WAIT_V(0);
    if constexpr (!ALIGN_EPI) { if (wr == 0) PG8_BAR; }
    PG8_BAR;
#undef PG8_ABASE
#undef PG8_KA
#undef PG8_SA
#undef PG8_SB
#undef PG8_STAGE
#undef PG8_LDA
#undef PG8_LDB
#undef PG8_MMA
#undef PG8_WAIT_V
#undef PG8_WAIT_L
#undef PG8_BAR
#undef PG8_SCHED
}
}
using pg8::bf16_t; using pg8::f32x4; using pg8::f32x2; using pg8::u32x4; using pg8::u32x2; using pg8::Unit; using pg8::cvt_pk_bf16;
#define LAS __attribute__((address_space(3)))
constexpr int BATCH = 8, SEQ = 4096, D = 1024, M = BATCH * SEQ, FF = 2816, FF2 = 5632;
constexpr int PADR = 8, SEQP = SEQ + PADR;
constexpr float RMS_EPS = 1e-6f, GN_EPS = 64e-5f;
constexpr size_t MiB = 1u << 20;
constexpr size_t WS_CTL = 0, CTL_BYTES = 2048 * 1024, WS_XS = 1 * MiB;
constexpr size_t WS_WSTAT = 2 * MiB;
constexpr size_t WJ_IN = 0, WJ_OUT = 4 * MiB, WJ_RKV = 6 * MiB, WJ_L2WA = 20 * MiB, WJ_L2G = 20 * MiB + 512 * 1024, WJ_O = 21 * MiB, WJ_STRIDE = 23 * MiB;
constexpr size_t WS_WFFN = 48 * MiB;
constexpr size_t WS_WDOWN = WS_WFFN + 11 * MiB;
constexpr size_t WS_A = 67 * MiB;
constexpr size_t WS_P = 134 * MiB;
constexpr size_t P_R = WS_P, P_K = WS_P + 64 * MiB, P_V = WS_P + 128 * MiB, P_LW = WS_P + 192 * MiB, P_LA = WS_P + 256 * MiB, P_WA = WS_P + 320 * MiB, P_GL = WS_P + 328 * MiB;
constexpr size_t P_U = WS_P, P_SV = WS_P + 64 * MiB;
constexpr size_t P_Z = WS_P, P_ACT = WS_P + 176 * MiB;
constexpr size_t WS_PA = WS_P + 352 * MiB, WS_PB = WS_PA + 2 * MiB, WS_PV = WS_PB + 2 * MiB;
constexpr size_t WS_END = WS_PV + 2 * MiB;

struct Args {
    const float* in[32]; float* out; unsigned char* ws; int ph_lo, ph_hi;
};
enum { I_X = 0, I_NMIX, I_NFFN, I_NFIN, I_SWIN, I_SBIN, I_SGV, I_SWS, I_SBS, I_SWOUT, I_MU, I_WR, I_WK, I_WV, I_WO, I_W0, I_W1, I_W2, I_A0, I_A1, I_A2, I_G1, I_G2, I_KK, I_KA, I_RK, I_LNW, I_LNB, I_FUP, I_FCW, I_FCB, I_FDN };

__device__ __forceinline__ float bf2f(unsigned short b) { return __uint_as_float((unsigned)b << 16); }
__device__ __forceinline__ float bflo(unsigned w) { return __uint_as_float(w << 16); }
__device__ __forceinline__ float bfhi(unsigned w) { return __uint_as_float(w & 0xffff0000u); }
__device__ __forceinline__ float wave_sum(float v) {
#pragma unroll
    for (int o = 1; o < 64; o <<= 1) v += __shfl_xor(v, o);
    return v;
}
__device__ __forceinline__ float row_rstd(const float* P, int row) { const f32x4* p = (const f32x4*)(P + (size_t)row * 16); const f32x4 a = p[0], b = p[1], c = p[2], d = p[3];
    const float s = ((a.x + a.y) + (a.z + a.w)) + ((b.x + b.y) + (b.z + b.w)) + ((c.x + c.y) + (c.z + c.w)) + ((d.x + d.y) + (d.z + d.w)); return rsqrtf(s * (1.f / D) + RMS_EPS); }
__device__ __forceinline__ void row_rstd4(const float* P, int row0, int rstride, int lo, int hi, float (&rs)[4]) {
    f32x4 p[4][4];
#pragma unroll
    for (int m = 0; m < 4; ++m) { int r = row0 + m * rstride; r = r < lo ? lo : (r > hi ? hi : r); const f32x4* q = (const f32x4*)(P + (size_t)r * 16);
#pragma unroll
        for (int k = 0; k < 4; ++k) p[m][k] = q[k]; }
#pragma unroll
    for (int m = 0; m < 4; ++m) { const f32x4 a = p[m][0], b = p[m][1], c = p[m][2], d = p[m][3];
        const float s = ((a.x + a.y) + (a.z + a.w)) + ((b.x + b.y) + (b.z + b.w)) + ((c.x + c.y) + (c.z + c.w)) + ((d.x + d.y) + (d.z + d.w)); rs[m] = rsqrtf(s * (1.f / D) + RMS_EPS); }
}
template <int CTRL> __device__ __forceinline__ float dpp_f(float v) { return __int_as_float(__builtin_amdgcn_mov_dpp(__float_as_int(v), CTRL, 0xf, 0xf, true)); }
__device__ __forceinline__ float sum8(float v) { v += dpp_f<0x141>(v); v += dpp_f<0xB1>(v); v += dpp_f<0x4E>(v); return v; }
__device__ __forceinline__ float sigmoidf_(float x) { return 1.f / (1.f + __expf(-x)); }

template <bool SCALE> struct EpiStore {
    static constexpr bool PERM = true;
    bf16_t* O; int ldc; int tsh; size_t split_stride; const float* ss;
    __device__ __forceinline__ void operator()(const f32x4 (&acc)[2][2][4][2], const Unit& u, int wr, int wc, int fr, int fq) const {
        bf16_t* base = O + (size_t)(u.pn >> tsh) * split_stride + (size_t)(u.pm * 256 + wr * 64 + fr) * ldc + (u.pn & ((1 << tsh) - 1)) * 256 + wc * 32 + 8 * fq;
        const int row0 = u.pm * 256 + wr * 64 + fr;
#pragma unroll
        for (int ai = 0; ai < 2; ++ai)
#pragma unroll
            for (int m = 0; m < 4; ++m) {
                const float rs = SCALE ? row_rstd(ss, row0 + ai * 128 + m * 16) : 1.f;
                bf16_t* rowp = base + (size_t)(ai * 128 + m * 16) * ldc;
#pragma unroll
                for (int bj = 0; bj < 2; ++bj) { const f32x4 v0 = acc[ai][bj][m][0] * rs, v1 = acc[ai][bj][m][1] * rs;
                    u32x4 w; w.x = cvt_pk_bf16(v0[0], v0[1]); w.y = cvt_pk_bf16(v0[2], v0[3]); w.z = cvt_pk_bf16(v1[0], v1[1]); w.w = cvt_pk_bf16(v1[2], v1[3]);
                    *(u32x4*)(rowp + bj * 128) = w; } }
    }
};
struct EpiSguIn {
    static constexpr bool PERM = true;
    bf16_t* U; bf16_t* V; const float* ss; const float* bias; float* ssv;
    __device__ __forceinline__ void operator()(const f32x4 (&acc)[2][2][4][2], const Unit& u, int wr, int wc, int fr, int fq) const {
        const bool isv = u.pn >= 4; bf16_t* base = isv ? V : U; const int colt = (u.pn & 3) * 256 + wc * 32 + 8 * fq, bcol = u.pn * 256 + wc * 32 + 8 * fq;
        f32x4 bv[2][2];
#pragma unroll
        for (int bj = 0; bj < 2; ++bj)
#pragma unroll
            for (int n = 0; n < 2; ++n) bv[bj][n] = *(const f32x4*)(bias + bcol + bj * 128 + 4 * n);
#pragma unroll
        for (int ai = 0; ai < 2; ++ai) {
            float rs4[4]; row_rstd4(ss, u.pm * 256 + ai * 128 + wr * 64 + fr, 16, 0, M - 1, rs4);
#pragma unroll
            for (int m = 0; m < 4; ++m) { const int row = u.pm * 256 + ai * 128 + wr * 64 + m * 16 + fr;
                const float rs = rs4[m]; float s = 0.f;
                bf16_t* rowp = base + (size_t)row * D + colt;
#pragma unroll
                for (int bj = 0; bj < 2; ++bj) { f32x4 v0 = acc[ai][bj][m][0] * rs + bv[bj][0], v1 = acc[ai][bj][m][1] * rs + bv[bj][1];
                    const f32x2 a = pg8::gelu_pk((f32x2){v0[0], v0[1]}), b = pg8::gelu_pk((f32x2){v0[2], v0[3]}), c = pg8::gelu_pk((f32x2){v1[0], v1[1]}), d = pg8::gelu_pk((f32x2){v1[2], v1[3]});
                    s += (a.x * a.x + a.y * a.y) + (b.x * b.x + b.y * b.y) + (c.x * c.x + c.y * c.y) + (d.x * d.x + d.y * d.y);
                    u32x4 w; w.x = cvt_pk_bf16(a.x, a.y); w.y = cvt_pk_bf16(b.x, b.y); w.z = cvt_pk_bf16(c.x, c.y); w.w = cvt_pk_bf16(d.x, d.y);
                    *(u32x4*)(rowp + bj * 128) = w; }
                if (isv) { s += __shfl_xor(s, 16); s += __shfl_xor(s, 32); if (fq == 0) ssv[(size_t)row * 16 + (u.pn - 4) * 4 + wc] = s; } } }
    }
};
struct EpiResid {
    static constexpr bool PERM = true;
    float* h; bf16_t* hb; float* ssn;
    __device__ __forceinline__ void operator()(const f32x4 (&acc)[2][2][4][2], const Unit& u, int wr, int wc, int fr, int fq) const {
        const int colt = u.pn * 256 + wc * 32 + 8 * fq;
#pragma unroll
        for (int ai = 0; ai < 2; ++ai) {
            const int rowb = u.pm * 256 + ai * 128 + wr * 64 + fr;
            f32x4 pre[4][2][2];
#pragma unroll
            for (int m = 0; m < 4; ++m)
#pragma unroll
                for (int bj = 0; bj < 2; ++bj) { const float* hp = h + (size_t)(rowb + m * 16) * D + colt + bj * 128; pre[m][bj][0] = *(const f32x4*)hp; pre[m][bj][1] = *(const f32x4*)(hp + 4); }
#pragma unroll
            for (int m = 0; m < 4; ++m) { const int row = rowb + m * 16; float s = 0.f;
                float* hp = h + (size_t)row * D + colt; bf16_t* bp = hb + (size_t)row * D + colt;
#pragma unroll
                for (int bj = 0; bj < 2; ++bj) { const f32x4 v0 = pre[m][bj][0] + acc[ai][bj][m][0], v1 = pre[m][bj][1] + acc[ai][bj][m][1];
                    *(f32x4*)(hp + bj * 128) = v0; *(f32x4*)(hp + bj * 128 + 4) = v1;
                    s += (v0[0] * v0[0] + v0[1] * v0[1]) + (v0[2] * v0[2] + v0[3] * v0[3]) + (v1[0] * v1[0] + v1[1] * v1[1]) + (v1[2] * v1[2] + v1[3] * v1[3]);
                    u32x4 w; w.x = cvt_pk_bf16(v0[0], v0[1]); w.y = cvt_pk_bf16(v0[2], v0[3]); w.z = cvt_pk_bf16(v1[0], v1[1]); w.w = cvt_pk_bf16(v1[2], v1[3]);
                    *(u32x4*)(bp + bj * 128) = w; }
                s += __shfl_xor(s, 16); s += __shfl_xor(s, 32); if (fq == 0) ssn[(size_t)row * 16 + u.pn * 4 + wc] = s; }
            asm volatile("" ::: "memory");
        }
    }
};
template <int CTRL> __device__ __forceinline__ f32x4 dpp4(f32x4 v) { f32x4 r; r.x = dpp_f<CTRL>(v.x); r.y = dpp_f<CTRL>(v.y); r.z = dpp_f<CTRL>(v.z); r.w = dpp_f<CTRL>(v.w); return r; }
struct EpiFfnUp {
    static constexpr bool PERM = true;
    bf16_t* ACT; const float* ss; const float* cw; const float* cb;
    __device__ __forceinline__ void conv4(f32x4& z0, f32x4& z1, f32x4& z2, f32x4& z3, const float (&rs)[4], const int (&tt)[4], const float* wcol, const float* bcol, int fr) const {
        const f32x4 w0 = *(const f32x4*)wcol, w1 = *(const f32x4*)(wcol + FF2), w2 = *(const f32x4*)(wcol + 2 * FF2), bb = *(const f32x4*)bcol;
#pragma unroll
        for (int e = 0; e < 4; e += 2) {
            const f32x2 w0p = {w0[e], w0[e + 1]}, w1p = {w1[e], w1[e + 1]}, w2p = {w2[e], w2[e + 1]}, bp = {bb[e], bb[e + 1]};
            f32x2 cur = (f32x2){z3[e], z3[e + 1]} * rs[3];
            f32x2 c1 = {dpp_f<0x121>(cur.x), dpp_f<0x121>(cur.y)}, c2 = {dpp_f<0x122>(cur.x), dpp_f<0x122>(cur.y)};
#define CONV_STEP(ZM, ZP, MI, HASP) { f32x2 prv = cur, p1 = c1, p2 = c2; if (HASP) { prv = (f32x2){ZP[e], ZP[e + 1]} * rs[MI - (HASP)]; p1 = (f32x2){dpp_f<0x121>(prv.x), dpp_f<0x121>(prv.y)}; p2 = (f32x2){dpp_f<0x122>(prv.x), dpp_f<0x122>(prv.y)}; } \
            f32x2 y1 = (fr == 0) ? p1 : c1, y2 = (fr < 2) ? p2 : c2; if (tt[MI] < 1) y1 = (f32x2){0.f, 0.f}; if (tt[MI] < 2) y2 = (f32x2){0.f, 0.f}; \
            const f32x2 o = w0p * y2 + (w1p * y1 + (w2p * cur + bp)); ZM[e] = o.x; ZM[e + 1] = o.y; cur = prv; c1 = p1; c2 = p2; }
            CONV_STEP(z3, z2, 3, 1) CONV_STEP(z2, z1, 2, 1) CONV_STEP(z1, z0, 1, 1) CONV_STEP(z0, z0, 0, 0)
#undef CONV_STEP
            asm volatile("" : "+v"(z0[e]), "+v"(z1[e]), "+v"(z2[e]), "+v"(z3[e]), "+v"(z0[e + 1]), "+v"(z1[e + 1]), "+v"(z2[e + 1]), "+v"(z3[e + 1]));
        }
    }
    __device__ __forceinline__ void operator()(f32x4 (&acc)[2][2][4][2], const Unit& u, int wr, int wc, int fr, int fq) const {
        const int f0 = u.pn * 128 + wc * 32 + 8 * fq;
#pragma unroll
        for (int ai = 0; ai < 2; ++ai) {
            const int gbase = u.pm * 248 - 2 + 62 * (2 * ai + wr) + fr;
            float rs[4]; int tt[4];
            row_rstd4(ss, gbase, 16, 0, M - 1, rs);
            asm volatile("" : "+v"(rs[0]), "+v"(rs[1]), "+v"(rs[2]), "+v"(rs[3]) :: "memory");
            { const int g0 = u.pm * 248 - 2 + 62 * (2 * ai + wr);
              const bool seqstart = ((g0 + 63) & (SEQ - 1)) < 65 || g0 < 0;
#pragma unroll
              for (int m = 0; m < 4; ++m) tt[m] = seqstart ? ((gbase + 16 * m) & (SEQ - 1)) : 2; }
#pragma unroll
            for (int n = 0; n < 2; ++n) {
                conv4(acc[ai][0][0][n], acc[ai][0][1][n], acc[ai][0][2][n], acc[ai][0][3][n], rs, tt, cw + f0 + 4 * n, cb + f0 + 4 * n, fr);
                asm volatile("" ::: "memory");
                conv4(acc[ai][1][0][n], acc[ai][1][1][n], acc[ai][1][2][n], acc[ai][1][3][n], rs, tt, cw + FF + f0 + 4 * n, cb + FF + f0 + 4 * n, fr);
                asm volatile("" ::: "memory");
#pragma unroll
                for (int m = 0; m < 4; ++m) { const int g = gbase + 16 * m;
                    if ((m > 0 || fr >= 2) && g < M) { const f32x4 gt = acc[ai][0][m][n], vl = acc[ai][1][m][n]; f32x4 o;
#pragma unroll
                        for (int e = 0; e < 4; ++e) o[e] = gt[e] * sigmoidf_(gt[e]) * vl[e];
                        u32x2 w; w.x = cvt_pk_bf16(o[0], o[1]); w.y = cvt_pk_bf16(o[2], o[3]);
                        *(u32x2*)(ACT + (size_t)g * FF + f0 + 4 * n) = w; } }
            }
        }
    }
};
struct EpiRkv {
    static constexpr bool PERM = true;
    bf16_t* R; bf16_t* WA; bf16_t* GL;
    __device__ __forceinline__ void operator()(const f32x4 (&acc)[2][2][4][2], const Unit& u, int wr, int wc, int fr, int fq) const {
        const int mode = u.pn < 12 ? 0 : (u.pn == 12 ? 1 : 2);
        bf16_t* base; int ldc, colt;
        if (mode == 0) { base = R + (size_t)(u.pn >> 2) * ((size_t)M * D); ldc = D; colt = (u.pn & 3) * 256 + wc * 32 + 8 * fq; }
        else if (mode == 1) { base = WA; ldc = 128; colt = wc * 32 + 8 * fq; }
        else { base = GL; ldc = 256; colt = wc * 32 + 8 * fq; }
#pragma unroll
        for (int ai = 0; ai < 2; ++ai)
#pragma unroll
            for (int m = 0; m < 4; ++m) { const int row = u.pm * 256 + ai * 128 + wr * 64 + m * 16 + fr;
                bf16_t* rowp = base + (size_t)row * ldc + colt;
#pragma unroll
                for (int bj = 0; bj < 2; ++bj) { f32x4 v0 = acc[ai][bj][m][0], v1 = acc[ai][bj][m][1];
                    if (mode == 1) { if (bj == 1) continue;
                        if (wc < 2) {
#pragma unroll
                            for (int e = 0; e < 4; ++e) { v0[e] = tanhf(v0[e]); v1[e] = tanhf(v1[e]); } } }
                    else if (mode == 2) {
#pragma unroll
                        for (int e = 0; e < 4; ++e) { v0[e] = sigmoidf_(v0[e]); v1[e] = sigmoidf_(v1[e]); } }
                    u32x4 w; w.x = cvt_pk_bf16(v0[0], v0[1]); w.y = cvt_pk_bf16(v0[2], v0[3]); w.z = cvt_pk_bf16(v1[0], v1[1]); w.w = cvt_pk_bf16(v1[2], v1[3]);
                    *(u32x4*)(rowp + bj * 128) = w; } }
    }
};

typedef const __attribute__((address_space(4))) Args* CA;
struct Ctx { LAS unsigned char* lds; int tid, lane, wave, G, bid; };

__device__ __forceinline__ void conv_mat(const Ctx& c, const float* src, int ldsrc, int K, int N, int Kp, int Np, bf16_t* dst, int ldd, int n_off, int k_off, const float* sc, int mode, int rot) {
    LAS float* tile = (LAS float*)c.lds;
    const int nnb = Np / 64, nit = (Kp / 64) * nnb; const int start = (c.bid + c.G - (rot % c.G)) % c.G;
    for (int it = start; it < nit; it += c.G) {
        const int kb = it / nnb, nb = it % nnb, k0 = kb * 64, n0 = nb * 64;
#pragma unroll
        for (int j = 0; j < 8; ++j) { const int kk = (c.tid >> 6) + 8 * j, nn = c.tid & 63, k = k0 + kk, n = n0 + nn; float v = 0.f;
            if (src && k < K && n < N) { v = src[(size_t)k * ldsrc + n]; if (mode == 1) v *= sc[k]; else if (mode == 2) v *= (1.f - sc[k]); }
            tile[nn * 65 + kk] = v; }
        __syncthreads();
        { const int nn = c.tid >> 3, cc = c.tid & 7; const LAS float* s = tile + nn * 65 + 8 * cc;
            u32x4 o; o.x = cvt_pk_bf16(s[0], s[1]); o.y = cvt_pk_bf16(s[2], s[3]); o.z = cvt_pk_bf16(s[4], s[5]); o.w = cvt_pk_bf16(s[6], s[7]);
            *(u32x4*)(dst + (size_t)(n_off + n0 + nn) * ldd + k_off + k0 + 8 * cc) = o; }
        __syncthreads();
    }
}

__device__ __forceinline__ void phase_static_weights(const Ctx& c, CA a, int j);
__device__ __forceinline__ void phase_prologue(const Ctx& c, CA a) {
    float* ss = (float*)(a->ws + WS_PA);
    const int gw = c.bid * 8 + c.wave, NGW = c.G * 8;
    bf16_t* hb = (bf16_t*)(a->ws + WS_A);
    for (int m = gw; m < M; m += NGW) {
        const f32x4* xr = (const f32x4*)(a->in[I_X] + (size_t)m * D) + c.lane; f32x4* hr = (f32x4*)(a->out + (size_t)m * D) + c.lane; u32x2* br = (u32x2*)(hb + (size_t)m * D) + c.lane;
        float s = 0.f;
#pragma unroll
        for (int j = 0; j < 4; ++j) { const f32x4 v = xr[64 * j]; s += (v.x * v.x + v.y * v.y) + (v.z * v.z + v.w * v.w); hr[64 * j] = v; u32x2 w; w.x = cvt_pk_bf16(v.x, v.y); w.y = cvt_pk_bf16(v.z, v.w); br[64 * j] = w; }
        s = wave_sum(s); if (c.lane < 16) ss[(size_t)m * 16 + c.lane] = c.lane == 0 ? s : 0.f;
    }
    phase_static_weights(c, a, 0);
}
__device__ __forceinline__ void phase_static_weights(const Ctx& c, CA a, int j) {
    int rot = 0;
    {
        unsigned char* wj = a->ws + WS_WSTAT + (size_t)j * WJ_STRIDE;
        conv_mat(c, a->in[I_SWIN] + (size_t)j * D * 2048, 2048, D, 2048, D, 2048, (bf16_t*)(wj + WJ_IN), D, 0, 0, a->in[I_NMIX] + (size_t)(2 * j) * D, 1, rot); rot += 512;
        conv_mat(c, a->in[I_SWOUT] + (size_t)j * D * D, D, D, D, D, D, (bf16_t*)(wj + WJ_OUT), D, 0, 0, nullptr, 0, rot); rot += 256;
        const float* mu = a->in[I_MU] + (size_t)j * 6 * D; bf16_t* rkv = (bf16_t*)(wj + WJ_RKV);
#define CONV_BIG(IDX, Q, MUB) do { conv_mat(c, a->in[IDX] + (size_t)j * D * D, D, D, D, D, D, rkv, 2048, (Q) * 1024, 0, mu + (MUB) * D, 2, rot); rot += 256; \
            conv_mat(c, a->in[IDX] + (size_t)j * D * D, D, D, D, D, D, rkv, 2048, (Q) * 1024, 1024, mu + (MUB) * D, 1, rot); rot += 256; } while (0)
        CONV_BIG(I_WR, 0, 0); CONV_BIG(I_WK, 1, 2); CONV_BIG(I_WV, 2, 3);
#undef CONV_BIG
        conv_mat(c, a->in[I_W1] + (size_t)j * D * 64, 64, D, 64, D, 64, rkv, 2048, 3072, 0, mu + 1 * D, 2, rot); rot += 16;
        conv_mat(c, a->in[I_W1] + (size_t)j * D * 64, 64, D, 64, D, 64, rkv, 2048, 3072, 1024, mu + 1 * D, 1, rot); rot += 16;
        conv_mat(c, a->in[I_A1] + (size_t)j * D * 64, 64, D, 64, D, 64, rkv, 2048, 3136, 0, mu + 4 * D, 2, rot); rot += 16;
        conv_mat(c, a->in[I_A1] + (size_t)j * D * 64, 64, D, 64, D, 64, rkv, 2048, 3136, 1024, mu + 4 * D, 1, rot); rot += 16;
        conv_mat(c, nullptr, 0, 0, 0, 2048, 128, rkv, 2048, 3200, 0, nullptr, 0, rot); rot += 64;
        conv_mat(c, a->in[I_G1] + (size_t)j * D * 160, 160, D, 160, D, 256, rkv, 2048, 3328, 0, mu + 5 * D, 2, rot); rot += 64;
        conv_mat(c, a->in[I_G1] + (size_t)j * D * 160, 160, D, 160, D, 256, rkv, 2048, 3328, 1024, mu + 5 * D, 1, rot); rot += 64;
        bf16_t* l2wa = (bf16_t*)(wj + WJ_L2WA);
        conv_mat(c, a->in[I_W2] + (size_t)j * 64 * D, D, 64, D, 64, D, l2wa, 128, 0, 0, nullptr, 0, rot); rot += 16;
        conv_mat(c, nullptr, 0, 0, 0, 64, D, l2wa, 128, 0, 64, nullptr, 0, rot); rot += 16;
        conv_mat(c, nullptr, 0, 0, 0, 64, D, l2wa, 128, 1024, 0, nullptr, 0, rot); rot += 16;
        conv_mat(c, a->in[I_A2] + (size_t)j * 64 * D, D, 64, D, 64, D, l2wa, 128, 1024, 64, nullptr, 0, rot); rot += 16;
        conv_mat(c, a->in[I_G2] + (size_t)j * 160 * D, D, 160, D, 256, D, (bf16_t*)(wj + WJ_L2G), 256, 0, 0, nullptr, 0, rot); rot += 64;
        conv_mat(c, a->in[I_WO] + (size_t)j * D * D, D, D, D, D, D, (bf16_t*)(wj + WJ_O), D, 0, 0, nullptr, 0, rot); rot += 256;
    }
}
__device__ __forceinline__ void phase_ffn_weights(const Ctx& c, CA a, int layer) {
    for (int pn = 0; pn < FF / 128; ++pn) {
        conv_mat(c, a->in[I_FUP] + (size_t)layer * D * FF2 + pn * 128, FF2, D, 128, D, 128, (bf16_t*)(a->ws + WS_WFFN), D, pn * 256, 0, a->in[I_NFFN] + (size_t)layer * D, 1, pn * 64);
        conv_mat(c, a->in[I_FUP] + (size_t)layer * D * FF2 + FF + pn * 128, FF2, D, 128, D, 128, (bf16_t*)(a->ws + WS_WFFN), D, pn * 256 + 128, 0, a->in[I_NFFN] + (size_t)layer * D, 1, pn * 64 + 32);
    }
    conv_mat(c, a->in[I_FDN] + (size_t)layer * FF * D, D, FF, D, FF, D, (bf16_t*)(a->ws + WS_WDOWN), FF, 0, 0, nullptr, 0, 128);
}

__device__ __forceinline__ void phase_sgu_spatial(const Ctx& c, CA a, int j, int rp) {
    typedef short bf16x8 __attribute__((ext_vector_type(8)));
    bf16_t* U = (bf16_t*)(a->ws + P_U); const bf16_t* V = (const bf16_t*)(a->ws + P_SV); bf16_t* UO = rp ? (bf16_t*)(a->ws + P_SV) : U;
    const float* ssv = (const float*)(a->ws + WS_PV);
    LAS bf16_t* WL = (LAS bf16_t*)c.lds; LAS bf16_t* VT = WL + 128 * 136;
    const int g = c.bid & 15;
    const float* Ws = a->in[I_SWS] + ((size_t)j * 16 + g) * 128 * 128; const float* bs = a->in[I_SBS] + ((size_t)j * 16 + g) * 128; const float* gv = a->in[I_SGV] + (size_t)j * D + g * 64;
    __syncthreads();
    { const int t = c.tid >> 2, s0 = (c.tid & 3) * 32; const float* wp = Ws + (size_t)t * 128 + s0;
#pragma unroll
      for (int q = 0; q < 4; ++q) { f32x4 x0 = *(const f32x4*)(wp + 8 * q), x1 = *(const f32x4*)(wp + 8 * q + 4);
#pragma unroll
          for (int e = 0; e < 4; ++e) { if (s0 + 8 * q + e > t) x0[e] = 0.f; if (s0 + 8 * q + 4 + e > t) x1[e] = 0.f; }
          u32x4 w; w.x = cvt_pk_bf16(x0[0], x0[1]); w.y = cvt_pk_bf16(x0[2], x0[3]); w.z = cvt_pk_bf16(x1[0], x1[1]); w.w = cvt_pk_bf16(x1[2], x1[3]);
          *(LAS u32x4*)(WL + t * 136 + s0 + 8 * q) = w; } }
    const int w8 = c.wave, fr = c.lane & 15, fq = c.lane >> 4, t0 = 16 * w8, nk = (w8 >> 1) + 1;
    const int vs = c.tid >> 2, vc = (c.tid & 3) * 16;
    f32x4 gq[4];
#pragma unroll
    for (int e = 0; e < 4; ++e) gq[e] = *(const f32x4*)(gv + vc + 4 * e);
    const float bb = bs[t0 + fr];
    for (int ub = c.bid >> 4; ub < M / 128; ub += c.G >> 4) {
        const int m0 = ub * 128;
        { const bf16_t* vp = V + (size_t)(m0 + vs) * D + g * 64 + vc; const u32x4 v0 = *(const u32x4*)vp, v1 = *(const u32x4*)(vp + 8);
          const float rs = row_rstd(ssv, m0 + vs);
          const unsigned vw[8] = {v0.x, v0.y, v0.z, v0.w, v1.x, v1.y, v1.z, v1.w};
#pragma unroll
          for (int e = 0; e < 8; ++e) { const float lo = bflo(vw[e]) * rs * gq[e >> 1][(2 * e) & 3], hi = bfhi(vw[e]) * rs * gq[e >> 1][(2 * e + 1) & 3];
              const unsigned pk = cvt_pk_bf16(lo, hi);
              VT[(vc + 2 * e) * 136 + vs] = (bf16_t)(pk & 0xffffu); VT[(vc + 2 * e + 1) * 136 + vs] = (bf16_t)(pk >> 16); } }
        __syncthreads();
        f32x4 acc[4];
#pragma unroll
        for (int ct = 0; ct < 4; ++ct) acc[ct] = (f32x4){0.f, 0.f, 0.f, 0.f};
        for (int k = 0; k < nk; ++k) {
            const bf16x8 wf = *(const LAS bf16x8*)(WL + (t0 + fr) * 136 + 32 * k + 8 * fq);
#pragma unroll
            for (int ct = 0; ct < 4; ++ct) { const bf16x8 vf = *(const LAS bf16x8*)(VT + (16 * ct + fr) * 136 + 32 * k + 8 * fq);
                acc[ct] = __builtin_amdgcn_mfma_f32_16x16x32_bf16(vf, wf, acc[ct], 0, 0, 0); }
        }
        { const size_t ro = (size_t)(m0 + t0 + fr) * D + g * 64 + 4 * fq;
#pragma unroll
          for (int ct = 0; ct < 4; ++ct) { const u32x2 uu = *(const u32x2*)(U + ro + 16 * ct); const f32x4 o = acc[ct] + bb;
              u32x2 w; w.x = cvt_pk_bf16(bflo(uu.x) * o[0], bfhi(uu.x) * o[1]); w.y = cvt_pk_bf16(bflo(uu.y) * o[2], bfhi(uu.y) * o[3]);
              *(u32x2*)(UO + ro + 16 * ct) = w; } }
        __syncthreads();
    }
}

__device__ __forceinline__ void phase_ffn_conv(const Ctx& c, CA a, int layer, int half) {
    const bf16_t* Z = (const bf16_t*)(a->ws + P_Z); bf16_t* ACT = (bf16_t*)(a->ws + P_ACT) + (size_t)half * (M / 2) * FF;
    const float* cw = a->in[I_FCW] + (size_t)layer * 3 * FF2; const float* cb = a->in[I_FCB] + (size_t)layer * FF2;
    const int gt = c.bid * 512 + c.tid, NT = c.G * 512;
    for (int idx = gt; idx < (M / 2) * (FF / 8); idx += NT) {
        const int ml = idx / (FF / 8), f = (idx % (FF / 8)) * 8, t = ml & (SEQ - 1);
        float gsum[8], vsum[8];
#pragma unroll
        for (int e = 0; e < 8; ++e) { gsum[e] = cb[f + e]; vsum[e] = cb[FF + f + e]; }
#pragma unroll
        for (int jj = 0; jj < 3; ++jj) { const int dt = 2 - jj; if (t - dt < 0) continue;
            const u32x4 zg = *(const u32x4*)(Z + (size_t)(ml - dt) * FF2 + f), zv = *(const u32x4*)(Z + (size_t)(ml - dt) * FF2 + FF + f);
            const float* wg = cw + (size_t)jj * FF2 + f; const float* wv = wg + FF;
            const unsigned zgw[4] = {zg.x, zg.y, zg.z, zg.w}, zvw[4] = {zv.x, zv.y, zv.z, zv.w};
#pragma unroll
            for (int e = 0; e < 4; ++e) { gsum[2 * e] += wg[2 * e] * bflo(zgw[e]); gsum[2 * e + 1] += wg[2 * e + 1] * bfhi(zgw[e]); vsum[2 * e] += wv[2 * e] * bflo(zvw[e]); vsum[2 * e + 1] += wv[2 * e + 1] * bfhi(zvw[e]); } }
        float o[8];
#pragma unroll
        for (int e = 0; e < 8; ++e) o[e] = gsum[e] * sigmoidf_(gsum[e]) * vsum[e];
        u32x4 w; w.x = cvt_pk_bf16(o[0], o[1]); w.y = cvt_pk_bf16(o[2], o[3]); w.z = cvt_pk_bf16(o[4], o[5]); w.w = cvt_pk_bf16(o[6], o[7]);
        *(u32x4*)(ACT + (size_t)ml * FF + f) = w;
    }
}

__device__ __forceinline__ void phase_rwkv_prep(const Ctx& c, CA a, int layer) {
    const float* ss = (const float*)(a->ws + WS_PA); const float* g = a->in[I_NMIX] + (size_t)layer * D;
    bf16_t* hn = (bf16_t*)(a->ws + WS_A);
    const int gw = c.bid * 8 + c.wave, NGW = c.G * 8;
    f32x4 gg[4];
#pragma unroll
    for (int j = 0; j < 4; ++j) gg[j] = *((const f32x4*)g + c.lane + 64 * j);
    for (int m = gw; m < M; m += NGW) {
        const float rs = row_rstd(ss, m);
        const f32x4* hr = (const f32x4*)(a->out + (size_t)m * D) + c.lane; const int prow = (m >> 12) * SEQP + PADR + (m & (SEQ - 1));
        u32x2* br = (u32x2*)(hn + (size_t)prow * D) + c.lane;
#pragma unroll
        for (int j = 0; j < 4; ++j) { const f32x4 v = hr[64 * j] * rs * gg[j]; u32x2 w; w.x = cvt_pk_bf16(v.x, v.y); w.y = cvt_pk_bf16(v.z, v.w); br[64 * j] = w; }
    }
    for (int r = gw; r < BATCH * PADR; r += NGW) { const int prow = (r / PADR) * SEQP + (r % PADR); u32x2* br = (u32x2*)(hn + (size_t)prow * D) + c.lane;
#pragma unroll
        for (int j = 0; j < 4; ++j) br[64 * j] = (u32x2){0u, 0u}; }
}

__device__ __forceinline__ f32x4 bf4(u32x2 w) { return (f32x4){bflo(w.x), bfhi(w.x), bflo(w.y), bfhi(w.y)}; }
__device__ __forceinline__ float hsum4(f32x4 p) { return (p.x + p.y) + (p.z + p.w); }
__device__ __forceinline__ float sum16(float v) { v = sum8(v); v += dpp_f<0x140>(v); return v; }
__device__ __forceinline__ f32x4 bf4lo(u32x4 w) { return (f32x4){bflo(w.x), bfhi(w.x), bflo(w.y), bfhi(w.y)}; }
__device__ __forceinline__ f32x4 bf4hi(u32x4 w) { return (f32x4){bflo(w.z), bfhi(w.z), bflo(w.w), bfhi(w.w)}; }
__device__ __forceinline__ void phase_scan(const Ctx& c, CA a, int j, int rp_out) {
    constexpr int CH = 32, NCH = SEQ / CH, VSZ = CH * 64, YSZ = CH * 32;
    LAS float* BIG = (LAS float*)c.lds; LAS float* VB = BIG + 2 * 5 * VSZ; LAS float* YB = VB + 4 * VSZ; LAS float* BON = YB + 3 * YSZ;
    bf16_t* R = (bf16_t*)(a->ws + P_R); const bf16_t* Kb = (const bf16_t*)(a->ws + P_K); const bf16_t* Vb = (const bf16_t*)(a->ws + P_V);
    const bf16_t* LWb = (const bf16_t*)(a->ws + P_LW); const bf16_t* LAb = (const bf16_t*)(a->ws + P_LA); const bf16_t* Gb = (const bf16_t*)(a->ws + WS_A);
    if (c.G != 256) return;
    const int unit = c.bid, b = unit >> 5, hh = (unit >> 1) & 15, half = unit & 1;
    unsigned long long* slot_own = (unsigned long long*)(a->ws + WS_XS) + (size_t)(j * 256 + unit) * 256; const unsigned long long* slot_par = (const unsigned long long*)(a->ws + WS_XS) + (size_t)(j * 256 + (unit ^ 1)) * 256;
    const bool cons = c.tid < 256;
    __syncthreads();
    if (cons) {
        const int rp = c.tid >> 3, q = c.tid & 7, row = 32 * half + rp;
        f32x4 S0 = (f32x4){0.f, 0.f, 0.f, 0.f}, S1 = S0;
        __builtin_amdgcn_s_setprio(2);
        __syncthreads();
        for (int i = 0; i <= NCH + 1; ++i) {
            if (i < NCH) {
                const LAS float* bg = BIG + (i & 1) * 5 * VSZ + 8 * q;
                const LAS f32x4* pw = (const LAS f32x4*)bg; const LAS f32x4* pa = (const LAS f32x4*)(bg + VSZ); const LAS f32x4* pb = (const LAS f32x4*)(bg + 2 * VSZ);
                const LAS f32x4* pk = (const LAS f32x4*)(bg + 3 * VSZ); const LAS f32x4* pr = (const LAS f32x4*)(bg + 4 * VSZ);
                const LAS float* pv = VB + (i & 3) * VSZ + row; LAS float* py = YB + (i % 3) * YSZ + rp;
                f32x4 a0v = pa[0], a1v = pa[1], w0v = pw[0], w1v = pw[1], b0v = pb[0], b1v = pb[1], k0v = pk[0], k1v = pk[1], r0v = pr[0], r1v = pr[1];
                float vv = pv[0];
#pragma unroll 2
                for (int t = 0; t < CH; ++t) {
                    const int tn = (t + 1) & (CH - 1);
                    const f32x4 na0 = pa[tn * 16], na1 = pa[tn * 16 + 1], nw0 = pw[tn * 16], nw1 = pw[tn * 16 + 1], nb0 = pb[tn * 16], nb1 = pb[tn * 16 + 1],
                                nk0 = pk[tn * 16], nk1 = pk[tn * 16 + 1], nr0 = pr[tn * 16], nr1 = pr[tn * 16 + 1];
                    const float nvv = pv[tn * 64];
                    const float sa = sum8(hsum4(S0 * a0v + S1 * a1v));
                    S0 = S0 * w0v + sa * b0v + vv * k0v; S1 = S1 * w1v + sa * b1v + vv * k1v;
                    const float y = sum8(hsum4(S0 * r0v + S1 * r1v));
                    if (q == 0) py[t * 32] = y;
                    a0v = na0; a1v = na1; w0v = nw0; w1v = nw1; b0v = nb0; b1v = nb1; k0v = nk0; k1v = nk1; r0v = nr0; r1v = nr1; vv = nvv;
                }
            }
            __syncthreads();
        }
        __builtin_amdgcn_s_setprio(0);
    } else {
        const int pt = c.tid - 256, st = pt >> 3, l8 = pt & 7, sc = l8 * 8, ch = hh * 64 + sc;
        const float* pp = a->in[I_W0] + (size_t)j * D + ch; const f32x4 w0a = *(const f32x4*)pp, w0b = *(const f32x4*)(pp + 4);
        pp = a->in[I_A0] + (size_t)j * D + ch; const f32x4 a0a = *(const f32x4*)pp, a0b = *(const f32x4*)(pp + 4);
        pp = a->in[I_KK] + (size_t)j * D + ch; const f32x4 kka = *(const f32x4*)pp, kkb = *(const f32x4*)(pp + 4);
        pp = a->in[I_KA] + (size_t)j * D + ch; const f32x4 kaa = *(const f32x4*)pp, kab = *(const f32x4*)(pp + 4);
        pp = a->in[I_RK] + (size_t)j * D + ch; const f32x4 rka = *(const f32x4*)pp, rkb = *(const f32x4*)(pp + 4);
        const int oc = 4 * l8, cho = hh * 64 + 32 * half + oc;
        const f32x4 lnw = *(const f32x4*)(a->in[I_LNW] + (size_t)j * D + cho), lnb = *(const f32x4*)(a->in[I_LNB] + (size_t)j * D + cho);
        const size_t gbase = ((size_t)b * SEQ + st) * D + ch, obase = ((size_t)b * SEQ + st) * D + cho;
        u32x4 qr = *(const u32x4*)(R + gbase), qk = *(const u32x4*)(Kb + gbase), qv = *(const u32x4*)(Vb + gbase), qlw = *(const u32x4*)(LWb + gbase), qla = *(const u32x4*)(LAb + gbase);
        u32x2 qg = (u32x2){0u, 0u};
#define SCAN_STAGE(n) { \
            f32x4 rr[2] = {bf4lo(qr), bf4hi(qr)}, kk_[2] = {bf4lo(qk), bf4hi(qk)}, vv_[2] = {bf4lo(qv), bf4hi(qv)}, lw_[2] = {bf4lo(qlw), bf4hi(qlw)}, la_[2] = {bf4lo(qla), bf4hi(qla)}; \
            const f32x4 w0_[2] = {w0a, w0b}, a0_[2] = {a0a, a0b}, kkp_[2] = {kka, kkb}, kap_[2] = {kaa, kab}, rkp_[2] = {rka, rkb}; \
            f32x4 dec[2], av[2], kn[2], kp[2]; float n2 = 0.f, bon = 0.f; \
            _Pragma("unroll") for (int h2 = 0; h2 < 2; ++h2) _Pragma("unroll") for (int e = 0; e < 4; ++e) { \
                const float xw = -(w0_[h2][e] + lw_[h2][e]); const float sp = xw > 20.f ? xw : __logf(1.f + __expf(xw)); \
                dec[h2][e] = __expf(-__expf(-sp - 0.5f)); av[h2][e] = __builtin_amdgcn_rcpf(1.f + __expf(-(a0_[h2][e] + la_[h2][e]))); \
                kn[h2][e] = kk_[h2][e] * kkp_[h2][e]; n2 += kn[h2][e] * kn[h2][e]; \
                kp[h2][e] = kk_[h2][e] * (1.f + (av[h2][e] - 1.f) * kap_[h2][e]); bon += rr[h2][e] * kp[h2][e] * rkp_[h2][e]; } \
            n2 = sum8(n2); bon = sum8(bon); const float inv = rsqrtf(fmaxf(n2, 1e-24f)); \
            LAS float* bg = BIG + ((n) & 1) * 5 * VSZ + st * 64 + sc; \
            _Pragma("unroll") for (int h2 = 0; h2 < 2; ++h2) { const f32x4 kq = kn[h2] * inv; \
                *(LAS f32x4*)(bg + 4 * h2) = dec[h2]; *(LAS f32x4*)(bg + VSZ + 4 * h2) = -kq; *(LAS f32x4*)(bg + 2 * VSZ + 4 * h2) = kq * av[h2]; \
                *(LAS f32x4*)(bg + 3 * VSZ + 4 * h2) = kp[h2]; *(LAS f32x4*)(bg + 4 * VSZ + 4 * h2) = rr[h2]; \
                *(LAS f32x4*)(VB + ((n) & 3) * VSZ + st * 64 + sc + 4 * h2) = vv_[h2]; } \
            if (l8 == 0) BON[((n) & 3) * CH + st] = bon; }
#define SCAN_YSTATS(n) \
            const f32x4 y = *(const LAS f32x4*)(YB + ((n) % 3) * YSZ + st * 32 + oc); \
            const float mh = sum8(hsum4(y)) * (1.f / 32.f); const f32x4 d = y - mh; const float m2h = sum8(hsum4(d * d));
        SCAN_STAGE(0)
        { const size_t go = gbase + (size_t)CH * D; qr = *(const u32x4*)(R + go); qk = *(const u32x4*)(Kb + go); qv = *(const u32x4*)(Vb + go); qlw = *(const u32x4*)(LWb + go); qla = *(const u32x4*)(LAb + go); }
        __syncthreads();
        for (int i = 0; i <= NCH + 1; ++i) {
            unsigned long long pw0 = 0ull, pw1 = 0ull; const unsigned long long* pp_ = slot_par + (((i - 2) & 3) * CH + st) * 2;
            if (i >= 2) { pw0 = __hip_atomic_load(pp_, __ATOMIC_RELAXED, __HIP_MEMORY_SCOPE_AGENT); pw1 = __hip_atomic_load(pp_ + 1, __ATOMIC_RELAXED, __HIP_MEMORY_SCOPE_AGENT); }
            if (i >= 1 && i <= NCH) {
                const int n = i - 1;
                SCAN_YSTATS(n)
                if (l8 == 0) { const unsigned long long tg = (unsigned long long)(unsigned)(n + 1) << 32; unsigned long long* sp_ = slot_own + ((n & 3) * CH + st) * 2;
                    __hip_atomic_store(sp_, tg | __float_as_uint(mh), __ATOMIC_RELAXED, __HIP_MEMORY_SCOPE_AGENT); __hip_atomic_store(sp_ + 1, tg | __float_as_uint(m2h), __ATOMIC_RELAXED, __HIP_MEMORY_SCOPE_AGENT); }
            }
            u32x4 nr = qr, nk = qk, nv = qv, nlw = qlw, nla = qla; u32x2 ng = qg;
            if (i + 2 < NCH) { const size_t go = gbase + (size_t)(i + 2) * CH * D; nr = *(const u32x4*)(R + go); nk = *(const u32x4*)(Kb + go); nv = *(const u32x4*)(Vb + go); nlw = *(const u32x4*)(LWb + go); nla = *(const u32x4*)(LAb + go); }
            if (i >= 1 && i <= NCH) ng = *(const u32x2*)(Gb + obase + (size_t)(i - 1) * CH * D);
            if (i + 1 < NCH) { SCAN_STAGE(i + 1) }
            if (i >= 2) {
                const int n = i - 2; const unsigned tag = (unsigned)(n + 1); unsigned sp = 0;
                while ((unsigned)(pw0 >> 32) != tag) { __builtin_amdgcn_s_sleep(1); if (++sp > (1u << 18)) break; pw0 = __hip_atomic_load(pp_, __ATOMIC_RELAXED, __HIP_MEMORY_SCOPE_AGENT); }
                while ((unsigned)(pw1 >> 32) != tag) { __builtin_amdgcn_s_sleep(1); if (++sp > (1u << 18)) break; pw1 = __hip_atomic_load(pp_ + 1, __ATOMIC_RELAXED, __HIP_MEMORY_SCOPE_AGENT); }
                const float mp = __uint_as_float((unsigned)pw0), m2p = __uint_as_float((unsigned)pw1);
                SCAN_YSTATS(n)
                const float mean = 0.5f * (mh + mp), dm = mh - mp; const float rstd = rsqrtf((m2h + m2p + 16.f * dm * dm) * (1.f / 64.f) + GN_EPS);
                const f32x4 v = *(const LAS f32x4*)(VB + (n & 3) * VSZ + st * 64 + 32 * half + oc); const float bon = BON[(n & 3) * CH + st];
                const f32x4 o = ((y - mean) * rstd * lnw + lnb + bon * v) * bf4(qg);
                u32x2 w; w.x = cvt_pk_bf16(o.x, o.y); w.y = cvt_pk_bf16(o.z, o.w);
                *(u32x2*)(R + obase + (size_t)n * CH * D) = w;
            }
            qg = ng; qr = nr; qk = nk; qv = nv; qlw = nlw; qla = nla;
            __syncthreads();
        }
#undef SCAN_STAGE
#undef SCAN_YSTATS
    }
}

__device__ __forceinline__ void phase_final(const Ctx& c, CA a) {
    const float* ss = (const float*)(a->ws + WS_PA); const float* g = a->in[I_NFIN];
    const int gw = c.bid * 8 + c.wave, NGW = c.G * 8;
    f32x4 gg[4];
#pragma unroll
    for (int j = 0; j < 4; ++j) gg[j] = *((const f32x4*)g + c.lane + 64 * j);
    for (int m = gw; m < M; m += NGW) {
        const float rs = row_rstd(ss, m);
        f32x4* hr = (f32x4*)(a->out + (size_t)m * D) + c.lane;
#pragma unroll
        for (int j = 0; j < 4; ++j) hr[64 * j] = hr[64 * j] * rs * gg[j];
    }
}

#define XB_TMO      128
#define XB_XCNT(j)  (256  + 64 * (j))
#define XB_XSUB(j)  (1280 + 64 * (j))
#define XB_XGEN(j)  (2304 + 64 * (j))
#define XB_TOP      3328
#define XB_TOPGEN   3392
#define XCD_BAR_WORDS 3456
#define XB_SPIN_CAP (1u << 18)

__device__ __forceinline__ unsigned xb_ld(unsigned* p)              { return __hip_atomic_load(p, __ATOMIC_RELAXED, __HIP_MEMORY_SCOPE_AGENT); }
__device__ __forceinline__ unsigned xb_add(unsigned* p, unsigned v) { return __hip_atomic_fetch_add(p, v, __ATOMIC_RELAXED, __HIP_MEMORY_SCOPE_AGENT); }
__device__ __forceinline__ unsigned xb_xcc_id() { return (unsigned)__builtin_amdgcn_s_getreg((3 << 11) | 20) & 0xFu; }
#define XB_SPIN(cond, bar) do { unsigned _sp = 0; while (cond) { __builtin_amdgcn_s_sleep(1); \
    if ((++_sp & 255u) == 0u) { if (xb_ld(&(bar)[XB_TMO])) break; if (_sp > XB_SPIN_CAP) { atomicAdd(&(bar)[XB_TMO], 1u); break; } } } } while (0)

struct XcdBarrier {
    unsigned* bar; unsigned x;
    volatile LAS unsigned* st;
};

__device__ __forceinline__ XcdBarrier xcd_barrier_post(unsigned* bar, volatile LAS unsigned* st) {
    XcdBarrier b; b.bar = bar; b.x = xb_xcc_id(); b.st = st;
    if (threadIdx.x == 0) (void)xb_add(&bar[XB_XCNT(b.x)], 1u);
    return b;
}
__device__ __forceinline__ void xcd_barrier_complete(unsigned* bar, unsigned x, unsigned& nloc, unsigned& nx) {
    const unsigned G = gridDim.x * gridDim.y * gridDim.z;
    unsigned sum, cnt, mine, sp = 0u;
    for (;;) {
        sum = 0u; cnt = 0u; mine = 0u;
#pragma unroll
        for (unsigned j = 0; j < 16; ++j) { const unsigned c = xb_ld(&bar[XB_XCNT(j)]); sum += c; cnt += (c > 0u) ? 1u : 0u; mine = (j == x) ? c : mine; }
        if (sum == G) break;
        __builtin_amdgcn_s_sleep(1);
        if ((++sp & 255u) == 0u) { if (xb_ld(&bar[XB_TMO])) break; if (sp > XB_SPIN_CAP) { atomicAdd(&bar[XB_TMO], 1u); break; } }
    }
    nloc = mine > 0u ? mine : 1u; nx = cnt > 0u ? cnt : 1u;
}

__device__ __forceinline__ void xcd_barrier(const XcdBarrier& b) {
    asm volatile("s_waitcnt vmcnt(0)" ::: "memory");
    __syncthreads();
    if (threadIdx.x == 0) {
        unsigned* bar = b.bar;
        __builtin_amdgcn_s_waitcnt(0);
        unsigned nloc = b.st[0], nx = b.st[1];
        if (nloc == 0u) { xcd_barrier_complete(bar, b.x, nloc, nx); b.st[0] = nloc; b.st[1] = nx; }
        const unsigned old = xb_add(&bar[XB_XSUB(b.x)], 1u);
        const unsigned gen = old / nloc;
        if (old + 1u == (gen + 1u) * nloc) {
            __builtin_amdgcn_fence(__ATOMIC_RELEASE, "agent");
            asm volatile("s_waitcnt vmcnt(0)" ::: "memory");
            const unsigned og = xb_add(&bar[XB_TOP], 1u);
            const unsigned tg = og / nx;
            if (og + 1u == (tg + 1u) * nx) xb_add(&bar[XB_TOPGEN], 1u);
            else XB_SPIN(xb_ld(&bar[XB_TOPGEN]) == tg, bar);
            __builtin_amdgcn_fence(__ATOMIC_ACQUIRE, "agent");
            xb_add(&bar[XB_XGEN(b.x)], 1u);
            asm volatile("s_waitcnt vmcnt(0)" ::: "memory");
        } else {
            XB_SPIN(xb_ld(&bar[XB_XGEN(b.x)]) == gen, bar);
            __builtin_amdgcn_fence(__ATOMIC_ACQUIRE, "agent");
            asm volatile("s_waitcnt vmcnt(0)" ::: "memory");
        }
    }
    __syncthreads();
}

constexpr int SLOTS = 11, NPH = 2 + 4 * SLOTS;
__host__ __device__ inline bool phase_active(int p) {
    if (p == 0 || p == NPH - 1) return true;
    const int i = (p - 1) / SLOTS, s = (p - 1) % SLOTS;
    if (s >= 5) return s == 6 || s == 10;
    return (i & 1) ? true : (s < 3);
}

__global__ void __launch_bounds__(512, 2) mk_fwd(Args a_) {
    extern __shared__ __attribute__((aligned(16))) unsigned char lds_raw[];
    int tid_ = threadIdx.x, bid_ = blockIdx.x, G_ = gridDim.x;
    volatile LAS unsigned* xst = (volatile LAS unsigned*)((LAS unsigned char*)lds_raw + 131072 + 64);
    if (tid_ < 2) xst[tid_] = 0u;
    __syncthreads();
    const XcdBarrier xbar = xcd_barrier_post((unsigned*)(a_.ws + WS_CTL), xst);
    CA a = (CA)__builtin_amdgcn_kernarg_segment_ptr();
    const int ph_lo = a_.ph_lo, ph_hi = a_.ph_hi;
    for (int p = ph_lo; p < ph_hi; ++p) {
        if (!phase_active(p)) continue;
        const int PL = (p - 1) / SLOTS, PS = (p - 1) % SLOTS; (void)PL; (void)PS;
        const int nrep = (MK_PROBE && p < NPH - 1 && (MK_PROBE_SEL)) ? 2 : 1;
        for (int rp = 0; rp < nrep; ++rp) {
        if (rp) cg::this_grid().sync();
        asm volatile("" : "+s"(a), "+s"(bid_), "+s"(G_)); asm volatile("" : "+v"(tid_));
        Ctx c; c.lds = (LAS unsigned char*)lds_raw; c.tid = tid_; c.lane = c.tid & 63; c.wave = __builtin_amdgcn_readfirstlane(c.tid >> 6); c.G = G_; c.bid = bid_;
        bf16_t* regA = (bf16_t*)(a->ws + WS_A);
        if (p == 0) phase_prologue(c, a);
        else if (p == NPH - 1) phase_final(c, a);
        else {
            const int layer = (p - 1) / SLOTS, s = (p - 1) % SLOTS, j = layer >> 1;
            unsigned char* wj = a->ws + WS_WSTAT + (size_t)j * WJ_STRIDE;
            float* ss_mix = (float*)(a->ws + WS_PA); float* ss_ffn = (float*)(a->ws + WS_PB); float* ss_next = ss_mix;
            if (s < 5 && !(layer & 1)) {
                if (s == 0) {
                    pg8::Gemm g{regA, (const bf16_t*)(wj + WJ_IN), M, 2048, D, D}; pg8::StaticOrder S; S.init(M / 256, 2048, c.G, c.bid);
                    EpiSguIn E{(bf16_t*)(a->ws + P_U), (bf16_t*)(a->ws + P_SV), ss_mix, a->in[I_SBIN] + (size_t)j * 2048, (float*)(a->ws + WS_PV)};
                    pg8::gemm_phase<EpiSguIn, pg8::StaticOrder, 0, false, true>(c.lds, c.tid, g, S, E);
                } else if (s == 1) { phase_ffn_weights(c, a, layer); phase_sgu_spatial(c, a, j, rp); }
                else {
                    pg8::Gemm g{(const bf16_t*)(a->ws + P_U), (const bf16_t*)(wj + WJ_OUT), M, D, D, D}; pg8::StaticOrder S; S.init(M / 256, D, c.G, c.bid);
                    EpiResid E{a->out, regA, ss_ffn};
                    pg8::gemm_phase<EpiResid, pg8::StaticOrder, 0, false, true>(c.lds, c.tid, g, S, E);
                }
            } else if (s < 5) {
                if (s == 0) { phase_rwkv_prep(c, a, layer); phase_ffn_weights(c, a, layer); if (layer == 1) phase_static_weights(c, a, 1); }
                else if (s == 1) {
                    pg8::Gemm g{regA, (const bf16_t*)(wj + WJ_RKV), M, 3584, 2048, D}; pg8::StaticOrder S; S.init(M / 256, 3584, c.G, c.bid);
                    EpiRkv E{(bf16_t*)(a->ws + P_R), (bf16_t*)(a->ws + P_WA), (bf16_t*)(a->ws + P_GL)};
                    pg8::gemm_phase<EpiRkv, pg8::StaticOrder, 1, true, true>(c.lds, c.tid, g, S, E);
                } else if (s == 2) {
                    { int kq = 128; asm volatile("" : "+s"(kq)); pg8::Gemm g{(const bf16_t*)(a->ws + P_WA), (const bf16_t*)(wj + WJ_L2WA), M, 2048, kq, kq}; pg8::StaticOrder S; S.init(M / 256, 2048, c.G, c.bid);
                      EpiStore<false> E{(bf16_t*)(a->ws + P_LW), D, 2, (size_t)M * D, nullptr};
                      pg8::gemm_phase<EpiStore<false>, pg8::StaticOrder, 0, false, true>(c.lds, c.tid, g, S, E); }
                    asm volatile("" : "+s"(a), "+s"(c.bid), "+s"(c.G), "+s"(wj)); asm volatile("" : "+v"(c.tid));
                    { int kq = 256; asm volatile("" : "+s"(kq)); pg8::Gemm g{(const bf16_t*)(a->ws + P_GL), (const bf16_t*)(wj + WJ_L2G), M, D, kq, kq}; pg8::StaticOrder S; S.init(M / 256, D, c.G, c.bid);
                      EpiStore<false> E{regA, D, 2, 0, nullptr};
                      pg8::gemm_phase<EpiStore<false>, pg8::StaticOrder, 0, false, true>(c.lds, c.tid, g, S, E); }
                } else if (s == 3) phase_scan(c, a, j, 0);
                else {
                    pg8::Gemm g{(const bf16_t*)(a->ws + P_R), (const bf16_t*)(wj + WJ_O), M, D, D, D}; pg8::StaticOrder S; S.init(M / 256, D, c.G, c.bid);
                    EpiResid E{a->out, regA, ss_ffn};
                    pg8::gemm_phase<EpiResid, pg8::StaticOrder, 0, false, true>(c.lds, c.tid, g, S, E);
                }
            }
            else if (s == 6) {
                pg8::Gemm g{regA - 2 * D, (const bf16_t*)(a->ws + WS_WFFN), M, FF2, D, D}; pg8::StaticOrder S; S.init(133, FF2, c.G, c.bid);
                EpiFfnUp E{(bf16_t*)(a->ws + P_ACT), ss_ffn, a->in[I_FCW] + (size_t)layer * 3 * FF2, a->in[I_FCB] + (size_t)layer * FF2};
                pg8::gemm_phase<EpiFfnUp, pg8::StaticOrder, 2, false, true>(c.lds, c.tid, g, S, E);
            }
            else {
                pg8::Gemm g{(const bf16_t*)(a->ws + P_ACT), (const bf16_t*)(a->ws + WS_WDOWN), M, D, FF, FF}; pg8::StaticOrder S; S.init(M / 256, D, c.G, c.bid);
                EpiResid E{a->out, regA, ss_next};
                pg8::gemm_phase<EpiResid, pg8::StaticOrder, 0, false, true>(c.lds, c.tid, g, S, E);
            }
        }
        }
        if (p + 1 < ph_hi) { if (p == 0) cg::this_grid().sync(); else xcd_barrier(xbar); }
    }
}

constexpr int LDS_BYTES = 147456;
#ifndef MK_ONE_LAUNCH
#define MK_ONE_LAUNCH 1
#endif
extern "C" void kernel_launch(void* const* d_in, const int* in_sizes, int n_in, void* d_out, int out_size, void* d_ws, size_t ws_size, hipStream_t stream) {
    static int grid = 0;
    if (grid == 0) {
        if (n_in != 32 || out_size != M * D || ws_size < WS_END) { fprintf(stderr, "kernel_launch: unexpected shapes (n_in %d out %d ws %zu, need %zu)\n", n_in, out_size, ws_size, (size_t)WS_END); grid = -1; return; }
        int dev = 0, cus = 0, per_cu = 0;
        (void)hipGetDevice(&dev); (void)hipDeviceGetAttribute(&cus, hipDeviceAttributeMultiprocessorCount, dev);
        if (hipFuncSetAttribute((const void*)mk_fwd, hipFuncAttributeMaxDynamicSharedMemorySize, LDS_BYTES) != hipSuccess) { fprintf(stderr, "kernel_launch: hipFuncSetAttribute failed\n"); grid = -1; return; }
        (void)hipOccupancyMaxActiveBlocksPerMultiprocessor(&per_cu, (const void*)mk_fwd, 512, LDS_BYTES);
        if (per_cu < 1) per_cu = 1;
        grid = cus * 1;
        (void)hipGetLastError();
    }
    if (grid < 0) return;
    if (hipMemsetAsync((char*)d_ws + WS_CTL, 0, CTL_BYTES, stream) != hipSuccess) { fprintf(stderr, "kernel_launch: memset failed\n"); return; }
    Args a{};
    for (int i = 0; i < 32; ++i) a.in[i] = (const float*)d_in[i];
    a.out = (float*)d_out; a.ws = (unsigned char*)d_ws;
#if MK_ONE_LAUNCH
    a.ph_lo = 0; a.ph_hi = NPH;
    void* args[] = {&a};
    hipError_t e = hipLaunchCooperativeKernel((const void*)mk_fwd, dim3(grid), dim3(512), args, LDS_BYTES, stream);
    if (e != hipSuccess) fprintf(stderr, "cooperative launch failed: %s (grid %d)\n", hipGetErrorString(e), grid);
#else
    for (int p = 0; p < NPH; ++p) { if (!phase_active(p)) continue; a.ph_lo = p; a.ph_hi = p + 1; hipLaunchKernelGGL(mk_fwd, dim3(grid), dim3(512), LDS_BYTES, stream, a); }
#endif
}
```

```cpp
#include <hip/hip_runtime.h>
#include <hip/hip_cooperative_groups.h>
#include <cstdio>
#include <cstdint>
#include <cmath>
namespace cg = cooperative_groups;
#ifndef MK_PROBE
#define MK_PROBE 0
#endif
#ifndef MK_PROBE_SEL
#define MK_PROBE_SEL 0
#endif
#ifndef MK_PROBE_MODE
#define MK_PROBE_MODE 1
#endif
namespace pg8 {
#define PG8_LAS __attribute__((address_space(3)))
typedef unsigned short bf16_t;
typedef short bf16x8 __attribute__((ext_vector_type(8)));
typedef float f32x4 __attribute__((ext_vector_type(4)));
typedef float f32x2 __attribute__((ext_vector_type(2)));
typedef unsigned u32x4 __attribute__((ext_vector_type(4)));
typedef unsigned u32x2 __attribute__((ext_vector_type(2)));
constexpr int BM = 256, BK = 64, HALF = 128, HTB = HALF * BK * 2  , STAGE_BYTES = 8 * HTB, NXCD = 8, WGM = 8;

__host__ __device__ __forceinline__ int lds_byte(int r, int c) { const int st = (r >> 4) * 2 + (c >> 5), rr = r & 15, cc = c & 31, ob = rr * 64 + cc * 2; return st * 1024 + (ob ^ (((ob >> 9) & 1) << 5)); }
__host__ __device__ __forceinline__ void stage_rc(int b, int& R, int& C) { const int st = b / 1024, sb = b % 1024, swz = sb ^ (((sb >> 9) & 1) << 5); R = (st >> 1) * 16 + swz / 64; C = (st & 1) * 32 + (swz % 64) / 2; }
__host__ __device__ __forceinline__ int perm32(int rho) { const int n = rho >> 4, i = rho & 15; return 8 * (i >> 2) + 4 * n + (i & 3); }

struct Unit { int pm, pn; };
struct Gemm { const bf16_t* A; const bf16_t* Bt; int M, N, K, lda; };

struct StaticOrder {
    int nM, nN, nwg, G, c;
    __host__ __device__ void init(int nM_, int N, int G_, int c_) { nM = nM_; nN = N / BM; nwg = nM * nN; G = G_; c = c_; }
    __host__ __device__ bool next(int i, Unit& u) const {
        const long L = (long)i * G + c; if (L >= nwg) return false;
        int wgid = (int)L; { const int q = nwg / NXCD, r = nwg % NXCD, xcd = wgid % NXCD, off = wgid / NXCD; wgid = (xcd < r ? xcd * (q + 1) : r * (q + 1) + (xcd - r) * q) + off; }
        const int nig = WGM * nN, gid = wgid / nig, fm = gid * WGM, gsz = (nM - fm) < WGM ? (nM - fm) : WGM;
        u.pm = fm + ((wgid % nig) % gsz); u.pn = (wgid % nig) / gsz; return true;
    }
};

__device__ __forceinline__ unsigned cvt_pk_bf16(float lo, float hi) { unsigned r; asm volatile("v_cvt_pk_bf16_f32 %0, %1, %2" : "=v"(r) : "v"(lo), "v"(hi)); return r; }
__device__ __forceinline__ f32x2 gelu_pk(f32x2 v) {
    const f32x2 av = __builtin_elementwise_abs(v), d = av * 0.2316418882f + 1.0f;
    f32x2 t; t.x = __builtin_amdgcn_rcpf(d.x); t.y = __builtin_amdgcn_rcpf(d.y);
    f32x2 q = t * 0.5307027145f + (-0.7265760135f); q = q * t + 0.7107068705f; q = q * t + (-0.142248368f); q = q * t + 0.127414796f; q = q * t;
    const f32x2 s = (v * v) * (-0.72134752044f);
    f32x2 e; e.x = __builtin_amdgcn_exp2f(s.x); e.y = __builtin_amdgcn_exp2f(s.y);
    const f32x2 m = v * (q * e), r = v - m;
    f32x2 o; o.x = v.x < 0.f ? m.x : r.x; o.y = v.y < 0.f ? m.y : r.y; return o;
}

template <class Epi, class Sched, int AMAP, bool KDBL, bool ALIGN_EPI>
__device__ __forceinline__ void gemm_phase(PG8_LAS unsigned char* lds, const int tid, const Gemm g, const Sched& S, const Epi& E) {
    const int wid = __builtin_amdgcn_readfirstlane(tid >> 6), lane = tid & 63, wr = wid >> 2, wc = wid & 3, fr = lane & 15, fq = lane >> 4;
    const int K = g.K, nt = K / BK, lda = g.lda;
    unsigned voffA[2], voffB[2];
#pragma unroll
    for (int i = 0; i < 2; ++i) { int R, C; stage_rc(tid * 16 + i * 8192, R, C); const int Rb = Epi::PERM ? ((R & ~31) + perm32(R & 31)) : R;
        const int Ra = (AMAP == 2) ? (R - 2 * (R >> 6)) : R;
        voffA[i] = (unsigned)(Ra * lda + C) * 2u; voffB[i] = (unsigned)(Rb * K + C) * 2u; }
    const size_t kstep = (size_t)(BK * 2);
    const size_t hstepA = (size_t)((AMAP == 2) ? 124 : HALF) * lda * 2;
    const size_t hstepB = (size_t)HALF * K * 2;
    const size_t tstepB = 2 * hstepB;
    const size_t rowA = (size_t)lda * 2;
    const unsigned ldsw = (unsigned)wid * 1024u;
    const int aoff = lds_byte(wr * 64 + fr, fq * 8), boff = lds_byte(wc * 32 + fr, fq * 8);
#define PG8_ABASE(pm) ((const char*)g.A + (AMAP == 1 ? (size_t)(((pm) >> 4) * 4104 + 8 + ((pm) & 15) * 256) * rowA : (AMAP == 2 ? (size_t)(pm) * 248 * rowA : (size_t)(pm) * 256 * rowA)))
#define PG8_KA(base, t) (KDBL ? ((base) + (size_t)((t) & 15) * kstep - (size_t)((t) >> 4) * rowA) : ((base) + (size_t)(t) * kstep))
#define PG8_SA(b, h) (((b) * 2 + (h)) * HTB)
#define PG8_SB(b, h) ((4 + (b) * 2 + (h)) * HTB)
#define PG8_STAGE(bufoff, gbase, voff) do { _Pragma("unroll") for (int _i = 0; _i < 2; ++_i) \
        __builtin_amdgcn_global_load_lds((const unsigned*)((const char*)(gbase) + (voff)[_i]), (PG8_LAS unsigned*)(lds + (bufoff) + ldsw + _i * 8192), 16, 0, 0); } while (0)
#define PG8_LDA(dst, b, h) do { _Pragma("unroll") for (int m = 0; m < 4; ++m) _Pragma("unroll") for (int k = 0; k < 2; ++k) dst[m][k] = *(const PG8_LAS bf16x8*)(lds + PG8_SA(b, h) + aoff + m * 2048 + k * 1024); } while (0)
#define PG8_LDB(dst, b, h) do { _Pragma("unroll") for (int n = 0; n < 2; ++n) _Pragma("unroll") for (int k = 0; k < 2; ++k) dst[n][k] = *(const PG8_LAS bf16x8*)(lds + PG8_SB(b, h) + boff + n * 2048 + k * 1024); } while (0)
#define PG8_MMA(ai, bj, At, Bt) do { __builtin_amdgcn_s_setprio(1); _Pragma("unroll") for (int m = 0; m < 4; ++m) _Pragma("unroll") for (int n = 0; n < 2; ++n) _Pragma("unroll") for (int k = 0; k < 2; ++k) \
        acc[ai][bj][m][n] = __builtin_amdgcn_mfma_f32_16x16x32_bf16(Bt[n][k], At[m][k], acc[ai][bj][m][n], 0, 0, 0); __builtin_amdgcn_s_setprio(0); } while (0)
#define PG8_WAIT_V(n) asm volatile("s_waitcnt vmcnt(" #n ")" ::: "memory")
#define PG8_WAIT_L(n) asm volatile("s_waitcnt lgkmcnt(" #n ")" ::: "memory")
#define PG8_BAR __builtin_amdgcn_s_barrier()
#define PG8_SCHED __builtin_amdgcn_sched_barrier(0)
    Unit cur, nxt; int ui = 0;
    if (!S.next(0, cur)) return;
    f32x4 acc[2][2][4][2];
#pragma unroll
    for (int a = 0; a < 2; ++a)
#pragma unroll
        for (int b = 0; b < 2; ++b)
#pragma unroll
            for (int m = 0; m < 4; ++m)
#pragma unroll
                for (int n = 0; n < 2; ++n) acc[a][b][m][n] = (f32x4){0.f, 0.f, 0.f, 0.f};
    bf16x8 At[4][2], B0[2][2], B1[2][2];
    const char* cA = PG8_ABASE(cur.pm); const char* cB = (const char*)g.Bt + (size_t)cur.pn * tstepB;
    {
        const char* cA1 = PG8_KA(cA, 1);
        PG8_STAGE(PG8_SB(0, 0), cB, voffB); PG8_STAGE(PG8_SB(0, 1), cB + hstepB, voffB); PG8_STAGE(PG8_SA(0, 0), cA, voffA); PG8_STAGE(PG8_SA(0, 1), cA + hstepA, voffA);
        if (wr == 1) PG8_BAR;
        PG8_WAIT_V(2); PG8_BAR;
        PG8_STAGE(PG8_SB(1, 0), cB + kstep, voffB); PG8_STAGE(PG8_SA(1, 0), cA1, voffA); PG8_STAGE(PG8_SB(1, 1), cB + hstepB + kstep, voffB);
        PG8_WAIT_V(6); PG8_BAR;
    }
    for (;;) {
        const bool has_next = S.next(ui + 1, nxt);
        const char* nA = has_next ? PG8_ABASE(nxt.pm) : cA; const char* nB = has_next ? (const char*)g.Bt + (size_t)nxt.pn * tstepB : cB;
        for (int t = 0; t < nt; t += 2) {
            const bool last = (t == nt - 2);
            const char* a1 = PG8_KA(cA, t + 1);
            const char* a2 = last ? nA : PG8_KA(cA, t + 2); const char* b2 = last ? nB : cB + (size_t)(t + 2) * kstep;
            const char* a3 = last ? PG8_KA(nA, 1) : PG8_KA(cA, t + 3); const char* b3 = b2 + kstep;
            PG8_LDB(B0, 0, 0); PG8_LDB(B1, 0, 1); PG8_SCHED; PG8_LDA(At, 0, 0); PG8_STAGE(PG8_SA(1, 1), a1 + hstepA, voffA);
            PG8_WAIT_V(8); PG8_WAIT_L(0); PG8_BAR; PG8_MMA(0, 0, At, B0); PG8_MMA(0, 1, At, B1); PG8_BAR; PG8_SCHED;
            PG8_LDA(At, 0, 1); PG8_STAGE(PG8_SB(0, 0), b2, voffB); PG8_STAGE(PG8_SB(0, 1), b2 + hstepB, voffB); PG8_STAGE(PG8_SA(0, 0), a2, voffA);
            PG8_WAIT_V(8); PG8_WAIT_L(0); PG8_BAR; PG8_MMA(1, 0, At, B0); PG8_MMA(1, 1, At, B1); PG8_BAR; PG8_SCHED;
            PG8_LDB(B0, 1, 0); PG8_LDB(B1, 1, 1); PG8_SCHED; PG8_LDA(At, 1, 0); PG8_STAGE(PG8_SA(0, 1), a2 + hstepA, voffA);
            PG8_WAIT_V(8); PG8_WAIT_L(0); PG8_BAR; PG8_MMA(0, 0, At, B0); PG8_MMA(0, 1, At, B1); PG8_BAR; PG8_SCHED;
            PG8_LDA(At, 1, 1); PG8_STAGE(PG8_SB(1, 0), b3, voffB); PG8_STAGE(PG8_SB(1, 1), b3 + hstepB, voffB); PG8_STAGE(PG8_SA(1, 0), a3, voffA);
            PG8_WAIT_V(8); PG8_WAIT_L(0); PG8_BAR; PG8_MMA(1, 0, At, B0); PG8_MMA(1, 1, At, B1); PG8_BAR; PG8_SCHED;
        }
        if constexpr (ALIGN_EPI) { if (wr == 0) PG8_BAR; }
        E(acc, cur, wr, wc, fr, fq);
        if (!has_next) break;
#pragma unroll
        for (int a = 0; a < 2; ++a)
#pragma unroll
            for (int b = 0; b < 2; ++b)
#pragma unroll
                for (int m = 0; m < 4; ++m)
#pragma unroll
                    for (int n = 0; n < 2; ++n) acc[a][b][m][n] = (f32x4){0.f, 0.f, 0.f, 0.f};
        cur = nxt; cA = nA; cB = nB; ++ui;
        if constexpr (ALIGN_EPI) { if (wr == 1) PG8_BAR; }
    }
    PG8_WAIT_V(0);
    if constexpr (!ALIGN_EPI) { if (wr == 0) PG8_BAR; }
    PG8_BAR;
#undef PG8_ABASE
#undef PG8_KA
#undef PG8_SA
#undef PG8_SB
#undef PG8_STAGE
#undef PG8_LDA
#undef PG8_LDB
#undef PG8_MMA
#undef PG8_WAIT_V
#undef PG8_WAIT_L
#undef PG8_BAR
#undef PG8_SCHED
}
}
using pg8::bf16_t; using pg8::f32x4; using pg8::f32x2; using pg8::u32x4; using pg8::u32x2; using pg8::Unit; using pg8::cvt_pk_bf16;
#define LAS __attribute__((address_space(3)))
constexpr int BATCH = 8, SEQ = 4096, D = 1024, M = BATCH * SEQ, FF = 2816, FF2 = 5632;
constexpr int PADR = 8, SEQP = SEQ + PADR;
constexpr float RMS_EPS = 1e-6f, GN_EPS = 64e-5f;
constexpr size_t MiB = 1u << 20;
constexpr size_t WS_CTL = 0, CTL_BYTES = 2048 * 1024, WS_XS = 1 * MiB;
constexpr size_t WS_WSTAT = 2 * MiB;
constexpr size_t WJ_IN = 0, WJ_OUT = 4 * MiB, WJ_RKV = 6 * MiB, WJ_L2WA = 20 * MiB, WJ_L2G = 20 * MiB + 512 * 1024, WJ_O = 21 * MiB, WJ_STRIDE = 23 * MiB;
constexpr size_t WS_WFFN = 48 * MiB;
constexpr size_t WS_WDOWN = WS_WFFN + 11 * MiB;
constexpr size_t WS_A = 67 * MiB;
constexpr size_t WS_P = 134 * MiB;
constexpr size_t P_R = WS_P, P_K = WS_P + 64 * MiB, P_V = WS_P + 128 * MiB, P_LW = WS_P + 192 * MiB, P_LA = WS_P + 256 * MiB, P_WA = WS_P + 320 * MiB, P_GL = WS_P + 328 * MiB;
constexpr size_t P_U = WS_P, P_SV = WS_P + 64 * MiB;
constexpr size_t P_Z = WS_P, P_ACT = WS_P + 176 * MiB;
constexpr size_t WS_PA = WS_P + 352 * MiB, WS_PB = WS_PA + 2 * MiB, WS_PV = WS_PB + 2 * MiB;
constexpr size_t WS_END = WS_PV + 2 * MiB;

struct Args {
    const float* in[32]; float* out; unsigned char* ws; int ph_lo, ph_hi;
};
enum { I_X = 0, I_NMIX, I_NFFN, I_NFIN, I_SWIN, I_SBIN, I_SGV, I_SWS, I_SBS, I_SWOUT, I_MU, I_WR, I_WK, I_WV, I_WO, I_W0, I_W1, I_W2, I_A0, I_A1, I_A2, I_G1, I_G2, I_KK, I_KA, I_RK, I_LNW, I_LNB, I_FUP, I_FCW, I_FCB, I_FDN };

__device__ __forceinline__ float bf2f(unsigned short b) { return __uint_as_float((unsigned)b << 16); }
__device__ __forceinline__ float bflo(unsigned w) { return __uint_as_float(w << 16); }
__device__ __forceinline__ float bfhi(unsigned w) { return __uint_as_float(w & 0xffff0000u); }
__device__ __forceinline__ float wave_sum(float v) {
#pragma unroll
    for (int o = 1; o < 64; o <<= 1) v += __shfl_xor(v, o);
    return v;
}
__device__ __forceinline__ float row_rstd(const float* P, int row) { const f32x4* p = (const f32x4*)(P + (size_t)row * 16); const f32x4 a = p[0], b = p[1], c = p[2], d = p[3];
    const float s = ((a.x + a.y) + (a.z + a.w)) + ((b.x + b.y) + (b.z + b.w)) + ((c.x + c.y) + (c.z + c.w)) + ((d.x + d.y) + (d.z + d.w)); return rsqrtf(s * (1.f / D) + RMS_EPS); }
__device__ __forceinline__ void row_rstd4(const float* P, int row0, int rstride, int lo, int hi, float (&rs)[4]) {
    f32x4 p[4][4];
#pragma unroll
    for (int m = 0; m < 4; ++m) { int r = row0 + m * rstride; r = r < lo ? lo : (r > hi ? hi : r); const f32x4* q = (const f32x4*)(P + (size_t)r * 16);
#pragma unroll
        for (int k = 0; k < 4; ++k) p[m][k] = q[k]; }
#pragma unroll
    for (int m = 0; m < 4; ++m) { const f32x4 a = p[m][0], b = p[m][1], c = p[m][2], d = p[m][3];
        const float s = ((a.x + a.y) + (a.z + a.w)) + ((b.x + b.y) + (b.z + b.w)) + ((c.x + c.y) + (c.z + c.w)) + ((d.x + d.y) + (d.z + d.w)); rs[m] = rsqrtf(s * (1.f / D) + RMS_EPS); }
}
template <int CTRL> __device__ __forceinline__ float dpp_f(float v) { return __int_as_float(__builtin_amdgcn_mov_dpp(__float_as_int(v), CTRL, 0xf, 0xf, true)); }
__device__ __forceinline__ float sum8(float v) { v += dpp_f<0x141>(v); v += dpp_f<0xB1>(v); v += dpp_f<0x4E>(v); return v; }
__device__ __forceinline__ float sigmoidf_(float x) { return 1.f / (1.f + __expf(-x)); }

template <bool SCALE> struct EpiStore {
    static constexpr bool PERM = true;
    bf16_t* O; int ldc; int tsh; size_t split_stride; const float* ss;
    __device__ __forceinline__ void operator()(const f32x4 (&acc)[2][2][4][2], const Unit& u, int wr, int wc, int fr, int fq) const {
        bf16_t* base = O + (size_t)(u.pn >> tsh) * split_stride + (size_t)(u.pm * 256 + wr * 64 + fr) * ldc + (u.pn & ((1 << tsh) - 1)) * 256 + wc * 32 + 8 * fq;
        const int row0 = u.pm * 256 + wr * 64 + fr;
#pragma unroll
        for (int ai = 0; ai < 2; ++ai)
#pragma unroll
            for (int m = 0; m < 4; ++m) {
                const float rs = SCALE ? row_rstd(ss, row0 + ai * 128 + m * 16) : 1.f;
                bf16_t* rowp = base + (size_t)(ai * 128 + m * 16) * ldc;
#pragma unroll
                for (int bj = 0; bj < 2; ++bj) { const f32x4 v0 = acc[ai][bj][m][0] * rs, v1 = acc[ai][bj][m][1] * rs;
                    u32x4 w; w.x = cvt_pk_bf16(v0[0], v0[1]); w.y = cvt_pk_bf16(v0[2], v0[3]); w.z = cvt_pk_bf16(v1[0], v1[1]); w.w = cvt_pk_bf16(v1[2], v1[3]);
                    *(u32x4*)(rowp + bj * 128) = w; } }
    }
};
struct EpiSguIn {
    static constexpr bool PERM = true;
    bf16_t* U; bf16_t* V; const float* ss; const float* bias; float* ssv;
    __device__ __forceinline__ void operator()(const f32x4 (&acc)[2][2][4][2], const Unit& u, int wr, int wc, int fr, int fq) const {
        const bool isv = u.pn >= 4; bf16_t* base = isv ? V : U; const int colt = (u.pn & 3) * 256 + wc * 32 + 8 * fq, bcol = u.pn * 256 + wc * 32 + 8 * fq;
        f32x4 bv[2][2];
#pragma unroll
        for (int bj = 0; bj < 2; ++bj)
#pragma unroll
            for (int n = 0; n < 2; ++n) bv[bj][n] = *(const f32x4*)(bias + bcol + bj * 128 + 4 * n);
#pragma unroll
        for (int ai = 0; ai < 2; ++ai) {
            float rs4[4]; row_rstd4(ss, u.pm * 256 + ai * 128 + wr * 64 + fr, 16, 0, M - 1, rs4);
#pragma unroll
            for (int m = 0; m < 4; ++m) { const int row = u.pm * 256 + ai * 128 + wr * 64 + m * 16 + fr;
                const float rs = rs4[m]; float s = 0.f;
                bf16_t* rowp = base + (size_t)row * D + colt;
#pragma unroll
                for (int bj = 0; bj < 2; ++bj) { f32x4 v0 = acc[ai][bj][m][0] * rs + bv[bj][0], v1 = acc[ai][bj][m][1] * rs + bv[bj][1];
                    const f32x2 a = pg8::gelu_pk((f32x2){v0[0], v0[1]}), b = pg8::gelu_pk((f32x2){v0[2], v0[3]}), c = pg8::gelu_pk((f32x2){v1[0], v1[1]}), d = pg8::gelu_pk((f32x2){v1[2], v1[3]});
                    s += (a.x * a.x + a.y * a.y) + (b.x * b.x + b.y * b.y) + (c.x * c.x + c.y * c.y) + (d.x * d.x + d.y * d.y);
                    u32x4 w; w.x = cvt_pk_bf16(a.x, a.y); w.y = cvt_pk_bf16(b.x, b.y); w.z = cvt_pk_bf16(c.x, c.y); w.w = cvt_pk_bf16(d.x, d.y);
                    *(u32x4*)(rowp + bj * 128) = w; }
                if (isv) { s += __shfl_xor(s, 16); s += __shfl_xor(s, 32); if (fq == 0) ssv[(size_t)row * 16 + (u.pn - 4) * 4 + wc] = s; } } }
    }
};
struct EpiResid {
    static constexpr bool PERM = true;
    const float* hin; float* h; bf16_t* hb; float* ssn;
    __device__ __forceinline__ void operator()(const f32x4 (&acc)[2][2][4][2], const Unit& u, int wr, int wc, int fr, int fq) const {
        const int colt = u.pn * 256 + wc * 32 + 8 * fq;
#pragma unroll
        for (int ai = 0; ai < 2; ++ai) {
            const int rowb = u.pm * 256 + ai * 128 + wr * 64 + fr;
            f32x4 pre[4][2][2];
#pragma unroll
            for (int m = 0; m < 4; ++m)
#pragma unroll
                for (int bj = 0; bj < 2; ++bj) { const float* hp = hin + (size_t)(rowb + m * 16) * D + colt + bj * 128; pre[m][bj][0] = *(const f32x4*)hp; pre[m][bj][1] = *(const f32x4*)(hp + 4); }
#pragma unroll
            for (int m = 0; m < 4; ++m) { const int row = rowb + m * 16; float s = 0.f;
                float* hp = h + (size_t)row * D + colt; bf16_t* bp = hb + (size_t)row * D + colt;
#pragma unroll
                for (int bj = 0; bj < 2; ++bj) { const f32x4 v0 = pre[m][bj][0] + acc[ai][bj][m][0], v1 = pre[m][bj][1] + acc[ai][bj][m][1];
                    *(f32x4*)(hp + bj * 128) = v0; *(f32x4*)(hp + bj * 128 + 4) = v1;
                    s += (v0[0] * v0[0] + v0[1] * v0[1]) + (v0[2] * v0[2] + v0[3] * v0[3]) + (v1[0] * v1[0] + v1[1] * v1[1]) + (v1[2] * v1[2] + v1[3] * v1[3]);
                    if (hb) { u32x4 w; w.x = cvt_pk_bf16(v0[0], v0[1]); w.y = cvt_pk_bf16(v0[2], v0[3]); w.z = cvt_pk_bf16(v1[0], v1[1]); w.w = cvt_pk_bf16(v1[2], v1[3]);
                    *(u32x4*)(bp + bj * 128) = w; } }
                s += __shfl_xor(s, 16); s += __shfl_xor(s, 32); if (fq == 0) ssn[(size_t)row * 16 + u.pn * 4 + wc] = s; }
            asm volatile("" ::: "memory");
        }
    }
};
template <int CTRL> __device__ __forceinline__ f32x4 dpp4(f32x4 v) { f32x4 r; r.x = dpp_f<CTRL>(v.x); r.y = dpp_f<CTRL>(v.y); r.z = dpp_f<CTRL>(v.z); r.w = dpp_f<CTRL>(v.w); return r; }
struct EpiFfnUp {
    static constexpr bool PERM = true;
    bf16_t* ACT; const float* ss; const float* cw; const float* cb;
    __device__ __forceinline__ void conv4(f32x4& z0, f32x4& z1, f32x4& z2, f32x4& z3, const float (&rs)[4], const int (&tt)[4], const float* wcol, const float* bcol, int fr) const {
        const f32x4 w0 = *(const f32x4*)wcol, w1 = *(const f32x4*)(wcol + FF2), w2 = *(const f32x4*)(wcol + 2 * FF2), bb = *(const f32x4*)bcol;
#pragma unroll
        for (int e = 0; e < 4; e += 2) {
            const f32x2 w0p = {w0[e], w0[e + 1]}, w1p = {w1[e], w1[e + 1]}, w2p = {w2[e], w2[e + 1]}, bp = {bb[e], bb[e + 1]};
            f32x2 cur = (f32x2){z3[e], z3[e + 1]} * rs[3];
            f32x2 c1 = {dpp_f<0x121>(cur.x), dpp_f<0x121>(cur.y)}, c2 = {dpp_f<0x122>(cur.x), dpp_f<0x122>(cur.y)};
#define CONV_STEP(ZM, ZP, MI, HASP) { f32x2 prv = cur, p1 = c1, p2 = c2; if (HASP) { prv = (f32x2){ZP[e], ZP[e + 1]} * rs[MI - (HASP)]; p1 = (f32x2){dpp_f<0x121>(prv.x), dpp_f<0x121>(prv.y)}; p2 = (f32x2){dpp_f<0x122>(prv.x), dpp_f<0x122>(prv.y)}; } \
            f32x2 y1 = (fr == 0) ? p1 : c1, y2 = (fr < 2) ? p2 : c2; if (tt[MI] < 1) y1 = (f32x2){0.f, 0.f}; if (tt[MI] < 2) y2 = (f32x2){0.f, 0.f}; \
            const f32x2 o = w0p * y2 + (w1p * y1 + (w2p * cur + bp)); ZM[e] = o.x; ZM[e + 1] = o.y; cur = prv; c1 = p1; c2 = p2; }
            CONV_STEP(z3, z2, 3, 1) CONV_STEP(z2, z1, 2, 1) CONV_STEP(z1, z0, 1, 1) CONV_STEP(z0, z0, 0, 0)
#undef CONV_STEP
            asm volatile("" : "+v"(z0[e]), "+v"(z1[e]), "+v"(z2[e]), "+v"(z3[e]), "+v"(z0[e + 1]), "+v"(z1[e + 1]), "+v"(z2[e + 1]), "+v"(z3[e + 1]));
        }
    }
    __device__ __forceinline__ void operator()(f32x4 (&acc)[2][2][4][2], const Unit& u, int wr, int wc, int fr, int fq) const {
        const int f0 = u.pn * 128 + wc * 32 + 8 * fq;
#pragma unroll
        for (int ai = 0; ai < 2; ++ai) {
            const int gbase = u.pm * 248 - 2 + 62 * (2 * ai + wr) + fr;
            float rs[4]; int tt[4];
            row_rstd4(ss, gbase, 16, 0, M - 1, rs);
            asm volatile("" : "+v"(rs[0]), "+v"(rs[1]), "+v"(rs[2]), "+v"(rs[3]) :: "memory");
            { const int g0 = u.pm * 248 - 2 + 62 * (2 * ai + wr);
              const bool seqstart = ((g0 + 63) & (SEQ - 1)) < 65 || g0 < 0;
#pragma unroll
              for (int m = 0; m < 4; ++m) tt[m] = seqstart ? ((gbase + 16 * m) & (SEQ - 1)) : 2; }
#pragma unroll
            for (int n = 0; n < 2; ++n) {
                conv4(acc[ai][0][0][n], acc[ai][0][1][n], acc[ai][0][2][n], acc[ai][0][3][n], rs, tt, cw + f0 + 4 * n, cb + f0 + 4 * n, fr);
                asm volatile("" ::: "memory");
                conv4(acc[ai][1][0][n], acc[ai][1][1][n], acc[ai][1][2][n], acc[ai][1][3][n], rs, tt, cw + FF + f0 + 4 * n, cb + FF + f0 + 4 * n, fr);
                asm volatile("" ::: "memory");
#pragma unroll
                for (int m = 0; m < 4; ++m) { const int g = gbase + 16 * m;
                    if ((m > 0 || fr >= 2) && g < M) { const f32x4 gt = acc[ai][0][m][n], vl = acc[ai][1][m][n]; f32x4 o;
#pragma unroll
                        for (int e = 0; e < 4; ++e) o[e] = gt[e] * sigmoidf_(gt[e]) * vl[e];
                        u32x2 w; w.x = cvt_pk_bf16(o[0], o[1]); w.y = cvt_pk_bf16(o[2], o[3]);
                        *(u32x2*)(ACT + (size_t)g * FF + f0 + 4 * n) = w; } }
            }
        }
    }
};
struct EpiRkv {
    static constexpr bool PERM = true;
    bf16_t* R; bf16_t* WA; bf16_t* GL;
    __device__ __forceinline__ void operator()(const f32x4 (&acc)[2][2][4][2], const Unit& u, int wr, int wc, int fr, int fq) const {
        const int mode = u.pn < 12 ? 0 : (u.pn == 12 ? 1 : 2);
        bf16_t* base; int ldc, colt;
        if (mode == 0) { base = R + (size_t)(u.pn >> 2) * ((size_t)M * D); ldc = D; colt = (u.pn & 3) * 256 + wc * 32 + 8 * fq; }
        else if (mode == 1) { base = WA; ldc = 128; colt = wc * 32 + 8 * fq; }
        else { base = GL; ldc = 256; colt = wc * 32 + 8 * fq; }
#pragma unroll
        for (int ai = 0; ai < 2; ++ai)
#pragma unroll
            for (int m = 0; m < 4; ++m) { const int row = u.pm * 256 + ai * 128 + wr * 64 + m * 16 + fr;
                bf16_t* rowp = base + (size_t)row * ldc + colt;
#pragma unroll
                for (int bj = 0; bj < 2; ++bj) { f32x4 v0 = acc[ai][bj][m][0], v1 = acc[ai][bj][m][1];
                    if (mode == 1) { if (bj == 1) continue;
                        if (wc < 2) {
#pragma unroll
                            for (int e = 0; e < 4; ++e) { v0[e] = tanhf(v0[e]); v1[e] = tanhf(v1[e]); } } }
                    else if (mode == 2) {
#pragma unroll
                        for (int e = 0; e < 4; ++e) { v0[e] = sigmoidf_(v0[e]); v1[e] = sigmoidf_(v1[e]); } }
                    u32x4 w; w.x = cvt_pk_bf16(v0[0], v0[1]); w.y = cvt_pk_bf16(v0[2], v0[3]); w.z = cvt_pk_bf16(v1[0], v1[1]); w.w = cvt_pk_bf16(v1[2], v1[3]);
                    *(u32x4*)(rowp + bj * 128) = w; } }
    }
};

typedef const __attribute__((address_space(4))) Args* CA;
struct Ctx { LAS unsigned char* lds; int tid, lane, wave, G, bid; };

__device__ __forceinline__ void conv_mat(const Ctx& c, const float* src, int ldsrc, int K, int N, int Kp, int Np, bf16_t* dst, int ldd, int n_off, int k_off, const float* sc, int mode, int rot) {
    LAS float* tile = (LAS float*)c.lds;
    const int nnb = Np / 64, nit = (Kp / 64) * nnb; const int start = (c.bid + c.G - (rot % c.G)) % c.G;
    for (int it = start; it < nit; it += c.G) {
        const int kb = it / nnb, nb = it % nnb, k0 = kb * 64, n0 = nb * 64;
#pragma unroll
        for (int j = 0; j < 2; ++j) { const int kk = (c.tid >> 4) + 32 * j, nn = (c.tid & 15) * 4, k = k0 + kk, n = n0 + nn; f32x4 v = (f32x4){0.f, 0.f, 0.f, 0.f};
            if (src && k < K && n < N) { v = *(const f32x4*)(src + (size_t)k * ldsrc + n); if (mode == 1) v = v * sc[k]; else if (mode == 2) v = v * (1.f - sc[k]); }
            tile[nn * 65 + kk] = v.x; tile[(nn + 1) * 65 + kk] = v.y; tile[(nn + 2) * 65 + kk] = v.z; tile[(nn + 3) * 65 + kk] = v.w; }
        __syncthreads();
        { const int nn = c.tid >> 3, cc = c.tid & 7; const LAS float* s = tile + nn * 65 + 8 * cc;
            u32x4 o; o.x = cvt_pk_bf16(s[0], s[1]); o.y = cvt_pk_bf16(s[2], s[3]); o.z = cvt_pk_bf16(s[4], s[5]); o.w = cvt_pk_bf16(s[6], s[7]);
            *(u32x4*)(dst + (size_t)(n_off + n0 + nn) * ldd + k_off + k0 + 8 * cc) = o; }
        __syncthreads();
    }
}

__device__ __forceinline__ void phase_static_weights(const Ctx& c, CA a, int j);
__device__ __forceinline__ void phase_prologue(const Ctx& c, CA a) {
    float* ss = (float*)(a->ws + WS_PA);
    const int gw = c.bid * 8 + c.wave, NGW = c.G * 8;
    bf16_t* hb = (bf16_t*)(a->ws + WS_A);
    for (int m = gw; m < M; m += NGW) {
        const f32x4* xr = (const f32x4*)(a->in[I_X] + (size_t)m * D) + c.lane; u32x2* br = (u32x2*)(hb + (size_t)m * D) + c.lane;
        float s = 0.f;
#pragma unroll
        for (int j = 0; j < 4; ++j) { const f32x4 v = xr[64 * j]; s += (v.x * v.x + v.y * v.y) + (v.z * v.z + v.w * v.w); u32x2 w; w.x = cvt_pk_bf16(v.x, v.y); w.y = cvt_pk_bf16(v.z, v.w); br[64 * j] = w; }
        s = wave_sum(s); if (c.lane < 16) ss[(size_t)m * 16 + c.lane] = c.lane == 0 ? s : 0.f;
    }
    phase_static_weights(c, a, 0);
}
__device__ __forceinline__ void phase_static_weights(const Ctx& c, CA a, int j) {
    int rot = 0;
    {
        unsigned char* wj = a->ws + WS_WSTAT + (size_t)j * WJ_STRIDE;
        conv_mat(c, a->in[I_SWIN] + (size_t)j * D * 2048, 2048, D, 2048, D, 2048, (bf16_t*)(wj + WJ_IN), D, 0, 0, a->in[I_NMIX] + (size_t)(2 * j) * D, 1, rot); rot += 512;
        conv_mat(c, a->in[I_SWOUT] + (size_t)j * D * D, D, D, D, D, D, (bf16_t*)(wj + WJ_OUT), D, 0, 0, nullptr, 0, rot); rot += 256;
        const float* mu = a->in[I_MU] + (size_t)j * 6 * D; bf16_t* rkv = (bf16_t*)(wj + WJ_RKV);
#define CONV_BIG(IDX, Q, MUB) do { conv_mat(c, a->in[IDX] + (size_t)j * D * D, D, D, D, D, D, rkv, 2048, (Q) * 1024, 0, mu + (MUB) * D, 2, rot); rot += 256; \
            conv_mat(c, a->in[IDX] + (size_t)j * D * D, D, D, D, D, D, rkv, 2048, (Q) * 1024, 1024, mu + (MUB) * D, 1, rot); rot += 256; } while (0)
        CONV_BIG(I_WR, 0, 0); CONV_BIG(I_WK, 1, 2); CONV_BIG(I_WV, 2, 3);
#undef CONV_BIG
        conv_mat(c, a->in[I_W1] + (size_t)j * D * 64, 64, D, 64, D, 64, rkv, 2048, 3072, 0, mu + 1 * D, 2, rot); rot += 16;
        conv_mat(c, a->in[I_W1] + (size_t)j * D * 64, 64, D, 64, D, 64, rkv, 2048, 3072, 1024, mu + 1 * D, 1, rot); rot += 16;
        conv_mat(c, a->in[I_A1] + (size_t)j * D * 64, 64, D, 64, D, 64, rkv, 2048, 3136, 0, mu + 4 * D, 2, rot); rot += 16;
        conv_mat(c, a->in[I_A1] + (size_t)j * D * 64, 64, D, 64, D, 64, rkv, 2048, 3136, 1024, mu + 4 * D, 1, rot); rot += 16;
        conv_mat(c, nullptr, 0, 0, 0, 2048, 128, rkv, 2048, 3200, 0, nullptr, 0, rot); rot += 64;
        conv_mat(c, a->in[I_G1] + (size_t)j * D * 160, 160, D, 160, D, 256, rkv, 2048, 3328, 0, mu + 5 * D, 2, rot); rot += 64;
        conv_mat(c, a->in[I_G1] + (size_t)j * D * 160, 160, D, 160, D, 256, rkv, 2048, 3328, 1024, mu + 5 * D, 1, rot); rot += 64;
        bf16_t* l2wa = (bf16_t*)(wj + WJ_L2WA);
        conv_mat(c, a->in[I_W2] + (size_t)j * 64 * D, D, 64, D, 64, D, l2wa, 128, 0, 0, nullptr, 0, rot); rot += 16;
        conv_mat(c, nullptr, 0, 0, 0, 64, D, l2wa, 128, 0, 64, nullptr, 0, rot); rot += 16;
        conv_mat(c, nullptr, 0, 0, 0, 64, D, l2wa, 128, 1024, 0, nullptr, 0, rot); rot += 16;
        conv_mat(c, a->in[I_A2] + (size_t)j * 64 * D, D, 64, D, 64, D, l2wa, 128, 1024, 64, nullptr, 0, rot); rot += 16;
        conv_mat(c, a->in[I_G2] + (size_t)j * 160 * D, D, 160, D, 256, D, (bf16_t*)(wj + WJ_L2G), 256, 0, 0, nullptr, 0, rot); rot += 64;
        conv_mat(c, a->in[I_WO] + (size_t)j * D * D, D, D, D, D, D, (bf16_t*)(wj + WJ_O), D, 0, 0, nullptr, 0, rot); rot += 256;
    }
}
__device__ __forceinline__ void phase_ffn_weights(const Ctx& c, CA a, int layer) {
    for (int pn = 0; pn < FF / 128; ++pn) {
        conv_mat(c, a->in[I_FUP] + (size_t)layer * D * FF2 + pn * 128, FF2, D, 128, D, 128, (bf16_t*)(a->ws + WS_WFFN), D, pn * 256, 0, a->in[I_NFFN] + (size_t)layer * D, 1, pn * 64);
        conv_mat(c, a->in[I_FUP] + (size_t)layer * D * FF2 + FF + pn * 128, FF2, D, 128, D, 128, (bf16_t*)(a->ws + WS_WFFN), D, pn * 256 + 128, 0, a->in[I_NFFN] + (size_t)layer * D, 1, pn * 64 + 32);
    }
    conv_mat(c, a->in[I_FDN] + (size_t)layer * FF * D, D, FF, D, FF, D, (bf16_t*)(a->ws + WS_WDOWN), FF, 0, 0, nullptr, 0, 128);
}

__device__ __forceinline__ void phase_sgu_spatial(const Ctx& c, CA a, int j, int rp) {
    typedef short bf16x8 __attribute__((ext_vector_type(8)));
    bf16_t* U = (bf16_t*)(a->ws + P_U); const bf16_t* V = (const bf16_t*)(a->ws + P_SV); bf16_t* UO = rp ? (bf16_t*)(a->ws + P_SV) : U;
    const float* ssv = (const float*)(a->ws + WS_PV);
    LAS bf16_t* WL = (LAS bf16_t*)c.lds; LAS bf16_t* VT = WL + 128 * 136;
    const int g = c.bid & 15;
    const float* Ws = a->in[I_SWS] + ((size_t)j * 16 + g) * 128 * 128; const float* bs = a->in[I_SBS] + ((size_t)j * 16 + g) * 128; const float* gv = a->in[I_SGV] + (size_t)j * D + g * 64;
    __syncthreads();
    { const int t = c.tid >> 2, s0 = (c.tid & 3) * 32; const float* wp = Ws + (size_t)t * 128 + s0;
#pragma unroll
      for (int q = 0; q < 4; ++q) { f32x4 x0 = *(const f32x4*)(wp + 8 * q), x1 = *(const f32x4*)(wp + 8 * q + 4);
#pragma unroll
          for (int e = 0; e < 4; ++e) { if (s0 + 8 * q + e > t) x0[e] = 0.f; if (s0 + 8 * q + 4 + e > t) x1[e] = 0.f; }
          u32x4 w; w.x = cvt_pk_bf16(x0[0], x0[1]); w.y = cvt_pk_bf16(x0[2], x0[3]); w.z = cvt_pk_bf16(x1[0], x1[1]); w.w = cvt_pk_bf16(x1[2], x1[3]);
          *(LAS u32x4*)(WL + t * 136 + s0 + 8 * q) = w; } }
    const int w8 = c.wave, fr = c.lane & 15, fq = c.lane >> 4, t0 = 16 * w8, nk = (w8 >> 1) + 1;
    const int vs = c.tid >> 2, vc = (c.tid & 3) * 16;
    f32x4 gq[4];
#pragma unroll
    for (int e = 0; e < 4; ++e) gq[e] = *(const f32x4*)(gv + vc + 4 * e);
    const float bb = bs[t0 + fr];
    for (int ub = c.bid >> 4; ub < M / 128; ub += c.G >> 4) {
        const int m0 = ub * 128;
        { const bf16_t* vp = V + (size_t)(m0 + vs) * D + g * 64 + vc; const u32x4 v0 = *(const u32x4*)vp, v1 = *(const u32x4*)(vp + 8);
          const float rs = row_rstd(ssv, m0 + vs);
          const unsigned vw[8] = {v0.x, v0.y, v0.z, v0.w, v1.x, v1.y, v1.z, v1.w};
#pragma unroll
          for (int e = 0; e < 8; ++e) { const float lo = bflo(vw[e]) * rs * gq[e >> 1][(2 * e) & 3], hi = bfhi(vw[e]) * rs * gq[e >> 1][(2 * e + 1) & 3];
              const unsigned pk = cvt_pk_bf16(lo, hi);
              VT[(vc + 2 * e) * 136 + vs] = (bf16_t)(pk & 0xffffu); VT[(vc + 2 * e + 1) * 136 + vs] = (bf16_t)(pk >> 16); } }
        __syncthreads();
        f32x4 acc[4];
#pragma unroll
        for (int ct = 0; ct < 4; ++ct) acc[ct] = (f32x4){0.f, 0.f, 0.f, 0.f};
        for (int k = 0; k < nk; ++k) {
            const bf16x8 wf = *(const LAS bf16x8*)(WL + (t0 + fr) * 136 + 32 * k + 8 * fq);
#pragma unroll
            for (int ct = 0; ct < 4; ++ct) { const bf16x8 vf = *(const LAS bf16x8*)(VT + (16 * ct + fr) * 136 + 32 * k + 8 * fq);
                acc[ct] = __builtin_amdgcn_mfma_f32_16x16x32_bf16(vf, wf, acc[ct], 0, 0, 0); }
        }
        { const size_t ro = (size_t)(m0 + t0 + fr) * D + g * 64 + 4 * fq;
#pragma unroll
          for (int ct = 0; ct < 4; ++ct) { const u32x2 uu = *(const u32x2*)(U + ro + 16 * ct); const f32x4 o = acc[ct] + bb;
              u32x2 w; w.x = cvt_pk_bf16(bflo(uu.x) * o[0], bfhi(uu.x) * o[1]); w.y = cvt_pk_bf16(bflo(uu.y) * o[2], bfhi(uu.y) * o[3]);
              *(u32x2*)(UO + ro + 16 * ct) = w; } }
        __syncthreads();
    }
}

__device__ __forceinline__ void phase_ffn_conv(const Ctx& c, CA a, int layer, int half) {
    const bf16_t* Z = (const bf16_t*)(a->ws + P_Z); bf16_t* ACT = (bf16_t*)(a->ws + P_ACT) + (size_t)half * (M / 2) * FF;
    const float* cw = a->in[I_FCW] + (size_t)layer * 3 * FF2; const float* cb = a->in[I_FCB] + (size_t)layer * FF2;
    const int gt = c.bid * 512 + c.tid, NT = c.G * 512;
    for (int idx = gt; idx < (M / 2) * (FF / 8); idx += NT) {
        const int ml = idx / (FF / 8), f = (idx % (FF / 8)) * 8, t = ml & (SEQ - 1);
        float gsum[8], vsum[8];
#pragma unroll
        for (int e = 0; e < 8; ++e) { gsum[e] = cb[f + e]; vsum[e] = cb[FF + f + e]; }
#pragma unroll
        for (int jj = 0; jj < 3; ++jj) { const int dt = 2 - jj; if (t - dt < 0) continue;
            const u32x4 zg = *(const u32x4*)(Z + (size_t)(ml - dt) * FF2 + f), zv = *(const u32x4*)(Z + (size_t)(ml - dt) * FF2 + FF + f);
            const float* wg = cw + (size_t)jj * FF2 + f; const float* wv = wg + FF;
            const unsigned zgw[4] = {zg.x, zg.y, zg.z, zg.w}, zvw[4] = {zv.x, zv.y, zv.z, zv.w};
#pragma unroll
            for (int e = 0; e < 4; ++e) { gsum[2 * e] += wg[2 * e] * bflo(zgw[e]); gsum[2 * e + 1] += wg[2 * e + 1] * bfhi(zgw[e]); vsum[2 * e] += wv[2 * e] * bflo(zvw[e]); vsum[2 * e + 1] += wv[2 * e + 1] * bfhi(zvw[e]); } }
        float o[8];
#pragma unroll
        for (int e = 0; e < 8; ++e) o[e] = gsum[e] * sigmoidf_(gsum[e]) * vsum[e];
        u32x4 w; w.x = cvt_pk_bf16(o[0], o[1]); w.y = cvt_pk_bf16(o[2], o[3]); w.z = cvt_pk_bf16(o[4], o[5]); w.w = cvt_pk_bf16(o[6], o[7]);
        *(u32x4*)(ACT + (size_t)ml * FF + f) = w;
    }
}

__device__ __forceinline__ void phase_rwkv_prep(const Ctx& c, CA a, int layer) {
    const float* ss = (const float*)(a->ws + WS_PA); const float* g = a->in[I_NMIX] + (size_t)layer * D;
    bf16_t* hn = (bf16_t*)(a->ws + WS_A);
    const int gw = c.bid * 8 + c.wave, NGW = c.G * 8;
    f32x4 gg[4];
#pragma unroll
    for (int j = 0; j < 4; ++j) gg[j] = *((const f32x4*)g + c.lane + 64 * j);
    for (int m = gw; m < M; m += NGW) {
        const float rs = row_rstd(ss, m);
        const f32x4* hr = (const f32x4*)(a->out + (size_t)m * D) + c.lane; const int prow = (m >> 12) * SEQP + PADR + (m & (SEQ - 1));
        u32x2* br = (u32x2*)(hn + (size_t)prow * D) + c.lane;
#pragma unroll
        for (int j = 0; j < 4; ++j) { const f32x4 v = hr[64 * j] * rs * gg[j]; u32x2 w; w.x = cvt_pk_bf16(v.x, v.y); w.y = cvt_pk_bf16(v.z, v.w); br[64 * j] = w; }
    }
    for (int r = gw; r < BATCH * PADR; r += NGW) { const int prow = (r / PADR) * SEQP + (r % PADR); u32x2* br = (u32x2*)(hn + (size_t)prow * D) + c.lane;
#pragma unroll
        for (int j = 0; j < 4; ++j) br[64 * j] = (u32x2){0u, 0u}; }
}

__device__ __forceinline__ f32x4 bf4(u32x2 w) { return (f32x4){bflo(w.x), bfhi(w.x), bflo(w.y), bfhi(w.y)}; }
__device__ __forceinline__ float hsum4(f32x4 p) { return (p.x + p.y) + (p.z + p.w); }
__device__ __forceinline__ float sum16(float v) { v = sum8(v); v += dpp_f<0x140>(v); return v; }
__device__ __forceinline__ f32x4 bf4lo(u32x4 w) { return (f32x4){bflo(w.x), bfhi(w.x), bflo(w.y), bfhi(w.y)}; }
__device__ __forceinline__ f32x4 bf4hi(u32x4 w) { return (f32x4){bflo(w.z), bfhi(w.z), bflo(w.w), bfhi(w.w)}; }
__device__ __forceinline__ void phase_scan(const Ctx& c, CA a, int j, int rp_out) {
    constexpr int CH = 32, NCH = SEQ / CH, VSZ = CH * 64, YSZ = CH * 32;
    LAS float* BIG = (LAS float*)c.lds; LAS float* VB = BIG + 2 * 5 * VSZ; LAS float* YB = VB + 4 * VSZ; LAS float* BON = YB + 3 * YSZ;
    bf16_t* R = (bf16_t*)(a->ws + P_R); const bf16_t* Kb = (const bf16_t*)(a->ws + P_K); const bf16_t* Vb = (const bf16_t*)(a->ws + P_V);
    const bf16_t* LWb = (const bf16_t*)(a->ws + P_LW); const bf16_t* LAb = (const bf16_t*)(a->ws + P_LA); const bf16_t* Gb = (const bf16_t*)(a->ws + WS_A);
    if (c.G != 256) return;
    const int unit = c.bid, b = unit >> 5, hh = (unit >> 1) & 15, half = unit & 1;
    unsigned long long* slot_own = (unsigned long long*)(a->ws + WS_XS) + (size_t)(j * 256 + unit) * 256; const unsigned long long* slot_par = (const unsigned long long*)(a->ws + WS_XS) + (size_t)(j * 256 + (unit ^ 1)) * 256;
    const bool cons = c.tid < 256;
    __syncthreads();
    if (cons) {
        const int rp = c.tid >> 3, q = c.tid & 7, row = 32 * half + rp;
        f32x4 S0 = (f32x4){0.f, 0.f, 0.f, 0.f}, S1 = S0;
        __builtin_amdgcn_s_setprio(2);
        __syncthreads();
        for (int i = 0; i <= NCH + 1; ++i) {
            if (i < NCH) {
                const LAS float* bg = BIG + (i & 1) * 5 * VSZ + 8 * q;
                const LAS f32x4* pw = (const LAS f32x4*)bg; const LAS f32x4* pa = (const LAS f32x4*)(bg + VSZ); const LAS f32x4* pb = (const LAS f32x4*)(bg + 2 * VSZ);
                const LAS f32x4* pk = (const LAS f32x4*)(bg + 3 * VSZ); const LAS f32x4* pr = (const LAS f32x4*)(bg + 4 * VSZ);
                const LAS float* pv = VB + (i & 3) * VSZ + row; LAS float* py = YB + (i % 3) * YSZ + rp;
                f32x4 a0v = pa[0], a1v = pa[1], w0v = pw[0], w1v = pw[1], b0v = pb[0], b1v = pb[1], k0v = pk[0], k1v = pk[1], r0v = pr[0], r1v = pr[1];
                float vv = pv[0];
#pragma unroll 2
                for (int t = 0; t < CH; ++t) {
                    const int tn = (t + 1) & (CH - 1);
                    const f32x4 na0 = pa[tn * 16], na1 = pa[tn * 16 + 1], nw0 = pw[tn * 16], nw1 = pw[tn * 16 + 1], nb0 = pb[tn * 16], nb1 = pb[tn * 16 + 1],
                                nk0 = pk[tn * 16], nk1 = pk[tn * 16 + 1], nr0 = pr[tn * 16], nr1 = pr[tn * 16 + 1];
                    const float nvv = pv[tn * 64];
                    const float sa = sum8(hsum4(S0 * a0v + S1 * a1v));
                    S0 = S0 * w0v + sa * b0v + vv * k0v; S1 = S1 * w1v + sa * b1v + vv * k1v;
                    const float y = sum8(hsum4(S0 * r0v + S1 * r1v));
                    if (q == 0) py[t * 32] = y;
                    a0v = na0; a1v = na1; w0v = nw0; w1v = nw1; b0v = nb0; b1v = nb1; k0v = nk0; k1v = nk1; r0v = nr0; r1v = nr1; vv = nvv;
                }
            }
            __syncthreads();
        }
        __builtin_amdgcn_s_setprio(0);
    } else {
        const int pt = c.tid - 256, st = pt >> 3, l8 = pt & 7, sc = l8 * 8, ch = hh * 64 + sc;
        const float* pp = a->in[I_W0] + (size_t)j * D + ch; const f32x4 w0a = *(const f32x4*)pp, w0b = *(const f32x4*)(pp + 4);
        pp = a->in[I_A0] + (size_t)j * D + ch; const f32x4 a0a = *(const f32x4*)pp, a0b = *(const f32x4*)(pp + 4);
        pp = a->in[I_KK] + (size_t)j * D + ch; const f32x4 kka = *(const f32x4*)pp, kkb = *(const f32x4*)(pp + 4);
        pp = a->in[I_KA] + (size_t)j * D + ch; const f32x4 kaa = *(const f32x4*)pp, kab = *(const f32x4*)(pp + 4);
        pp = a->in[I_RK] + (size_t)j * D + ch; const f32x4 rka = *(const f32x4*)pp, rkb = *(const f32x4*)(pp + 4);
        const int oc = 4 * l8, cho = hh * 64 + 32 * half + oc;
        const f32x4 lnw = *(const f32x4*)(a->in[I_LNW] + (size_t)j * D + cho), lnb = *(const f32x4*)(a->in[I_LNB] + (size_t)j * D + cho);
        const size_t gbase = ((size_t)b * SEQ + st) * D + ch, obase = ((size_t)b * SEQ + st) * D + cho;
        u32x4 qr = *(const u32x4*)(R + gbase), qk = *(const u32x4*)(Kb + gbase), qv = *(const u32x4*)(Vb + gbase), qlw = *(const u32x4*)(LWb + gbase), qla = *(const u32x4*)(LAb + gbase);
        u32x2 qg = (u32x2){0u, 0u};
#define SCAN_STAGE(n) { \
            f32x4 rr[2] = {bf4lo(qr), bf4hi(qr)}, kk_[2] = {bf4lo(qk), bf4hi(qk)}, vv_[2] = {bf4lo(qv), bf4hi(qv)}, lw_[2] = {bf4lo(qlw), bf4hi(qlw)}, la_[2] = {bf4lo(qla), bf4hi(qla)}; \
            const f32x4 w0_[2] = {w0a, w0b}, a0_[2] = {a0a, a0b}, kkp_[2] = {kka, kkb}, kap_[2] = {kaa, kab}, rkp_[2] = {rka, rkb}; \
            f32x4 dec[2], av[2], kn[2], kp[2]; float n2 = 0.f, bon = 0.f; \
            _Pragma("unroll") for (int h2 = 0; h2 < 2; ++h2) _Pragma("unroll") for (int e = 0; e < 4; ++e) { \
                const float xw = -(w0_[h2][e] + lw_[h2][e]); const float sp = xw > 20.f ? xw : __logf(1.f + __expf(xw)); \
                dec[h2][e] = __expf(-__expf(-sp - 0.5f)); av[h2][e] = __builtin_amdgcn_rcpf(1.f + __expf(-(a0_[h2][e] + la_[h2][e]))); \
                kn[h2][e] = kk_[h2][e] * kkp_[h2][e]; n2 += kn[h2][e] * kn[h2][e]; \
                kp[h2][e] = kk_[h2][e] * (1.f + (av[h2][e] - 1.f) * kap_[h2][e]); bon += rr[h2][e] * kp[h2][e] * rkp_[h2][e]; } \
            n2 = sum8(n2); bon = sum8(bon); const float inv = rsqrtf(fmaxf(n2, 1e-24f)); \
            LAS float* bg = BIG + ((n) & 1) * 5 * VSZ + st * 64 + sc; \
            _Pragma("unroll") for (int h2 = 0; h2 < 2; ++h2) { const f32x4 kq = kn[h2] * inv; \
                *(LAS f32x4*)(bg + 4 * h2) = dec[h2]; *(LAS f32x4*)(bg + VSZ + 4 * h2) = -kq; *(LAS f32x4*)(bg + 2 * VSZ + 4 * h2) = kq * av[h2]; \
                *(LAS f32x4*)(bg + 3 * VSZ + 4 * h2) = kp[h2]; *(LAS f32x4*)(bg + 4 * VSZ + 4 * h2) = rr[h2]; \
                *(LAS f32x4*)(VB + ((n) & 3) * VSZ + st * 64 + sc + 4 * h2) = vv_[h2]; } \
            if (l8 == 0) BON[((n) & 3) * CH + st] = bon; }
#define SCAN_YSTATS(n) \
            const f32x4 y = *(const LAS f32x4*)(YB + ((n) % 3) * YSZ + st * 32 + oc); \
            const float mh = sum8(hsum4(y)) * (1.f / 32.f); const f32x4 d = y - mh; const float m2h = sum8(hsum4(d * d));
        SCAN_STAGE(0)
        { const size_t go = gbase + (size_t)CH * D; qr = *(const u32x4*)(R + go); qk = *(const u32x4*)(Kb + go); qv = *(const u32x4*)(Vb + go); qlw = *(const u32x4*)(LWb + go); qla = *(const u32x4*)(LAb + go); }
        __syncthreads();
        for (int i = 0; i <= NCH + 1; ++i) {
            unsigned long long pw0 = 0ull, pw1 = 0ull; const unsigned long long* pp_ = slot_par + (((i - 2) & 3) * CH + st) * 2;
            if (i >= 2) { pw0 = __hip_atomic_load(pp_, __ATOMIC_RELAXED, __HIP_MEMORY_SCOPE_AGENT); pw1 = __hip_atomic_load(pp_ + 1, __ATOMIC_RELAXED, __HIP_MEMORY_SCOPE_AGENT); }
            if (i >= 1 && i <= NCH) {
                const int n = i - 1;
                SCAN_YSTATS(n)
                if (l8 == 0) { const unsigned long long tg = (unsigned long long)(unsigned)(n + 1) << 32; unsigned long long* sp_ = slot_own + ((n & 3) * CH + st) * 2;
                    __hip_atomic_store(sp_, tg | __float_as_uint(mh), __ATOMIC_RELAXED, __HIP_MEMORY_SCOPE_AGENT); __hip_atomic_store(sp_ + 1, tg | __float_as_uint(m2h), __ATOMIC_RELAXED, __HIP_MEMORY_SCOPE_AGENT); }
            }
            u32x4 nr = qr, nk = qk, nv = qv, nlw = qlw, nla = qla; u32x2 ng = qg;
            if (i + 2 < NCH) { const size_t go = gbase + (size_t)(i + 2) * CH * D; nr = *(const u32x4*)(R + go); nk = *(const u32x4*)(Kb + go); nv = *(const u32x4*)(Vb + go); nlw = *(const u32x4*)(LWb + go); nla = *(const u32x4*)(LAb + go); }
            if (i >= 1 && i <= NCH) ng = *(const u32x2*)(Gb + obase + (size_t)(i - 1) * CH * D);
            if (i + 1 < NCH) { SCAN_STAGE(i + 1) }
            if (i >= 2) {
                const int n = i - 2; const unsigned tag = (unsigned)(n + 1); unsigned sp = 0;
                while ((unsigned)(pw0 >> 32) != tag) { __builtin_amdgcn_s_sleep(1); if (++sp > (1u << 18)) break; pw0 = __hip_atomic_load(pp_, __ATOMIC_RELAXED, __HIP_MEMORY_SCOPE_AGENT); }
                while ((unsigned)(pw1 >> 32) != tag) { __builtin_amdgcn_s_sleep(1); if (++sp > (1u << 18)) break; pw1 = __hip_atomic_load(pp_ + 1, __ATOMIC_RELAXED, __HIP_MEMORY_SCOPE_AGENT); }
                const float mp = __uint_as_float((unsigned)pw0), m2p = __uint_as_float((unsigned)pw1);
                SCAN_YSTATS(n)
                const float mean = 0.5f * (mh + mp), dm = mh - mp; const float rstd = rsqrtf((m2h + m2p + 16.f * dm * dm) * (1.f / 64.f) + GN_EPS);
                const f32x4 v = *(const LAS f32x4*)(VB + (n & 3) * VSZ + st * 64 + 32 * half + oc); const float bon = BON[(n & 3) * CH + st];
                const f32x4 o = ((y - mean) * rstd * lnw + lnb + bon * v) * bf4(qg);
                u32x2 w; w.x = cvt_pk_bf16(o.x, o.y); w.y = cvt_pk_bf16(o.z, o.w);
                *(u32x2*)(R + obase + (size_t)n * CH * D) = w;
            }
            qg = ng; qr = nr; qk = nk; qv = nv; qlw = nlw; qla = nla;
            __syncthreads();
        }
#undef SCAN_STAGE
#undef SCAN_YSTATS
    }
}

__device__ __forceinline__ void phase_final(const Ctx& c, CA a) {
    const float* ss = (const float*)(a->ws + WS_PA); const float* g = a->in[I_NFIN];
    const int gw = c.bid * 8 + c.wave, NGW = c.G * 8;
    f32x4 gg[4];
#pragma unroll
    for (int j = 0; j < 4; ++j) gg[j] = *((const f32x4*)g + c.lane + 64 * j);
    for (int m = gw; m < M; m += NGW) {
        const float rs = row_rstd(ss, m);
        f32x4* hr = (f32x4*)(a->out + (size_t)m * D) + c.lane;
#pragma unroll
        for (int j = 0; j < 4; ++j) hr[64 * j] = hr[64 * j] * rs * gg[j];
    }
}

#define XB_TMO      128
#define XB_XCNT(j)  (256  + 64 * (j))
#define XB_XSUB(j)  (1280 + 64 * (j))
#define XB_XGEN(j)  (2304 + 64 * (j))
#define XB_TOP      3328
#define XB_TOPGEN   3392
#define XCD_BAR_WORDS 3456
#define XB_SPIN_CAP (1u << 18)

__device__ __forceinline__ unsigned xb_ld(unsigned* p)              { return __hip_atomic_load(p, __ATOMIC_RELAXED, __HIP_MEMORY_SCOPE_AGENT); }
__device__ __forceinline__ unsigned xb_add(unsigned* p, unsigned v) { return __hip_atomic_fetch_add(p, v, __ATOMIC_RELAXED, __HIP_MEMORY_SCOPE_AGENT); }
__device__ __forceinline__ unsigned xb_xcc_id() { return (unsigned)__builtin_amdgcn_s_getreg((3 << 11) | 20) & 0xFu; }
#define XB_SPIN(cond, bar) do { unsigned _sp = 0; while (cond) { __builtin_amdgcn_s_sleep(1); \
    if ((++_sp & 255u) == 0u) { if (xb_ld(&(bar)[XB_TMO])) break; if (_sp > XB_SPIN_CAP) { atomicAdd(&(bar)[XB_TMO], 1u); break; } } } } while (0)

struct XcdBarrier {
    unsigned* bar; unsigned x;
    volatile LAS unsigned* st;
};

__device__ __forceinline__ XcdBarrier xcd_barrier_post(unsigned* bar, volatile LAS unsigned* st) {
    XcdBarrier b; b.bar = bar; b.x = xb_xcc_id(); b.st = st;
    if (threadIdx.x == 0) (void)xb_add(&bar[XB_XCNT(b.x)], 1u);
    return b;
}
__device__ __forceinline__ void xcd_barrier_complete(unsigned* bar, unsigned x, unsigned& nloc, unsigned& nx) {
    const unsigned G = gridDim.x * gridDim.y * gridDim.z;
    unsigned sum, cnt, mine, sp = 0u;
    for (;;) {
        sum = 0u; cnt = 0u; mine = 0u;
#pragma unroll
        for (unsigned j = 0; j < 16; ++j) { const unsigned c = xb_ld(&bar[XB_XCNT(j)]); sum += c; cnt += (c > 0u) ? 1u : 0u; mine = (j == x) ? c : mine; }
        if (sum == G) break;
        __builtin_amdgcn_s_sleep(1);
        if ((++sp & 255u) == 0u) { if (xb_ld(&bar[XB_TMO])) break; if (sp > XB_SPIN_CAP) { atomicAdd(&bar[XB_TMO], 1u); break; } }
    }
    nloc = mine > 0u ? mine : 1u; nx = cnt > 0u ? cnt : 1u;
}

__device__ __forceinline__ void xcd_barrier(const XcdBarrier& b) {
    asm volatile("s_waitcnt vmcnt(0)" ::: "memory");
    __syncthreads();
    if (threadIdx.x == 0) {
        unsigned* bar = b.bar;
        __builtin_amdgcn_s_waitcnt(0);
        unsigned nloc = b.st[0], nx = b.st[1];
        if (nloc == 0u) { xcd_barrier_complete(bar, b.x, nloc, nx); b.st[0] = nloc; b.st[1] = nx; }
        const unsigned old = xb_add(&bar[XB_XSUB(b.x)], 1u);
        const unsigned gen = old / nloc;
        if (old + 1u == (gen + 1u) * nloc) {
            __builtin_amdgcn_fence(__ATOMIC_RELEASE, "agent");
            asm volatile("s_waitcnt vmcnt(0)" ::: "memory");
            const unsigned og = xb_add(&bar[XB_TOP], 1u);
            const unsigned tg = og / nx;
            if (og + 1u == (tg + 1u) * nx) xb_add(&bar[XB_TOPGEN], 1u);
            else XB_SPIN(xb_ld(&bar[XB_TOPGEN]) == tg, bar);
            __builtin_amdgcn_fence(__ATOMIC_ACQUIRE, "agent");
            xb_add(&bar[XB_XGEN(b.x)], 1u);
            asm volatile("s_waitcnt vmcnt(0)" ::: "memory");
        } else {
            XB_SPIN(xb_ld(&bar[XB_XGEN(b.x)]) == gen, bar);
            __builtin_amdgcn_fence(__ATOMIC_ACQUIRE, "agent");
            asm volatile("s_waitcnt vmcnt(0)" ::: "memory");
        }
    }
    __syncthreads();
}

constexpr int SLOTS = 11, NPH = 2 + 4 * SLOTS;
__host__ __device__ inline bool phase_active(int p) {
    if (p == 0 || p == NPH - 1) return true;
    const int i = (p - 1) / SLOTS, s = (p - 1) % SLOTS;
    if (s >= 5) return s == 6 || s == 10;
    return (i & 1) ? true : (s < 3);
}

__global__ void __launch_bounds__(512, 2) mk_fwd(Args a_) {
    extern __shared__ __attribute__((aligned(16))) unsigned char lds_raw[];
    int tid_ = threadIdx.x, bid_ = blockIdx.x, G_ = gridDim.x;
    volatile LAS unsigned* xst = (volatile LAS unsigned*)((LAS unsigned char*)lds_raw + 131072 + 64);
    if (tid_ < 2) xst[tid_] = 0u;
    __syncthreads();
    const XcdBarrier xbar = xcd_barrier_post((unsigned*)(a_.ws + WS_CTL), xst);
    CA a = (CA)__builtin_amdgcn_kernarg_segment_ptr();
    const int ph_lo = a_.ph_lo, ph_hi = a_.ph_hi;
    for (int p = ph_lo; p < ph_hi; ++p) {
        if (!phase_active(p)) continue;
        const int PL = (p - 1) / SLOTS, PS = (p - 1) % SLOTS; (void)PL; (void)PS;
        const int nrep = (MK_PROBE && p < NPH - 1 && (MK_PROBE_SEL)) ? 2 : 1;
        for (int rp = 0; rp < nrep; ++rp) {
        if (rp) cg::this_grid().sync();
        asm volatile("" : "+s"(a), "+s"(bid_), "+s"(G_)); asm volatile("" : "+v"(tid_));
        Ctx c; c.lds = (LAS unsigned char*)lds_raw; c.tid = tid_; c.lane = c.tid & 63; c.wave = __builtin_amdgcn_readfirstlane(c.tid >> 6); c.G = G_; c.bid = bid_;
        bf16_t* regA = (bf16_t*)(a->ws + WS_A);
        if (p == 0) phase_prologue(c, a);
        else if (p == NPH - 1) phase_final(c, a);
        else {
            const int layer = (p - 1) / SLOTS, s = (p - 1) % SLOTS, j = layer >> 1;
            unsigned char* wj = a->ws + WS_WSTAT + (size_t)j * WJ_STRIDE;
            float* ss_mix = (float*)(a->ws + WS_PA); float* ss_ffn = (float*)(a->ws + WS_PB); float* ss_next = ss_mix;
            if (s < 5 && !(layer & 1)) {
                if (s == 0) {
                    pg8::Gemm g{regA, (const bf16_t*)(wj + WJ_IN), M, 2048, D, D}; pg8::StaticOrder S; S.init(M / 256, 2048, c.G, c.bid);
                    EpiSguIn E{(bf16_t*)(a->ws + P_U), (bf16_t*)(a->ws + P_SV), ss_mix, a->in[I_SBIN] + (size_t)j * 2048, (float*)(a->ws + WS_PV)};
                    pg8::gemm_phase<EpiSguIn, pg8::StaticOrder, 0, false, true>(c.lds, c.tid, g, S, E);
                } else if (s == 1) { phase_ffn_weights(c, a, layer); phase_sgu_spatial(c, a, j, rp); }
                else {
                    pg8::Gemm g{(const bf16_t*)(a->ws + P_U), (const bf16_t*)(wj + WJ_OUT), M, D, D, D}; pg8::StaticOrder S; S.init(M / 256, D, c.G, c.bid);
                    EpiResid E{layer == 0 ? a->in[I_X] : (const float*)a->out, a->out, regA, ss_ffn};
                    pg8::gemm_phase<EpiResid, pg8::StaticOrder, 0, false, true>(c.lds, c.tid, g, S, E);
                }
            } else if (s < 5) {
                if (s == 0) { phase_rwkv_prep(c, a, layer); phase_ffn_weights(c, a, layer); if (layer == 1) phase_static_weights(c, a, 1); }
                else if (s == 1) {
                    pg8::Gemm g{regA, (const bf16_t*)(wj + WJ_RKV), M, 3584, 2048, D}; pg8::StaticOrder S; S.init(M / 256, 3584, c.G, c.bid);
                    EpiRkv E{(bf16_t*)(a->ws + P_R), (bf16_t*)(a->ws + P_WA), (bf16_t*)(a->ws + P_GL)};
                    pg8::gemm_phase<EpiRkv, pg8::StaticOrder, 1, true, true>(c.lds, c.tid, g, S, E);
                } else if (s == 2) {
                    { int kq = 128; asm volatile("" : "+s"(kq)); pg8::Gemm g{(const bf16_t*)(a->ws + P_WA), (const bf16_t*)(wj + WJ_L2WA), M, 2048, kq, kq}; pg8::StaticOrder S; S.init(M / 256, 2048, c.G, c.bid);
                      EpiStore<false> E{(bf16_t*)(a->ws + P_LW), D, 2, (size_t)M * D, nullptr};
                      pg8::gemm_phase<EpiStore<false>, pg8::StaticOrder, 0, false, true>(c.lds, c.tid, g, S, E); }
                    asm volatile("" : "+s"(a), "+s"(c.bid), "+s"(c.G), "+s"(wj)); asm volatile("" : "+v"(c.tid));
                    { int kq = 256; asm volatile("" : "+s"(kq)); pg8::Gemm g{(const bf16_t*)(a->ws + P_GL), (const bf16_t*)(wj + WJ_L2G), M, D, kq, kq}; pg8::StaticOrder S; S.init(M / 256, D, c.G, c.bid);
                      EpiStore<false> E{regA, D, 2, 0, nullptr};
                      pg8::gemm_phase<EpiStore<false>, pg8::StaticOrder, 0, false, true>(c.lds, c.tid, g, S, E); }
                } else if (s == 3) phase_scan(c, a, j, 0);
                else {
                    pg8::Gemm g{(const bf16_t*)(a->ws + P_R), (const bf16_t*)(wj + WJ_O), M, D, D, D}; pg8::StaticOrder S; S.init(M / 256, D, c.G, c.bid);
                    EpiResid E{a->out, a->out, regA, ss_ffn};
                    pg8::gemm_phase<EpiResid, pg8::StaticOrder, 0, false, true>(c.lds, c.tid, g, S, E);
                }
            }
            else if (s == 6) {
                pg8::Gemm g{regA - 2 * D, (const bf16_t*)(a->ws + WS_WFFN), M, FF2, D, D}; pg8::StaticOrder S; S.init(133, FF2, c.G, c.bid);
                EpiFfnUp E{(bf16_t*)(a->ws + P_ACT), ss_ffn, a->in[I_FCW] + (size_t)layer * 3 * FF2, a->in[I_FCB] + (size_t)layer * FF2};
                pg8::gemm_phase<EpiFfnUp, pg8::StaticOrder, 2, false, true>(c.lds, c.tid, g, S, E);
            }
            else {
                pg8::Gemm g{(const bf16_t*)(a->ws + P_ACT), (const bf16_t*)(a->ws + WS_WDOWN), M, D, FF, FF}; pg8::StaticOrder S; S.init(M / 256, D, c.G, c.bid);
                EpiResid E{a->out, a->out, layer == 1 ? regA : (bf16_t*)nullptr, ss_next};
                pg8::gemm_phase<EpiResid, pg8::StaticOrder, 0, false, true>(c.lds, c.tid, g, S, E);
            }
        }
        }
        if (p + 1 < ph_hi) { if (p == 0) cg::this_grid().sync(); else xcd_barrier(xbar); }
    }
}

constexpr int LDS_BYTES = 147456;
#ifndef MK_ONE_LAUNCH
#define MK_ONE_LAUNCH 1
#endif
extern "C" void kernel_launch(void* const* d_in, const int* in_sizes, int n_in, void* d_out, int out_size, void* d_ws, size_t ws_size, hipStream_t stream) {
    static int grid = 0;
    if (grid == 0) {
        if (n_in != 32 || out_size != M * D || ws_size < WS_END) { fprintf(stderr, "kernel_launch: unexpected shapes (n_in %d out %d ws %zu, need %zu)\n", n_in, out_size, ws_size, (size_t)WS_END); grid = -1; return; }
        int dev = 0, cus = 0, per_cu = 0;
        (void)hipGetDevice(&dev); (void)hipDeviceGetAttribute(&cus, hipDeviceAttributeMultiprocessorCount, dev);
        if (hipFuncSetAttribute((const void*)mk_fwd, hipFuncAttributeMaxDynamicSharedMemorySize, LDS_BYTES) != hipSuccess) { fprintf(stderr, "kernel_launch: hipFuncSetAttribute failed\n"); grid = -1; return; }
        (void)hipOccupancyMaxActiveBlocksPerMultiprocessor(&per_cu, (const void*)mk_fwd, 512, LDS_BYTES);
        if (per_cu < 1) per_cu = 1;
        grid = cus * 1;
        (void)hipGetLastError();
    }
    if (grid < 0) return;
    if (hipMemsetAsync((char*)d_ws + WS_CTL, 0, CTL_BYTES, stream) != hipSuccess) { fprintf(stderr, "kernel_launch: memset failed\n"); return; }
    Args a{};
    for (int i = 0; i < 32; ++i) a.in[i] = (const float*)d_in[i];
    a.out = (float*)d_out; a.ws = (unsigned char*)d_ws;
#if MK_ONE_LAUNCH
    a.ph_lo = 0; a.ph_hi = NPH;
    void* args[] = {&a};
    hipError_t e = hipLaunchCooperativeKernel((const void*)mk_fwd, dim3(grid), dim3(512), args, LDS_BYTES, stream);
    if (e != hipSuccess) fprintf(stderr, "cooperative launch failed: %s (grid %d)\n", hipGetErrorString(e), grid);
#else
    for (int p = 0; p < NPH; ++p) { if (!phase_active(p)) continue; a.ph_lo = p; a.ph_hi = p + 1; hipLaunchKernelGGL(mk_fwd, dim3(grid), dim3(512), LDS_BYTES, stream, a); }
#endif
}
```

```cpp
#include <hip/hip_runtime.h>
#include <hip/hip_cooperative_groups.h>
#include <cstdio>
#include <cstdint>
#include <cmath>
namespace cg = cooperative_groups;
#ifndef MK_PROBE
#define MK_PROBE 0
#endif
#ifndef MK_PROBE_SEL
#define MK_PROBE_SEL 0
#endif
#ifndef MK_PROBE_MODE
#define MK_PROBE_MODE 1
#endif
namespace pg8 {
#define PG8_LAS __attribute__((address_space(3)))
typedef unsigned short bf16_t;
typedef short bf16x8 __attribute__((ext_vector_type(8)));
typedef float f32x4 __attribute__((ext_vector_type(4)));
typedef float f32x2 __attribute__((ext_vector_type(2)));
typedef unsigned u32x4 __attribute__((ext_vector_type(4)));
typedef unsigned u32x2 __attribute__((ext_vector_type(2)));
constexpr int BM = 256, BK = 64, HALF = 128, HTB = HALF * BK * 2  , STAGE_BYTES = 8 * HTB, NXCD = 8, WGM = 8;

__host__ __device__ __forceinline__ int lds_byte(int r, int c) { const int st = (r >> 4) * 2 + (c >> 5), rr = r & 15, cc = c & 31, ob = rr * 64 + cc * 2; return st * 1024 + (ob ^ (((ob >> 9) & 1) << 5)); }
__host__ __device__ __forceinline__ void stage_rc(int b, int& R, int& C) { const int st = b / 1024, sb = b % 1024, swz = sb ^ (((sb >> 9) & 1) << 5); R = (st >> 1) * 16 + swz / 64; C = (st & 1) * 32 + (swz % 64) / 2; }
__host__ __device__ __forceinline__ int perm32(int rho) { const int n = rho >> 4, i = rho & 15; return 8 * (i >> 2) + 4 * n + (i & 3); }

struct Unit { int pm, pn; };
struct Gemm { const bf16_t* A; const bf16_t* Bt; int M, N, K, lda; size_t astride; };

struct StaticOrder {
    int nM, nN, nwg, G, c;
    __host__ __device__ void init(int nM_, int N, int G_, int c_) { nM = nM_; nN = N / BM; nwg = nM * nN; G = G_; c = c_; }
    __host__ __device__ bool next(int i, Unit& u) const {
        const long L = (long)i * G + c; if (L >= nwg) return false;
        int wgid = (int)L; { const int q = nwg / NXCD, r = nwg % NXCD, xcd = wgid % NXCD, off = wgid / NXCD; wgid = (xcd < r ? xcd * (q + 1) : r * (q + 1) + (xcd - r) * q) + off; }
        const int nig = WGM * nN, gid = wgid / nig, fm = gid * WGM, gsz = (nM - fm) < WGM ? (nM - fm) : WGM;
        u.pm = fm + ((wgid % nig) % gsz); u.pn = (wgid % nig) / gsz; return true;
    }
};

__device__ __forceinline__ unsigned cvt_pk_bf16(float lo, float hi) { unsigned r; asm volatile("v_cvt_pk_bf16_f32 %0, %1, %2" : "=v"(r) : "v"(lo), "v"(hi)); return r; }
__device__ __forceinline__ f32x2 gelu_pk(f32x2 v) {
    const f32x2 av = __builtin_elementwise_abs(v), d = av * 0.2316418882f + 1.0f;
    f32x2 t; t.x = __builtin_amdgcn_rcpf(d.x); t.y = __builtin_amdgcn_rcpf(d.y);
    f32x2 q = t * 0.5307027145f + (-0.7265760135f); q = q * t + 0.7107068705f; q = q * t + (-0.142248368f); q = q * t + 0.127414796f; q = q * t;
    const f32x2 s = (v * v) * (-0.72134752044f);
    f32x2 e; e.x = __builtin_amdgcn_exp2f(s.x); e.y = __builtin_amdgcn_exp2f(s.y);
    const f32x2 m = v * (q * e), r = v - m;
    f32x2 o; o.x = v.x < 0.f ? m.x : r.x; o.y = v.y < 0.f ? m.y : r.y; return o;
}

template <class Epi, class Sched, int AMAP, bool KDBL, bool ALIGN_EPI>
__device__ __forceinline__ void gemm_phase(PG8_LAS unsigned char* lds, const int tid, const Gemm g, const Sched& S, const Epi& E) {
    const int wid = __builtin_amdgcn_readfirstlane(tid >> 6), lane = tid & 63, wr = wid >> 2, wc = wid & 3, fr = lane & 15, fq = lane >> 4;
    const int K = g.K, nt = K / BK, lda = g.lda;
    unsigned voffA[2], voffB[2];
#pragma unroll
    for (int i = 0; i < 2; ++i) { int R, C; stage_rc(tid * 16 + i * 8192, R, C); const int Rb = Epi::PERM ? ((R & ~31) + perm32(R & 31)) : R;
        const int Ra = (AMAP == 2) ? (R - 2 * (R >> 6)) : R;
        voffA[i] = (unsigned)(Ra * lda + C) * 2u; voffB[i] = (unsigned)(Rb * K + C) * 2u; }
    const size_t kstep = (size_t)(BK * 2);
    const size_t hstepA = (size_t)((AMAP == 2) ? 124 : HALF) * lda * 2;
    const size_t hstepB = (size_t)HALF * K * 2;
    const size_t tstepB = 2 * hstepB;
    const size_t rowA = (size_t)lda * 2;
    const unsigned ldsw = (unsigned)wid * 1024u;
    const int aoff = lds_byte(wr * 64 + fr, fq * 8), boff = lds_byte(wc * 32 + fr, fq * 8);
#define PG8_ABASE(pm, pn) ((const char*)g.A + (AMAP == 3 ? (size_t)((pn) >> 2) * g.astride + (size_t)(pm) * 256 * rowA : AMAP == 1 ? (size_t)(((pm) >> 4) * 4104 + 8 + ((pm) & 15) * 256) * rowA : (AMAP == 2 ? (size_t)(pm) * 248 * rowA : (size_t)(pm) * 256 * rowA)))
#define PG8_KA(base, t) (KDBL ? ((base) + (size_t)((t) & 15) * kstep - (size_t)((t) >> 4) * rowA) : ((base) + (size_t)(t) * kstep))
#define PG8_SA(b, h) (((b) * 2 + (h)) * HTB)
#define PG8_SB(b, h) ((4 + (b) * 2 + (h)) * HTB)
#define PG8_STAGE(bufoff, gbase, voff) do { _Pragma("unroll") for (int _i = 0; _i < 2; ++_i) \
        __builtin_amdgcn_global_load_lds((const unsigned*)((const char*)(gbase) + (voff)[_i]), (PG8_LAS unsigned*)(lds + (bufoff) + ldsw + _i * 8192), 16, 0, 0); } while (0)
#define PG8_LDA(dst, b, h) do { _Pragma("unroll") for (int m = 0; m < 4; ++m) _Pragma("unroll") for (int k = 0; k < 2; ++k) dst[m][k] = *(const PG8_LAS bf16x8*)(lds + PG8_SA(b, h) + aoff + m * 2048 + k * 1024); } while (0)
#define PG8_LDB(dst, b, h) do { _Pragma("unroll") for (int n = 0; n < 2; ++n) _Pragma("unroll") for (int k = 0; k < 2; ++k) dst[n][k] = *(const PG8_LAS bf16x8*)(lds + PG8_SB(b, h) + boff + n * 2048 + k * 1024); } while (0)
#define PG8_MMA(ai, bj, At, Bt) do { __builtin_amdgcn_s_setprio(1); _Pragma("unroll") for (int m = 0; m < 4; ++m) _Pragma("unroll") for (int n = 0; n < 2; ++n) _Pragma("unroll") for (int k = 0; k < 2; ++k) \
        acc[ai][bj][m][n] = __builtin_amdgcn_mfma_f32_16x16x32_bf16(Bt[n][k], At[m][k], acc[ai][bj][m][n], 0, 0, 0); __builtin_amdgcn_s_setprio(0); } while (0)
#define PG8_WAIT_V(n) asm volatile("s_waitcnt vmcnt(" #n ")" ::: "memory")
#define PG8_WAIT_L(n) asm volatile("s_waitcnt lgkmcnt(" #n ")" ::: "memory")
#define PG8_BAR __builtin_amdgcn_s_barrier()
#define PG8_SCHED __builtin_amdgcn_sched_barrier(0)
    Unit cur, nxt; int ui = 0;
    if (!S.next(0, cur)) return;
    f32x4 acc[2][2][4][2];
#pragma unroll
    for (int a = 0; a < 2; ++a)
#pragma unroll
        for (int b = 0; b < 2; ++b)
#pragma unroll
            for (int m = 0; m < 4; ++m)
#pragma unroll
                for (int n = 0; n < 2; ++n) acc[a][b][m][n] = (f32x4){0.f, 0.f, 0.f, 0.f};
    bf16x8 At[4][2], B0[2][2], B1[2][2];
    const char* cA = PG8_ABASE(cur.pm, cur.pn); const char* cB = (const char*)g.Bt + (size_t)cur.pn * tstepB;
    {
        const char* cA1 = PG8_KA(cA, 1);
        PG8_STAGE(PG8_SB(0, 0), cB, voffB); PG8_STAGE(PG8_SB(0, 1), cB + hstepB, voffB); PG8_STAGE(PG8_SA(0, 0), cA, voffA); PG8_STAGE(PG8_SA(0, 1), cA + hstepA, voffA);
        if (wr == 1) PG8_BAR;
        PG8_WAIT_V(2); PG8_BAR;
        PG8_STAGE(PG8_SB(1, 0), cB + kstep, voffB); PG8_STAGE(PG8_SA(1, 0), cA1, voffA); PG8_STAGE(PG8_SB(1, 1), cB + hstepB + kstep, voffB);
        PG8_WAIT_V(6); PG8_BAR;
    }
    for (;;) {
        const bool has_next = S.next(ui + 1, nxt);
        const char* nA = has_next ? PG8_ABASE(nxt.pm, nxt.pn) : cA; const char* nB = has_next ? (const char*)g.Bt + (size_t)nxt.pn * tstepB : cB;
        for (int t = 0; t < nt; t += 2) {
            const bool last = (t == nt - 2);
            const char* a1 = PG8_KA(cA, t + 1);
            const char* a2 = last ? nA : PG8_KA(cA, t + 2); const char* b2 = last ? nB : cB + (size_t)(t + 2) * kstep;
            const char* a3 = last ? PG8_KA(nA, 1) : PG8_KA(cA, t + 3); const char* b3 = b2 + kstep;
            PG8_LDB(B0, 0, 0); PG8_LDB(B1, 0, 1); PG8_SCHED; PG8_LDA(At, 0, 0); PG8_STAGE(PG8_SA(1, 1), a1 + hstepA, voffA);
            PG8_WAIT_V(8); PG8_WAIT_L(0); PG8_BAR; PG8_MMA(0, 0, At, B0); PG8_MMA(0, 1, At, B1); PG8_BAR; PG8_SCHED;
            PG8_LDA(At, 0, 1); PG8_STAGE(PG8_SB(0, 0), b2, voffB); PG8_STAGE(PG8_SB(0, 1), b2 + hstepB, voffB); PG8_STAGE(PG8_SA(0, 0), a2, voffA);
            PG8_WAIT_V(8); PG8_WAIT_L(0); PG8_BAR; PG8_MMA(1, 0, At, B0); PG8_MMA(1, 1, At, B1); PG8_BAR; PG8_SCHED;
            PG8_LDB(B0, 1, 0); PG8_LDB(B1, 1, 1); PG8_SCHED; PG8_LDA(At, 1, 0); PG8_STAGE(PG8_SA(0, 1), a2 + hstepA, voffA);
            PG8_WAIT_V(8); PG8_WAIT_L(0); PG8_BAR; PG8_MMA(0, 0, At, B0); PG8_MMA(0, 1, At, B1); PG8_BAR; PG8_SCHED;
            PG8_LDA(At, 1, 1); PG8_STAGE(PG8_SB(1, 0), b3, voffB); PG8_STAGE(PG8_SB(1, 1), b3 + hstepB, voffB); PG8_STAGE(PG8_SA(1, 0), a3, voffA);
            PG8_WAIT_V(8); PG8_WAIT_L(0); PG8_BAR; PG8_MMA(1, 0, At, B0); PG8_MMA(1, 1, At, B1); PG8_BAR; PG8_SCHED;
        }
        if constexpr (ALIGN_EPI) { if (wr == 0) PG8_BAR; }
        E(acc, cur, wr, wc, fr, fq);
        if (!has_next) break;
#pragma unroll
        for (int a = 0; a < 2; ++a)
#pragma unroll
            for (int b = 0; b < 2; ++b)
#pragma unroll
                for (int m = 0; m < 4; ++m)
#pragma unroll
                    for (int n = 0; n < 2; ++n) acc[a][b][m][n] = (f32x4){0.f, 0.f, 0.f, 0.f};
        cur = nxt; cA = nA; cB = nB; ++ui;
        if constexpr (ALIGN_EPI) { if (wr == 1) PG8_BAR; }
    }
    PG8_WAIT_V(0);
    if constexpr (!ALIGN_EPI) { if (wr == 0) PG8_BAR; }
    PG8_BAR;
#undef PG8_ABASE
#undef PG8_KA
#undef PG8_SA
#undef PG8_SB
#undef PG8_STAGE
#undef PG8_LDA
#undef PG8_LDB
#undef PG8_MMA
#undef PG8_WAIT_V
#undef PG8_WAIT_L
#undef PG8_BAR
#undef PG8_SCHED
}
}
using pg8::bf16_t; using pg8::f32x4; using pg8::f32x2; using pg8::u32x4; using pg8::u32x2; using pg8::Unit; using pg8::cvt_pk_bf16;
#define LAS __attribute__((address_space(3)))
constexpr int BATCH = 8, SEQ = 4096, D = 1024, M = BATCH * SEQ, FF = 2816, FF2 = 5632;
constexpr int PADR = 8, SEQP = SEQ + PADR;
constexpr float RMS_EPS = 1e-6f, GN_EPS = 64e-5f;
constexpr size_t MiB = 1u << 20;
constexpr size_t WS_CTL = 0, CTL_BYTES = 2048 * 1024, WS_XS = 1 * MiB;
constexpr size_t WS_WSTAT = 2 * MiB;
constexpr size_t WJ_IN = 0, WJ_OUT = 4 * MiB, WJ_RKV = 6 * MiB, WJ_L2WA = 20 * MiB, WJ_L2G = 20 * MiB + 512 * 1024, WJ_O = 21 * MiB, WJ_STRIDE = 23 * MiB;
constexpr size_t WS_WFFN = 48 * MiB;
constexpr size_t WS_WDOWN = WS_WFFN + 11 * MiB;
constexpr size_t WS_A = 67 * MiB;
constexpr size_t WS_P = 134 * MiB;
constexpr size_t P_R = WS_P, P_K = WS_P + 64 * MiB, P_V = WS_P + 128 * MiB, P_LW = WS_P + 192 * MiB, P_LA = WS_P + 256 * MiB, P_WA = WS_P + 320 * MiB, P_GL = WS_P + 328 * MiB;
constexpr size_t P_U = WS_P, P_SV = WS_P + 64 * MiB;
constexpr size_t P_Z = WS_P, P_ACT = WS_P + 176 * MiB;
constexpr size_t WS_PA = WS_P + 352 * MiB, WS_PB = WS_PA + 2 * MiB, WS_PV = WS_PB + 2 * MiB;
constexpr size_t WS_END = WS_PV + 2 * MiB;

struct Args {
    const float* in[32]; float* out; unsigned char* ws; int ph_lo, ph_hi;
};
enum { I_X = 0, I_NMIX, I_NFFN, I_NFIN, I_SWIN, I_SBIN, I_SGV, I_SWS, I_SBS, I_SWOUT, I_MU, I_WR, I_WK, I_WV, I_WO, I_W0, I_W1, I_W2, I_A0, I_A1, I_A2, I_G1, I_G2, I_KK, I_KA, I_RK, I_LNW, I_LNB, I_FUP, I_FCW, I_FCB, I_FDN };

__device__ __forceinline__ float bf2f(unsigned short b) { return __uint_as_float((unsigned)b << 16); }
__device__ __forceinline__ float bflo(unsigned w) { return __uint_as_float(w << 16); }
__device__ __forceinline__ float bfhi(unsigned w) { return __uint_as_float(w & 0xffff0000u); }
__device__ __forceinline__ float wave_sum(float v) {
#pragma unroll
    for (int o = 1; o < 64; o <<= 1) v += __shfl_xor(v, o);
    return v;
}
__device__ __forceinline__ float row_rstd(const float* P, int row) { const f32x4* p = (const f32x4*)(P + (size_t)row * 16); const f32x4 a = p[0], b = p[1], c = p[2], d = p[3];
    const float s = ((a.x + a.y) + (a.z + a.w)) + ((b.x + b.y) + (b.z + b.w)) + ((c.x + c.y) + (c.z + c.w)) + ((d.x + d.y) + (d.z + d.w)); return rsqrtf(s * (1.f / D) + RMS_EPS); }
__device__ __forceinline__ void row_rstd4(const float* P, int row0, int rstride, int lo, int hi, float (&rs)[4]) {
    f32x4 p[4][4];
#pragma unroll
    for (int m = 0; m < 4; ++m) { int r = row0 + m * rstride; r = r < lo ? lo : (r > hi ? hi : r); const f32x4* q = (const f32x4*)(P + (size_t)r * 16);
#pragma unroll
        for (int k = 0; k < 4; ++k) p[m][k] = q[k]; }
#pragma unroll
    for (int m = 0; m < 4; ++m) { const f32x4 a = p[m][0], b = p[m][1], c = p[m][2], d = p[m][3];
        const float s = ((a.x + a.y) + (a.z + a.w)) + ((b.x + b.y) + (b.z + b.w)) + ((c.x + c.y) + (c.z + c.w)) + ((d.x + d.y) + (d.z + d.w)); rs[m] = rsqrtf(s * (1.f / D) + RMS_EPS); }
}
template <int CTRL> __device__ __forceinline__ float dpp_f(float v) { return __int_as_float(__builtin_amdgcn_mov_dpp(__float_as_int(v), CTRL, 0xf, 0xf, true)); }
__device__ __forceinline__ float sum8(float v) { v += dpp_f<0x141>(v); v += dpp_f<0xB1>(v); v += dpp_f<0x4E>(v); return v; }
__device__ __forceinline__ float sigmoidf_(float x) { return 1.f / (1.f + __expf(-x)); }

template <bool SCALE> struct EpiStore {
    static constexpr bool PERM = true;
    bf16_t* O; int ldc; int tsh; size_t split_stride; const float* ss;
    __device__ __forceinline__ void operator()(const f32x4 (&acc)[2][2][4][2], const Unit& u, int wr, int wc, int fr, int fq) const {
        bf16_t* base = O + (size_t)(u.pn >> tsh) * split_stride + (size_t)(u.pm * 256 + wr * 64 + fr) * ldc + (u.pn & ((1 << tsh) - 1)) * 256 + wc * 32 + 8 * fq;
        const int row0 = u.pm * 256 + wr * 64 + fr;
#pragma unroll
        for (int ai = 0; ai < 2; ++ai)
#pragma unroll
            for (int m = 0; m < 4; ++m) {
                const float rs = SCALE ? row_rstd(ss, row0 + ai * 128 + m * 16) : 1.f;
                bf16_t* rowp = base + (size_t)(ai * 128 + m * 16) * ldc;
#pragma unroll
                for (int bj = 0; bj < 2; ++bj) { const f32x4 v0 = acc[ai][bj][m][0] * rs, v1 = acc[ai][bj][m][1] * rs;
                    u32x4 w; w.x = cvt_pk_bf16(v0[0], v0[1]); w.y = cvt_pk_bf16(v0[2], v0[3]); w.z = cvt_pk_bf16(v1[0], v1[1]); w.w = cvt_pk_bf16(v1[2], v1[3]);
                    *(u32x4*)(rowp + bj * 128) = w; } }
    }
};
struct EpiSguIn {
    static constexpr bool PERM = true;
    bf16_t* U; bf16_t* V; const float* ss; const float* bias; float* ssv;
    __device__ __forceinline__ void operator()(const f32x4 (&acc)[2][2][4][2], const Unit& u, int wr, int wc, int fr, int fq) const {
        const bool isv = u.pn >= 4; bf16_t* base = isv ? V : U; const int colt = (u.pn & 3) * 256 + wc * 32 + 8 * fq, bcol = u.pn * 256 + wc * 32 + 8 * fq;
        f32x4 bv[2][2];
#pragma unroll
        for (int bj = 0; bj < 2; ++bj)
#pragma unroll
            for (int n = 0; n < 2; ++n) bv[bj][n] = *(const f32x4*)(bias + bcol + bj * 128 + 4 * n);
#pragma unroll
        for (int ai = 0; ai < 2; ++ai) {
            float rs4[4]; row_rstd4(ss, u.pm * 256 + ai * 128 + wr * 64 + fr, 16, 0, M - 1, rs4);
#pragma unroll
            for (int m = 0; m < 4; ++m) { const int row = u.pm * 256 + ai * 128 + wr * 64 + m * 16 + fr;
                const float rs = rs4[m]; float s = 0.f;
                bf16_t* rowp = base + (size_t)row * D + colt;
#pragma unroll
                for (int bj = 0; bj < 2; ++bj) { f32x4 v0 = acc[ai][bj][m][0] * rs + bv[bj][0], v1 = acc[ai][bj][m][1] * rs + bv[bj][1];
                    const f32x2 a = pg8::gelu_pk((f32x2){v0[0], v0[1]}), b = pg8::gelu_pk((f32x2){v0[2], v0[3]}), c = pg8::gelu_pk((f32x2){v1[0], v1[1]}), d = pg8::gelu_pk((f32x2){v1[2], v1[3]});
                    s += (a.x * a.x + a.y * a.y) + (b.x * b.x + b.y * b.y) + (c.x * c.x + c.y * c.y) + (d.x * d.x + d.y * d.y);
                    u32x4 w; w.x = cvt_pk_bf16(a.x, a.y); w.y = cvt_pk_bf16(b.x, b.y); w.z = cvt_pk_bf16(c.x, c.y); w.w = cvt_pk_bf16(d.x, d.y);
                    *(u32x4*)(rowp + bj * 128) = w; }
                if (isv) { s += __shfl_xor(s, 16); s += __shfl_xor(s, 32); if (fq == 0) ssv[(size_t)row * 16 + (u.pn - 4) * 4 + wc] = s; } } }
    }
};
struct EpiResid {
    static constexpr bool PERM = true;
    const float* hin; float* h; bf16_t* hb; float* ssn;
    __device__ __forceinline__ void operator()(const f32x4 (&acc)[2][2][4][2], const Unit& u, int wr, int wc, int fr, int fq) const {
        const int colt = u.pn * 256 + wc * 32 + 8 * fq;
#pragma unroll
        for (int ai = 0; ai < 2; ++ai) {
            const int rowb = u.pm * 256 + ai * 128 + wr * 64 + fr;
            f32x4 pre[4][2][2];
#pragma unroll
            for (int m = 0; m < 4; ++m)
#pragma unroll
                for (int bj = 0; bj < 2; ++bj) { const float* hp = hin + (size_t)(rowb + m * 16) * D + colt + bj * 128; pre[m][bj][0] = *(const f32x4*)hp; pre[m][bj][1] = *(const f32x4*)(hp + 4); }
#pragma unroll
            for (int m = 0; m < 4; ++m) { const int row = rowb + m * 16; float s = 0.f;
                float* hp = h + (size_t)row * D + colt; bf16_t* bp = hb + (size_t)row * D + colt;
#pragma unroll
                for (int bj = 0; bj < 2; ++bj) { const f32x4 v0 = pre[m][bj][0] + acc[ai][bj][m][0], v1 = pre[m][bj][1] + acc[ai][bj][m][1];
                    *(f32x4*)(hp + bj * 128) = v0; *(f32x4*)(hp + bj * 128 + 4) = v1;
                    s += (v0[0] * v0[0] + v0[1] * v0[1]) + (v0[2] * v0[2] + v0[3] * v0[3]) + (v1[0] * v1[0] + v1[1] * v1[1]) + (v1[2] * v1[2] + v1[3] * v1[3]);
                    if (hb) { u32x4 w; w.x = cvt_pk_bf16(v0[0], v0[1]); w.y = cvt_pk_bf16(v0[2], v0[3]); w.z = cvt_pk_bf16(v1[0], v1[1]); w.w = cvt_pk_bf16(v1[2], v1[3]);
                    *(u32x4*)(bp + bj * 128) = w; } }
                s += __shfl_xor(s, 16); s += __shfl_xor(s, 32); if (fq == 0) ssn[(size_t)row * 16 + u.pn * 4 + wc] = s; }
            asm volatile("" ::: "memory");
        }
    }
};
template <int CTRL> __device__ __forceinline__ f32x4 dpp4(f32x4 v) { f32x4 r; r.x = dpp_f<CTRL>(v.x); r.y = dpp_f<CTRL>(v.y); r.z = dpp_f<CTRL>(v.z); r.w = dpp_f<CTRL>(v.w); return r; }
struct EpiFfnUp {
    static constexpr bool PERM = true;
    bf16_t* ACT; const float* ss; const float* cw; const float* cb;
    __device__ __forceinline__ void conv4(f32x4& z0, f32x4& z1, f32x4& z2, f32x4& z3, const float (&rs)[4], const int (&tt)[4], const float* wcol, const float* bcol, int fr) const {
        const f32x4 w0 = *(const f32x4*)wcol, w1 = *(const f32x4*)(wcol + FF2), w2 = *(const f32x4*)(wcol + 2 * FF2), bb = *(const f32x4*)bcol;
#pragma unroll
        for (int e = 0; e < 4; e += 2) {
            const f32x2 w0p = {w0[e], w0[e + 1]}, w1p = {w1[e], w1[e + 1]}, w2p = {w2[e], w2[e + 1]}, bp = {bb[e], bb[e + 1]};
            f32x2 cur = (f32x2){z3[e], z3[e + 1]} * rs[3];
            f32x2 c1 = {dpp_f<0x121>(cur.x), dpp_f<0x121>(cur.y)}, c2 = {dpp_f<0x122>(cur.x), dpp_f<0x122>(cur.y)};
#define CONV_STEP(ZM, ZP, MI, HASP) { f32x2 prv = cur, p1 = c1, p2 = c2; if (HASP) { prv = (f32x2){ZP[e], ZP[e + 1]} * rs[MI - (HASP)]; p1 = (f32x2){dpp_f<0x121>(prv.x), dpp_f<0x121>(prv.y)}; p2 = (f32x2){dpp_f<0x122>(prv.x), dpp_f<0x122>(prv.y)}; } \
            f32x2 y1 = (fr == 0) ? p1 : c1, y2 = (fr < 2) ? p2 : c2; if (tt[MI] < 1) y1 = (f32x2){0.f, 0.f}; if (tt[MI] < 2) y2 = (f32x2){0.f, 0.f}; \
            const f32x2 o = w0p * y2 + (w1p * y1 + (w2p * cur + bp)); ZM[e] = o.x; ZM[e + 1] = o.y; cur = prv; c1 = p1; c2 = p2; }
            CONV_STEP(z3, z2, 3, 1) CONV_STEP(z2, z1, 2, 1) CONV_STEP(z1, z0, 1, 1) CONV_STEP(z0, z0, 0, 0)
#undef CONV_STEP
            asm volatile("" : "+v"(z0[e]), "+v"(z1[e]), "+v"(z2[e]), "+v"(z3[e]), "+v"(z0[e + 1]), "+v"(z1[e + 1]), "+v"(z2[e + 1]), "+v"(z3[e + 1]));
        }
    }
    __device__ __forceinline__ void operator()(f32x4 (&acc)[2][2][4][2], const Unit& u, int wr, int wc, int fr, int fq) const {
        const int f0 = u.pn * 128 + wc * 32 + 8 * fq;
#pragma unroll
        for (int ai = 0; ai < 2; ++ai) {
            const int gbase = u.pm * 248 - 2 + 62 * (2 * ai + wr) + fr;
            float rs[4]; int tt[4];
            row_rstd4(ss, gbase, 16, 0, M - 1, rs);
            asm volatile("" : "+v"(rs[0]), "+v"(rs[1]), "+v"(rs[2]), "+v"(rs[3]) :: "memory");
            { const int g0 = u.pm * 248 - 2 + 62 * (2 * ai + wr);
              const bool seqstart = ((g0 + 63) & (SEQ - 1)) < 65 || g0 < 0;
#pragma unroll
              for (int m = 0; m < 4; ++m) tt[m] = seqstart ? ((gbase + 16 * m) & (SEQ - 1)) : 2; }
#pragma unroll
            for (int n = 0; n < 2; ++n) {
                conv4(acc[ai][0][0][n], acc[ai][0][1][n], acc[ai][0][2][n], acc[ai][0][3][n], rs, tt, cw + f0 + 4 * n, cb + f0 + 4 * n, fr);
                asm volatile("" ::: "memory");
                conv4(acc[ai][1][0][n], acc[ai][1][1][n], acc[ai][1][2][n], acc[ai][1][3][n], rs, tt, cw + FF + f0 + 4 * n, cb + FF + f0 + 4 * n, fr);
                asm volatile("" ::: "memory");
#pragma unroll
                for (int m = 0; m < 4; ++m) { const int g = gbase + 16 * m;
                    if ((m > 0 || fr >= 2) && g < M) { const f32x4 gt = acc[ai][0][m][n], vl = acc[ai][1][m][n]; f32x4 o;
#pragma unroll
                        for (int e = 0; e < 4; ++e) o[e] = gt[e] * sigmoidf_(gt[e]) * vl[e];
                        u32x2 w; w.x = cvt_pk_bf16(o[0], o[1]); w.y = cvt_pk_bf16(o[2], o[3]);
                        *(u32x2*)(ACT + (size_t)g * FF + f0 + 4 * n) = w; } }
            }
        }
    }
};
struct EpiRkv {
    static constexpr bool PERM = true;
    bf16_t* R; bf16_t* WA; bf16_t* GL; int row_off, pn_off;
    __device__ __forceinline__ void operator()(const f32x4 (&acc)[2][2][4][2], const Unit& u, int wr, int wc, int fr, int fq) const {
        const int pne = u.pn + pn_off; const int mode = pne < 12 ? 0 : (pne == 12 ? 1 : 2);
        bf16_t* base; int ldc, colt;
        if (mode == 0) { base = R + (size_t)(pne >> 2) * ((size_t)M * D); ldc = D; colt = (pne & 3) * 256 + wc * 32 + 8 * fq; }
        else if (mode == 1) { base = WA; ldc = 128; colt = wc * 32 + 8 * fq; }
        else { base = GL; ldc = 256; colt = wc * 32 + 8 * fq; }
#pragma unroll
        for (int ai = 0; ai < 2; ++ai)
#pragma unroll
            for (int m = 0; m < 4; ++m) { const int row = row_off + u.pm * 256 + ai * 128 + wr * 64 + m * 16 + fr;
                bf16_t* rowp = base + (size_t)row * ldc + colt;
#pragma unroll
                for (int bj = 0; bj < 2; ++bj) { f32x4 v0 = acc[ai][bj][m][0], v1 = acc[ai][bj][m][1];
                    if (mode == 1) { if (bj == 1) continue;
                        if (wc < 2) {
#pragma unroll
                            for (int e = 0; e < 4; ++e) { v0[e] = tanhf(v0[e]); v1[e] = tanhf(v1[e]); } } }
                    else if (mode == 2) {
#pragma unroll
                        for (int e = 0; e < 4; ++e) { v0[e] = sigmoidf_(v0[e]); v1[e] = sigmoidf_(v1[e]); } }
                    u32x4 w; w.x = cvt_pk_bf16(v0[0], v0[1]); w.y = cvt_pk_bf16(v0[2], v0[3]); w.z = cvt_pk_bf16(v1[0], v1[1]); w.w = cvt_pk_bf16(v1[2], v1[3]);
                    *(u32x4*)(rowp + bj * 128) = w; } }
    }
};

typedef const __attribute__((address_space(4))) Args* CA;
struct Ctx { LAS unsigned char* lds; int tid, lane, wave, G, bid; };

__device__ __forceinline__ void conv_mat(const Ctx& c, const float* src, int ldsrc, int K, int N, int Kp, int Np, bf16_t* dst, int ldd, int n_off, int k_off, const float* sc, int mode, int rot) {
    LAS float* tile = (LAS float*)c.lds;
    const int nnb = Np / 64, nit = (Kp / 64) * nnb; const int start = (c.bid + c.G - (rot % c.G)) % c.G;
    for (int it = start; it < nit; it += c.G) {
        const int kb = it / nnb, nb = it % nnb, k0 = kb * 64, n0 = nb * 64;
#pragma unroll
        for (int j = 0; j < 2; ++j) { const int kk = (c.tid >> 4) + 32 * j, nn = (c.tid & 15) * 4, k = k0 + kk, n = n0 + nn; f32x4 v = (f32x4){0.f, 0.f, 0.f, 0.f};
            if (src && k < K && n < N) { v = *(const f32x4*)(src + (size_t)k * ldsrc + n); if (mode == 1) v = v * sc[k]; else if (mode == 2) v = v * (1.f - sc[k]); }
            tile[nn * 65 + kk] = v.x; tile[(nn + 1) * 65 + kk] = v.y; tile[(nn + 2) * 65 + kk] = v.z; tile[(nn + 3) * 65 + kk] = v.w; }
        __syncthreads();
        { const int nn = c.tid >> 3, cc = c.tid & 7; const LAS float* s = tile + nn * 65 + 8 * cc;
            u32x4 o; o.x = cvt_pk_bf16(s[0], s[1]); o.y = cvt_pk_bf16(s[2], s[3]); o.z = cvt_pk_bf16(s[4], s[5]); o.w = cvt_pk_bf16(s[6], s[7]);
            *(u32x4*)(dst + (size_t)(n_off + n0 + nn) * ldd + k_off + k0 + 8 * cc) = o; }
        __syncthreads();
    }
}

__device__ __forceinline__ void phase_static_weights(const Ctx& c, CA a, int j);
__device__ __forceinline__ void phase_prologue(const Ctx& c, CA a) {
    float* ss = (float*)(a->ws + WS_PA);
    const int gw = c.bid * 8 + c.wave, NGW = c.G * 8;
    bf16_t* hb = (bf16_t*)(a->ws + WS_A);
    for (int m = gw; m < M; m += NGW) {
        const f32x4* xr = (const f32x4*)(a->in[I_X] + (size_t)m * D) + c.lane; u32x2* br = (u32x2*)(hb + (size_t)m * D) + c.lane;
        float s = 0.f;
#pragma unroll
        for (int j = 0; j < 4; ++j) { const f32x4 v = xr[64 * j]; s += (v.x * v.x + v.y * v.y) + (v.z * v.z + v.w * v.w); u32x2 w; w.x = cvt_pk_bf16(v.x, v.y); w.y = cvt_pk_bf16(v.z, v.w); br[64 * j] = w; }
        s = wave_sum(s); if (c.lane < 16) ss[(size_t)m * 16 + c.lane] = c.lane == 0 ? s : 0.f;
    }
    phase_static_weights(c, a, 0);
}
__device__ __forceinline__ void phase_static_weights(const Ctx& c, CA a, int j) {
    int rot = 0;
    {
        unsigned char* wj = a->ws + WS_WSTAT + (size_t)j * WJ_STRIDE;
        conv_mat(c, a->in[I_SWIN] + (size_t)j * D * 2048, 2048, D, 2048, D, 2048, (bf16_t*)(wj + WJ_IN), D, 0, 0, a->in[I_NMIX] + (size_t)(2 * j) * D, 1, rot); rot += 512;
        conv_mat(c, a->in[I_SWOUT] + (size_t)j * D * D, D, D, D, D, D, (bf16_t*)(wj + WJ_OUT), D, 0, 0, nullptr, 0, rot); rot += 256;
        const float* mu = a->in[I_MU] + (size_t)j * 6 * D; bf16_t* rkv3 = (bf16_t*)(wj + WJ_RKV); bf16_t* rkv = (bf16_t*)(wj + WJ_RKV + 6 * MiB) - (size_t)3072 * 2048;
#define CONV_BIG(IDX, Q, MUB) do { conv_mat(c, a->in[IDX] + (size_t)j * D * D, D, D, D, D, D, rkv3, 1024, (Q) * 1024, 0, nullptr, 0, rot); rot += 256; } while (0)
        CONV_BIG(I_WR, 0, 0); CONV_BIG(I_WK, 1, 2); CONV_BIG(I_WV, 2, 3);
#undef CONV_BIG
        conv_mat(c, a->in[I_W1] + (size_t)j * D * 64, 64, D, 64, D, 64, rkv, 2048, 3072, 0, mu + 1 * D, 2, rot); rot += 16;
        conv_mat(c, a->in[I_W1] + (size_t)j * D * 64, 64, D, 64, D, 64, rkv, 2048, 3072, 1024, mu + 1 * D, 1, rot); rot += 16;
        conv_mat(c, a->in[I_A1] + (size_t)j * D * 64, 64, D, 64, D, 64, rkv, 2048, 3136, 0, mu + 4 * D, 2, rot); rot += 16;
        conv_mat(c, a->in[I_A1] + (size_t)j * D * 64, 64, D, 64, D, 64, rkv, 2048, 3136, 1024, mu + 4 * D, 1, rot); rot += 16;
        conv_mat(c, nullptr, 0, 0, 0, 2048, 128, rkv, 2048, 3200, 0, nullptr, 0, rot); rot += 64;
        conv_mat(c, a->in[I_G1] + (size_t)j * D * 160, 160, D, 160, D, 256, rkv, 2048, 3328, 0, mu + 5 * D, 2, rot); rot += 64;
        conv_mat(c, a->in[I_G1] + (size_t)j * D * 160, 160, D, 160, D, 256, rkv, 2048, 3328, 1024, mu + 5 * D, 1, rot); rot += 64;
        bf16_t* l2wa = (bf16_t*)(wj + WJ_L2WA);
        conv_mat(c, a->in[I_W2] + (size_t)j * 64 * D, D, 64, D, 64, D, l2wa, 128, 0, 0, nullptr, 0, rot); rot += 16;
        conv_mat(c, nullptr, 0, 0, 0, 64, D, l2wa, 128, 0, 64, nullptr, 0, rot); rot += 16;
        conv_mat(c, nullptr, 0, 0, 0, 64, D, l2wa, 128, 1024, 0, nullptr, 0, rot); rot += 16;
        conv_mat(c, a->in[I_A2] + (size_t)j * 64 * D, D, 64, D, 64, D, l2wa, 128, 1024, 64, nullptr, 0, rot); rot += 16;
        conv_mat(c, a->in[I_G2] + (size_t)j * 160 * D, D, 160, D, 256, D, (bf16_t*)(wj + WJ_L2G), 256, 0, 0, nullptr, 0, rot); rot += 64;
        conv_mat(c, a->in[I_WO] + (size_t)j * D * D, D, D, D, D, D, (bf16_t*)(wj + WJ_O), D, 0, 0, nullptr, 0, rot); rot += 256;
    }
}
__device__ __forceinline__ void phase_ffn_weights(const Ctx& c, CA a, int layer) {
    for (int pn = 0; pn < FF / 128; ++pn) {
        conv_mat(c, a->in[I_FUP] + (size_t)layer * D * FF2 + pn * 128, FF2, D, 128, D, 128, (bf16_t*)(a->ws + WS_WFFN), D, pn * 256, 0, a->in[I_NFFN] + (size_t)layer * D, 1, pn * 64);
        conv_mat(c, a->in[I_FUP] + (size_t)layer * D * FF2 + FF + pn * 128, FF2, D, 128, D, 128, (bf16_t*)(a->ws + WS_WFFN), D, pn * 256 + 128, 0, a->in[I_NFFN] + (size_t)layer * D, 1, pn * 64 + 32);
    }
    conv_mat(c, a->in[I_FDN] + (size_t)layer * FF * D, D, FF, D, FF, D, (bf16_t*)(a->ws + WS_WDOWN), FF, 0, 0, nullptr, 0, 128);
}

__device__ __forceinline__ void phase_sgu_spatial(const Ctx& c, CA a, int j, int rp) {
    typedef short bf16x8 __attribute__((ext_vector_type(8)));
    bf16_t* U = (bf16_t*)(a->ws + P_U); const bf16_t* V = (const bf16_t*)(a->ws + P_SV); bf16_t* UO = rp ? (bf16_t*)(a->ws + P_SV) : U;
    const float* ssv = (const float*)(a->ws + WS_PV);
    LAS bf16_t* WL = (LAS bf16_t*)c.lds; LAS bf16_t* VT = WL + 128 * 136;
    const int g = c.bid & 15;
    const float* Ws = a->in[I_SWS] + ((size_t)j * 16 + g) * 128 * 128; const float* bs = a->in[I_SBS] + ((size_t)j * 16 + g) * 128; const float* gv = a->in[I_SGV] + (size_t)j * D + g * 64;
    __syncthreads();
    { const int t = c.tid >> 2, s0 = (c.tid & 3) * 32; const float* wp = Ws + (size_t)t * 128 + s0;
#pragma unroll
      for (int q = 0; q < 4; ++q) { f32x4 x0 = *(const f32x4*)(wp + 8 * q), x1 = *(const f32x4*)(wp + 8 * q + 4);
#pragma unroll
          for (int e = 0; e < 4; ++e) { if (s0 + 8 * q + e > t) x0[e] = 0.f; if (s0 + 8 * q + 4 + e > t) x1[e] = 0.f; }
          u32x4 w; w.x = cvt_pk_bf16(x0[0], x0[1]); w.y = cvt_pk_bf16(x0[2], x0[3]); w.z = cvt_pk_bf16(x1[0], x1[1]); w.w = cvt_pk_bf16(x1[2], x1[3]);
          *(LAS u32x4*)(WL + t * 136 + s0 + 8 * q) = w; } }
    const int w8 = c.wave, fr = c.lane & 15, fq = c.lane >> 4, t0 = 16 * w8, nk = (w8 >> 1) + 1;
    const int vs = c.tid >> 2, vc = (c.tid & 3) * 16;
    f32x4 gq[4];
#pragma unroll
    for (int e = 0; e < 4; ++e) gq[e] = *(const f32x4*)(gv + vc + 4 * e);
    const float bb = bs[t0 + fr];
    for (int ub = c.bid >> 4; ub < M / 128; ub += c.G >> 4) {
        const int m0 = ub * 128;
        { const bf16_t* vp = V + (size_t)(m0 + vs) * D + g * 64 + vc; const u32x4 v0 = *(const u32x4*)vp, v1 = *(const u32x4*)(vp + 8);
          const float rs = row_rstd(ssv, m0 + vs);
          const unsigned vw[8] = {v0.x, v0.y, v0.z, v0.w, v1.x, v1.y, v1.z, v1.w};
#pragma unroll
          for (int e = 0; e < 8; ++e) { const float lo = bflo(vw[e]) * rs * gq[e >> 1][(2 * e) & 3], hi = bfhi(vw[e]) * rs * gq[e >> 1][(2 * e + 1) & 3];
              const unsigned pk = cvt_pk_bf16(lo, hi);
              VT[(vc + 2 * e) * 136 + vs] = (bf16_t)(pk & 0xffffu); VT[(vc + 2 * e + 1) * 136 + vs] = (bf16_t)(pk >> 16); } }
        __syncthreads();
        f32x4 acc[4];
#pragma unroll
        for (int ct = 0; ct < 4; ++ct) acc[ct] = (f32x4){0.f, 0.f, 0.f, 0.f};
        for (int k = 0; k < nk; ++k) {
            const bf16x8 wf = *(const LAS bf16x8*)(WL + (t0 + fr) * 136 + 32 * k + 8 * fq);
#pragma unroll
            for (int ct = 0; ct < 4; ++ct) { const bf16x8 vf = *(const LAS bf16x8*)(VT + (16 * ct + fr) * 136 + 32 * k + 8 * fq);
                acc[ct] = __builtin_amdgcn_mfma_f32_16x16x32_bf16(vf, wf, acc[ct], 0, 0, 0); }
        }
        { const size_t ro = (size_t)(m0 + t0 + fr) * D + g * 64 + 4 * fq;
#pragma unroll
          for (int ct = 0; ct < 4; ++ct) { const u32x2 uu = *(const u32x2*)(U + ro + 16 * ct); const f32x4 o = acc[ct] + bb;
              u32x2 w; w.x = cvt_pk_bf16(bflo(uu.x) * o[0], bfhi(uu.x) * o[1]); w.y = cvt_pk_bf16(bflo(uu.y) * o[2], bfhi(uu.y) * o[3]);
              *(u32x2*)(UO + ro + 16 * ct) = w; } }
        __syncthreads();
    }
}

__device__ __forceinline__ void phase_ffn_conv(const Ctx& c, CA a, int layer, int half) {
    const bf16_t* Z = (const bf16_t*)(a->ws + P_Z); bf16_t* ACT = (bf16_t*)(a->ws + P_ACT) + (size_t)half * (M / 2) * FF;
    const float* cw = a->in[I_FCW] + (size_t)layer * 3 * FF2; const float* cb = a->in[I_FCB] + (size_t)layer * FF2;
    const int gt = c.bid * 512 + c.tid, NT = c.G * 512;
    for (int idx = gt; idx < (M / 2) * (FF / 8); idx += NT) {
        const int ml = idx / (FF / 8), f = (idx % (FF / 8)) * 8, t = ml & (SEQ - 1);
        float gsum[8], vsum[8];
#pragma unroll
        for (int e = 0; e < 8; ++e) { gsum[e] = cb[f + e]; vsum[e] = cb[FF + f + e]; }
#pragma unroll
        for (int jj = 0; jj < 3; ++jj) { const int dt = 2 - jj; if (t - dt < 0) continue;
            const u32x4 zg = *(const u32x4*)(Z + (size_t)(ml - dt) * FF2 + f), zv = *(const u32x4*)(Z + (size_t)(ml - dt) * FF2 + FF + f);
            const float* wg = cw + (size_t)jj * FF2 + f; const float* wv = wg + FF;
            const unsigned zgw[4] = {zg.x, zg.y, zg.z, zg.w}, zvw[4] = {zv.x, zv.y, zv.z, zv.w};
#pragma unroll
            for (int e = 0; e < 4; ++e) { gsum[2 * e] += wg[2 * e] * bflo(zgw[e]); gsum[2 * e + 1] += wg[2 * e + 1] * bfhi(zgw[e]); vsum[2 * e] += wv[2 * e] * bflo(zvw[e]); vsum[2 * e + 1] += wv[2 * e + 1] * bfhi(zvw[e]); } }
        float o[8];
#pragma unroll
        for (int e = 0; e < 8; ++e) o[e] = gsum[e] * sigmoidf_(gsum[e]) * vsum[e];
        u32x4 w; w.x = cvt_pk_bf16(o[0], o[1]); w.y = cvt_pk_bf16(o[2], o[3]); w.z = cvt_pk_bf16(o[4], o[5]); w.w = cvt_pk_bf16(o[6], o[7]);
        *(u32x4*)(ACT + (size_t)ml * FF + f) = w;
    }
}

__device__ __forceinline__ void phase_rwkv_prep(const Ctx& c, CA a, int layer, int mode) {
    const float* ss = (const float*)(a->ws + WS_PA); const float* g = a->in[I_NMIX] + (size_t)layer * D; const float* mu = a->in[I_MU] + (size_t)(layer >> 1) * 6 * D;
    bf16_t* hn = (bf16_t*)(a->ws + WS_A); bf16_t* X = (bf16_t*)(a->ws + P_LW);
    const int gw = c.bid * 8 + c.wave, NGW = c.G * 8;
    f32x4 gg[4], mr[4], mk[4], mv[4];
#pragma unroll
    for (int j = 0; j < 4; ++j) { gg[j] = *((const f32x4*)g + c.lane + 64 * j); mr[j] = *((const f32x4*)mu + c.lane + 64 * j); mk[j] = *((const f32x4*)(mu + 2 * D) + c.lane + 64 * j); mv[j] = *((const f32x4*)(mu + 3 * D) + c.lane + 64 * j); }
    for (int m = gw + (mode ? M / 2 : 0); m < M; m += NGW) {
        const float rs = row_rstd(ss, m); const int t = m & (SEQ - 1);
        const f32x4* hr = (const f32x4*)(a->out + (size_t)m * D) + c.lane;
        f32x4 cur[4];
#pragma unroll
        for (int j = 0; j < 4; ++j) cur[j] = hr[64 * j] * rs * gg[j];
        if (mode == 0) { const int prow = (m >> 12) * SEQP + PADR + t; u32x2* br = (u32x2*)(hn + (size_t)prow * D) + c.lane;
#pragma unroll
            for (int j = 0; j < 4; ++j) { u32x2 w; w.x = cvt_pk_bf16(cur[j].x, cur[j].y); w.y = cvt_pk_bf16(cur[j].z, cur[j].w); br[64 * j] = w; } }
        if (mode == 1 || m < M / 2) {
            const float rsp = t > 0 ? row_rstd(ss, m - 1) : 0.f; const f32x4* hp = (const f32x4*)(a->out + (size_t)(t > 0 ? m - 1 : m) * D) + c.lane;
            const size_t lo = (size_t)(m & (M / 2 - 1)) * D;
            u32x2* xr = (u32x2*)(X + lo) + c.lane; u32x2* xk = (u32x2*)(X + (size_t)(M / 2) * D + lo) + c.lane; u32x2* xv = (u32x2*)(X + (size_t)M * D + lo) + c.lane;
#pragma unroll
            for (int j = 0; j < 4; ++j) { const f32x4 dl = hp[64 * j] * rsp * gg[j] - cur[j];
                const f32x4 vr = cur[j] + dl * mr[j], vk = cur[j] + dl * mk[j], vv = cur[j] + dl * mv[j]; u32x2 w;
                w.x = cvt_pk_bf16(vr.x, vr.y); w.y = cvt_pk_bf16(vr.z, vr.w); xr[64 * j] = w;
                w.x = cvt_pk_bf16(vk.x, vk.y); w.y = cvt_pk_bf16(vk.z, vk.w); xk[64 * j] = w;
                w.x = cvt_pk_bf16(vv.x, vv.y); w.y = cvt_pk_bf16(vv.z, vv.w); xv[64 * j] = w; }
        }
    }
    if (mode == 0) for (int r = gw; r < BATCH * PADR; r += NGW) { const int prow = (r / PADR) * SEQP + (r % PADR); u32x2* br = (u32x2*)(hn + (size_t)prow * D) + c.lane;
#pragma unroll
        for (int j = 0; j < 4; ++j) br[64 * j] = (u32x2){0u, 0u}; }
}

__device__ __forceinline__ f32x4 bf4(u32x2 w) { return (f32x4){bflo(w.x), bfhi(w.x), bflo(w.y), bfhi(w.y)}; }
__device__ __forceinline__ float hsum4(f32x4 p) { return (p.x + p.y) + (p.z + p.w); }
__device__ __forceinline__ float sum16(float v) { v = sum8(v); v += dpp_f<0x140>(v); return v; }
__device__ __forceinline__ f32x4 bf4lo(u32x4 w) { return (f32x4){bflo(w.x), bfhi(w.x), bflo(w.y), bfhi(w.y)}; }
__device__ __forceinline__ f32x4 bf4hi(u32x4 w) { return (f32x4){bflo(w.z), bfhi(w.z), bflo(w.w), bfhi(w.w)}; }
__device__ __forceinline__ void phase_scan(const Ctx& c, CA a, int j, int rp_out) {
    constexpr int CH = 32, NCH = SEQ / CH, VSZ = CH * 64, YSZ = CH * 32;
    LAS float* BIG = (LAS float*)c.lds; LAS float* VB = BIG + 2 * 5 * VSZ; LAS float* YB = VB + 4 * VSZ; LAS float* BON = YB + 3 * YSZ;
    bf16_t* R = (bf16_t*)(a->ws + P_R); const bf16_t* Kb = (const bf16_t*)(a->ws + P_K); const bf16_t* Vb = (const bf16_t*)(a->ws + P_V);
    const bf16_t* LWb = (const bf16_t*)(a->ws + P_LW); const bf16_t* LAb = (const bf16_t*)(a->ws + P_LA); const bf16_t* Gb = (const bf16_t*)(a->ws + WS_A);
    if (c.G != 256) return;
    const int unit = c.bid, b = unit >> 5, hh = (unit >> 1) & 15, half = unit & 1;
    unsigned long long* slot_own = (unsigned long long*)(a->ws + WS_XS) + (size_t)(j * 256 + unit) * 256; const unsigned long long* slot_par = (const unsigned long long*)(a->ws + WS_XS) + (size_t)(j * 256 + (unit ^ 1)) * 256;
    const bool cons = c.tid < 256;
    __syncthreads();
    if (cons) {
        const int rp = c.tid >> 3, q = c.tid & 7, row = 32 * half + rp;
        f32x4 S0 = (f32x4){0.f, 0.f, 0.f, 0.f}, S1 = S0;
        __builtin_amdgcn_s_setprio(2);
        __syncthreads();
        for (int i = 0; i <= NCH + 1; ++i) {
            if (i < NCH) {
                const LAS float* bg = BIG + (i & 1) * 5 * VSZ + 8 * q;
                const LAS f32x4* pw = (const LAS f32x4*)bg; const LAS f32x4* pa = (const LAS f32x4*)(bg + VSZ); const LAS f32x4* pb = (const LAS f32x4*)(bg + 2 * VSZ);
                const LAS f32x4* pk = (const LAS f32x4*)(bg + 3 * VSZ); const LAS f32x4* pr = (const LAS f32x4*)(bg + 4 * VSZ);
                const LAS float* pv = VB + (i & 3) * VSZ + row; LAS float* py = YB + (i % 3) * YSZ + rp;
                f32x4 a0v = pa[0], a1v = pa[1], w0v = pw[0], w1v = pw[1], b0v = pb[0], b1v = pb[1], k0v = pk[0], k1v = pk[1], r0v = pr[0], r1v = pr[1];
                float vv = pv[0];
#pragma unroll 2
                for (int t = 0; t < CH; ++t) {
                    const int tn = (t + 1) & (CH - 1);
                    const f32x4 na0 = pa[tn * 16], na1 = pa[tn * 16 + 1], nw0 = pw[tn * 16], nw1 = pw[tn * 16 + 1], nb0 = pb[tn * 16], nb1 = pb[tn * 16 + 1],
                                nk0 = pk[tn * 16], nk1 = pk[tn * 16 + 1], nr0 = pr[tn * 16], nr1 = pr[tn * 16 + 1];
                    const float nvv = pv[tn * 64];
                    const float sa = sum8(hsum4(S0 * a0v + S1 * a1v));
                    S0 = S0 * w0v + sa * b0v + vv * k0v; S1 = S1 * w1v + sa * b1v + vv * k1v;
                    const float y = sum8(hsum4(S0 * r0v + S1 * r1v));
                    if (q == 0) py[t * 32] = y;
                    a0v = na0; a1v = na1; w0v = nw0; w1v = nw1; b0v = nb0; b1v = nb1; k0v = nk0; k1v = nk1; r0v = nr0; r1v = nr1; vv = nvv;
                }
            }
            __syncthreads();
        }
        __builtin_amdgcn_s_setprio(0);
    } else {
        const int pt = c.tid - 256, st = pt >> 3, l8 = pt & 7, sc = l8 * 8, ch = hh * 64 + sc;
        const float* pp = a->in[I_W0] + (size_t)j * D + ch; const f32x4 w0a = *(const f32x4*)pp, w0b = *(const f32x4*)(pp + 4);
        pp = a->in[I_A0] + (size_t)j * D + ch; const f32x4 a0a = *(const f32x4*)pp, a0b = *(const f32x4*)(pp + 4);
        pp = a->in[I_KK] + (size_t)j * D + ch; const f32x4 kka = *(const f32x4*)pp, kkb = *(const f32x4*)(pp + 4);
        pp = a->in[I_KA] + (size_t)j * D + ch; const f32x4 kaa = *(const f32x4*)pp, kab = *(const f32x4*)(pp + 4);
        pp = a->in[I_RK] + (size_t)j * D + ch; const f32x4 rka = *(const f32x4*)pp, rkb = *(const f32x4*)(pp + 4);
        const int oc = 4 * l8, cho = hh * 64 + 32 * half + oc;
        const f32x4 lnw = *(const f32x4*)(a->in[I_LNW] + (size_t)j * D + cho), lnb = *(const f32x4*)(a->in[I_LNB] + (size_t)j * D + cho);
        const size_t gbase = ((size_t)b * SEQ + st) * D + ch, obase = ((size_t)b * SEQ + st) * D + cho;
        u32x4 qr = *(const u32x4*)(R + gbase), qk = *(const u32x4*)(Kb + gbase), qv = *(const u32x4*)(Vb + gbase), qlw = *(const u32x4*)(LWb + gbase), qla = *(const u32x4*)(LAb + gbase);
        u32x2 qg = (u32x2){0u, 0u};
#define SCAN_STAGE(n) { \
            f32x4 rr[2] = {bf4lo(qr), bf4hi(qr)}, kk_[2] = {bf4lo(qk), bf4hi(qk)}, vv_[2] = {bf4lo(qv), bf4hi(qv)}, lw_[2] = {bf4lo(qlw), bf4hi(qlw)}, la_[2] = {bf4lo(qla), bf4hi(qla)}; \
            const f32x4 w0_[2] = {w0a, w0b}, a0_[2] = {a0a, a0b}, kkp_[2] = {kka, kkb}, kap_[2] = {kaa, kab}, rkp_[2] = {rka, rkb}; \
            f32x4 dec[2], av[2], kn[2], kp[2]; float n2 = 0.f, bon = 0.f; \
            _Pragma("unroll") for (int h2 = 0; h2 < 2; ++h2) _Pragma("unroll") for (int e = 0; e < 4; ++e) { \
                const float xw = -(w0_[h2][e] + lw_[h2][e]); const float sp = xw > 20.f ? xw : __logf(1.f + __expf(xw)); \
                dec[h2][e] = __expf(-__expf(-sp - 0.5f)); av[h2][e] = __builtin_amdgcn_rcpf(1.f + __expf(-(a0_[h2][e] + la_[h2][e]))); \
                kn[h2][e] = kk_[h2][e] * kkp_[h2][e]; n2 += kn[h2][e] * kn[h2][e]; \
                kp[h2][e] = kk_[h2][e] * (1.f + (av[h2][e] - 1.f) * kap_[h2][e]); bon += rr[h2][e] * kp[h2][e] * rkp_[h2][e]; } \
            n2 = sum8(n2); bon = sum8(bon); const float inv = rsqrtf(fmaxf(n2, 1e-24f)); \
            LAS float* bg = BIG + ((n) & 1) * 5 * VSZ + st * 64 + sc; \
            _Pragma("unroll") for (int h2 = 0; h2 < 2; ++h2) { const f32x4 kq = kn[h2] * inv; \
                *(LAS f32x4*)(bg + 4 * h2) = dec[h2]; *(LAS f32x4*)(bg + VSZ + 4 * h2) = -kq; *(LAS f32x4*)(bg + 2 * VSZ + 4 * h2) = kq * av[h2]; \
                *(LAS f32x4*)(bg + 3 * VSZ + 4 * h2) = kp[h2]; *(LAS f32x4*)(bg + 4 * VSZ + 4 * h2) = rr[h2]; \
                *(LAS f32x4*)(VB + ((n) & 3) * VSZ + st * 64 + sc + 4 * h2) = vv_[h2]; } \
            if (l8 == 0) BON[((n) & 3) * CH + st] = bon; }
#define SCAN_YSTATS(n) \
            const f32x4 y = *(const LAS f32x4*)(YB + ((n) % 3) * YSZ + st * 32 + oc); \
            const float mh = sum8(hsum4(y)) * (1.f / 32.f); const f32x4 d = y - mh; const float m2h = sum8(hsum4(d * d));
        SCAN_STAGE(0)
        { const size_t go = gbase + (size_t)CH * D; qr = *(const u32x4*)(R + go); qk = *(const u32x4*)(Kb + go); qv = *(const u32x4*)(Vb + go); qlw = *(const u32x4*)(LWb + go); qla = *(const u32x4*)(LAb + go); }
        __syncthreads();
        for (int i = 0; i <= NCH + 1; ++i) {
            unsigned long long pw0 = 0ull, pw1 = 0ull; const unsigned long long* pp_ = slot_par + (((i - 2) & 3) * CH + st) * 2;
            if (i >= 2) { pw0 = __hip_atomic_load(pp_, __ATOMIC_RELAXED, __HIP_MEMORY_SCOPE_AGENT); pw1 = __hip_atomic_load(pp_ + 1, __ATOMIC_RELAXED, __HIP_MEMORY_SCOPE_AGENT); }
            if (i >= 1 && i <= NCH) {
                const int n = i - 1;
                SCAN_YSTATS(n)
                if (l8 == 0) { const unsigned long long tg = (unsigned long long)(unsigned)(n + 1) << 32; unsigned long long* sp_ = slot_own + ((n & 3) * CH + st) * 2;
                    __hip_atomic_store(sp_, tg | __float_as_uint(mh), __ATOMIC_RELAXED, __HIP_MEMORY_SCOPE_AGENT); __hip_atomic_store(sp_ + 1, tg | __float_as_uint(m2h), __ATOMIC_RELAXED, __HIP_MEMORY_SCOPE_AGENT); }
            }
            u32x4 nr = qr, nk = qk, nv = qv, nlw = qlw, nla = qla; u32x2 ng = qg;
            if (i + 2 < NCH) { const size_t go = gbase + (size_t)(i + 2) * CH * D; nr = *(const u32x4*)(R + go); nk = *(const u32x4*)(Kb + go); nv = *(const u32x4*)(Vb + go); nlw = *(const u32x4*)(LWb + go); nla = *(const u32x4*)(LAb + go); }
            if (i >= 1 && i <= NCH) ng = *(const u32x2*)(Gb + obase + (size_t)(i - 1) * CH * D);
            if (i + 1 < NCH) { SCAN_STAGE(i + 1) }
            if (i >= 2) {
                const int n = i - 2; const unsigned tag = (unsigned)(n + 1); unsigned sp = 0;
                while ((unsigned)(pw0 >> 32) != tag) { __builtin_amdgcn_s_sleep(1); if (++sp > (1u << 18)) break; pw0 = __hip_atomic_load(pp_, __ATOMIC_RELAXED, __HIP_MEMORY_SCOPE_AGENT); }
                while ((unsigned)(pw1 >> 32) != tag) { __builtin_amdgcn_s_sleep(1); if (++sp > (1u << 18)) break; pw1 = __hip_atomic_load(pp_ + 1, __ATOMIC_RELAXED, __HIP_MEMORY_SCOPE_AGENT); }
                const float mp = __uint_as_float((unsigned)pw0), m2p = __uint_as_float((unsigned)pw1);
                SCAN_YSTATS(n)
                const float mean = 0.5f * (mh + mp), dm = mh - mp; const float rstd = rsqrtf((m2h + m2p + 16.f * dm * dm) * (1.f / 64.f) + GN_EPS);
                const f32x4 v = *(const LAS f32x4*)(VB + (n & 3) * VSZ + st * 64 + 32 * half + oc); const float bon = BON[(n & 3) * CH + st];
                const f32x4 o = ((y - mean) * rstd * lnw + lnb + bon * v) * bf4(qg);
                u32x2 w; w.x = cvt_pk_bf16(o.x, o.y); w.y = cvt_pk_bf16(o.z, o.w);
                *(u32x2*)(R + obase + (size_t)n * CH * D) = w;
            }
            qg = ng; qr = nr; qk = nk; qv = nv; qlw = nlw; qla = nla;
            __syncthreads();
        }
#undef SCAN_STAGE
#undef SCAN_YSTATS
    }
}

__device__ __forceinline__ void phase_final(const Ctx& c, CA a) {
    const float* ss = (const float*)(a->ws + WS_PA); const float* g = a->in[I_NFIN];
    const int gw = c.bid * 8 + c.wave, NGW = c.G * 8;
    f32x4 gg[4];
#pragma unroll
    for (int j = 0; j < 4; ++j) gg[j] = *((const f32x4*)g + c.lane + 64 * j);
    for (int m = gw; m < M; m += NGW) {
        const float rs = row_rstd(ss, m);
        f32x4* hr = (f32x4*)(a->out + (size_t)m * D) + c.lane;
#pragma unroll
        for (int j = 0; j < 4; ++j) hr[64 * j] = hr[64 * j] * rs * gg[j];
    }
}

#define XB_TMO      128
#define XB_XCNT(j)  (256  + 64 * (j))
#define XB_XSUB(j)  (1280 + 64 * (j))
#define XB_XGEN(j)  (2304 + 64 * (j))
#define XB_TOP      3328
#define XB_TOPGEN   3392
#define XCD_BAR_WORDS 3456
#define XB_SPIN_CAP (1u << 18)

__device__ __forceinline__ unsigned xb_ld(unsigned* p)              { return __hip_atomic_load(p, __ATOMIC_RELAXED, __HIP_MEMORY_SCOPE_AGENT); }
__device__ __forceinline__ unsigned xb_add(unsigned* p, unsigned v) { return __hip_atomic_fetch_add(p, v, __ATOMIC_RELAXED, __HIP_MEMORY_SCOPE_AGENT); }
__device__ __forceinline__ unsigned xb_xcc_id() { return (unsigned)__builtin_amdgcn_s_getreg((3 << 11) | 20) & 0xFu; }
#define XB_SPIN(cond, bar) do { unsigned _sp = 0; while (cond) { __builtin_amdgcn_s_sleep(1); \
    if ((++_sp & 255u) == 0u) { if (xb_ld(&(bar)[XB_TMO])) break; if (_sp > XB_SPIN_CAP) { atomicAdd(&(bar)[XB_TMO], 1u); break; } } } } while (0)

struct XcdBarrier {
    unsigned* bar; unsigned x;
    volatile LAS unsigned* st;
};

__device__ __forceinline__ XcdBarrier xcd_barrier_post(unsigned* bar, volatile LAS unsigned* st) {
    XcdBarrier b; b.bar = bar; b.x = xb_xcc_id(); b.st = st;
    if (threadIdx.x == 0) (void)xb_add(&bar[XB_XCNT(b.x)], 1u);
    return b;
}
__device__ __forceinline__ void xcd_barrier_complete(unsigned* bar, unsigned x, unsigned& nloc, unsigned& nx) {
    const unsigned G = gridDim.x * gridDim.y * gridDim.z;
    unsigned sum, cnt, mine, sp = 0u;
    for (;;) {
        sum = 0u; cnt = 0u; mine = 0u;
#pragma unroll
        for (unsigned j = 0; j < 16; ++j) { const unsigned c = xb_ld(&bar[XB_XCNT(j)]); sum += c; cnt += (c > 0u) ? 1u : 0u; mine = (j == x) ? c : mine; }
        if (sum == G) break;
        __builtin_amdgcn_s_sleep(1);
        if ((++sp & 255u) == 0u) { if (xb_ld(&bar[XB_TMO])) break; if (sp > XB_SPIN_CAP) { atomicAdd(&bar[XB_TMO], 1u); break; } }
    }
    nloc = mine > 0u ? mine : 1u; nx = cnt > 0u ? cnt : 1u;
}

__device__ __forceinline__ void xcd_barrier(const XcdBarrier& b) {
    asm volatile("s_waitcnt vmcnt(0)" ::: "memory");
    __syncthreads();
    if (threadIdx.x == 0) {
        unsigned* bar = b.bar;
        __builtin_amdgcn_s_waitcnt(0);
        unsigned nloc = b.st[0], nx = b.st[1];
        if (nloc == 0u) { xcd_barrier_complete(bar, b.x, nloc, nx); b.st[0] = nloc; b.st[1] = nx; }
        const unsigned old = xb_add(&bar[XB_XSUB(b.x)], 1u);
        const unsigned gen = old / nloc;
        if (old + 1u == (gen + 1u) * nloc) {
            __builtin_amdgcn_fence(__ATOMIC_RELEASE, "agent");
            asm volatile("s_waitcnt vmcnt(0)" ::: "memory");
            const unsigned og = xb_add(&bar[XB_TOP], 1u);
            const unsigned tg = og / nx;
            if (og + 1u == (tg + 1u) * nx) xb_add(&bar[XB_TOPGEN], 1u);
            else XB_SPIN(xb_ld(&bar[XB_TOPGEN]) == tg, bar);
            __builtin_amdgcn_fence(__ATOMIC_ACQUIRE, "agent");
            xb_add(&bar[XB_XGEN(b.x)], 1u);
            asm volatile("s_waitcnt vmcnt(0)" ::: "memory");
        } else {
            XB_SPIN(xb_ld(&bar[XB_XGEN(b.x)]) == gen, bar);
            __builtin_amdgcn_fence(__ATOMIC_ACQUIRE, "agent");
            asm volatile("s_waitcnt vmcnt(0)" ::: "memory");
        }
    }
    __syncthreads();
}

constexpr int SLOTS = 11, NPH = 2 + 4 * SLOTS;
__host__ __device__ inline bool phase_active(int p) {
    if (p == 0 || p == NPH - 1) return true;
    const int i = (p - 1) / SLOTS, s = (p - 1) % SLOTS;
    if (s >= 8) return s == 8 || s == 10;
    return (i & 1) ? (s <= 5 || s == 7) : (s < 3);
}

__global__ void __launch_bounds__(512, 2) mk_fwd(Args a_) {
    extern __shared__ __attribute__((aligned(16))) unsigned char lds_raw[];
    int tid_ = threadIdx.x, bid_ = blockIdx.x, G_ = gridDim.x;
    volatile LAS unsigned* xst = (volatile LAS unsigned*)((LAS unsigned char*)lds_raw + 131072 + 64);
    if (tid_ < 2) xst[tid_] = 0u;
    __syncthreads();
    const XcdBarrier xbar = xcd_barrier_post((unsigned*)(a_.ws + WS_CTL), xst);
    CA a = (CA)__builtin_amdgcn_kernarg_segment_ptr();
    const int ph_lo = a_.ph_lo, ph_hi = a_.ph_hi;
    for (int p = ph_lo; p < ph_hi; ++p) {
        if (!phase_active(p)) continue;
        const int PL = (p - 1) / SLOTS, PS = (p - 1) % SLOTS; (void)PL; (void)PS;
        const int nrep = (MK_PROBE && p < NPH - 1 && (MK_PROBE_SEL)) ? 2 : 1;
        for (int rp = 0; rp < nrep; ++rp) {
        if (rp) cg::this_grid().sync();
        asm volatile("" : "+s"(a), "+s"(bid_), "+s"(G_)); asm volatile("" : "+v"(tid_));
        Ctx c; c.lds = (LAS unsigned char*)lds_raw; c.tid = tid_; c.lane = c.tid & 63; c.wave = __builtin_amdgcn_readfirstlane(c.tid >> 6); c.G = G_; c.bid = bid_;
        bf16_t* regA = (bf16_t*)(a->ws + WS_A);
        if (p == 0) phase_prologue(c, a);
        else if (p == NPH - 1) phase_final(c, a);
        else {
            const int layer = (p - 1) / SLOTS, s = (p - 1) % SLOTS, j = layer >> 1;
            unsigned char* wj = a->ws + WS_WSTAT + (size_t)j * WJ_STRIDE;
            float* ss_mix = (float*)(a->ws + WS_PA); float* ss_ffn = (float*)(a->ws + WS_PB); float* ss_next = ss_mix;
            if (s < 8 && !(layer & 1)) {
                if (s == 0) {
                    pg8::Gemm g{regA, (const bf16_t*)(wj + WJ_IN), M, 2048, D, D, 0}; pg8::StaticOrder S; S.init(M / 256, 2048, c.G, c.bid);
                    EpiSguIn E{(bf16_t*)(a->ws + P_U), (bf16_t*)(a->ws + P_SV), ss_mix, a->in[I_SBIN] + (size_t)j * 2048, (float*)(a->ws + WS_PV)};
                    pg8::gemm_phase<EpiSguIn, pg8::StaticOrder, 0, false, true>(c.lds, c.tid, g, S, E);
                } else if (s == 1) { phase_ffn_weights(c, a, layer); phase_sgu_spatial(c, a, j, rp); }
                else {
                    pg8::Gemm g{(const bf16_t*)(a->ws + P_U), (const bf16_t*)(wj + WJ_OUT), M, D, D, D, 0}; pg8::StaticOrder S; S.init(M / 256, D, c.G, c.bid);
                    EpiResid E{layer == 0 ? a->in[I_X] : (const float*)a->out, a->out, regA, ss_ffn};
                    pg8::gemm_phase<EpiResid, pg8::StaticOrder, 0, false, true>(c.lds, c.tid, g, S, E);
                }
            } else if (s < 8) {
                if (s == 0) { phase_rwkv_prep(c, a, layer, 0); phase_ffn_weights(c, a, layer); if (layer == 1) phase_static_weights(c, a, 1); }
                else if (s == 2) phase_rwkv_prep(c, a, layer, 1);
                else if (s == 1 || s == 3) {
                    { pg8::Gemm g{(const bf16_t*)(a->ws + P_LW), (const bf16_t*)(wj + WJ_RKV), M / 2, 3072, D, D, (size_t)(M / 2) * D * 2}; pg8::StaticOrder S; S.init(M / 512, 3072, c.G, c.bid);
                      EpiRkv E{(bf16_t*)(a->ws + P_R), (bf16_t*)(a->ws + P_WA), (bf16_t*)(a->ws + P_GL), s == 3 ? M / 2 : 0, 0};
                      pg8::gemm_phase<EpiRkv, pg8::StaticOrder, 3, false, true>(c.lds, c.tid, g, S, E); }
                    if (s == 1) {
                      asm volatile("" : "+s"(a), "+s"(c.bid), "+s"(c.G), "+s"(wj)); asm volatile("" : "+v"(c.tid));
                      pg8::Gemm g{(const bf16_t*)(a->ws + WS_A), (const bf16_t*)(wj + WJ_RKV + 6 * MiB), M, 512, 2048, D, 0}; pg8::StaticOrder S; S.init(M / 256, 512, c.G, c.bid);
                      EpiRkv E{(bf16_t*)(a->ws + P_R), (bf16_t*)(a->ws + P_WA), (bf16_t*)(a->ws + P_GL), 0, 12};
                      pg8::gemm_phase<EpiRkv, pg8::StaticOrder, 1, true, true>(c.lds, c.tid, g, S, E); }
                } else if (s == 4) {
                    { int kq = 128; asm volatile("" : "+s"(kq)); pg8::Gemm g{(const bf16_t*)(a->ws + P_WA), (const bf16_t*)(wj + WJ_L2WA), M, 2048, kq, kq, 0}; pg8::StaticOrder S; S.init(M / 256, 2048, c.G, c.bid);
                      EpiStore<false> E{(bf16_t*)(a->ws + P_LW), D, 2, (size_t)M * D, nullptr};
                      pg8::gemm_phase<EpiStore<false>, pg8::StaticOrder, 0, false, true>(c.lds, c.tid, g, S, E); }
                    asm volatile("" : "+s"(a), "+s"(c.bid), "+s"(c.G), "+s"(wj)); asm volatile("" : "+v"(c.tid));
                    { int kq = 256; asm volatile("" : "+s"(kq)); pg8::Gemm g{(const bf16_t*)(a->ws + P_GL), (const bf16_t*)(wj + WJ_L2G), M, D, kq, kq, 0}; pg8::StaticOrder S; S.init(M / 256, D, c.G, c.bid);
                      EpiStore<false> E{regA, D, 2, 0, nullptr};
                      pg8::gemm_phase<EpiStore<false>, pg8::StaticOrder, 0, false, true>(c.lds, c.tid, g, S, E); }
                } else if (s == 5) phase_scan(c, a, j, 0);
                else {
                    pg8::Gemm g{(const bf16_t*)(a->ws + P_R), (const bf16_t*)(wj + WJ_O), M, D, D, D, 0}; pg8::StaticOrder S; S.init(M / 256, D, c.G, c.bid);
                    EpiResid E{a->out, a->out, regA, ss_ffn};
                    pg8::gemm_phase<EpiResid, pg8::StaticOrder, 0, false, true>(c.lds, c.tid, g, S, E);
                }
            }
            else if (s == 8) {
                pg8::Gemm g{regA - 2 * D, (const bf16_t*)(a->ws + WS_WFFN), M, FF2, D, D, 0}; pg8::StaticOrder S; S.init(133, FF2, c.G, c.bid);
                EpiFfnUp E{(bf16_t*)(a->ws + P_ACT), ss_ffn, a->in[I_FCW] + (size_t)layer * 3 * FF2, a->in[I_FCB] + (size_t)layer * FF2};
                pg8::gemm_phase<EpiFfnUp, pg8::StaticOrder, 2, false, true>(c.lds, c.tid, g, S, E);
            }
            else {
                pg8::Gemm g{(const bf16_t*)(a->ws + P_ACT), (const bf16_t*)(a->ws + WS_WDOWN), M, D, FF, FF, 0}; pg8::StaticOrder S; S.init(M / 256, D, c.G, c.bid);
                EpiResid E{a->out, a->out, layer == 1 ? regA : (bf16_t*)nullptr, ss_next};
                pg8::gemm_phase<EpiResid, pg8::StaticOrder, 0, false, true>(c.lds, c.tid, g, S, E);
            }
        }
        }
        if (p + 1 < ph_hi) { if (p == 0) cg::this_grid().sync(); else xcd_barrier(xbar); }
    }
}

constexpr int LDS_BYTES = 147456;
#ifndef MK_ONE_LAUNCH
#define MK_ONE_LAUNCH 1
#endif
extern "C" void kernel_launch(void* const* d_in, const int* in_sizes, int n_in, void* d_out, int out_size, void* d_ws, size_t ws_size, hipStream_t stream) {
    static int grid = 0;
    if (grid == 0) {
        if (n_in != 32 || out_size != M * D || ws_size < WS_END) { fprintf(stderr, "kernel_launch: unexpected shapes (n_in %d out %d ws %zu, need %zu)\n", n_in, out_size, ws_size, (size_t)WS_END); grid = -1; return; }
        int dev = 0, cus = 0, per_cu = 0;
        (void)hipGetDevice(&dev); (void)hipDeviceGetAttribute(&cus, hipDeviceAttributeMultiprocessorCount, dev);
        if (hipFuncSetAttribute((const void*)mk_fwd, hipFuncAttributeMaxDynamicSharedMemorySize, LDS_BYTES) != hipSuccess) { fprintf(stderr, "kernel_launch: hipFuncSetAttribute failed\n"); grid = -1; return; }
        (void)hipOccupancyMaxActiveBlocksPerMultiprocessor(&per_cu, (const void*)mk_fwd, 512, LDS_BYTES);
        if (per_cu < 1) per_cu = 1;
        grid = cus * 1;
        (void)hipGetLastError();
    }
    if (grid < 0) return;
    if (hipMemsetAsync((char*)d_ws + WS_CTL, 0, CTL_BYTES, stream) != hipSuccess) { fprintf(stderr, "kernel_launch: memset failed\n"); return; }
    Args a{};
    for (int i = 0; i < 32; ++i) a.in[i] = (const float*)d_in[i];
    a.out = (float*)d_out; a.ws = (unsigned char*)d_ws;
#if MK_ONE_LAUNCH
    a.ph_lo = 0; a.ph_hi = NPH;
    void* args[] = {&a};
    hipError_t e = hipLaunchCooperativeKernel((const void*)mk_fwd, dim3(grid), dim3(512), args, LDS_BYTES, stream);
    if (e != hipSuccess) fprintf(stderr, "cooperative launch failed: %s (grid %d)\n", hipGetErrorString(e), grid);
#else
    for (int p = 0; p < NPH; ++p) { if (!phase_active(p)) continue; a.ph_lo = p; a.ph_hi = p + 1; hipLaunchKernelGGL(mk_fwd, dim3(grid), dim3(512), LDS_BYTES, stream, a); }
#endif
}
```

```cpp
#include <hip/hip_runtime.h>
#include <hip/hip_cooperative_groups.h>
#include <cstdio>
#include <cstdint>
#include <cmath>
namespace cg = cooperative_groups;
#ifndef MK_PROBE
#define MK_PROBE 0
#endif
#ifndef MK_PROBE_SEL
#define MK_PROBE_SEL 0
#endif
#ifndef MK_PROBE_MODE
#define MK_PROBE_MODE 1
#endif
namespace pg8 {
#define PG8_LAS __attribute__((address_space(3)))
typedef unsigned short bf16_t;
typedef short bf16x8 __attribute__((ext_vector_type(8)));
typedef float f32x4 __attribute__((ext_vector_type(4)));
typedef float f32x2 __attribute__((ext_vector_type(2)));
typedef unsigned u32x4 __attribute__((ext_vector_type(4)));
typedef unsigned u32x2 __attribute__((ext_vector_type(2)));
constexpr int BM = 256, BK = 64, HALF = 128, HTB = HALF * BK * 2  , STAGE_BYTES = 8 * HTB, NXCD = 8, WGM = 8;

__host__ __device__ __forceinline__ int lds_byte(int r, int c) { const int st = (r >> 4) * 2 + (c >> 5), rr = r & 15, cc = c & 31, ob = rr * 64 + cc * 2; return st * 1024 + (ob ^ (((ob >> 9) & 1) << 5)); }
__host__ __device__ __forceinline__ void stage_rc(int b, int& R, int& C) { const int st = b / 1024, sb = b % 1024, swz = sb ^ (((sb >> 9) & 1) << 5); R = (st >> 1) * 16 + swz / 64; C = (st & 1) * 32 + (swz % 64) / 2; }
__host__ __device__ __forceinline__ int perm32(int rho) { const int n = rho >> 4, i = rho & 15; return 8 * (i >> 2) + 4 * n + (i & 3); }

struct Unit { int pm, pn; };
struct Gemm { const bf16_t* A; const bf16_t* Bt; int M, N, K, lda; size_t astride; };

struct StaticOrder {
    int nM, nN, nwg, G, c;
    __host__ __device__ void init(int nM_, int N, int G_, int c_) { nM = nM_; nN = N / BM; nwg = nM * nN; G = G_; c = c_; }
    __host__ __device__ bool next(int i, Unit& u) const {
        const long L = (long)i * G + c; if (L >= nwg) return false;
        int wgid = (int)L; { const int q = nwg / NXCD, r = nwg % NXCD, xcd = wgid % NXCD, off = wgid / NXCD; wgid = (xcd < r ? xcd * (q + 1) : r * (q + 1) + (xcd - r) * q) + off; }
        const int nig = WGM * nN, gid = wgid / nig, fm = gid * WGM, gsz = (nM - fm) < WGM ? (nM - fm) : WGM;
        u.pm = fm + ((wgid % nig) % gsz); u.pn = (wgid % nig) / gsz; return true;
    }
};

__device__ __forceinline__ unsigned cvt_pk_bf16(float lo, float hi) { unsigned r; asm volatile("v_cvt_pk_bf16_f32 %0, %1, %2" : "=v"(r) : "v"(lo), "v"(hi)); return r; }
__device__ __forceinline__ f32x2 gelu_pk(f32x2 v) {
    const f32x2 av = __builtin_elementwise_abs(v), d = av * 0.2316418882f + 1.0f;
    f32x2 t; t.x = __builtin_amdgcn_rcpf(d.x); t.y = __builtin_amdgcn_rcpf(d.y);
    f32x2 q = t * 0.5307027145f + (-0.7265760135f); q = q * t + 0.7107068705f; q = q * t + (-0.142248368f); q = q * t + 0.127414796f; q = q * t;
    const f32x2 s = (v * v) * (-0.72134752044f);
    f32x2 e; e.x = __builtin_amdgcn_exp2f(s.x); e.y = __builtin_amdgcn_exp2f(s.y);
    const f32x2 m = v * (q * e), r = v - m;
    f32x2 o; o.x = v.x < 0.f ? m.x : r.x; o.y = v.y < 0.f ? m.y : r.y; return o;
}

template <class Epi, class Sched, int AMAP, bool KDBL, bool ALIGN_EPI>
__device__ __forceinline__ void gemm_phase(PG8_LAS unsigned char* lds, const int tid, const Gemm g, const Sched& S, const Epi& E) {
    const int wid = __builtin_amdgcn_readfirstlane(tid >> 6), lane = tid & 63, wr = wid >> 2, wc = wid & 3, fr = lane & 15, fq = lane >> 4;
    const int K = g.K, nt = K / BK, lda = g.lda;
    unsigned voffA[2], voffB[2];
#pragma unroll
    for (int i = 0; i < 2; ++i) { int R, C; stage_rc(tid * 16 + i * 8192, R, C); const int Rb = Epi::PERM ? ((R & ~31) + perm32(R & 31)) : R;
        const int Ra = (AMAP == 2) ? (R - 2 * (R >> 6)) : R;
        voffA[i] = (unsigned)(Ra * lda + C) * 2u; voffB[i] = (unsigned)(Rb * K + C) * 2u; }
    const size_t kstep = (size_t)(BK * 2);
    const size_t hstepA = (size_t)((AMAP == 2) ? 124 : HALF) * lda * 2;
    const size_t hstepB = (size_t)HALF * K * 2;
    const size_t tstepB = 2 * hstepB;
    const size_t rowA = (size_t)lda * 2;
    const unsigned ldsw = (unsigned)wid * 1024u;
    const int aoff = lds_byte(wr * 64 + fr, fq * 8), boff = lds_byte(wc * 32 + fr, fq * 8);
#define PG8_ABASE(pm, pn) ((const char*)g.A + (AMAP == 3 ? (size_t)((pn) >> 2) * g.astride + (size_t)(pm) * 256 * rowA : AMAP == 1 ? (size_t)(((pm) >> 4) * 4104 + 8 + ((pm) & 15) * 256) * rowA : (AMAP == 2 ? (size_t)(pm) * 248 * rowA : (size_t)(pm) * 256 * rowA)))
#define PG8_KA(base, t) (KDBL ? ((base) + (size_t)((t) & 15) * kstep - (size_t)((t) >> 4) * rowA) : ((base) + (size_t)(t) * kstep))
#define PG8_SA(b, h) (((b) * 2 + (h)) * HTB)
#define PG8_SB(b, h) ((4 + (b) * 2 + (h)) * HTB)
#define PG8_STAGE(bufoff, gbase, voff) do { _Pragma("unroll") for (int _i = 0; _i < 2; ++_i) \
        __builtin_amdgcn_global_load_lds((const unsigned*)((const char*)(gbase) + (voff)[_i]), (PG8_LAS unsigned*)(lds + (bufoff) + ldsw + _i * 8192), 16, 0, 0); } while (0)
#define PG8_LDA(dst, b, h) do { _Pragma("unroll") for (int m = 0; m < 4; ++m) _Pragma("unroll") for (int k = 0; k < 2; ++k) dst[m][k] = *(const PG8_LAS bf16x8*)(lds + PG8_SA(b, h) + aoff + m * 2048 + k * 1024); } while (0)
#define PG8_LDB(dst, b, h) do { _Pragma("unroll") for (int n = 0; n < 2; ++n) _Pragma("unroll") for (int k = 0; k < 2; ++k) dst[n][k] = *(const PG8_LAS bf16x8*)(lds + PG8_SB(b, h) + boff + n * 2048 + k * 1024); } while (0)
#define PG8_MMA(ai, bj, At, Bt) do { __builtin_amdgcn_s_setprio(1); _Pragma("unroll") for (int m = 0; m < 4; ++m) _Pragma("unroll") for (int n = 0; n < 2; ++n) _Pragma("unroll") for (int k = 0; k < 2; ++k) \
        acc[ai][bj][m][n] = __builtin_amdgcn_mfma_f32_16x16x32_bf16(Bt[n][k], At[m][k], acc[ai][bj][m][n], 0, 0, 0); __builtin_amdgcn_s_setprio(0); } while (0)
#define PG8_WAIT_V(n) asm volatile("s_waitcnt vmcnt(" #n ")" ::: "memory")
#define PG8_WAIT_L(n) asm volatile("s_waitcnt lgkmcnt(" #n ")" ::: "memory")
#define PG8_BAR __builtin_amdgcn_s_barrier()
#define PG8_SCHED __builtin_amdgcn_sched_barrier(0)
    Unit cur, nxt; int ui = 0;
    if (!S.next(0, cur)) return;
    f32x4 acc[2][2][4][2];
#pragma unroll
    for (int a = 0; a < 2; ++a)
#pragma unroll
        for (int b = 0; b < 2; ++b)
#pragma unroll
            for (int m = 0; m < 4; ++m)
#pragma unroll
                for (int n = 0; n < 2; ++n) acc[a][b][m][n] = (f32x4){0.f, 0.f, 0.f, 0.f};
    bf16x8 At[4][2], B0[2][2], B1[2][2];
    const char* cA = PG8_ABASE(cur.pm, cur.pn); const char* cB = (const char*)g.Bt + (size_t)cur.pn * tstepB;
    {
        const char* cA1 = PG8_KA(cA, 1);
        PG8_STAGE(PG8_SB(0, 0), cB, voffB); PG8_STAGE(PG8_SB(0, 1), cB + hstepB, voffB); PG8_STAGE(PG8_SA(0, 0), cA, voffA); PG8_STAGE(PG8_SA(0, 1), cA + hstepA, voffA);
        if (wr == 1) PG8_BAR;
        PG8_WAIT_V(2); PG8_BAR;
        PG8_STAGE(PG8_SB(1, 0), cB + kstep, voffB); PG8_STAGE(PG8_SA(1, 0), cA1, voffA); PG8_STAGE(PG8_SB(1, 1), cB + hstepB + kstep, voffB);
        PG8_WAIT_V(6); PG8_BAR;
    }
    for (;;) {
        const bool has_next = S.next(ui + 1, nxt);
        const char* nA = has_next ? PG8_ABASE(nxt.pm, nxt.pn) : cA; const char* nB = has_next ? (const char*)g.Bt + (size_t)nxt.pn * tstepB : cB;
        for (int t = 0; t < nt; t += 2) {
            const bool last = (t == nt - 2);
            const char* a1 = PG8_KA(cA, t + 1);
            const char* a2 = last ? nA : PG8_KA(cA, t + 2); const char* b2 = last ? nB : cB + (size_t)(t + 2) * kstep;
            const char* a3 = last ? PG8_KA(nA, 1) : PG8_KA(cA, t + 3); const char* b3 = b2 + kstep;
            PG8_LDB(B0, 0, 0); PG8_LDB(B1, 0, 1); PG8_SCHED; PG8_LDA(At, 0, 0); PG8_STAGE(PG8_SA(1, 1), a1 + hstepA, voffA);
            PG8_WAIT_V(8); PG8_WAIT_L(0); PG8_BAR; PG8_MMA(0, 0, At, B0); PG8_MMA(0, 1, At, B1); PG8_BAR; PG8_SCHED;
            PG8_LDA(At, 0, 1); PG8_STAGE(PG8_SB(0, 0), b2, voffB); PG8_STAGE(PG8_SB(0, 1), b2 + hstepB, voffB); PG8_STAGE(PG8_SA(0, 0), a2, voffA);
            PG8_WAIT_V(8); PG8_WAIT_L(0); PG8_BAR; PG8_MMA(1, 0, At, B0); PG8_MMA(1, 1, At, B1); PG8_BAR; PG8_SCHED;
            PG8_LDB(B0, 1, 0); PG8_LDB(B1, 1, 1); PG8_SCHED; PG8_LDA(At, 1, 0); PG8_STAGE(PG8_SA(0, 1), a2 + hstepA, voffA);
            PG8_WAIT_V(8); PG8_WAIT_L(0); PG8_BAR; PG8_MMA(0, 0, At, B0); PG8_MMA(0, 1, At, B1); PG8_BAR; PG8_SCHED;
            PG8_LDA(At, 1, 1); PG8_STAGE(PG8_SB(1, 0), b3, voffB); PG8_STAGE(PG8_SB(1, 1), b3 + hstepB, voffB); PG8_STAGE(PG8_SA(1, 0), a3, voffA);
            PG8_WAIT_V(8); PG8_WAIT_L(0); PG8_BAR; PG8_MMA(1, 0, At, B0); PG8_MMA(1, 1, At, B1); PG8_BAR; PG8_SCHED;
        }
        if constexpr (ALIGN_EPI) { if (wr == 0) PG8_BAR; }
        E(acc, cur, wr, wc, fr, fq);
        if (!has_next) break;
#pragma unroll
        for (int a = 0; a < 2; ++a)
#pragma unroll
            for (int b = 0; b < 2; ++b)
#pragma unroll
                for (int m = 0; m < 4; ++m)
#pragma unroll
                    for (int n = 0; n < 2; ++n) acc[a][b][m][n] = (f32x4){0.f, 0.f, 0.f, 0.f};
        cur = nxt; cA = nA; cB = nB; ++ui;
        if constexpr (ALIGN_EPI) { if (wr == 1) PG8_BAR; }
    }
    PG8_WAIT_V(0);
    if constexpr (!ALIGN_EPI) { if (wr == 0) PG8_BAR; }
    PG8_BAR;
#undef PG8_ABASE
#undef PG8_KA
#undef PG8_SA
#undef PG8_SB
#undef PG8_STAGE
#undef PG8_LDA
#undef PG8_LDB
#undef PG8_MMA
#undef PG8_WAIT_V
#undef PG8_WAIT_L
#undef PG8_BAR
#undef PG8_SCHED
}
}
using pg8::bf16_t; using pg8::f32x4; using pg8::f32x2; using pg8::u32x4; using pg8::u32x2; using pg8::Unit; using pg8::cvt_pk_bf16;
#define LAS __attribute__((address_space(3)))
constexpr int BATCH = 8, SEQ = 4096, D = 1024, M = BATCH * SEQ, FF = 2816, FF2 = 5632;
constexpr int PADR = 8, SEQP = SEQ + PADR;
constexpr float RMS_EPS = 1e-6f, GN_EPS = 64e-5f;
constexpr size_t MiB = 1u << 20;
constexpr size_t WS_CTL = 0, CTL_BYTES = 2048 * 1024, WS_XS = 1 * MiB;
constexpr size_t WS_WSTAT = 2 * MiB;
constexpr size_t WJ_IN = 0, WJ_OUT = 4 * MiB, WJ_RKV = 6 * MiB, WJ_L2WA = 20 * MiB, WJ_L2G = 20 * MiB + 512 * 1024, WJ_O = 21 * MiB, WJ_STRIDE = 23 * MiB;
constexpr size_t WS_WFFN = 48 * MiB;
constexpr size_t WS_WDOWN = WS_WFFN + 11 * MiB;
constexpr size_t WS_A = 67 * MiB;
constexpr size_t WS_P = 134 * MiB;
constexpr size_t P_R = WS_P, P_K = WS_P + 64 * MiB, P_V = WS_P + 128 * MiB, P_LW = WS_P + 192 * MiB, P_LA = WS_P + 256 * MiB, P_WA = WS_P + 320 * MiB, P_GL = WS_P + 328 * MiB;
constexpr size_t P_U = WS_P, P_SV = WS_P + 64 * MiB;
constexpr size_t P_Z = WS_P, P_ACT = WS_P + 176 * MiB;
constexpr size_t WS_PA = WS_P + 352 * MiB, WS_PB = WS_PA + 2 * MiB, WS_PV = WS_PB + 2 * MiB;
constexpr size_t WS_END = WS_PV + 2 * MiB;

struct Args {
    const float* in[32]; float* out; unsigned char* ws; int ph_lo, ph_hi;
};
enum { I_X = 0, I_NMIX, I_NFFN, I_NFIN, I_SWIN, I_SBIN, I_SGV, I_SWS, I_SBS, I_SWOUT, I_MU, I_WR, I_WK, I_WV, I_WO, I_W0, I_W1, I_W2, I_A0, I_A1, I_A2, I_G1, I_G2, I_KK, I_KA, I_RK, I_LNW, I_LNB, I_FUP, I_FCW, I_FCB, I_FDN };

__device__ __forceinline__ float bf2f(unsigned short b) { return __uint_as_float((unsigned)b << 16); }
__device__ __forceinline__ float bflo(unsigned w) { return __uint_as_float(w << 16); }
__device__ __forceinline__ float bfhi(unsigned w) { return __uint_as_float(w & 0xffff0000u); }
__device__ __forceinline__ float wave_sum(float v) {
#pragma unroll
    for (int o = 1; o < 64; o <<= 1) v += __shfl_xor(v, o);
    return v;
}
__device__ __forceinline__ float row_rstd(const float* P, int row) { const f32x4* p = (const f32x4*)(P + (size_t)row * 16); const f32x4 a = p[0], b = p[1], c = p[2], d = p[3];
    const float s = ((a.x + a.y) + (a.z + a.w)) + ((b.x + b.y) + (b.z + b.w)) + ((c.x + c.y) + (c.z + c.w)) + ((d.x + d.y) + (d.z + d.w)); return rsqrtf(s * (1.f / D) + RMS_EPS); }
__device__ __forceinline__ void row_rstd4(const float* P, int row0, int rstride, int lo, int hi, float (&rs)[4]) {
    f32x4 p[4][4];
#pragma unroll
    for (int m = 0; m < 4; ++m) { int r = row0 + m * rstride; r = r < lo ? lo : (r > hi ? hi : r); const f32x4* q = (const f32x4*)(P + (size_t)r * 16);
#pragma unroll
        for (int k = 0; k < 4; ++k) p[m][k] = q[k]; }
#pragma unroll
    for (int m = 0; m < 4; ++m) { const f32x4 a = p[m][0], b = p[m][1], c = p[m][2], d = p[m][3];
        const float s = ((a.x + a.y) + (a.z + a.w)) + ((b.x + b.y) + (b.z + b.w)) + ((c.x + c.y) + (c.z + c.w)) + ((d.x + d.y) + (d.z + d.w)); rs[m] = rsqrtf(s * (1.f / D) + RMS_EPS); }
}
template <int CTRL> __device__ __forceinline__ float dpp_f(float v) { return __int_as_float(__builtin_amdgcn_mov_dpp(__float_as_int(v), CTRL, 0xf, 0xf, true)); }
__device__ __forceinline__ float sum8(float v) { v += dpp_f<0x141>(v); v += dpp_f<0xB1>(v); v += dpp_f<0x4E>(v); return v; }
__device__ __forceinline__ float sigmoidf_(float x) { return 1.f / (1.f + __expf(-x)); }

template <bool SCALE> struct EpiStore {
    static constexpr bool PERM = true;
    bf16_t* O; int ldc; int tsh; size_t split_stride; const float* ss;
    __device__ __forceinline__ void operator()(const f32x4 (&acc)[2][2][4][2], const Unit& u, int wr, int wc, int fr, int fq) const {
        bf16_t* base = O + (size_t)(u.pn >> tsh) * split_stride + (size_t)(u.pm * 256 + wr * 64 + fr) * ldc + (u.pn & ((1 << tsh) - 1)) * 256 + wc * 32 + 8 * fq;
        const int row0 = u.pm * 256 + wr * 64 + fr;
#pragma unroll
        for (int ai = 0; ai < 2; ++ai)
#pragma unroll
            for (int m = 0; m < 4; ++m) {
                const float rs = SCALE ? row_rstd(ss, row0 + ai * 128 + m * 16) : 1.f;
                bf16_t* rowp = base + (size_t)(ai * 128 + m * 16) * ldc;
#pragma unroll
                for (int bj = 0; bj < 2; ++bj) { const f32x4 v0 = acc[ai][bj][m][0] * rs, v1 = acc[ai][bj][m][1] * rs;
                    u32x4 w; w.x = cvt_pk_bf16(v0[0], v0[1]); w.y = cvt_pk_bf16(v0[2], v0[3]); w.z = cvt_pk_bf16(v1[0], v1[1]); w.w = cvt_pk_bf16(v1[2], v1[3]);
                    *(u32x4*)(rowp + bj * 128) = w; } }
    }
};
struct EpiSguIn {
    static constexpr bool PERM = true;
    bf16_t* U; bf16_t* V; const float* ss; const float* bias; float* ssv;
    __device__ __forceinline__ void operator()(const f32x4 (&acc)[2][2][4][2], const Unit& u, int wr, int wc, int fr, int fq) const {
        const bool isv = u.pn >= 4; bf16_t* base = isv ? V : U; const int colt = (u.pn & 3) * 256 + wc * 32 + 8 * fq, bcol = u.pn * 256 + wc * 32 + 8 * fq;
        f32x4 bv[2][2];
#pragma unroll
        for (int bj = 0; bj < 2; ++bj)
#pragma unroll
            for (int n = 0; n < 2; ++n) bv[bj][n] = *(const f32x4*)(bias + bcol + bj * 128 + 4 * n);
#pragma unroll
        for (int ai = 0; ai < 2; ++ai) {
            float rs4[4]; row_rstd4(ss, u.pm * 256 + ai * 128 + wr * 64 + fr, 16, 0, M - 1, rs4);
#pragma unroll
            for (int m = 0; m < 4; ++m) { const int row = u.pm * 256 + ai * 128 + wr * 64 + m * 16 + fr;
                const float rs = rs4[m]; float s = 0.f;
                bf16_t* rowp = base + (size_t)row * D + colt;
#pragma unroll
                for (int bj = 0; bj < 2; ++bj) { f32x4 v0 = acc[ai][bj][m][0] * rs + bv[bj][0], v1 = acc[ai][bj][m][1] * rs + bv[bj][1];
                    const f32x2 a = pg8::gelu_pk((f32x2){v0[0], v0[1]}), b = pg8::gelu_pk((f32x2){v0[2], v0[3]}), c = pg8::gelu_pk((f32x2){v1[0], v1[1]}), d = pg8::gelu_pk((f32x2){v1[2], v1[3]});
                    s += (a.x * a.x + a.y * a.y) + (b.x * b.x + b.y * b.y) + (c.x * c.x + c.y * c.y) + (d.x * d.x + d.y * d.y);
                    u32x4 w; w.x = cvt_pk_bf16(a.x, a.y); w.y = cvt_pk_bf16(b.x, b.y); w.z = cvt_pk_bf16(c.x, c.y); w.w = cvt_pk_bf16(d.x, d.y);
                    *(u32x4*)(rowp + bj * 128) = w; }
                if (isv) { s += __shfl_xor(s, 16); s += __shfl_xor(s, 32); if (fq == 0) ssv[(size_t)row * 16 + (u.pn - 4) * 4 + wc] = s; } } }
    }
};
struct EpiResid {
    static constexpr bool PERM = true;
    const float* hin; float* h; bf16_t* hb; float* ssn;
    __device__ __forceinline__ void operator()(const f32x4 (&acc)[2][2][4][2], const Unit& u, int wr, int wc, int fr, int fq) const {
        const int colt = u.pn * 256 + wc * 32 + 8 * fq;
#pragma unroll
        for (int ai = 0; ai < 2; ++ai) {
            const int rowb = u.pm * 256 + ai * 128 + wr * 64 + fr;
            f32x4 pre[4][2][2];
#pragma unroll
            for (int m = 0; m < 4; ++m)
#pragma unroll
                for (int bj = 0; bj < 2; ++bj) { const float* hp = hin + (size_t)(rowb + m * 16) * D + colt + bj * 128; pre[m][bj][0] = *(const f32x4*)hp; pre[m][bj][1] = *(const f32x4*)(hp + 4); }
#pragma unroll
            for (int m = 0; m < 4; ++m) { const int row = rowb + m * 16; float s = 0.f;
                float* hp = h + (size_t)row * D + colt; bf16_t* bp = hb + (size_t)row * D + colt;
#pragma unroll
                for (int bj = 0; bj < 2; ++bj) { const f32x4 v0 = pre[m][bj][0] + acc[ai][bj][m][0], v1 = pre[m][bj][1] + acc[ai][bj][m][1];
                    *(f32x4*)(hp + bj * 128) = v0; *(f32x4*)(hp + bj * 128 + 4) = v1;
                    s += (v0[0] * v0[0] + v0[1] * v0[1]) + (v0[2] * v0[2] + v0[3] * v0[3]) + (v1[0] * v1[0] + v1[1] * v1[1]) + (v1[2] * v1[2] + v1[3] * v1[3]);
                    if (hb) { u32x4 w; w.x = cvt_pk_bf16(v0[0], v0[1]); w.y = cvt_pk_bf16(v0[2], v0[3]); w.z = cvt_pk_bf16(v1[0], v1[1]); w.w = cvt_pk_bf16(v1[2], v1[3]);
                    *(u32x4*)(bp + bj * 128) = w; } }
                s += __shfl_xor(s, 16); s += __shfl_xor(s, 32); if (fq == 0) ssn[(size_t)row * 16 + u.pn * 4 + wc] = s; }
            asm volatile("" ::: "memory");
        }
    }
};
template <int CTRL> __device__ __forceinline__ f32x4 dpp4(f32x4 v) { f32x4 r; r.x = dpp_f<CTRL>(v.x); r.y = dpp_f<CTRL>(v.y); r.z = dpp_f<CTRL>(v.z); r.w = dpp_f<CTRL>(v.w); return r; }
struct EpiFfnUp {
    static constexpr bool PERM = true;
    bf16_t* ACT; const float* ss; const float* cw; const float* cb;
    template <bool MASK> __device__ __forceinline__ void conv4(f32x4& z0, f32x4& z1, f32x4& z2, f32x4& z3, const float (&rs)[4], const int (&tt)[4], const float* wcol, const float* bcol, int fr) const {
        const f32x4 w0 = *(const f32x4*)wcol, w1 = *(const f32x4*)(wcol + FF2), w2 = *(const f32x4*)(wcol + 2 * FF2), bb = *(const f32x4*)bcol;
#pragma unroll
        for (int e = 0; e < 4; e += 2) {
            const f32x2 w0p = {w0[e], w0[e + 1]}, w1p = {w1[e], w1[e + 1]}, w2p = {w2[e], w2[e + 1]}, bp = {bb[e], bb[e + 1]};
            f32x2 cur = (f32x2){z3[e], z3[e + 1]} * rs[3];
            f32x2 c1 = {dpp_f<0x121>(cur.x), dpp_f<0x121>(cur.y)}, c2 = {dpp_f<0x122>(cur.x), dpp_f<0x122>(cur.y)};
#define CONV_STEP(ZM, ZP, MI, HASP) { f32x2 prv = cur, p1 = c1, p2 = c2; if (HASP) { prv = (f32x2){ZP[e], ZP[e + 1]} * rs[MI - (HASP)]; p1 = (f32x2){dpp_f<0x121>(prv.x), dpp_f<0x121>(prv.y)}; p2 = (f32x2){dpp_f<0x122>(prv.x), dpp_f<0x122>(prv.y)}; } \
            f32x2 y1 = (fr == 0) ? p1 : c1, y2 = (fr < 2) ? p2 : c2; if (MASK) { if (tt[MI] < 1) y1 = (f32x2){0.f, 0.f}; if (tt[MI] < 2) y2 = (f32x2){0.f, 0.f}; } \
            const f32x2 o = w0p * y2 + (w1p * y1 + (w2p * cur + bp)); ZM[e] = o.x; ZM[e + 1] = o.y; cur = prv; c1 = p1; c2 = p2; }
            CONV_STEP(z3, z2, 3, 1) CONV_STEP(z2, z1, 2, 1) CONV_STEP(z1, z0, 1, 1) CONV_STEP(z0, z0, 0, 0)
#undef CONV_STEP
            asm volatile("" : "+v"(z0[e]), "+v"(z1[e]), "+v"(z2[e]), "+v"(z3[e]), "+v"(z0[e + 1]), "+v"(z1[e + 1]), "+v"(z2[e + 1]), "+v"(z3[e + 1]));
        }
    }
    __device__ __forceinline__ void operator()(f32x4 (&acc)[2][2][4][2], const Unit& u, int wr, int wc, int fr, int fq) const {
        const int f0 = u.pn * 128 + wc * 32 + 8 * fq;
#pragma unroll
        for (int ai = 0; ai < 2; ++ai) {
            const int gbase = u.pm * 248 - 2 + 62 * (2 * ai + wr) + fr;
            float rs[4]; int tt[4];
            row_rstd4(ss, gbase, 16, 0, M - 1, rs);
            asm volatile("" : "+v"(rs[0]), "+v"(rs[1]), "+v"(rs[2]), "+v"(rs[3]) :: "memory");
            const int g0 = u.pm * 248 - 2 + 62 * (2 * ai + wr);
            const bool seqstart = ((g0 + 63) & (SEQ - 1)) < 65 || g0 < 0;
#pragma unroll
            for (int m = 0; m < 4; ++m) tt[m] = (gbase + 16 * m) & (SEQ - 1);
#pragma unroll
            for (int n = 0; n < 2; ++n) {
                if (seqstart) {
                    conv4<true>(acc[ai][0][0][n], acc[ai][0][1][n], acc[ai][0][2][n], acc[ai][0][3][n], rs, tt, cw + f0 + 4 * n, cb + f0 + 4 * n, fr);
                    asm volatile("" ::: "memory");
                    conv4<true>(acc[ai][1][0][n], acc[ai][1][1][n], acc[ai][1][2][n], acc[ai][1][3][n], rs, tt, cw + FF + f0 + 4 * n, cb + FF + f0 + 4 * n, fr);
                } else {
                    conv4<false>(acc[ai][0][0][n], acc[ai][0][1][n], acc[ai][0][2][n], acc[ai][0][3][n], rs, tt, cw + f0 + 4 * n, cb + f0 + 4 * n, fr);
                    asm volatile("" ::: "memory");
                    conv4<false>(acc[ai][1][0][n], acc[ai][1][1][n], acc[ai][1][2][n], acc[ai][1][3][n], rs, tt, cw + FF + f0 + 4 * n, cb + FF + f0 + 4 * n, fr);
                }
                asm volatile("" ::: "memory");
#pragma unroll
                for (int m = 0; m < 4; ++m) { const int g = gbase + 16 * m;
                    if ((m > 0 || fr >= 2) && g < M) { const f32x4 gt = acc[ai][0][m][n], vl = acc[ai][1][m][n]; f32x4 o;
#pragma unroll
                        for (int e = 0; e < 4; ++e) o[e] = gt[e] * sigmoidf_(gt[e]) * vl[e];
                        u32x2 w; w.x = cvt_pk_bf16(o[0], o[1]); w.y = cvt_pk_bf16(o[2], o[3]);
                        *(u32x2*)(ACT + (size_t)g * FF + f0 + 4 * n) = w; } }
            }
        }
    }
};
struct EpiRkv {
    static constexpr bool PERM = true;
    bf16_t* R; bf16_t* WA; bf16_t* GL; int row_off, pn_off;
    __device__ __forceinline__ void operator()(const f32x4 (&acc)[2][2][4][2], const Unit& u, int wr, int wc, int fr, int fq) const {
        const int pne = u.pn + pn_off; const int mode = pne < 12 ? 0 : (pne == 12 ? 1 : 2);
        bf16_t* base; int ldc, colt;
        if (mode == 0) { base = R + (size_t)(pne >> 2) * ((size_t)M * D); ldc = D; colt = (pne & 3) * 256 + wc * 32 + 8 * fq; }
        else if (mode == 1) { base = WA; ldc = 128; colt = wc * 32 + 8 * fq; }
        else { base = GL; ldc = 256; colt = wc * 32 + 8 * fq; }
#pragma unroll
        for (int ai = 0; ai < 2; ++ai)
#pragma unroll
            for (int m = 0; m < 4; ++m) { const int row = row_off + u.pm * 256 + ai * 128 + wr * 64 + m * 16 + fr;
                bf16_t* rowp = base + (size_t)row * ldc + colt;
#pragma unroll
                for (int bj = 0; bj < 2; ++bj) { f32x4 v0 = acc[ai][bj][m][0], v1 = acc[ai][bj][m][1];
                    if (mode == 1) { if (bj == 1) continue;
                        if (wc < 2) {
#pragma unroll
                            for (int e = 0; e < 4; ++e) { v0[e] = tanhf(v0[e]); v1[e] = tanhf(v1[e]); } } }
                    else if (mode == 2) {
#pragma unroll
                        for (int e = 0; e < 4; ++e) { v0[e] = sigmoidf_(v0[e]); v1[e] = sigmoidf_(v1[e]); } }
                    u32x4 w; w.x = cvt_pk_bf16(v0[0], v0[1]); w.y = cvt_pk_bf16(v0[2], v0[3]); w.z = cvt_pk_bf16(v1[0], v1[1]); w.w = cvt_pk_bf16(v1[2], v1[3]);
                    *(u32x4*)(rowp + bj * 128) = w; } }
    }
};

typedef const __attribute__((address_space(4))) Args* CA;
struct Ctx { LAS unsigned char* lds; int tid, lane, wave, G, bid; };

__device__ __forceinline__ void conv_mat(const Ctx& c, const float* src, int ldsrc, int K, int N, int Kp, int Np, bf16_t* dst, int ldd, int n_off, int k_off, const float* sc, int mode, int rot) {
    LAS float* tile = (LAS float*)c.lds;
    const int nnb = Np / 64, nit = (Kp / 64) * nnb; const int start = (c.bid + c.G - (rot % c.G)) % c.G;
    for (int it = start; it < nit; it += c.G) {
        const int kb = it / nnb, nb = it % nnb, k0 = kb * 64, n0 = nb * 64;
#pragma unroll
        for (int j = 0; j < 2; ++j) { const int kk = (c.tid >> 4) + 32 * j, nn = (c.tid & 15) * 4, k = k0 + kk, n = n0 + nn; f32x4 v = (f32x4){0.f, 0.f, 0.f, 0.f};
            if (src && k < K && n < N) { v = *(const f32x4*)(src + (size_t)k * ldsrc + n); if (mode == 1) v = v * sc[k]; else if (mode == 2) v = v * (1.f - sc[k]); }
            tile[nn * 65 + kk] = v.x; tile[(nn + 1) * 65 + kk] = v.y; tile[(nn + 2) * 65 + kk] = v.z; tile[(nn + 3) * 65 + kk] = v.w; }
        __syncthreads();
        { const int nn = c.tid >> 3, cc = c.tid & 7; const LAS float* s = tile + nn * 65 + 8 * cc;
            u32x4 o; o.x = cvt_pk_bf16(s[0], s[1]); o.y = cvt_pk_bf16(s[2], s[3]); o.z = cvt_pk_bf16(s[4], s[5]); o.w = cvt_pk_bf16(s[6], s[7]);
            *(u32x4*)(dst + (size_t)(n_off + n0 + nn) * ldd + k_off + k0 + 8 * cc) = o; }
        __syncthreads();
    }
}

__device__ __forceinline__ void phase_static_weights(const Ctx& c, CA a, int j);
__device__ __forceinline__ void phase_prologue(const Ctx& c, CA a) {
    float* ss = (float*)(a->ws + WS_PA);
    const int gw = c.bid * 8 + c.wave, NGW = c.G * 8;
    bf16_t* hb = (bf16_t*)(a->ws + WS_A);
    for (int m = gw; m < M; m += NGW) {
        const f32x4* xr = (const f32x4*)(a->in[I_X] + (size_t)m * D) + c.lane; u32x2* br = (u32x2*)(hb + (size_t)m * D) + c.lane;
        float s = 0.f;
#pragma unroll
        for (int j = 0; j < 4; ++j) { const f32x4 v = xr[64 * j]; s += (v.x * v.x + v.y * v.y) + (v.z * v.z + v.w * v.w); u32x2 w; w.x = cvt_pk_bf16(v.x, v.y); w.y = cvt_pk_bf16(v.z, v.w); br[64 * j] = w; }
        s = wave_sum(s); if (c.lane < 16) ss[(size_t)m * 16 + c.lane] = c.lane == 0 ? s : 0.f;
    }
    phase_static_weights(c, a, 0);
}
__device__ __forceinline__ void phase_static_weights(const Ctx& c, CA a, int j) {
    int rot = 0;
    {
        unsigned char* wj = a->ws + WS_WSTAT + (size_t)j * WJ_STRIDE;
        conv_mat(c, a->in[I_SWIN] + (size_t)j * D * 2048, 2048, D, 2048, D, 2048, (bf16_t*)(wj + WJ_IN), D, 0, 0, a->in[I_NMIX] + (size_t)(2 * j) * D, 1, rot); rot += 512;
        conv_mat(c, a->in[I_SWOUT] + (size_t)j * D * D, D, D, D, D, D, (bf16_t*)(wj + WJ_OUT), D, 0, 0, nullptr, 0, rot); rot += 256;
        const float* mu = a->in[I_MU] + (size_t)j * 6 * D; bf16_t* rkv3 = (bf16_t*)(wj + WJ_RKV); bf16_t* rkv = (bf16_t*)(wj + WJ_RKV + 6 * MiB) - (size_t)3072 * 2048;
#define CONV_BIG(IDX, Q, MUB) do { conv_mat(c, a->in[IDX] + (size_t)j * D * D, D, D, D, D, D, rkv3, 1024, (Q) * 1024, 0, nullptr, 0, rot); rot += 256; } while (0)
        CONV_BIG(I_WR, 0, 0); CONV_BIG(I_WK, 1, 2); CONV_BIG(I_WV, 2, 3);
#undef CONV_BIG
        conv_mat(c, a->in[I_W1] + (size_t)j * D * 64, 64, D, 64, D, 64, rkv, 2048, 3072, 0, mu + 1 * D, 2, rot); rot += 16;
        conv_mat(c, a->in[I_W1] + (size_t)j * D * 64, 64, D, 64, D, 64, rkv, 2048, 3072, 1024, mu + 1 * D, 1, rot); rot += 16;
        conv_mat(c, a->in[I_A1] + (size_t)j * D * 64, 64, D, 64, D, 64, rkv, 2048, 3136, 0, mu + 4 * D, 2, rot); rot += 16;
        conv_mat(c, a->in[I_A1] + (size_t)j * D * 64, 64, D, 64, D, 64, rkv, 2048, 3136, 1024, mu + 4 * D, 1, rot); rot += 16;
        conv_mat(c, nullptr, 0, 0, 0, 2048, 128, rkv, 2048, 3200, 0, nullptr, 0, rot); rot += 64;
        conv_mat(c, a->in[I_G1] + (size_t)j * D * 160, 160, D, 160, D, 256, rkv, 2048, 3328, 0, mu + 5 * D, 2, rot); rot += 64;
        conv_mat(c, a->in[I_G1] + (size_t)j * D * 160, 160, D, 160, D, 256, rkv, 2048, 3328, 1024, mu + 5 * D, 1, rot); rot += 64;
        bf16_t* l2wa = (bf16_t*)(wj + WJ_L2WA);
        conv_mat(c, a->in[I_W2] + (size_t)j * 64 * D, D, 64, D, 64, D, l2wa, 128, 0, 0, nullptr, 0, rot); rot += 16;
        conv_mat(c, nullptr, 0, 0, 0, 64, D, l2wa, 128, 0, 64, nullptr, 0, rot); rot += 16;
        conv_mat(c, nullptr, 0, 0, 0, 64, D, l2wa, 128, 1024, 0, nullptr, 0, rot); rot += 16;
        conv_mat(c, a->in[I_A2] + (size_t)j * 64 * D, D, 64, D, 64, D, l2wa, 128, 1024, 64, nullptr, 0, rot); rot += 16;
        conv_mat(c, a->in[I_G2] + (size_t)j * 160 * D, D, 160, D, 256, D, (bf16_t*)(wj + WJ_L2G), 256, 0, 0, nullptr, 0, rot); rot += 64;
        conv_mat(c, a->in[I_WO] + (size_t)j * D * D, D, D, D, D, D, (bf16_t*)(wj + WJ_O), D, 0, 0, nullptr, 0, rot); rot += 256;
    }
}
__device__ __forceinline__ void phase_ffn_weights(const Ctx& c, CA a, int layer) {
    for (int pn = 0; pn < FF / 128; ++pn) {
        conv_mat(c, a->in[I_FUP] + (size_t)layer * D * FF2 + pn * 128, FF2, D, 128, D, 128, (bf16_t*)(a->ws + WS_WFFN), D, pn * 256, 0, a->in[I_NFFN] + (size_t)layer * D, 1, pn * 64);
        conv_mat(c, a->in[I_FUP] + (size_t)layer * D * FF2 + FF + pn * 128, FF2, D, 128, D, 128, (bf16_t*)(a->ws + WS_WFFN), D, pn * 256 + 128, 0, a->in[I_NFFN] + (size_t)layer * D, 1, pn * 64 + 32);
    }
    conv_mat(c, a->in[I_FDN] + (size_t)layer * FF * D, D, FF, D, FF, D, (bf16_t*)(a->ws + WS_WDOWN), FF, 0, 0, nullptr, 0, 128);
}

__device__ __forceinline__ void phase_sgu_spatial(const Ctx& c, CA a, int j, int rp) {
    typedef short bf16x8 __attribute__((ext_vector_type(8)));
    bf16_t* U = (bf16_t*)(a->ws + P_U); const bf16_t* V = (const bf16_t*)(a->ws + P_SV); bf16_t* UO = rp ? (bf16_t*)(a->ws + P_SV) : U;
    const float* ssv = (const float*)(a->ws + WS_PV);
    LAS bf16_t* WL = (LAS bf16_t*)c.lds; LAS bf16_t* VT = WL + 128 * 136;
    const int g = c.bid & 15;
    const float* Ws = a->in[I_SWS] + ((size_t)j * 16 + g) * 128 * 128; const float* bs = a->in[I_SBS] + ((size_t)j * 16 + g) * 128; const float* gv = a->in[I_SGV] + (size_t)j * D + g * 64;
    __syncthreads();
    { const int t = c.tid >> 2, s0 = (c.tid & 3) * 32; const float* wp = Ws + (size_t)t * 128 + s0;
#pragma unroll
      for (int q = 0; q < 4; ++q) { f32x4 x0 = *(const f32x4*)(wp + 8 * q), x1 = *(const f32x4*)(wp + 8 * q + 4);
#pragma unroll
          for (int e = 0; e < 4; ++e) { if (s0 + 8 * q + e > t) x0[e] = 0.f; if (s0 + 8 * q + 4 + e > t) x1[e] = 0.f; }
          u32x4 w; w.x = cvt_pk_bf16(x0[0], x0[1]); w.y = cvt_pk_bf16(x0[2], x0[3]); w.z = cvt_pk_bf16(x1[0], x1[1]); w.w = cvt_pk_bf16(x1[2], x1[3]);
          *(LAS u32x4*)(WL + t * 136 + s0 + 8 * q) = w; } }
    const int w8 = c.wave, fr = c.lane & 15, fq = c.lane >> 4, t0 = 16 * w8, nk = (w8 >> 1) + 1;
    const int vs = c.tid >> 2, vc = (c.tid & 3) * 16;
    f32x4 gq[4];
#pragma unroll
    for (int e = 0; e < 4; ++e) gq[e] = *(const f32x4*)(gv + vc + 4 * e);
    const float bb = bs[t0 + fr];
    for (int ub = c.bid >> 4; ub < M / 128; ub += c.G >> 4) {
        const int m0 = ub * 128;
        { const bf16_t* vp = V + (size_t)(m0 + vs) * D + g * 64 + vc; const u32x4 v0 = *(const u32x4*)vp, v1 = *(const u32x4*)(vp + 8);
          const float rs = row_rstd(ssv, m0 + vs);
          const unsigned vw[8] = {v0.x, v0.y, v0.z, v0.w, v1.x, v1.y, v1.z, v1.w};
#pragma unroll
          for (int e = 0; e < 8; ++e) { const float lo = bflo(vw[e]) * rs * gq[e >> 1][(2 * e) & 3], hi = bfhi(vw[e]) * rs * gq[e >> 1][(2 * e + 1) & 3];
              const unsigned pk = cvt_pk_bf16(lo, hi);
              VT[(vc + 2 * e) * 136 + vs] = (bf16_t)(pk & 0xffffu); VT[(vc + 2 * e + 1) * 136 + vs] = (bf16_t)(pk >> 16); } }
        __syncthreads();
        f32x4 acc[4];
#pragma unroll
        for (int ct = 0; ct < 4; ++ct) acc[ct] = (f32x4){0.f, 0.f, 0.f, 0.f};
        for (int k = 0; k < nk; ++k) {
            const bf16x8 wf = *(const LAS bf16x8*)(WL + (t0 + fr) * 136 + 32 * k + 8 * fq);
#pragma unroll
            for (int ct = 0; ct < 4; ++ct) { const bf16x8 vf = *(const LAS bf16x8*)(VT + (16 * ct + fr) * 136 + 32 * k + 8 * fq);
                acc[ct] = __builtin_amdgcn_mfma_f32_16x16x32_bf16(vf, wf, acc[ct], 0, 0, 0); }
        }
        { const size_t ro = (size_t)(m0 + t0 + fr) * D + g * 64 + 4 * fq;
#pragma unroll
          for (int ct = 0; ct < 4; ++ct) { const u32x2 uu = *(const u32x2*)(U + ro + 16 * ct); const f32x4 o = acc[ct] + bb;
              u32x2 w; w.x = cvt_pk_bf16(bflo(uu.x) * o[0], bfhi(uu.x) * o[1]); w.y = cvt_pk_bf16(bflo(uu.y) * o[2], bfhi(uu.y) * o[3]);
              *(u32x2*)(UO + ro + 16 * ct) = w; } }
        __syncthreads();
    }
}

__device__ __forceinline__ void phase_ffn_conv(const Ctx& c, CA a, int layer, int half) {
    const bf16_t* Z = (const bf16_t*)(a->ws + P_Z); bf16_t* ACT = (bf16_t*)(a->ws + P_ACT) + (size_t)half * (M / 2) * FF;
    const float* cw = a->in[I_FCW] + (size_t)layer * 3 * FF2; const float* cb = a->in[I_FCB] + (size_t)layer * FF2;
    const int gt = c.bid * 512 + c.tid, NT = c.G * 512;
    for (int idx = gt; idx < (M / 2) * (FF / 8); idx += NT) {
        const int ml = idx / (FF / 8), f = (idx % (FF / 8)) * 8, t = ml & (SEQ - 1);
        float gsum[8], vsum[8];
#pragma unroll
        for (int e = 0; e < 8; ++e) { gsum[e] = cb[f + e]; vsum[e] = cb[FF + f + e]; }
#pragma unroll
        for (int jj = 0; jj < 3; ++jj) { const int dt = 2 - jj; if (t - dt < 0) continue;
            const u32x4 zg = *(const u32x4*)(Z + (size_t)(ml - dt) * FF2 + f), zv = *(const u32x4*)(Z + (size_t)(ml - dt) * FF2 + FF + f);
            const float* wg = cw + (size_t)jj * FF2 + f; const float* wv = wg + FF;
            const unsigned zgw[4] = {zg.x, zg.y, zg.z, zg.w}, zvw[4] = {zv.x, zv.y, zv.z, zv.w};
#pragma unroll
            for (int e = 0; e < 4; ++e) { gsum[2 * e] += wg[2 * e] * bflo(zgw[e]); gsum[2 * e + 1] += wg[2 * e + 1] * bfhi(zgw[e]); vsum[2 * e] += wv[2 * e] * bflo(zvw[e]); vsum[2 * e + 1] += wv[2 * e + 1] * bfhi(zvw[e]); } }
        float o[8];
#pragma unroll
        for (int e = 0; e < 8; ++e) o[e] = gsum[e] * sigmoidf_(gsum[e]) * vsum[e];
        u32x4 w; w.x = cvt_pk_bf16(o[0], o[1]); w.y = cvt_pk_bf16(o[2], o[3]); w.z = cvt_pk_bf16(o[4], o[5]); w.w = cvt_pk_bf16(o[6], o[7]);
        *(u32x4*)(ACT + (size_t)ml * FF + f) = w;
    }
}

__device__ __forceinline__ void phase_rwkv_prep(const Ctx& c, CA a, int layer, int mode) {
    const float* ss = (const float*)(a->ws + WS_PA); const float* g = a->in[I_NMIX] + (size_t)layer * D; const float* mu = a->in[I_MU] + (size_t)(layer >> 1) * 6 * D;
    bf16_t* hn = (bf16_t*)(a->ws + WS_A); bf16_t* X = (bf16_t*)(a->ws + P_LW);
    const int gw = c.bid * 8 + c.wave, NGW = c.G * 8;
    f32x4 gg[4], mr[4], mk[4], mv[4];
#pragma unroll
    for (int j = 0; j < 4; ++j) { gg[j] = *((const f32x4*)g + c.lane + 64 * j); mr[j] = *((const f32x4*)mu + c.lane + 64 * j); mk[j] = *((const f32x4*)(mu + 2 * D) + c.lane + 64 * j); mv[j] = *((const f32x4*)(mu + 3 * D) + c.lane + 64 * j); }
    for (int m = gw + (mode ? M / 2 : 0); m < M; m += NGW) {
        const float rs = row_rstd(ss, m); const int t = m & (SEQ - 1);
        const f32x4* hr = (const f32x4*)(a->out + (size_t)m * D) + c.lane;
        f32x4 cur[4];
#pragma unroll
        for (int j = 0; j < 4; ++j) cur[j] = hr[64 * j] * rs * gg[j];
        if (mode == 0) { const int prow = (m >> 12) * SEQP + PADR + t; u32x2* br = (u32x2*)(hn + (size_t)prow * D) + c.lane;
#pragma unroll
            for (int j = 0; j < 4; ++j) { u32x2 w; w.x = cvt_pk_bf16(cur[j].x, cur[j].y); w.y = cvt_pk_bf16(cur[j].z, cur[j].w); br[64 * j] = w; } }
        if (mode == 1 || m < M / 2) {
            const float rsp = t > 0 ? row_rstd(ss, m - 1) : 0.f; const f32x4* hp = (const f32x4*)(a->out + (size_t)(t > 0 ? m - 1 : m) * D) + c.lane;
            const size_t lo = (size_t)(m & (M / 2 - 1)) * D;
            u32x2* xr = (u32x2*)(X + lo) + c.lane; u32x2* xk = (u32x2*)(X + (size_t)(M / 2) * D + lo) + c.lane; u32x2* xv = (u32x2*)(X + (size_t)M * D + lo) + c.lane;
#pragma unroll
            for (int j = 0; j < 4; ++j) { const f32x4 dl = hp[64 * j] * rsp * gg[j] - cur[j];
                const f32x4 vr = cur[j] + dl * mr[j], vk = cur[j] + dl * mk[j], vv = cur[j] + dl * mv[j]; u32x2 w;
                w.x = cvt_pk_bf16(vr.x, vr.y); w.y = cvt_pk_bf16(vr.z, vr.w); xr[64 * j] = w;
                w.x = cvt_pk_bf16(vk.x, vk.y); w.y = cvt_pk_bf16(vk.z, vk.w); xk[64 * j] = w;
                w.x = cvt_pk_bf16(vv.x, vv.y); w.y = cvt_pk_bf16(vv.z, vv.w); xv[64 * j] = w; }
        }
    }
    if (mode == 0) for (int r = gw; r < BATCH * PADR; r += NGW) { const int prow = (r / PADR) * SEQP + (r % PADR); u32x2* br = (u32x2*)(hn + (size_t)prow * D) + c.lane;
#pragma unroll
        for (int j = 0; j < 4; ++j) br[64 * j] = (u32x2){0u, 0u}; }
}

__device__ __forceinline__ f32x4 bf4(u32x2 w) { return (f32x4){bflo(w.x), bfhi(w.x), bflo(w.y), bfhi(w.y)}; }
__device__ __forceinline__ float hsum4(f32x4 p) { return (p.x + p.y) + (p.z + p.w); }
__device__ __forceinline__ float sum16(float v) { v = sum8(v); v += dpp_f<0x140>(v); return v; }
__device__ __forceinline__ f32x4 bf4lo(u32x4 w) { return (f32x4){bflo(w.x), bfhi(w.x), bflo(w.y), bfhi(w.y)}; }
__device__ __forceinline__ f32x4 bf4hi(u32x4 w) { return (f32x4){bflo(w.z), bfhi(w.z), bflo(w.w), bfhi(w.w)}; }
__device__ __forceinline__ void phase_scan(const Ctx& c, CA a, int j, int rp_out) {
    constexpr int CH = 32, NCH = SEQ / CH, VSZ = CH * 64, YSZ = CH * 32;
    LAS float* BIG = (LAS float*)c.lds; LAS float* VB = BIG + 2 * 5 * VSZ; LAS float* YB = VB + 4 * VSZ; LAS float* BON = YB + 3 * YSZ;
    bf16_t* R = (bf16_t*)(a->ws + P_R); const bf16_t* Kb = (const bf16_t*)(a->ws + P_K); const bf16_t* Vb = (const bf16_t*)(a->ws + P_V);
    const bf16_t* LWb = (const bf16_t*)(a->ws + P_LW); const bf16_t* LAb = (const bf16_t*)(a->ws + P_LA); const bf16_t* Gb = (const bf16_t*)(a->ws + WS_A);
    if (c.G != 256) return;
    const int unit = c.bid, b = unit >> 5, hh = (unit >> 1) & 15, half = unit & 1;
    unsigned long long* slot_own = (unsigned long long*)(a->ws + WS_XS) + (size_t)(j * 256 + unit) * 256; const unsigned long long* slot_par = (const unsigned long long*)(a->ws + WS_XS) + (size_t)(j * 256 + (unit ^ 1)) * 256;
    const bool cons = c.tid < 256;
    __syncthreads();
    if (cons) {
        const int rp = c.tid >> 3, q = c.tid & 7, row = 32 * half + rp;
        f32x4 S0 = (f32x4){0.f, 0.f, 0.f, 0.f}, S1 = S0;
        __builtin_amdgcn_s_setprio(2);
        __syncthreads();
        for (int i = 0; i <= NCH + 1; ++i) {
            if (i < NCH) {
                const LAS float* bg = BIG + (i & 1) * 5 * VSZ + 8 * q;
                const LAS f32x4* pw = (const LAS f32x4*)bg; const LAS f32x4* pa = (const LAS f32x4*)(bg + VSZ); const LAS f32x4* pb = (const LAS f32x4*)(bg + 2 * VSZ);
                const LAS f32x4* pk = (const LAS f32x4*)(bg + 3 * VSZ); const LAS f32x4* pr = (const LAS f32x4*)(bg + 4 * VSZ);
                const LAS float* pv = VB + (i & 3) * VSZ + row; LAS float* py = YB + (i % 3) * YSZ + rp;
                f32x4 a0v = pa[0], a1v = pa[1], w0v = pw[0], w1v = pw[1], b0v = pb[0], b1v = pb[1], k0v = pk[0], k1v = pk[1], r0v = pr[0], r1v = pr[1];
                float vv = pv[0];
#pragma unroll 2
                for (int t = 0; t < CH; ++t) {
                    const int tn = (t + 1) & (CH - 1);
                    const f32x4 na0 = pa[tn * 16], na1 = pa[tn * 16 + 1], nw0 = pw[tn * 16], nw1 = pw[tn * 16 + 1], nb0 = pb[tn * 16], nb1 = pb[tn * 16 + 1],
                                nk0 = pk[tn * 16], nk1 = pk[tn * 16 + 1], nr0 = pr[tn * 16], nr1 = pr[tn * 16 + 1];
                    const float nvv = pv[tn * 64];
                    const float sa = sum8(hsum4(S0 * a0v + S1 * a1v));
                    S0 = S0 * w0v + sa * b0v + vv * k0v; S1 = S1 * w1v + sa * b1v + vv * k1v;
                    const float y = sum8(hsum4(S0 * r0v + S1 * r1v));
                    if (q == 0) py[t * 32] = y;
                    a0v = na0; a1v = na1; w0v = nw0; w1v = nw1; b0v = nb0; b1v = nb1; k0v = nk0; k1v = nk1; r0v = nr0; r1v = nr1; vv = nvv;
                }
            }
            __syncthreads();
        }
        __builtin_amdgcn_s_setprio(0);
    } else {
        const int pt = c.tid - 256, st = pt >> 3, l8 = pt & 7, sc = l8 * 8, ch = hh * 64 + sc;
        const float* pp = a->in[I_W0] + (size_t)j * D + ch; const f32x4 w0a = *(const f32x4*)pp, w0b = *(const f32x4*)(pp + 4);
        pp = a->in[I_A0] + (size_t)j * D + ch; const f32x4 a0a = *(const f32x4*)pp, a0b = *(const f32x4*)(pp + 4);
        pp = a->in[I_KK] + (size_t)j * D + ch; const f32x4 kka = *(const f32x4*)pp, kkb = *(const f32x4*)(pp + 4);
        pp = a->in[I_KA] + (size_t)j * D + ch; const f32x4 kaa = *(const f32x4*)pp, kab = *(const f32x4*)(pp + 4);
        pp = a->in[I_RK] + (size_t)j * D + ch; const f32x4 rka = *(const f32x4*)pp, rkb = *(const f32x4*)(pp + 4);
        const int oc = 4 * l8, cho = hh * 64 + 32 * half + oc;
        const f32x4 lnw = *(const f32x4*)(a->in[I_LNW] + (size_t)j * D + cho), lnb = *(const f32x4*)(a->in[I_LNB] + (size_t)j * D + cho);
        const size_t gbase = ((size_t)b * SEQ + st) * D + ch, obase = ((size_t)b * SEQ + st) * D + cho;
        u32x4 qr = *(const u32x4*)(R + gbase), qk = *(const u32x4*)(Kb + gbase), qv = *(const u32x4*)(Vb + gbase), qlw = *(const u32x4*)(LWb + gbase), qla = *(const u32x4*)(LAb + gbase);
        u32x2 qg = (u32x2){0u, 0u};
#define SCAN_STAGE(n) { \
            f32x4 rr[2] = {bf4lo(qr), bf4hi(qr)}, kk_[2] = {bf4lo(qk), bf4hi(qk)}, vv_[2] = {bf4lo(qv), bf4hi(qv)}, lw_[2] = {bf4lo(qlw), bf4hi(qlw)}, la_[2] = {bf4lo(qla), bf4hi(qla)}; \
            const f32x4 w0_[2] = {w0a, w0b}, a0_[2] = {a0a, a0b}, kkp_[2] = {kka, kkb}, kap_[2] = {kaa, kab}, rkp_[2] = {rka, rkb}; \
            f32x4 dec[2], av[2], kn[2], kp[2]; float n2 = 0.f, bon = 0.f; \
            _Pragma("unroll") for (int h2 = 0; h2 < 2; ++h2) _Pragma("unroll") for (int e = 0; e < 4; ++e) { \
                const float xw = -(w0_[h2][e] + lw_[h2][e]); const float sp = xw > 20.f ? xw : __logf(1.f + __expf(xw)); \
                dec[h2][e] = __expf(-__expf(-sp - 0.5f)); av[h2][e] = __builtin_amdgcn_rcpf(1.f + __expf(-(a0_[h2][e] + la_[h2][e]))); \
                kn[h2][e] = kk_[h2][e] * kkp_[h2][e]; n2 += kn[h2][e] * kn[h2][e]; \
                kp[h2][e] = kk_[h2][e] * (1.f + (av[h2][e] - 1.f) * kap_[h2][e]); bon += rr[h2][e] * kp[h2][e] * rkp_[h2][e]; } \
            n2 = sum8(n2); bon = sum8(bon); const float inv = rsqrtf(fmaxf(n2, 1e-24f)); \
            LAS float* bg = BIG + ((n) & 1) * 5 * VSZ + st * 64 + sc; \
            _Pragma("unroll") for (int h2 = 0; h2 < 2; ++h2) { const f32x4 kq = kn[h2] * inv; \
                *(LAS f32x4*)(bg + 4 * h2) = dec[h2]; *(LAS f32x4*)(bg + VSZ + 4 * h2) = -kq; *(LAS f32x4*)(bg + 2 * VSZ + 4 * h2) = kq * av[h2]; \
                *(LAS f32x4*)(bg + 3 * VSZ + 4 * h2) = kp[h2]; *(LAS f32x4*)(bg + 4 * VSZ + 4 * h2) = rr[h2]; \
                *(LAS f32x4*)(VB + ((n) & 3) * VSZ + st * 64 + sc + 4 * h2) = vv_[h2]; } \
            if (l8 == 0) BON[((n) & 3) * CH + st] = bon; }
#define SCAN_YSTATS(n) \
            const f32x4 y = *(const LAS f32x4*)(YB + ((n) % 3) * YSZ + st * 32 + oc); \
            const float mh = sum8(hsum4(y)) * (1.f / 32.f); const f32x4 d = y - mh; const float m2h = sum8(hsum4(d * d));
        SCAN_STAGE(0)
        { const size_t go = gbase + (size_t)CH * D; qr = *(const u32x4*)(R + go); qk = *(const u32x4*)(Kb + go); qv = *(const u32x4*)(Vb + go); qlw = *(const u32x4*)(LWb + go); qla = *(const u32x4*)(LAb + go); }
        __syncthreads();
        for (int i = 0; i <= NCH + 1; ++i) {
            unsigned long long pw0 = 0ull, pw1 = 0ull; const unsigned long long* pp_ = slot_par + (((i - 2) & 3) * CH + st) * 2;
            if (i >= 2) { pw0 = __hip_atomic_load(pp_, __ATOMIC_RELAXED, __HIP_MEMORY_SCOPE_AGENT); pw1 = __hip_atomic_load(pp_ + 1, __ATOMIC_RELAXED, __HIP_MEMORY_SCOPE_AGENT); }
            if (i >= 1 && i <= NCH) {
                const int n = i - 1;
                SCAN_YSTATS(n)
                if (l8 == 0) { const unsigned long long tg = (unsigned long long)(unsigned)(n + 1) << 32; unsigned long long* sp_ = slot_own + ((n & 3) * CH + st) * 2;
                    __hip_atomic_store(sp_, tg | __float_as_uint(mh), __ATOMIC_RELAXED, __HIP_MEMORY_SCOPE_AGENT); __hip_atomic_store(sp_ + 1, tg | __float_as_uint(m2h), __ATOMIC_RELAXED, __HIP_MEMORY_SCOPE_AGENT); }
            }
            u32x4 nr = qr, nk = qk, nv = qv, nlw = qlw, nla = qla; u32x2 ng = qg;
            if (i + 2 < NCH) { const size_t go = gbase + (size_t)(i + 2) * CH * D; nr = *(const u32x4*)(R + go); nk = *(const u32x4*)(Kb + go); nv = *(const u32x4*)(Vb + go); nlw = *(const u32x4*)(LWb + go); nla = *(const u32x4*)(LAb + go); }
            if (i >= 1 && i <= NCH) ng = *(const u32x2*)(Gb + obase + (size_t)(i - 1) * CH * D);
            if (i + 1 < NCH) { SCAN_STAGE(i + 1) }
            if (i >= 2) {
                const int n = i - 2; const unsigned tag = (unsigned)(n + 1); unsigned sp = 0;
                while ((unsigned)(pw0 >> 32) != tag) { __builtin_amdgcn_s_sleep(1); if (++sp > (1u << 18)) break; pw0 = __hip_atomic_load(pp_, __ATOMIC_RELAXED, __HIP_MEMORY_SCOPE_AGENT); }
                while ((unsigned)(pw1 >> 32) != tag) { __builtin_amdgcn_s_sleep(1); if (++sp > (1u << 18)) break; pw1 = __hip_atomic_load(pp_ + 1, __ATOMIC_RELAXED, __HIP_MEMORY_SCOPE_AGENT); }
                const float mp = __uint_as_float((unsigned)pw0), m2p = __uint_as_float((unsigned)pw1);
                SCAN_YSTATS(n)
                const float mean = 0.5f * (mh + mp), dm = mh - mp; const float rstd = rsqrtf((m2h + m2p + 16.f * dm * dm) * (1.f / 64.f) + GN_EPS);
                const f32x4 v = *(const LAS f32x4*)(VB + (n & 3) * VSZ + st * 64 + 32 * half + oc); const float bon = BON[(n & 3) * CH + st];
                const f32x4 o = ((y - mean) * rstd * lnw + lnb + bon * v) * bf4(qg);
                u32x2 w; w.x = cvt_pk_bf16(o.x, o.y); w.y = cvt_pk_bf16(o.z, o.w);
                *(u32x2*)(R + obase + (size_t)n * CH * D) = w;
            }
            qg = ng; qr = nr; qk = nk; qv = nv; qlw = nlw; qla = nla;
            __syncthreads();
        }
#undef SCAN_STAGE
#undef SCAN_YSTATS
    }
}

__device__ __forceinline__ void phase_final(const Ctx& c, CA a) {
    const float* ss = (const float*)(a->ws + WS_PA); const float* g = a->in[I_NFIN];
    const int gw = c.bid * 8 + c.wave, NGW = c.G * 8;
    f32x4 gg[4];
#pragma unroll
    for (int j = 0; j < 4; ++j) gg[j] = *((const f32x4*)g + c.lane + 64 * j);
    for (int m = gw; m < M; m += NGW) {
        const float rs = row_rstd(ss, m);
        f32x4* hr = (f32x4*)(a->out + (size_t)m * D) + c.lane;
#pragma unroll
        for (int j = 0; j < 4; ++j) hr[64 * j] = hr[64 * j] * rs * gg[j];
    }
}

#define XB_TMO      128
#define XB_XCNT(j)  (256  + 64 * (j))
#define XB_XSUB(j)  (1280 + 64 * (j))
#define XB_XGEN(j)  (2304 + 64 * (j))
#define XB_TOP      3328
#define XB_TOPGEN   3392
#define XCD_BAR_WORDS 3456
#define XB_SPIN_CAP (1u << 18)

__device__ __forceinline__ unsigned xb_ld(unsigned* p)              { return __hip_atomic_load(p, __ATOMIC_RELAXED, __HIP_MEMORY_SCOPE_AGENT); }
__device__ __forceinline__ unsigned xb_add(unsigned* p, unsigned v) { return __hip_atomic_fetch_add(p, v, __ATOMIC_RELAXED, __HIP_MEMORY_SCOPE_AGENT); }
__device__ __forceinline__ unsigned xb_xcc_id() { return (unsigned)__builtin_amdgcn_s_getreg((3 << 11) | 20) & 0xFu; }
#define XB_SPIN(cond, bar) do { unsigned _sp = 0; while (cond) { __builtin_amdgcn_s_sleep(1); \
    if ((++_sp & 255u) == 0u) { if (xb_ld(&(bar)[XB_TMO])) break; if (_sp > XB_SPIN_CAP) { atomicAdd(&(bar)[XB_TMO], 1u); break; } } } } while (0)

struct XcdBarrier {
    unsigned* bar; unsigned x;
    volatile LAS unsigned* st;
};

__device__ __forceinline__ XcdBarrier xcd_barrier_post(unsigned* bar, volatile LAS unsigned* st) {
    XcdBarrier b; b.bar = bar; b.x = xb_xcc_id(); b.st = st;
    if (threadIdx.x == 0) (void)xb_add(&bar[XB_XCNT(b.x)], 1u);
    return b;
}
__device__ __forceinline__ void xcd_barrier_complete(unsigned* bar, unsigned x, unsigned& nloc, unsigned& nx) {
    const unsigned G = gridDim.x * gridDim.y * gridDim.z;
    unsigned sum, cnt, mine, sp = 0u;
    for (;;) {
        sum = 0u; cnt = 0u; mine = 0u;
#pragma unroll
        for (unsigned j = 0; j < 16; ++j) { const unsigned c = xb_ld(&bar[XB_XCNT(j)]); sum += c; cnt += (c > 0u) ? 1u : 0u; mine = (j == x) ? c : mine; }
        if (sum == G) break;
        __builtin_amdgcn_s_sleep(1);
        if ((++sp & 255u) == 0u) { if (xb_ld(&bar[XB_TMO])) break; if (sp > XB_SPIN_CAP) { atomicAdd(&bar[XB_TMO], 1u); break; } }
    }
    nloc = mine > 0u ? mine : 1u; nx = cnt > 0u ? cnt : 1u;
}

__device__ __forceinline__ void xcd_barrier(const XcdBarrier& b) {
    asm volatile("s_waitcnt vmcnt(0)" ::: "memory");
    __syncthreads();
    if (threadIdx.x == 0) {
        unsigned* bar = b.bar;
        __builtin_amdgcn_s_waitcnt(0);
        unsigned nloc = b.st[0], nx = b.st[1];
        if (nloc == 0u) { xcd_barrier_complete(bar, b.x, nloc, nx); b.st[0] = nloc; b.st[1] = nx; }
        const unsigned old = xb_add(&bar[XB_XSUB(b.x)], 1u);
        const unsigned gen = old / nloc;
        if (old + 1u == (gen + 1u) * nloc) {
            __builtin_amdgcn_fence(__ATOMIC_RELEASE, "agent");
            asm volatile("s_waitcnt vmcnt(0)" ::: "memory");
            const unsigned og = xb_add(&bar[XB_TOP], 1u);
            const unsigned tg = og / nx;
            if (og + 1u == (tg + 1u) * nx) xb_add(&bar[XB_TOPGEN], 1u);
            else XB_SPIN(xb_ld(&bar[XB_TOPGEN]) == tg, bar);
            __builtin_amdgcn_fence(__ATOMIC_ACQUIRE, "agent");
            xb_add(&bar[XB_XGEN(b.x)], 1u);
            asm volatile("s_waitcnt vmcnt(0)" ::: "memory");
        } else {
            XB_SPIN(xb_ld(&bar[XB_XGEN(b.x)]) == gen, bar);
            __builtin_amdgcn_fence(__ATOMIC_ACQUIRE, "agent");
            asm volatile("s_waitcnt vmcnt(0)" ::: "memory");
        }
    }
    __syncthreads();
}

constexpr int SLOTS = 11, NPH = 2 + 4 * SLOTS;
__host__ __device__ inline bool phase_active(int p) {
    if (p == 0 || p == NPH - 1) return true;
    const int i = (p - 1) / SLOTS, s = (p - 1) % SLOTS;
    if (s >= 8) return s == 8 || s == 10;
    return (i & 1) ? (s <= 5 || s == 7) : (s < 3);
}

__global__ void __launch_bounds__(512, 2) mk_fwd(Args a_) {
    extern __shared__ __attribute__((aligned(16))) unsigned char lds_raw[];
    int tid_ = threadIdx.x, bid_ = blockIdx.x, G_ = gridDim.x;
    volatile LAS unsigned* xst = (volatile LAS unsigned*)((LAS unsigned char*)lds_raw + 131072 + 64);
    if (tid_ < 2) xst[tid_] = 0u;
    __syncthreads();
    const XcdBarrier xbar = xcd_barrier_post((unsigned*)(a_.ws + WS_CTL), xst);
    CA a = (CA)__builtin_amdgcn_kernarg_segment_ptr();
    const int ph_lo = a_.ph_lo, ph_hi = a_.ph_hi;
    for (int p = ph_lo; p < ph_hi; ++p) {
        if (!phase_active(p)) continue;
        const int PL = (p - 1) / SLOTS, PS = (p - 1) % SLOTS; (void)PL; (void)PS;
        const int nrep = (MK_PROBE && p < NPH - 1 && (MK_PROBE_SEL)) ? 2 : 1;
        for (int rp = 0; rp < nrep; ++rp) {
        if (rp) cg::this_grid().sync();
        asm volatile("" : "+s"(a), "+s"(bid_), "+s"(G_)); asm volatile("" : "+v"(tid_));
        Ctx c; c.lds = (LAS unsigned char*)lds_raw; c.tid = tid_; c.lane = c.tid & 63; c.wave = __builtin_amdgcn_readfirstlane(c.tid >> 6); c.G = G_; c.bid = bid_;
        bf16_t* regA = (bf16_t*)(a->ws + WS_A);
        if (p == 0) phase_prologue(c, a);
        else if (p == NPH - 1) phase_final(c, a);
        else {
            const int layer = (p - 1) / SLOTS, s = (p - 1) % SLOTS, j = layer >> 1;
            unsigned char* wj = a->ws + WS_WSTAT + (size_t)j * WJ_STRIDE;
            float* ss_mix = (float*)(a->ws + WS_PA); float* ss_ffn = (float*)(a->ws + WS_PB); float* ss_next = ss_mix;
            if (s < 8 && !(layer & 1)) {
                if (s == 0) {
                    pg8::Gemm g{regA, (const bf16_t*)(wj + WJ_IN), M, 2048, D, D, 0}; pg8::StaticOrder S; S.init(M / 256, 2048, c.G, c.bid);
                    EpiSguIn E{(bf16_t*)(a->ws + P_U), (bf16_t*)(a->ws + P_SV), ss_mix, a->in[I_SBIN] + (size_t)j * 2048, (float*)(a->ws + WS_PV)};
                    pg8::gemm_phase<EpiSguIn, pg8::StaticOrder, 0, false, true>(c.lds, c.tid, g, S, E);
                } else if (s == 1) { phase_ffn_weights(c, a, layer); phase_sgu_spatial(c, a, j, rp); }
                else {
                    pg8::Gemm g{(const bf16_t*)(a->ws + P_U), (const bf16_t*)(wj + WJ_OUT), M, D, D, D, 0}; pg8::StaticOrder S; S.init(M / 256, D, c.G, c.bid);
                    EpiResid E{layer == 0 ? a->in[I_X] : (const float*)a->out, a->out, regA, ss_ffn};
                    pg8::gemm_phase<EpiResid, pg8::StaticOrder, 0, false, true>(c.lds, c.tid, g, S, E);
                }
            } else if (s < 8) {
                if (s == 0) { phase_rwkv_prep(c, a, layer, 0); phase_ffn_weights(c, a, layer); if (layer == 1) phase_static_weights(c, a, 1); }
                else if (s == 2) phase_rwkv_prep(c, a, layer, 1);
                else if (s == 1 || s == 3) {
                    { pg8::Gemm g{(const bf16_t*)(a->ws + P_LW), (const bf16_t*)(wj + WJ_RKV), M / 2, 3072, D, D, (size_t)(M / 2) * D * 2}; pg8::StaticOrder S; S.init(M / 512, 3072, c.G, c.bid);
                      EpiRkv E{(bf16_t*)(a->ws + P_R), (bf16_t*)(a->ws + P_WA), (bf16_t*)(a->ws + P_GL), s == 3 ? M / 2 : 0, 0};
                      pg8::gemm_phase<EpiRkv, pg8::StaticOrder, 3, false, true>(c.lds, c.tid, g, S, E); }
                    if (s == 1) {
                      asm volatile("" : "+s"(a), "+s"(c.bid), "+s"(c.G), "+s"(wj)); asm volatile("" : "+v"(c.tid));
                      pg8::Gemm g{(const bf16_t*)(a->ws + WS_A), (const bf16_t*)(wj + WJ_RKV + 6 * MiB), M, 512, 2048, D, 0}; pg8::StaticOrder S; S.init(M / 256, 512, c.G, c.bid);
                      EpiRkv E{(bf16_t*)(a->ws + P_R), (bf16_t*)(a->ws + P_WA), (bf16_t*)(a->ws + P_GL), 0, 12};
                      pg8::gemm_phase<EpiRkv, pg8::StaticOrder, 1, true, true>(c.lds, c.tid, g, S, E); }
                } else if (s == 4) {
                    { int kq = 128; asm volatile("" : "+s"(kq)); pg8::Gemm g{(const bf16_t*)(a->ws + P_WA), (const bf16_t*)(wj + WJ_L2WA), M, 2048, kq, kq, 0}; pg8::StaticOrder S; S.init(M / 256, 2048, c.G, c.bid);
                      EpiStore<false> E{(bf16_t*)(a->ws + P_LW), D, 2, (size_t)M * D, nullptr};
                      pg8::gemm_phase<EpiStore<false>, pg8::StaticOrder, 0, false, true>(c.lds, c.tid, g, S, E); }
                    asm volatile("" : "+s"(a), "+s"(c.bid), "+s"(c.G), "+s"(wj)); asm volatile("" : "+v"(c.tid));
                    { int kq = 256; asm volatile("" : "+s"(kq)); pg8::Gemm g{(const bf16_t*)(a->ws + P_GL), (const bf16_t*)(wj + WJ_L2G), M, D, kq, kq, 0}; pg8::StaticOrder S; S.init(M / 256, D, c.G, c.bid);
                      EpiStore<false> E{regA, D, 2, 0, nullptr};
                      pg8::gemm_phase<EpiStore<false>, pg8::StaticOrder, 0, false, true>(c.lds, c.tid, g, S, E); }
                } else if (s == 5) phase_scan(c, a, j, 0);
                else {
                    pg8::Gemm g{(const bf16_t*)(a->ws + P_R), (const bf16_t*)(wj + WJ_O), M, D, D, D, 0}; pg8::StaticOrder S; S.init(M / 256, D, c.G, c.bid);
                    EpiResid E{a->out, a->out, regA, ss_ffn};
                    pg8::gemm_phase<EpiResid, pg8::StaticOrder, 0, false, true>(c.lds, c.tid, g, S, E);
                }
            }
            else if (s == 8) {
                pg8::Gemm g{regA - 2 * D, (const bf16_t*)(a->ws + WS_WFFN), M, FF2, D, D, 0}; pg8::StaticOrder S; S.init(133, FF2, c.G, c.bid);
                EpiFfnUp E{(bf16_t*)(a->ws + P_ACT), ss_ffn, a->in[I_FCW] + (size_t)layer * 3 * FF2, a->in[I_FCB] + (size_t)layer * FF2};
                pg8::gemm_phase<EpiFfnUp, pg8::StaticOrder, 2, false, true>(c.lds, c.tid, g, S, E);
            }
            else {
                pg8::Gemm g{(const bf16_t*)(a->ws + P_ACT), (const bf16_t*)(a->ws + WS_WDOWN), M, D, FF, FF, 0}; pg8::StaticOrder S; S.init(M / 256, D, c.G, c.bid);
                EpiResid E{a->out, a->out, layer == 1 ? regA : (bf16_t*)nullptr, ss_next};
                pg8::gemm_phase<EpiResid, pg8::StaticOrder, 0, false, true>(c.lds, c.tid, g, S, E);
            }
        }
        }
        if (p + 1 < ph_hi) { if (p == 0) cg::this_grid().sync(); else xcd_barrier(xbar); }
    }
}

constexpr int LDS_BYTES = 147456;
#ifndef MK_ONE_LAUNCH
#define MK_ONE_LAUNCH 1
#endif
extern "C" void kernel_launch(void* const* d_in, const int* in_sizes, int n_in, void* d_out, int out_size, void* d_ws, size_t ws_size, hipStream_t stream) {
    static int grid = 0;
    if (grid == 0) {
        if (n_in != 32 || out_size != M * D || ws_size < WS_END) { fprintf(stderr, "kernel_launch: unexpected shapes (n_in %d out %d ws %zu, need %zu)\n", n_in, out_size, ws_size, (size_t)WS_END); grid = -1; return; }
        int dev = 0, cus = 0, per_cu = 0;
        (void)hipGetDevice(&dev); (void)hipDeviceGetAttribute(&cus, hipDeviceAttributeMultiprocessorCount, dev);
        if (hipFuncSetAttribute((const void*)mk_fwd, hipFuncAttributeMaxDynamicSharedMemorySize, LDS_BYTES) != hipSuccess) { fprintf(stderr, "kernel_launch: hipFuncSetAttribute failed\n"); grid = -1; return; }
        (void)hipOccupancyMaxActiveBlocksPerMultiprocessor(&per_cu, (const void*)mk_fwd, 512, LDS_BYTES);
        if (per_cu < 1) per_cu = 1;
        grid = cus * 1;
        (void)hipGetLastError();
    }
    if (grid < 0) return;
    if (hipMemsetAsync((char*)d_ws + WS_CTL, 0, CTL_BYTES, stream) != hipSuccess) { fprintf(stderr, "kernel_launch: memset failed\n"); return; }
    Args a{};
    for (int i = 0; i < 32; ++i) a.in[i] = (const float*)d_in[i];
    a.out = (float*)d_out; a.ws = (unsigned char*)d_ws;
#if MK_ONE_LAUNCH
    a.ph_lo = 0; a.ph_hi = NPH;
    void* args[] = {&a};
    hipError_t e = hipLaunchCooperativeKernel((const void*)mk_fwd, dim3(grid), dim3(512), args, LDS_BYTES, stream);
    if (e != hipSuccess) fprintf(stderr, "cooperative launch failed: %s (grid %d)\n", hipGetErrorString(e), grid);
#else
    for (int p = 0; p < NPH; ++p) { if (!phase_active(p)) continue; a.ph_lo = p; a.ph_hi = p + 1; hipLaunchKernelGGL(mk_fwd, dim3(grid), dim3(512), LDS_BYTES, stream, a); }
#endif
}
```

```cpp
#include <hip/hip_runtime.h>
#include <hip/hip_cooperative_groups.h>
#include <cstdio>
#include <cstdint>
#include <cmath>
namespace cg = cooperative_groups;
#ifndef MK_PROBE
#define MK_PROBE 0
#endif
#ifndef MK_PROBE_SEL
#define MK_PROBE_SEL 0
#endif
#ifndef MK_PROBE_MODE
#define MK_PROBE_MODE 1
#endif
namespace pg8 {
#define PG8_LAS __attribute__((address_space(3)))
typedef unsigned short bf16_t;
typedef short bf16x8 __attribute__((ext_vector_type(8)));
typedef float f32x4 __attribute__((ext_vector_type(4)));
typedef float f32x2 __attribute__((ext_vector_type(2)));
typedef unsigned u32x4 __attribute__((ext_vector_type(4)));
typedef unsigned u32x2 __attribute__((ext_vector_type(2)));
constexpr int BM = 256, BK = 64, HALF = 128, HTB = HALF * BK * 2  , STAGE_BYTES = 8 * HTB, NXCD = 8, WGM = 8;

__host__ __device__ __forceinline__ int lds_byte(int r, int c) { const int st = (r >> 4) * 2 + (c >> 5), rr = r & 15, cc = c & 31, ob = rr * 64 + cc * 2; return st * 1024 + (ob ^ (((ob >> 9) & 1) << 5)); }
__host__ __device__ __forceinline__ void stage_rc(int b, int& R, int& C) { const int st = b / 1024, sb = b % 1024, swz = sb ^ (((sb >> 9) & 1) << 5); R = (st >> 1) * 16 + swz / 64; C = (st & 1) * 32 + (swz % 64) / 2; }
__host__ __device__ __forceinline__ int perm32(int rho) { const int n = rho >> 4, i = rho & 15; return 8 * (i >> 2) + 4 * n + (i & 3); }

struct Unit { int pm, pn; };
struct Gemm { const bf16_t* A; const bf16_t* Bt; int M, N, K, lda; size_t astride; };

struct StaticOrder {
    int nM, nN, nwg, G, c;
    __host__ __device__ void init(int nM_, int N, int G_, int c_) { nM = nM_; nN = N / BM; nwg = nM * nN; G = G_; c = c_; }
    __host__ __device__ bool next(int i, Unit& u) const {
        const long L = (long)i * G + c; if (L >= nwg) return false;
        int wgid = (int)L; { const int q = nwg / NXCD, r = nwg % NXCD, xcd = wgid % NXCD, off = wgid / NXCD; wgid = (xcd < r ? xcd * (q + 1) : r * (q + 1) + (xcd - r) * q) + off; }
        const int nig = WGM * nN, gid = wgid / nig, fm = gid * WGM, gsz = (nM - fm) < WGM ? (nM - fm) : WGM;
        u.pm = fm + ((wgid % nig) % gsz); u.pn = (wgid % nig) / gsz; return true;
    }
};

__device__ __forceinline__ unsigned cvt_pk_bf16(float lo, float hi) { unsigned r; asm volatile("v_cvt_pk_bf16_f32 %0, %1, %2" : "=v"(r) : "v"(lo), "v"(hi)); return r; }
__device__ __forceinline__ f32x2 gelu_pk(f32x2 v) {
    const f32x2 av = __builtin_elementwise_abs(v), d = av * 0.2316418882f + 1.0f;
    f32x2 t; t.x = __builtin_amdgcn_rcpf(d.x); t.y = __builtin_amdgcn_rcpf(d.y);
    f32x2 q = t * 0.5307027145f + (-0.7265760135f); q = q * t + 0.7107068705f; q = q * t + (-0.142248368f); q = q * t + 0.127414796f; q = q * t;
    const f32x2 s = (v * v) * (-0.72134752044f);
    f32x2 e; e.x = __builtin_amdgcn_exp2f(s.x); e.y = __builtin_amdgcn_exp2f(s.y);
    const f32x2 m = v * (q * e), r = v - m;
    f32x2 o; o.x = v.x < 0.f ? m.x : r.x; o.y = v.y < 0.f ? m.y : r.y; return o;
}

template <class Epi, class Sched, int AMAP, bool KDBL, bool ALIGN_EPI>
__device__ __forceinline__ void gemm_phase(PG8_LAS unsigned char* lds, const int tid, const Gemm g, const Sched& S, const Epi& E) {
    const int wid = __builtin_amdgcn_readfirstlane(tid >> 6), lane = tid & 63, wr = wid >> 2, wc = wid & 3, fr = lane & 15, fq = lane >> 4;
    const int K = g.K, nt = K / BK, lda = g.lda;
    unsigned voffA[2], voffB[2];
#pragma unroll
    for (int i = 0; i < 2; ++i) { int R, C; stage_rc(tid * 16 + i * 8192, R, C); const int Rb = Epi::PERM ? ((R & ~31) + perm32(R & 31)) : R;
        const int Ra = (AMAP == 2) ? (R - 2 * (R >> 6)) : R;
        voffA[i] = (unsigned)(Ra * lda + C) * 2u; voffB[i] = (unsigned)(Rb * K + C) * 2u; }
    const size_t kstep = (size_t)(BK * 2);
    const size_t hstepA = (size_t)((AMAP == 2) ? 124 : HALF) * lda * 2;
    const size_t hstepB = (size_t)HALF * K * 2;
    const size_t tstepB = 2 * hstepB;
    const size_t rowA = (size_t)lda * 2;
    const unsigned ldsw = (unsigned)wid * 1024u;
    const int aoff = lds_byte(wr * 64 + fr, fq * 8), boff = lds_byte(wc * 32 + fr, fq * 8);
#define PG8_ABASE(pm, pn) ((const char*)g.A + (AMAP == 3 ? (size_t)((pn) >> 2) * g.astride + (size_t)(pm) * 256 * rowA : AMAP == 1 ? (size_t)(((pm) >> 4) * 4104 + 8 + ((pm) & 15) * 256) * rowA : (AMAP == 2 ? (size_t)(pm) * 248 * rowA : (size_t)(pm) * 256 * rowA)))
#define PG8_KA(base, t) (KDBL ? ((base) + (size_t)((t) & 15) * kstep - (size_t)((t) >> 4) * rowA) : ((base) + (size_t)(t) * kstep))
#define PG8_SA(b, h) (((b) * 2 + (h)) * HTB)
#define PG8_SB(b, h) ((4 + (b) * 2 + (h)) * HTB)
#define PG8_STAGE(bufoff, gbase, voff) do { _Pragma("unroll") for (int _i = 0; _i < 2; ++_i) \
        __builtin_amdgcn_global_load_lds((const unsigned*)((const char*)(gbase) + (voff)[_i]), (PG8_LAS unsigned*)(lds + (bufoff) + ldsw + _i * 8192), 16, 0, 0); } while (0)
#define PG8_LDA(dst, b, h) do { _Pragma("unroll") for (int m = 0; m < 4; ++m) _Pragma("unroll") for (int k = 0; k < 2; ++k) dst[m][k] = *(const PG8_LAS bf16x8*)(lds + PG8_SA(b, h) + aoff + m * 2048 + k * 1024); } while (0)
#define PG8_LDB(dst, b, h) do { _Pragma("unroll") for (int n = 0; n < 2; ++n) _Pragma("unroll") for (int k = 0; k < 2; ++k) dst[n][k] = *(const PG8_LAS bf16x8*)(lds + PG8_SB(b, h) + boff + n * 2048 + k * 1024); } while (0)
#define PG8_MMA(ai, bj, At, Bt) do { __builtin_amdgcn_s_setprio(1); _Pragma("unroll") for (int m = 0; m < 4; ++m) _Pragma("unroll") for (int n = 0; n < 2; ++n) _Pragma("unroll") for (int k = 0; k < 2; ++k) \
        acc[ai][bj][m][n] = __builtin_amdgcn_mfma_f32_16x16x32_bf16(Bt[n][k], At[m][k], acc[ai][bj][m][n], 0, 0, 0); __builtin_amdgcn_s_setprio(0); } while (0)
#define PG8_WAIT_V(n) asm volatile("s_waitcnt vmcnt(" #n ")" ::: "memory")
#define PG8_WAIT_L(n) asm volatile("s_waitcnt lgkmcnt(" #n ")" ::: "memory")
#define PG8_BAR __builtin_amdgcn_s_barrier()
#define PG8_SCHED __builtin_amdgcn_sched_barrier(0)
    Unit cur, nxt; int ui = 0;
    if (!S.next(0, cur)) return;
    f32x4 acc[2][2][4][2];
#pragma unroll
    for (int a = 0; a < 2; ++a)
#pragma unroll
        for (int b = 0; b < 2; ++b)
#pragma unroll
            for (int m = 0; m < 4; ++m)
#pragma unroll
                for (int n = 0; n < 2; ++n) acc[a][b][m][n] = (f32x4){0.f, 0.f, 0.f, 0.f};
    bf16x8 At[4][2], B0[2][2], B1[2][2];
    const char* cA = PG8_ABASE(cur.pm, cur.pn); const char* cB = (const char*)g.Bt + (size_t)cur.pn * tstepB;
    {
        const char* cA1 = PG8_KA(cA, 1);
        PG8_STAGE(PG8_SB(0, 0), cB, voffB); PG8_STAGE(PG8_SB(0, 1), cB + hstepB, voffB); PG8_STAGE(PG8_SA(0, 0), cA, voffA); PG8_STAGE(PG8_SA(0, 1), cA + hstepA, voffA);
        if (wr == 1) PG8_BAR;
        PG8_WAIT_V(2); PG8_BAR;
        PG8_STAGE(PG8_SB(1, 0), cB + kstep, voffB); PG8_STAGE(PG8_SA(1, 0), cA1, voffA); PG8_STAGE(PG8_SB(1, 1), cB + hstepB + kstep, voffB);
        PG8_WAIT_V(6); PG8_BAR;
    }
    for (;;) {
        const bool has_next = S.next(ui + 1, nxt);
        const char* nA = has_next ? PG8_ABASE(nxt.pm, nxt.pn) : cA; const char* nB = has_next ? (const char*)g.Bt + (size_t)nxt.pn * tstepB : cB;
        for (int t = 0; t < nt; t += 2) {
            const bool last = (t == nt - 2);
            const char* a1 = PG8_KA(cA, t + 1);
            const char* a2 = last ? nA : PG8_KA(cA, t + 2); const char* b2 = last ? nB : cB + (size_t)(t + 2) * kstep;
            const char* a3 = last ? PG8_KA(nA, 1) : PG8_KA(cA, t + 3); const char* b3 = b2 + kstep;
            PG8_LDB(B0, 0, 0); PG8_LDB(B1, 0, 1); PG8_SCHED; PG8_LDA(At, 0, 0); PG8_STAGE(PG8_SA(1, 1), a1 + hstepA, voffA);
            PG8_WAIT_V(8); PG8_WAIT_L(0); PG8_BAR; PG8_MMA(0, 0, At, B0); PG8_MMA(0, 1, At, B1); PG8_BAR; PG8_SCHED;
            PG8_LDA(At, 0, 1); PG8_STAGE(PG8_SB(0, 0), b2, voffB); PG8_STAGE(PG8_SB(0, 1), b2 + hstepB, voffB); PG8_STAGE(PG8_SA(0, 0), a2, voffA);
            PG8_WAIT_V(8); PG8_WAIT_L(0); PG8_BAR; PG8_MMA(1, 0, At, B0); PG8_MMA(1, 1, At, B1); PG8_BAR; PG8_SCHED;
            PG8_LDB(B0, 1, 0); PG8_LDB(B1, 1, 1); PG8_SCHED; PG8_LDA(At, 1, 0); PG8_STAGE(PG8_SA(0, 1), a2 + hstepA, voffA);
            PG8_WAIT_V(8); PG8_WAIT_L(0); PG8_BAR; PG8_MMA(0, 0, At, B0); PG8_MMA(0, 1, At, B1); PG8_BAR; PG8_SCHED;
            PG8_LDA(At, 1, 1); PG8_STAGE(PG8_SB(1, 0), b3, voffB); PG8_STAGE(PG8_SB(1, 1), b3 + hstepB, voffB); PG8_STAGE(PG8_SA(1, 0), a3, voffA);
            PG8_WAIT_V(8); PG8_WAIT_L(0); PG8_BAR; PG8_MMA(1, 0, At, B0); PG8_MMA(1, 1, At, B1); PG8_BAR; PG8_SCHED;
        }
        if constexpr (ALIGN_EPI) { if (wr == 0) PG8_BAR; }
        E(acc, cur, wr, wc, fr, fq);
        if (!has_next) break;
#pragma unroll
        for (int a = 0; a < 2; ++a)
#pragma unroll
            for (int b = 0; b < 2; ++b)
#pragma unroll
                for (int m = 0; m < 4; ++m)
#pragma unroll
                    for (int n = 0; n < 2; ++n) acc[a][b][m][n] = (f32x4){0.f, 0.f, 0.f, 0.f};
        cur = nxt; cA = nA; cB = nB; ++ui;
        if constexpr (ALIGN_EPI) { if (wr == 1) PG8_BAR; }
    }
    PG8_WAIT_V(0);
    if constexpr (!ALIGN_EPI) { if (wr == 0) PG8_BAR; }
    PG8_BAR;
#undef PG8_ABASE
#undef PG8_KA
#undef PG8_SA
#undef PG8_SB
#undef PG8_STAGE
#undef PG8_LDA
#undef PG8_LDB
#undef PG8_MMA
#undef PG8_WAIT_V
#undef PG8_WAIT_L
#undef PG8_BAR
#undef PG8_SCHED
}
}
using pg8::bf16_t; using pg8::f32x4; using pg8::f32x2; using pg8::u32x4; using pg8::u32x2; using pg8::Unit; using pg8::cvt_pk_bf16;
#define LAS __attribute__((address_space(3)))
constexpr int BATCH = 8, SEQ = 4096, D = 1024, M = BATCH * SEQ, FF = 2816, FF2 = 5632;
constexpr int PADR = 8, SEQP = SEQ + PADR;
constexpr float RMS_EPS = 1e-6f, GN_EPS = 64e-5f;
constexpr size_t MiB = 1u << 20;
constexpr size_t WS_CTL = 0, CTL_BYTES = 2048 * 1024, WS_XS = 1 * MiB;
constexpr size_t WS_WSTAT = 2 * MiB;
constexpr size_t WJ_IN = 0, WJ_OUT = 4 * MiB, WJ_RKV = 6 * MiB, WJ_L2WA = 20 * MiB, WJ_L2G = 20 * MiB + 512 * 1024, WJ_O = 21 * MiB, WJ_STRIDE = 23 * MiB;
constexpr size_t WS_WFFN = 48 * MiB;
constexpr size_t WS_WDOWN = WS_WFFN + 11 * MiB;
constexpr size_t WS_A = 67 * MiB;
constexpr size_t WS_P = 134 * MiB;
constexpr size_t P_R = WS_P, P_K = WS_P + 64 * MiB, P_V = WS_P + 128 * MiB, P_LW = WS_P + 192 * MiB, P_LA = WS_P + 256 * MiB, P_WA = WS_P + 320 * MiB, P_GL = WS_P + 328 * MiB;
constexpr size_t P_U = WS_P, P_SV = WS_P + 64 * MiB;
constexpr size_t P_Z = WS_P, P_ACT = WS_P + 176 * MiB;
constexpr size_t WS_PA = WS_P + 352 * MiB, WS_PB = WS_PA + 2 * MiB, WS_PV = WS_PB + 2 * MiB;
constexpr size_t WS_END = WS_PV + 2 * MiB;

struct Args {
    const float* in[32]; float* out; unsigned char* ws; int ph_lo, ph_hi;
};
enum { I_X = 0, I_NMIX, I_NFFN, I_NFIN, I_SWIN, I_SBIN, I_SGV, I_SWS, I_SBS, I_SWOUT, I_MU, I_WR, I_WK, I_WV, I_WO, I_W0, I_W1, I_W2, I_A0, I_A1, I_A2, I_G1, I_G2, I_KK, I_KA, I_RK, I_LNW, I_LNB, I_FUP, I_FCW, I_FCB, I_FDN };

__device__ __forceinline__ float bf2f(unsigned short b) { return __uint_as_float((unsigned)b << 16); }
__device__ __forceinline__ float bflo(unsigned w) { return __uint_as_float(w << 16); }
__device__ __forceinline__ float bfhi(unsigned w) { return __uint_as_float(w & 0xffff0000u); }
__device__ __forceinline__ float wave_sum(float v) {
#pragma unroll
    for (int o = 1; o < 64; o <<= 1) v += __shfl_xor(v, o);
    return v;
}
__device__ __forceinline__ float row_rstd(const float* P, int row) { const f32x4* p = (const f32x4*)(P + (size_t)row * 16); const f32x4 a = p[0], b = p[1], c = p[2], d = p[3];
    const float s = ((a.x + a.y) + (a.z + a.w)) + ((b.x + b.y) + (b.z + b.w)) + ((c.x + c.y) + (c.z + c.w)) + ((d.x + d.y) + (d.z + d.w)); return rsqrtf(s * (1.f / D) + RMS_EPS); }
__device__ __forceinline__ void row_rstd4(const float* P, int row0, int rstride, int lo, int hi, float (&rs)[4]) {
    f32x4 p[4][4];
#pragma unroll
    for (int m = 0; m < 4; ++m) { int r = row0 + m * rstride; r = r < lo ? lo : (r > hi ? hi : r); const f32x4* q = (const f32x4*)(P + (size_t)r * 16);
#pragma unroll
        for (int k = 0; k < 4; ++k) p[m][k] = q[k]; }
#pragma unroll
    for (int m = 0; m < 4; ++m) { const f32x4 a = p[m][0], b = p[m][1], c = p[m][2], d = p[m][3];
        const float s = ((a.x + a.y) + (a.z + a.w)) + ((b.x + b.y) + (b.z + b.w)) + ((c.x + c.y) + (c.z + c.w)) + ((d.x + d.y) + (d.z + d.w)); rs[m] = rsqrtf(s * (1.f / D) + RMS_EPS); }
}
template <int CTRL> __device__ __forceinline__ float dpp_f(float v) { return __int_as_float(__builtin_amdgcn_mov_dpp(__float_as_int(v), CTRL, 0xf, 0xf, true)); }
__device__ __forceinline__ float sum8(float v) { v += dpp_f<0x141>(v); v += dpp_f<0xB1>(v); v += dpp_f<0x4E>(v); return v; }
__device__ __forceinline__ float sigmoidf_(float x) { return 1.f / (1.f + __expf(-x)); }

template <bool SCALE> struct EpiStore {
    static constexpr bool PERM = true;
    bf16_t* O; int ldc; int tsh; size_t split_stride; const float* ss;
    __device__ __forceinline__ void operator()(const f32x4 (&acc)[2][2][4][2], const Unit& u, int wr, int wc, int fr, int fq) const {
        bf16_t* base = O + (size_t)(u.pn >> tsh) * split_stride + (size_t)(u.pm * 256 + wr * 64 + fr) * ldc + (u.pn & ((1 << tsh) - 1)) * 256 + wc * 32 + 8 * fq;
        const int row0 = u.pm * 256 + wr * 64 + fr;
#pragma unroll
        for (int ai = 0; ai < 2; ++ai)
#pragma unroll
            for (int m = 0; m < 4; ++m) {
                const float rs = SCALE ? row_rstd(ss, row0 + ai * 128 + m * 16) : 1.f;
                bf16_t* rowp = base + (size_t)(ai * 128 + m * 16) * ldc;
#pragma unroll
                for (int bj = 0; bj < 2; ++bj) { const f32x4 v0 = acc[ai][bj][m][0] * rs, v1 = acc[ai][bj][m][1] * rs;
                    u32x4 w; w.x = cvt_pk_bf16(v0[0], v0[1]); w.y = cvt_pk_bf16(v0[2], v0[3]); w.z = cvt_pk_bf16(v1[0], v1[1]); w.w = cvt_pk_bf16(v1[2], v1[3]);
                    *(u32x4*)(rowp + bj * 128) = w; } }
    }
};
struct EpiSguIn {
    static constexpr bool PERM = true;
    bf16_t* U; bf16_t* V; const float* ss; const float* bias; float* ssv;
    __device__ __forceinline__ void operator()(const f32x4 (&acc)[2][2][4][2], const Unit& u, int wr, int wc, int fr, int fq) const {
        const bool isv = u.pn >= 4; bf16_t* base = isv ? V : U; const int colt = (u.pn & 3) * 256 + wc * 32 + 8 * fq, bcol = u.pn * 256 + wc * 32 + 8 * fq;
        f32x4 bv[2][2];
#pragma unroll
        for (int bj = 0; bj < 2; ++bj)
#pragma unroll
            for (int n = 0; n < 2; ++n) bv[bj][n] = *(const f32x4*)(bias + bcol + bj * 128 + 4 * n);
#pragma unroll
        for (int ai = 0; ai < 2; ++ai) {
            float rs4[4]; row_rstd4(ss, u.pm * 256 + ai * 128 + wr * 64 + fr, 16, 0, M - 1, rs4);
#pragma unroll
            for (int m = 0; m < 4; ++m) { const int row = u.pm * 256 + ai * 128 + wr * 64 + m * 16 + fr;
                const float rs = rs4[m]; float s = 0.f;
                bf16_t* rowp = base + (size_t)row * D + colt;
#pragma unroll
                for (int bj = 0; bj < 2; ++bj) { f32x4 v0 = acc[ai][bj][m][0] * rs + bv[bj][0], v1 = acc[ai][bj][m][1] * rs + bv[bj][1];
                    const f32x2 a = pg8::gelu_pk((f32x2){v0[0], v0[1]}), b = pg8::gelu_pk((f32x2){v0[2], v0[3]}), c = pg8::gelu_pk((f32x2){v1[0], v1[1]}), d = pg8::gelu_pk((f32x2){v1[2], v1[3]});
                    s += (a.x * a.x + a.y * a.y) + (b.x * b.x + b.y * b.y) + (c.x * c.x + c.y * c.y) + (d.x * d.x + d.y * d.y);
                    u32x4 w; w.x = cvt_pk_bf16(a.x, a.y); w.y = cvt_pk_bf16(b.x, b.y); w.z = cvt_pk_bf16(c.x, c.y); w.w = cvt_pk_bf16(d.x, d.y);
                    *(u32x4*)(rowp + bj * 128) = w; }
                if (isv) { s += __shfl_xor(s, 16); s += __shfl_xor(s, 32); if (fq == 0) ssv[(size_t)row * 16 + (u.pn - 4) * 4 + wc] = s; } } }
    }
};
struct EpiResid {
    static constexpr bool PERM = true;
    const float* hin; float* h; bf16_t* hb; float* ssn;
    __device__ __forceinline__ void operator()(const f32x4 (&acc)[2][2][4][2], const Unit& u, int wr, int wc, int fr, int fq) const {
        const int colt = u.pn * 256 + wc * 32 + 8 * fq;
#pragma unroll
        for (int ai = 0; ai < 2; ++ai) {
            const int rowb = u.pm * 256 + ai * 128 + wr * 64 + fr;
            f32x4 pre[4][2][2];
#pragma unroll
            for (int m = 0; m < 4; ++m)
#pragma unroll
                for (int bj = 0; bj < 2; ++bj) { const float* hp = hin + (size_t)(rowb + m * 16) * D + colt + bj * 128; pre[m][bj][0] = *(const f32x4*)hp; pre[m][bj][1] = *(const f32x4*)(hp + 4); }
#pragma unroll
            for (int m = 0; m < 4; ++m) { const int row = rowb + m * 16; float s = 0.f;
                float* hp = h + (size_t)row * D + colt; bf16_t* bp = hb + (size_t)row * D + colt;
#pragma unroll
                for (int bj = 0; bj < 2; ++bj) { const f32x4 v0 = pre[m][bj][0] + acc[ai][bj][m][0], v1 = pre[m][bj][1] + acc[ai][bj][m][1];
                    *(f32x4*)(hp + bj * 128) = v0; *(f32x4*)(hp + bj * 128 + 4) = v1;
                    s += (v0[0] * v0[0] + v0[1] * v0[1]) + (v0[2] * v0[2] + v0[3] * v0[3]) + (v1[0] * v1[0] + v1[1] * v1[1]) + (v1[2] * v1[2] + v1[3] * v1[3]);
                    if (hb) { u32x4 w; w.x = cvt_pk_bf16(v0[0], v0[1]); w.y = cvt_pk_bf16(v0[2], v0[3]); w.z = cvt_pk_bf16(v1[0], v1[1]); w.w = cvt_pk_bf16(v1[2], v1[3]);
                    *(u32x4*)(bp + bj * 128) = w; } }
                s += __shfl_xor(s, 16); s += __shfl_xor(s, 32); if (fq == 0) ssn[(size_t)row * 16 + u.pn * 4 + wc] = s; }
            asm volatile("" ::: "memory");
        }
    }
};
template <int CTRL> __device__ __forceinline__ f32x4 dpp4(f32x4 v) { f32x4 r; r.x = dpp_f<CTRL>(v.x); r.y = dpp_f<CTRL>(v.y); r.z = dpp_f<CTRL>(v.z); r.w = dpp_f<CTRL>(v.w); return r; }
struct EpiFfnUp {
    static constexpr bool PERM = true;
    bf16_t* ACT; const float* ss; const float* cw; const float* cb;
    template <bool MASK> __device__ __forceinline__ void conv4(f32x4& z0, f32x4& z1, f32x4& z2, f32x4& z3, const float (&rs)[4], const int (&tt)[4], const float* wcol, const float* bcol, int fr) const {
        const f32x4 w0 = *(const f32x4*)wcol, w1 = *(const f32x4*)(wcol + FF2), w2 = *(const f32x4*)(wcol + 2 * FF2), bb = *(const f32x4*)bcol;
#pragma unroll
        for (int e = 0; e < 4; e += 2) {
            const f32x2 w0p = {w0[e], w0[e + 1]}, w1p = {w1[e], w1[e + 1]}, w2p = {w2[e], w2[e + 1]}, bp = {bb[e], bb[e + 1]};
            f32x2 cur = (f32x2){z3[e], z3[e + 1]} * rs[3];
            f32x2 c1 = {dpp_f<0x121>(cur.x), dpp_f<0x121>(cur.y)}, c2 = {dpp_f<0x122>(cur.x), dpp_f<0x122>(cur.y)};
#define CONV_STEP(ZM, ZP, MI, HASP) { f32x2 prv = cur, p1 = c1, p2 = c2; if (HASP) { prv = (f32x2){ZP[e], ZP[e + 1]} * rs[MI - (HASP)]; p1 = (f32x2){dpp_f<0x121>(prv.x), dpp_f<0x121>(prv.y)}; p2 = (f32x2){dpp_f<0x122>(prv.x), dpp_f<0x122>(prv.y)}; } \
            f32x2 y1 = (fr == 0) ? p1 : c1, y2 = (fr < 2) ? p2 : c2; if (MASK) { if (tt[MI] < 1) y1 = (f32x2){0.f, 0.f}; if (tt[MI] < 2) y2 = (f32x2){0.f, 0.f}; } \
            const f32x2 o = w0p * y2 + (w1p * y1 + (w2p * cur + bp)); ZM[e] = o.x; ZM[e + 1] = o.y; cur = prv; c1 = p1; c2 = p2; }
            CONV_STEP(z3, z2, 3, 1) CONV_STEP(z2, z1, 2, 1) CONV_STEP(z1, z0, 1, 1) CONV_STEP(z0, z0, 0, 0)
#undef CONV_STEP
            asm volatile("" : "+v"(z0[e]), "+v"(z1[e]), "+v"(z2[e]), "+v"(z3[e]), "+v"(z0[e + 1]), "+v"(z1[e + 1]), "+v"(z2[e + 1]), "+v"(z3[e + 1]));
        }
    }
    __device__ __forceinline__ void operator()(f32x4 (&acc)[2][2][4][2], const Unit& u, int wr, int wc, int fr, int fq) const {
        const int f0 = u.pn * 128 + wc * 32 + 8 * fq;
#pragma unroll
        for (int ai = 0; ai < 2; ++ai) {
            const int gbase = u.pm * 248 - 2 + 62 * (2 * ai + wr) + fr;
            float rs[4]; int tt[4];
            row_rstd4(ss, gbase, 16, 0, M - 1, rs);
            asm volatile("" : "+v"(rs[0]), "+v"(rs[1]), "+v"(rs[2]), "+v"(rs[3]) :: "memory");
            const int g0 = u.pm * 248 - 2 + 62 * (2 * ai + wr);
            const bool seqstart = ((g0 + 63) & (SEQ - 1)) < 65 || g0 < 0;
#pragma unroll
            for (int m = 0; m < 4; ++m) tt[m] = (gbase + 16 * m) & (SEQ - 1);
#pragma unroll
            for (int n = 0; n < 2; ++n) {
                if (seqstart) {
                    conv4<true>(acc[ai][0][0][n], acc[ai][0][1][n], acc[ai][0][2][n], acc[ai][0][3][n], rs, tt, cw + f0 + 4 * n, cb + f0 + 4 * n, fr);
                    asm volatile("" ::: "memory");
                    conv4<true>(acc[ai][1][0][n], acc[ai][1][1][n], acc[ai][1][2][n], acc[ai][1][3][n], rs, tt, cw + FF + f0 + 4 * n, cb + FF + f0 + 4 * n, fr);
                } else {
                    conv4<false>(acc[ai][0][0][n], acc[ai][0][1][n], acc[ai][0][2][n], acc[ai][0][3][n], rs, tt, cw + f0 + 4 * n, cb + f0 + 4 * n, fr);
                    asm volatile("" ::: "memory");
                    conv4<false>(acc[ai][1][0][n], acc[ai][1][1][n], acc[ai][1][2][n], acc[ai][1][3][n], rs, tt, cw + FF + f0 + 4 * n, cb + FF + f0 + 4 * n, fr);
                }
                asm volatile("" ::: "memory");
#pragma unroll
                for (int m = 0; m < 4; ++m) { const int g = gbase + 16 * m;
                    if ((m > 0 || fr >= 2) && g < M) { const f32x4 gt = acc[ai][0][m][n], vl = acc[ai][1][m][n]; f32x4 o;
#pragma unroll
                        for (int e = 0; e < 4; ++e) o[e] = gt[e] * sigmoidf_(gt[e]) * vl[e];
                        u32x2 w; w.x = cvt_pk_bf16(o[0], o[1]); w.y = cvt_pk_bf16(o[2], o[3]);
                        *(u32x2*)(ACT + (size_t)g * FF + f0 + 4 * n) = w; } }
            }
        }
    }
};
struct EpiRkv {
    static constexpr bool PERM = true;
    bf16_t* R; bf16_t* WA; bf16_t* GL; int row_off, pn_off;
    __device__ __forceinline__ void operator()(const f32x4 (&acc)[2][2][4][2], const Unit& u, int wr, int wc, int fr, int fq) const {
        const int pne = u.pn + pn_off; const int mode = pne < 12 ? 0 : (pne == 12 ? 1 : 2);
        bf16_t* base; int ldc, colt;
        if (mode == 0) { base = R + (size_t)(pne >> 2) * ((size_t)M * D); ldc = D; colt = (pne & 3) * 256 + wc * 32 + 8 * fq; }
        else if (mode == 1) { base = WA; ldc = 128; colt = wc * 32 + 8 * fq; }
        else { base = GL; ldc = 256; colt = wc * 32 + 8 * fq; }
#pragma unroll
        for (int ai = 0; ai < 2; ++ai)
#pragma unroll
            for (int m = 0; m < 4; ++m) { const int row = row_off + u.pm * 256 + ai * 128 + wr * 64 + m * 16 + fr;
                bf16_t* rowp = base + (size_t)row * ldc + colt;
#pragma unroll
                for (int bj = 0; bj < 2; ++bj) { f32x4 v0 = acc[ai][bj][m][0], v1 = acc[ai][bj][m][1];
                    if (mode == 1) { if (bj == 1) continue;
                        if (wc < 2) {
#pragma unroll
                            for (int e = 0; e < 4; ++e) { v0[e] = tanhf(v0[e]); v1[e] = tanhf(v1[e]); } } }
                    else if (mode == 2) {
#pragma unroll
                        for (int e = 0; e < 4; ++e) { v0[e] = sigmoidf_(v0[e]); v1[e] = sigmoidf_(v1[e]); } }
                    u32x4 w; w.x = cvt_pk_bf16(v0[0], v0[1]); w.y = cvt_pk_bf16(v0[2], v0[3]); w.z = cvt_pk_bf16(v1[0], v1[1]); w.w = cvt_pk_bf16(v1[2], v1[3]);
                    *(u32x4*)(rowp + bj * 128) = w; } }
    }
};

typedef const __attribute__((address_space(4))) Args* CA;
struct Ctx { LAS unsigned char* lds; int tid, lane, wave, G, bid; };

__device__ __forceinline__ void conv_mat(const Ctx& c, const float* src, int ldsrc, int K, int N, int Kp, int Np, bf16_t* dst, int ldd, int n_off, int k_off, const float* sc, int mode, int rot) {
    LAS float* tile = (LAS float*)c.lds;
    const int nnb = Np / 64, nit = (Kp / 64) * nnb; const int start = (c.bid + c.G - (rot % c.G)) % c.G;
    for (int it = start; it < nit; it += c.G) {
        const int kb = it / nnb, nb = it % nnb, k0 = kb * 64, n0 = nb * 64;
#pragma unroll
        for (int j = 0; j < 2; ++j) { const int kk = (c.tid >> 4) + 32 * j, nn = (c.tid & 15) * 4, k = k0 + kk, n = n0 + nn; f32x4 v = (f32x4){0.f, 0.f, 0.f, 0.f};
            if (src && k < K && n < N) { v = *(const f32x4*)(src + (size_t)k * ldsrc + n); if (mode == 1) v = v * sc[k]; else if (mode == 2) v = v * (1.f - sc[k]); }
            tile[nn * 65 + kk] = v.x; tile[(nn + 1) * 65 + kk] = v.y; tile[(nn + 2) * 65 + kk] = v.z; tile[(nn + 3) * 65 + kk] = v.w; }
        __syncthreads();
        { const int nn = c.tid >> 3, cc = c.tid & 7; const LAS float* s = tile + nn * 65 + 8 * cc;
            u32x4 o; o.x = cvt_pk_bf16(s[0], s[1]); o.y = cvt_pk_bf16(s[2], s[3]); o.z = cvt_pk_bf16(s[4], s[5]); o.w = cvt_pk_bf16(s[6], s[7]);
            *(u32x4*)(dst + (size_t)(n_off + n0 + nn) * ldd + k_off + k0 + 8 * cc) = o; }
        __syncthreads();
    }
}

__device__ __forceinline__ void phase_static_weights(const Ctx& c, CA a, int j);
__device__ __forceinline__ void phase_prologue(const Ctx& c, CA a) {
    float* ss = (float*)(a->ws + WS_PA);
    const int gw = c.bid * 8 + c.wave, NGW = c.G * 8;
    bf16_t* hb = (bf16_t*)(a->ws + WS_A);
    for (int m = gw; m < M; m += NGW) {
        const f32x4* xr = (const f32x4*)(a->in[I_X] + (size_t)m * D) + c.lane; u32x2* br = (u32x2*)(hb + (size_t)m * D) + c.lane;
        float s = 0.f;
#pragma unroll
        for (int j = 0; j < 4; ++j) { const f32x4 v = xr[64 * j]; s += (v.x * v.x + v.y * v.y) + (v.z * v.z + v.w * v.w); u32x2 w; w.x = cvt_pk_bf16(v.x, v.y); w.y = cvt_pk_bf16(v.z, v.w); br[64 * j] = w; }
        s = wave_sum(s); if (c.lane < 16) ss[(size_t)m * 16 + c.lane] = c.lane == 0 ? s : 0.f;
    }
    phase_static_weights(c, a, 0);
}
__device__ __forceinline__ void phase_static_weights(const Ctx& c, CA a, int j) {
    int rot = 0;
    {
        unsigned char* wj = a->ws + WS_WSTAT + (size_t)j * WJ_STRIDE;
        conv_mat(c, a->in[I_SWIN] + (size_t)j * D * 2048, 2048, D, 2048, D, 2048, (bf16_t*)(wj + WJ_IN), D, 0, 0, a->in[I_NMIX] + (size_t)(2 * j) * D, 1, rot); rot += 512;
        conv_mat(c, a->in[I_SWOUT] + (size_t)j * D * D, D, D, D, D, D, (bf16_t*)(wj + WJ_OUT), D, 0, 0, nullptr, 0, rot); rot += 256;
        const float* mu = a->in[I_MU] + (size_t)j * 6 * D; bf16_t* rkv3 = (bf16_t*)(wj + WJ_RKV); bf16_t* rkv = (bf16_t*)(wj + WJ_RKV + 6 * MiB) - (size_t)3072 * 2048;
#define CONV_BIG(IDX, Q, MUB) do { conv_mat(c, a->in[IDX] + (size_t)j * D * D, D, D, D, D, D, rkv3, 1024, (Q) * 1024, 0, nullptr, 0, rot); rot += 256; } while (0)
        CONV_BIG(I_WR, 0, 0); CONV_BIG(I_WK, 1, 2); CONV_BIG(I_WV, 2, 3);
#undef CONV_BIG
        conv_mat(c, a->in[I_W1] + (size_t)j * D * 64, 64, D, 64, D, 64, rkv, 2048, 3072, 0, mu + 1 * D, 2, rot); rot += 16;
        conv_mat(c, a->in[I_W1] + (size_t)j * D * 64, 64, D, 64, D, 64, rkv, 2048, 3072, 1024, mu + 1 * D, 1, rot); rot += 16;
        conv_mat(c, a->in[I_A1] + (size_t)j * D * 64, 64, D, 64, D, 64, rkv, 2048, 3136, 0, mu + 4 * D, 2, rot); rot += 16;
        conv_mat(c, a->in[I_A1] + (size_t)j * D * 64, 64, D, 64, D, 64, rkv, 2048, 3136, 1024, mu + 4 * D, 1, rot); rot += 16;
        conv_mat(c, nullptr, 0, 0, 0, 2048, 128, rkv, 2048, 3200, 0, nullptr, 0, rot); rot += 64;
        conv_mat(c, a->in[I_G1] + (size_t)j * D * 160, 160, D, 160, D, 256, rkv, 2048, 3328, 0, mu + 5 * D, 2, rot); rot += 64;
        conv_mat(c, a->in[I_G1] + (size_t)j * D * 160, 160, D, 160, D, 256, rkv, 2048, 3328, 1024, mu + 5 * D, 1, rot); rot += 64;
        bf16_t* l2wa = (bf16_t*)(wj + WJ_L2WA);
        conv_mat(c, a->in[I_W2] + (size_t)j * 64 * D, D, 64, D, 64, D, l2wa, 128, 0, 0, nullptr, 0, rot); rot += 16;
        conv_mat(c, nullptr, 0, 0, 0, 64, D, l2wa, 128, 0, 64, nullptr, 0, rot); rot += 16;
        conv_mat(c, nullptr, 0, 0, 0, 64, D, l2wa, 128, 1024, 0, nullptr, 0, rot); rot += 16;
        conv_mat(c, a->in[I_A2] + (size_t)j * 64 * D, D, 64, D, 64, D, l2wa, 128, 1024, 64, nullptr, 0, rot); rot += 16;
        conv_mat(c, a->in[I_G2] + (size_t)j * 160 * D, D, 160, D, 256, D, (bf16_t*)(wj + WJ_L2G), 256, 0, 0, nullptr, 0, rot); rot += 64;
        conv_mat(c, a->in[I_WO] + (size_t)j * D * D, D, D, D, D, D, (bf16_t*)(wj + WJ_O), D, 0, 0, nullptr, 0, rot); rot += 256;
    }
}
__device__ __forceinline__ void phase_ffn_weights(const Ctx& c, CA a, int layer) {
    for (int pn = 0; pn < FF / 128; ++pn) {
        conv_mat(c, a->in[I_FUP] + (size_t)layer * D * FF2 + pn * 128, FF2, D, 128, D, 128, (bf16_t*)(a->ws + WS_WFFN), D, pn * 256, 0, a->in[I_NFFN] + (size_t)layer * D, 1, pn * 64);
        conv_mat(c, a->in[I_FUP] + (size_t)layer * D * FF2 + FF + pn * 128, FF2, D, 128, D, 128, (bf16_t*)(a->ws + WS_WFFN), D, pn * 256 + 128, 0, a->in[I_NFFN] + (size_t)layer * D, 1, pn * 64 + 32);
    }
    conv_mat(c, a->in[I_FDN] + (size_t)layer * FF * D, D, FF, D, FF, D, (bf16_t*)(a->ws + WS_WDOWN), FF, 0, 0, nullptr, 0, 128);
}

__device__ __forceinline__ void phase_sgu_spatial(const Ctx& c, CA a, int j, int rp) {
    typedef short bf16x8 __attribute__((ext_vector_type(8)));
    bf16_t* U = (bf16_t*)(a->ws + P_U); const bf16_t* V = (const bf16_t*)(a->ws + P_SV); bf16_t* UO = rp ? (bf16_t*)(a->ws + P_SV) : U;
    const float* ssv = (const float*)(a->ws + WS_PV);
    LAS bf16_t* WL = (LAS bf16_t*)c.lds; LAS bf16_t* VT = WL + 128 * 136;
    const int g = c.bid & 15;
    const float* Ws = a->in[I_SWS] + ((size_t)j * 16 + g) * 128 * 128; const float* bs = a->in[I_SBS] + ((size_t)j * 16 + g) * 128; const float* gv = a->in[I_SGV] + (size_t)j * D + g * 64;
    __syncthreads();
    { const int t = c.tid >> 2, s0 = (c.tid & 3) * 32; const float* wp = Ws + (size_t)t * 128 + s0;
#pragma unroll
      for (int q = 0; q < 4; ++q) { f32x4 x0 = *(const f32x4*)(wp + 8 * q), x1 = *(const f32x4*)(wp + 8 * q + 4);
#pragma unroll
          for (int e = 0; e < 4; ++e) { if (s0 + 8 * q + e > t) x0[e] = 0.f; if (s0 + 8 * q + 4 + e > t) x1[e] = 0.f; }
          u32x4 w; w.x = cvt_pk_bf16(x0[0], x0[1]); w.y = cvt_pk_bf16(x0[2], x0[3]); w.z = cvt_pk_bf16(x1[0], x1[1]); w.w = cvt_pk_bf16(x1[2], x1[3]);
          *(LAS u32x4*)(WL + t * 136 + s0 + 8 * q) = w; } }
    const int w8 = c.wave, fr = c.lane & 15, fq = c.lane >> 4, t0 = 16 * w8, nk = (w8 >> 1) + 1;
    const int vs = c.tid >> 2, vc = (c.tid & 3) * 16;
    f32x4 gq[4];
#pragma unroll
    for (int e = 0; e < 4; ++e) gq[e] = *(const f32x4*)(gv + vc + 4 * e);
    const float bb = bs[t0 + fr];
    for (int ub = c.bid >> 4; ub < M / 128; ub += c.G >> 4) {
        const int m0 = ub * 128;
        { const bf16_t* vp = V + (size_t)(m0 + vs) * D + g * 64 + vc; const u32x4 v0 = *(const u32x4*)vp, v1 = *(const u32x4*)(vp + 8);
          const float rs = row_rstd(ssv, m0 + vs);
          const unsigned vw[8] = {v0.x, v0.y, v0.z, v0.w, v1.x, v1.y, v1.z, v1.w};
#pragma unroll
          for (int e = 0; e < 8; ++e) { const float lo = bflo(vw[e]) * rs * gq[e >> 1][(2 * e) & 3], hi = bfhi(vw[e]) * rs * gq[e >> 1][(2 * e + 1) & 3];
              const unsigned pk = cvt_pk_bf16(lo, hi);
              VT[(vc + 2 * e) * 136 + vs] = (bf16_t)(pk & 0xffffu); VT[(vc + 2 * e + 1) * 136 + vs] = (bf16_t)(pk >> 16); } }
        __syncthreads();
        f32x4 acc[4];
#pragma unroll
        for (int ct = 0; ct < 4; ++ct) acc[ct] = (f32x4){0.f, 0.f, 0.f, 0.f};
        for (int k = 0; k < nk; ++k) {
            const bf16x8 wf = *(const LAS bf16x8*)(WL + (t0 + fr) * 136 + 32 * k + 8 * fq);
#pragma unroll
            for (int ct = 0; ct < 4; ++ct) { const bf16x8 vf = *(const LAS bf16x8*)(VT + (16 * ct + fr) * 136 + 32 * k + 8 * fq);
                acc[ct] = __builtin_amdgcn_mfma_f32_16x16x32_bf16(vf, wf, acc[ct], 0, 0, 0); }
        }
        { const size_t ro = (size_t)(m0 + t0 + fr) * D + g * 64 + 4 * fq;
#pragma unroll
          for (int ct = 0; ct < 4; ++ct) { const u32x2 uu = *(const u32x2*)(U + ro + 16 * ct); const f32x4 o = acc[ct] + bb;
              u32x2 w; w.x = cvt_pk_bf16(bflo(uu.x) * o[0], bfhi(uu.x) * o[1]); w.y = cvt_pk_bf16(bflo(uu.y) * o[2], bfhi(uu.y) * o[3]);
              *(u32x2*)(UO + ro + 16 * ct) = w; } }
        __syncthreads();
    }
}

__device__ __forceinline__ void phase_ffn_conv(const Ctx& c, CA a, int layer, int half) {
    const bf16_t* Z = (const bf16_t*)(a->ws + P_Z); bf16_t* ACT = (bf16_t*)(a->ws + P_ACT) + (size_t)half * (M / 2) * FF;
    const float* cw = a->in[I_FCW] + (size_t)layer * 3 * FF2; const float* cb = a->in[I_FCB] + (size_t)layer * FF2;
    const int gt = c.bid * 512 + c.tid, NT = c.G * 512;
    for (int idx = gt; idx < (M / 2) * (FF / 8); idx += NT) {
        const int ml = idx / (FF / 8), f = (idx % (FF / 8)) * 8, t = ml & (SEQ - 1);
        float gsum[8], vsum[8];
#pragma unroll
        for (int e = 0; e < 8; ++e) { gsum[e] = cb[f + e]; vsum[e] = cb[FF + f + e]; }
#pragma unroll
        for (int jj = 0; jj < 3; ++jj) { const int dt = 2 - jj; if (t - dt < 0) continue;
            const u32x4 zg = *(const u32x4*)(Z + (size_t)(ml - dt) * FF2 + f), zv = *(const u32x4*)(Z + (size_t)(ml - dt) * FF2 + FF + f);
            const float* wg = cw + (size_t)jj * FF2 + f; const float* wv = wg + FF;
            const unsigned zgw[4] = {zg.x, zg.y, zg.z, zg.w}, zvw[4] = {zv.x, zv.y, zv.z, zv.w};
#pragma unroll
            for (int e = 0; e < 4; ++e) { gsum[2 * e] += wg[2 * e] * bflo(zgw[e]); gsum[2 * e + 1] += wg[2 * e + 1] * bfhi(zgw[e]); vsum[2 * e] += wv[2 * e] * bflo(zvw[e]); vsum[2 * e + 1] += wv[2 * e + 1] * bfhi(zvw[e]); } }
        float o[8];
#pragma unroll
        for (int e = 0; e < 8; ++e) o[e] = gsum[e] * sigmoidf_(gsum[e]) * vsum[e];
        u32x4 w; w.x = cvt_pk_bf16(o[0], o[1]); w.y = cvt_pk_bf16(o[2], o[3]); w.z = cvt_pk_bf16(o[4], o[5]); w.w = cvt_pk_bf16(o[6], o[7]);
        *(u32x4*)(ACT + (size_t)ml * FF + f) = w;
    }
}

__device__ __forceinline__ void phase_rwkv_prep(const Ctx& c, CA a, int layer, int mode) {
    const float* ss = (const float*)(a->ws + WS_PA); const float* g = a->in[I_NMIX] + (size_t)layer * D; const float* mu = a->in[I_MU] + (size_t)(layer >> 1) * 6 * D;
    bf16_t* hn = (bf16_t*)(a->ws + WS_A); bf16_t* X = (bf16_t*)(a->ws + P_LW);
    const int gw = c.bid * 8 + c.wave, NGW = c.G * 8;
    f32x4 gg[4], mr[4], mk[4], mv[4];
#pragma unroll
    for (int j = 0; j < 4; ++j) { gg[j] = *((const f32x4*)g + c.lane + 64 * j); mr[j] = *((const f32x4*)mu + c.lane + 64 * j); mk[j] = *((const f32x4*)(mu + 2 * D) + c.lane + 64 * j); mv[j] = *((const f32x4*)(mu + 3 * D) + c.lane + 64 * j); }
    for (int m = gw + (mode ? M / 2 : 0); m < M; m += NGW) {
        const float rs = row_rstd(ss, m); const int t = m & (SEQ - 1);
        const f32x4* hr = (const f32x4*)(a->out + (size_t)m * D) + c.lane;
        f32x4 cur[4];
#pragma unroll
        for (int j = 0; j < 4; ++j) cur[j] = hr[64 * j] * rs * gg[j];
        if (mode == 0) { const int prow = (m >> 12) * SEQP + PADR + t; u32x2* br = (u32x2*)(hn + (size_t)prow * D) + c.lane;
#pragma unroll
            for (int j = 0; j < 4; ++j) { u32x2 w; w.x = cvt_pk_bf16(cur[j].x, cur[j].y); w.y = cvt_pk_bf16(cur[j].z, cur[j].w); br[64 * j] = w; } }
        if (mode == 1 || m < M / 2) {
            const float rsp = t > 0 ? row_rstd(ss, m - 1) : 0.f; const f32x4* hp = (const f32x4*)(a->out + (size_t)(t > 0 ? m - 1 : m) * D) + c.lane;
            const size_t lo = (size_t)(m & (M / 2 - 1)) * D;
            u32x2* xr = (u32x2*)(X + lo) + c.lane; u32x2* xk = (u32x2*)(X + (size_t)(M / 2) * D + lo) + c.lane; u32x2* xv = (u32x2*)(X + (size_t)M * D + lo) + c.lane;
#pragma unroll
            for (int j = 0; j < 4; ++j) { const f32x4 dl = hp[64 * j] * rsp * gg[j] - cur[j];
                const f32x4 vr = cur[j] + dl * mr[j], vk = cur[j] + dl * mk[j], vv = cur[j] + dl * mv[j]; u32x2 w;
                w.x = cvt_pk_bf16(vr.x, vr.y); w.y = cvt_pk_bf16(vr.z, vr.w); xr[64 * j] = w;
                w.x = cvt_pk_bf16(vk.x, vk.y); w.y = cvt_pk_bf16(vk.z, vk.w); xk[64 * j] = w;
                w.x = cvt_pk_bf16(vv.x, vv.y); w.y = cvt_pk_bf16(vv.z, vv.w); xv[64 * j] = w; }
        }
    }
    if (mode == 0) for (int r = gw; r < BATCH * PADR; r += NGW) { const int prow = (r / PADR) * SEQP + (r % PADR); u32x2* br = (u32x2*)(hn + (size_t)prow * D) + c.lane;
#pragma unroll
        for (int j = 0; j < 4; ++j) br[64 * j] = (u32x2){0u, 0u}; }
}

__device__ __forceinline__ f32x4 bf4(u32x2 w) { return (f32x4){bflo(w.x), bfhi(w.x), bflo(w.y), bfhi(w.y)}; }
__device__ __forceinline__ float hsum4(f32x4 p) { return (p.x + p.y) + (p.z + p.w); }
__device__ __forceinline__ float sum16(float v) { v = sum8(v); v += dpp_f<0x140>(v); return v; }
__device__ __forceinline__ f32x4 bf4lo(u32x4 w) { return (f32x4){bflo(w.x), bfhi(w.x), bflo(w.y), bfhi(w.y)}; }
__device__ __forceinline__ f32x4 bf4hi(u32x4 w) { return (f32x4){bflo(w.z), bfhi(w.z), bflo(w.w), bfhi(w.w)}; }
__device__ __forceinline__ void phase_scan(const Ctx& c, CA a, int j, int rp_out) {
    constexpr int CH = 32, NCH = SEQ / CH, VSZ = CH * 64, YSZ = CH * 32;
    LAS float* BIG = (LAS float*)c.lds; LAS float* VB = BIG + 2 * 5 * VSZ; LAS float* YB = VB + 4 * VSZ; LAS float* BON = YB + 3 * YSZ; LAS float* SCR = BON + 128;
    bf16_t* R = (bf16_t*)(a->ws + P_R); const bf16_t* Kb = (const bf16_t*)(a->ws + P_K); const bf16_t* Vb = (const bf16_t*)(a->ws + P_V);
    const bf16_t* LWb = (const bf16_t*)(a->ws + P_LW); const bf16_t* LAb = (const bf16_t*)(a->ws + P_LA); const bf16_t* Gb = (const bf16_t*)(a->ws + WS_A);
    if (c.G != 256) return;
    const int unit = c.bid, b = unit >> 5, hh = (unit >> 1) & 15, half = unit & 1;
    unsigned long long* slot_own = (unsigned long long*)(a->ws + WS_XS) + (size_t)(j * 256 + unit) * 256; const unsigned long long* slot_par = (const unsigned long long*)(a->ws + WS_XS) + (size_t)(j * 256 + (unit ^ 1)) * 256;
    const bool cons = c.tid < 256;
    __syncthreads();
    if (cons) {
        const int rp = c.tid >> 3, q = c.tid & 7, row = 32 * half + rp;
        f32x4 S0 = (f32x4){0.f, 0.f, 0.f, 0.f}, S1 = S0;
        __builtin_amdgcn_s_setprio(2);
        __syncthreads();
        for (int i = 0; i <= NCH + 1; ++i) {
            if (i < NCH) {
                const LAS float* bg = BIG + (i & 1) * 5 * VSZ + 8 * q;
                const LAS f32x4* pw = (const LAS f32x4*)bg; const LAS f32x4* pa = (const LAS f32x4*)(bg + VSZ); const LAS f32x4* pb = (const LAS f32x4*)(bg + 2 * VSZ);
                const LAS f32x4* pk = (const LAS f32x4*)(bg + 3 * VSZ); const LAS f32x4* pr = (const LAS f32x4*)(bg + 4 * VSZ);
                const LAS float* pv = VB + (i & 3) * VSZ + row; LAS float* py = YB + (i % 3) * YSZ + rp;
                f32x4 a0v = pa[0], a1v = pa[1], b0v = pb[0], b1v = pb[1], k0v = pk[0], k1v = pk[1], r0v = pr[0], r1v = pr[1];
                float vv = pv[0];
                for (int t8 = 0; t8 < CH; t8 += 8) {
#pragma unroll
                    for (int u = 0; u < 8; ++u) {
                        const int t = t8 + u, tn = (t + 1) & (CH - 1);
                        const f32x4 na0 = pa[tn * 16], na1 = pa[tn * 16 + 1], nb0 = pb[tn * 16], nb1 = pb[tn * 16 + 1],
                                    nk0 = pk[tn * 16], nk1 = pk[tn * 16 + 1], nr0 = pr[tn * 16], nr1 = pr[tn * 16 + 1];
                        const float nvv = pv[tn * 64];
                        const float sa = sum8(hsum4(S0 * a0v + S1 * a1v));
                        S0 = S0 + sa * b0v + vv * k0v; S1 = S1 + sa * b1v + vv * k1v;
                        const float y = sum8(hsum4(S0 * r0v + S1 * r1v));
                        if (q == 0) py[t * 32] = y;
                        if (u == 7) { S0 = S0 * pw[t * 16]; S1 = S1 * pw[t * 16 + 1]; }
                        a0v = na0; a1v = na1; b0v = nb0; b1v = nb1; k0v = nk0; k1v = nk1; r0v = nr0; r1v = nr1; vv = nvv;
                    }
                }
            }
            __syncthreads();
        }
        __builtin_amdgcn_s_setprio(0);
    } else {
        const int pt = c.tid - 256, st = pt >> 3, l8 = pt & 7, sc = l8 * 8, ch = hh * 64 + sc;
        const float* pp = a->in[I_W0] + (size_t)j * D + ch; const f32x4 w0a = *(const f32x4*)pp, w0b = *(const f32x4*)(pp + 4);
        pp = a->in[I_A0] + (size_t)j * D + ch; const f32x4 a0a = *(const f32x4*)pp, a0b = *(const f32x4*)(pp + 4);
        pp = a->in[I_KK] + (size_t)j * D + ch; const f32x4 kka = *(const f32x4*)pp, kkb = *(const f32x4*)(pp + 4);
        pp = a->in[I_KA] + (size_t)j * D + ch; const f32x4 kaa = *(const f32x4*)pp, kab = *(const f32x4*)(pp + 4);
        pp = a->in[I_RK] + (size_t)j * D + ch; const f32x4 rka = *(const f32x4*)pp, rkb = *(const f32x4*)(pp + 4);
        const int oc = 4 * l8, cho = hh * 64 + 32 * half + oc;
        const f32x4 lnw = *(const f32x4*)(a->in[I_LNW] + (size_t)j * D + cho), lnb = *(const f32x4*)(a->in[I_LNB] + (size_t)j * D + cho);
        const size_t gbase = ((size_t)b * SEQ + st) * D + ch, obase = ((size_t)b * SEQ + st) * D + cho;
        u32x4 qr = *(const u32x4*)(R + gbase), qk = *(const u32x4*)(Kb + gbase), qv = *(const u32x4*)(Vb + gbase), qlw = *(const u32x4*)(LWb + gbase), qla = *(const u32x4*)(LAb + gbase);
        u32x2 qg = (u32x2){0u, 0u};
#define SCAN_STAGE(n) { \
            f32x4 rr[2] = {bf4lo(qr), bf4hi(qr)}, kk_[2] = {bf4lo(qk), bf4hi(qk)}, vv_[2] = {bf4lo(qv), bf4hi(qv)}, lw_[2] = {bf4lo(qlw), bf4hi(qlw)}, la_[2] = {bf4lo(qla), bf4hi(qla)}; \
            const f32x4 w0_[2] = {w0a, w0b}, a0_[2] = {a0a, a0b}, kkp_[2] = {kka, kkb}, kap_[2] = {kaa, kab}, rkp_[2] = {rka, rkb}; \
            f32x4 dec[2], av[2], kn[2], kp[2]; float n2 = 0.f, bon = 0.f; \
            _Pragma("unroll") for (int h2 = 0; h2 < 2; ++h2) _Pragma("unroll") for (int e = 0; e < 4; ++e) { \
                const float xw = -(w0_[h2][e] + lw_[h2][e]); const float sp = xw > 20.f ? xw : __logf(1.f + __expf(xw)); \
                dec[h2][e] = __expf(-sp - 0.5f); av[h2][e] = __builtin_amdgcn_rcpf(1.f + __expf(-(a0_[h2][e] + la_[h2][e]))); \
                kn[h2][e] = kk_[h2][e] * kkp_[h2][e]; n2 += kn[h2][e] * kn[h2][e]; \
                kp[h2][e] = kk_[h2][e] * (1.f + (av[h2][e] - 1.f) * kap_[h2][e]); bon += rr[h2][e] * kp[h2][e] * rkp_[h2][e]; } \
            n2 = sum8(n2); bon = sum8(bon); const float inv = rsqrtf(fmaxf(n2, 1e-24f)); \
            LAS float* scr = SCR + (pt >> 6) * 512; *(LAS f32x4*)(scr + (st & 7) * 64 + sc) = dec[0]; *(LAS f32x4*)(scr + (st & 7) * 64 + sc + 4) = dec[1]; \
            f32x4 cum[2] = {(f32x4){0.f, 0.f, 0.f, 0.f}, (f32x4){0.f, 0.f, 0.f, 0.f}}; \
            asm volatile("s_waitcnt lgkmcnt(0)" ::: "memory"); \
            for (int t2 = 0; t2 <= (st & 7); ++t2) { cum[0] += *(const LAS f32x4*)(scr + t2 * 64 + sc); cum[1] += *(const LAS f32x4*)(scr + t2 * 64 + sc + 4); } \
            asm volatile("s_waitcnt lgkmcnt(0)" ::: "memory"); \
            LAS float* bg = BIG + ((n) & 1) * 5 * VSZ + st * 64 + sc; \
            _Pragma("unroll") for (int h2 = 0; h2 < 2; ++h2) { const f32x4 kq = kn[h2] * inv; f32x4 Pt, Pp, Pi; \
                _Pragma("unroll") for (int e = 0; e < 4; ++e) { Pt[e] = __expf(-cum[h2][e]); Pp[e] = __expf(dec[h2][e] - cum[h2][e]); Pi[e] = __expf(cum[h2][e]); } \
                *(LAS f32x4*)(bg + 4 * h2) = Pt; *(LAS f32x4*)(bg + VSZ + 4 * h2) = -kq * Pp; *(LAS f32x4*)(bg + 2 * VSZ + 4 * h2) = kq * av[h2] * Pi; \
                *(LAS f32x4*)(bg + 3 * VSZ + 4 * h2) = kp[h2] * Pi; *(LAS f32x4*)(bg + 4 * VSZ + 4 * h2) = rr[h2] * Pt; \
                *(LAS f32x4*)(VB + ((n) & 3) * VSZ + st * 64 + sc + 4 * h2) = vv_[h2]; } \
            if (l8 == 0) BON[((n) & 3) * CH + st] = bon; }
#define SCAN_YSTATS(n) \
            const f32x4 y = *(const LAS f32x4*)(YB + ((n) % 3) * YSZ + st * 32 + oc); \
            const float mh = sum8(hsum4(y)) * (1.f / 32.f); const f32x4 d = y - mh; const float m2h = sum8(hsum4(d * d));
        SCAN_STAGE(0)
        { const size_t go = gbase + (size_t)CH * D; qr = *(const u32x4*)(R + go); qk = *(const u32x4*)(Kb + go); qv = *(const u32x4*)(Vb + go); qlw = *(const u32x4*)(LWb + go); qla = *(const u32x4*)(LAb + go); }
        __syncthreads();
        for (int i = 0; i <= NCH + 1; ++i) {
            unsigned long long pw0 = 0ull, pw1 = 0ull; const unsigned long long* pp_ = slot_par + (((i - 2) & 3) * CH + st) * 2;
            if (i >= 2) { pw0 = __hip_atomic_load(pp_, __ATOMIC_RELAXED, __HIP_MEMORY_SCOPE_AGENT); pw1 = __hip_atomic_load(pp_ + 1, __ATOMIC_RELAXED, __HIP_MEMORY_SCOPE_AGENT); }
            if (i >= 1 && i <= NCH) {
                const int n = i - 1;
                SCAN_YSTATS(n)
                if (l8 == 0) { const unsigned long long tg = (unsigned long long)(unsigned)(n + 1) << 32; unsigned long long* sp_ = slot_own + ((n & 3) * CH + st) * 2;
                    __hip_atomic_store(sp_, tg | __float_as_uint(mh), __ATOMIC_RELAXED, __HIP_MEMORY_SCOPE_AGENT); __hip_atomic_store(sp_ + 1, tg | __float_as_uint(m2h), __ATOMIC_RELAXED, __HIP_MEMORY_SCOPE_AGENT); }
            }
            u32x4 nr = qr, nk = qk, nv = qv, nlw = qlw, nla = qla; u32x2 ng = qg;
            if (i + 2 < NCH) { const size_t go = gbase + (size_t)(i + 2) * CH * D; nr = *(const u32x4*)(R + go); nk = *(const u32x4*)(Kb + go); nv = *(const u32x4*)(Vb + go); nlw = *(const u32x4*)(LWb + go); nla = *(const u32x4*)(LAb + go); }
            if (i >= 1 && i <= NCH) ng = *(const u32x2*)(Gb + obase + (size_t)(i - 1) * CH * D);
            if (i + 1 < NCH) { SCAN_STAGE(i + 1) }
            if (i >= 2) {
                const int n = i - 2; const unsigned tag = (unsigned)(n + 1); unsigned sp = 0;
                while ((unsigned)(pw0 >> 32) != tag) { __builtin_amdgcn_s_sleep(1); if (++sp > (1u << 18)) break; pw0 = __hip_atomic_load(pp_, __ATOMIC_RELAXED, __HIP_MEMORY_SCOPE_AGENT); }
                while ((unsigned)(pw1 >> 32) != tag) { __builtin_amdgcn_s_sleep(1); if (++sp > (1u << 18)) break; pw1 = __hip_atomic_load(pp_ + 1, __ATOMIC_RELAXED, __HIP_MEMORY_SCOPE_AGENT); }
                const float mp = __uint_as_float((unsigned)pw0), m2p = __uint_as_float((unsigned)pw1);
                SCAN_YSTATS(n)
                const float mean = 0.5f * (mh + mp), dm = mh - mp; const float rstd = rsqrtf((m2h + m2p + 16.f * dm * dm) * (1.f / 64.f) + GN_EPS);
                const f32x4 v = *(const LAS f32x4*)(VB + (n & 3) * VSZ + st * 64 + 32 * half + oc); const float bon = BON[(n & 3) * CH + st];
                const f32x4 o = ((y - mean) * rstd * lnw + lnb + bon * v) * bf4(qg);
                u32x2 w; w.x = cvt_pk_bf16(o.x, o.y); w.y = cvt_pk_bf16(o.z, o.w);
                *(u32x2*)(R + obase + (size_t)n * CH * D) = w;
            }
            qg = ng; qr = nr; qk = nk; qv = nv; qlw = nlw; qla = nla;
            __syncthreads();
        }
#undef SCAN_STAGE
#undef SCAN_YSTATS
    }
}

__device__ __forceinline__ void phase_final(const Ctx& c, CA a) {
    const float* ss = (const float*)(a->ws + WS_PA); const float* g = a->in[I_NFIN];
    const int gw = c.bid * 8 + c.wave, NGW = c.G * 8;
    f32x4 gg[4];
#pragma unroll
    for (int j = 0; j < 4; ++j) gg[j] = *((const f32x4*)g + c.lane + 64 * j);
    for (int m = gw; m < M; m += NGW) {
        const float rs = row_rstd(ss, m);
        f32x4* hr = (f32x4*)(a->out + (size_t)m * D) + c.lane;
#pragma unroll
        for (int j = 0; j < 4; ++j) hr[64 * j] = hr[64 * j] * rs * gg[j];
    }
}

#define XB_TMO      128
#define XB_XCNT(j)  (256  + 64 * (j))
#define XB_XSUB(j)  (1280 + 64 * (j))
#define XB_XGEN(j)  (2304 + 64 * (j))
#define XB_TOP      3328
#define XB_TOPGEN   3392
#define XCD_BAR_WORDS 3456
#define XB_SPIN_CAP (1u << 18)

__device__ __forceinline__ unsigned xb_ld(unsigned* p)              { return __hip_atomic_load(p, __ATOMIC_RELAXED, __HIP_MEMORY_SCOPE_AGENT); }
__device__ __forceinline__ unsigned xb_add(unsigned* p, unsigned v) { return __hip_atomic_fetch_add(p, v, __ATOMIC_RELAXED, __HIP_MEMORY_SCOPE_AGENT); }
__device__ __forceinline__ unsigned xb_xcc_id() { return (unsigned)__builtin_amdgcn_s_getreg((3 << 11) | 20) & 0xFu; }
#define XB_SPIN(cond, bar) do { unsigned _sp = 0; while (cond) { __builtin_amdgcn_s_sleep(1); \
    if ((++_sp & 255u) == 0u) { if (xb_ld(&(bar)[XB_TMO])) break; if (_sp > XB_SPIN_CAP) { atomicAdd(&(bar)[XB_TMO], 1u); break; } } } } while (0)

struct XcdBarrier {
    unsigned* bar; unsigned x;
    volatile LAS unsigned* st;
};

__device__ __forceinline__ XcdBarrier xcd_barrier_post(unsigned* bar, volatile LAS unsigned* st) {
    XcdBarrier b; b.bar = bar; b.x = xb_xcc_id(); b.st = st;
    if (threadIdx.x == 0) (void)xb_add(&bar[XB_XCNT(b.x)], 1u);
    return b;
}
__device__ __forceinline__ void xcd_barrier_complete(unsigned* bar, unsigned x, unsigned& nloc, unsigned& nx) {
    const unsigned G = gridDim.x * gridDim.y * gridDim.z;
    unsigned sum, cnt, mine, sp = 0u;
    for (;;) {
        sum = 0u; cnt = 0u; mine = 0u;
#pragma unroll
        for (unsigned j = 0; j < 16; ++j) { const unsigned c = xb_ld(&bar[XB_XCNT(j)]); sum += c; cnt += (c > 0u) ? 1u : 0u; mine = (j == x) ? c : mine; }
        if (sum == G) break;
        __builtin_amdgcn_s_sleep(1);
        if ((++sp & 255u) == 0u) { if (xb_ld(&bar[XB_TMO])) break; if (sp > XB_SPIN_CAP) { atomicAdd(&bar[XB_TMO], 1u); break; } }
    }
    nloc = mine > 0u ? mine : 1u; nx = cnt > 0u ? cnt : 1u;
}

__device__ __forceinline__ void xcd_barrier(const XcdBarrier& b) {
    asm volatile("s_waitcnt vmcnt(0)" ::: "memory");
    __syncthreads();
    if (threadIdx.x == 0) {
        unsigned* bar = b.bar;
        __builtin_amdgcn_s_waitcnt(0);
        unsigned nloc = b.st[0], nx = b.st[1];
        if (nloc == 0u) { xcd_barrier_complete(bar, b.x, nloc, nx); b.st[0] = nloc; b.st[1] = nx; }
        const unsigned old = xb_add(&bar[XB_XSUB(b.x)], 1u);
        const unsigned gen = old / nloc;
        if (old + 1u == (gen + 1u) * nloc) {
            __builtin_amdgcn_fence(__ATOMIC_RELEASE, "agent");
            asm volatile("s_waitcnt vmcnt(0)" ::: "memory");
            const unsigned og = xb_add(&bar[XB_TOP], 1u);
            const unsigned tg = og / nx;
            if (og + 1u == (tg + 1u) * nx) xb_add(&bar[XB_TOPGEN], 1u);
            else XB_SPIN(xb_ld(&bar[XB_TOPGEN]) == tg, bar);
            __builtin_amdgcn_fence(__ATOMIC_ACQUIRE, "agent");
            xb_add(&bar[XB_XGEN(b.x)], 1u);
            asm volatile("s_waitcnt vmcnt(0)" ::: "memory");
        } else {
            XB_SPIN(xb_ld(&bar[XB_XGEN(b.x)]) == gen, bar);
            __builtin_amdgcn_fence(__ATOMIC_ACQUIRE, "agent");
            asm volatile("s_waitcnt vmcnt(0)" ::: "memory");
        }
    }
    __syncthreads();
}

constexpr int SLOTS = 11, NPH = 2 + 4 * SLOTS;
__host__ __device__ inline bool phase_active(int p) {
    if (p == 0 || p == NPH - 1) return true;
    const int i = (p - 1) / SLOTS, s = (p - 1) % SLOTS;
    if (s >= 8) return s == 8 || s == 10;
    return (i & 1) ? (s <= 5 || s == 7) : (s < 3);
}

__global__ void __launch_bounds__(512, 2) mk_fwd(Args a_) {
    extern __shared__ __attribute__((aligned(16))) unsigned char lds_raw[];
    int tid_ = threadIdx.x, bid_ = blockIdx.x, G_ = gridDim.x;
    volatile LAS unsigned* xst = (volatile LAS unsigned*)((LAS unsigned char*)lds_raw + 144000);
    if (tid_ < 2) xst[tid_] = 0u;
    __syncthreads();
    const XcdBarrier xbar = xcd_barrier_post((unsigned*)(a_.ws + WS_CTL), xst);
    CA a = (CA)__builtin_amdgcn_kernarg_segment_ptr();
    const int ph_lo = a_.ph_lo, ph_hi = a_.ph_hi;
    for (int p = ph_lo; p < ph_hi; ++p) {
        if (!phase_active(p)) continue;
        const int PL = (p - 1) / SLOTS, PS = (p - 1) % SLOTS; (void)PL; (void)PS;
        const int nrep = (MK_PROBE && p < NPH - 1 && (MK_PROBE_SEL)) ? 2 : 1;
        for (int rp = 0; rp < nrep; ++rp) {
        if (rp) cg::this_grid().sync();
        asm volatile("" : "+s"(a), "+s"(bid_), "+s"(G_)); asm volatile("" : "+v"(tid_));
        Ctx c; c.lds = (LAS unsigned char*)lds_raw; c.tid = tid_; c.lane = c.tid & 63; c.wave = __builtin_amdgcn_readfirstlane(c.tid >> 6); c.G = G_; c.bid = bid_;
        bf16_t* regA = (bf16_t*)(a->ws + WS_A);
        if (p == 0) phase_prologue(c, a);
        else if (p == NPH - 1) phase_final(c, a);
        else {
            const int layer = (p - 1) / SLOTS, s = (p - 1) % SLOTS, j = layer >> 1;
            unsigned char* wj = a->ws + WS_WSTAT + (size_t)j * WJ_STRIDE;
            float* ss_mix = (float*)(a->ws + WS_PA); float* ss_ffn = (float*)(a->ws + WS_PB); float* ss_next = ss_mix;
            if (s < 8 && !(layer & 1)) {
                if (s == 0) {
                    pg8::Gemm g{regA, (const bf16_t*)(wj + WJ_IN), M, 2048, D, D, 0}; pg8::StaticOrder S; S.init(M / 256, 2048, c.G, c.bid);
                    EpiSguIn E{(bf16_t*)(a->ws + P_U), (bf16_t*)(a->ws + P_SV), ss_mix, a->in[I_SBIN] + (size_t)j * 2048, (float*)(a->ws + WS_PV)};
                    pg8::gemm_phase<EpiSguIn, pg8::StaticOrder, 0, false, true>(c.lds, c.tid, g, S, E);
                } else if (s == 1) { phase_ffn_weights(c, a, layer); phase_sgu_spatial(c, a, j, rp); }
                else {
                    pg8::Gemm g{(const bf16_t*)(a->ws + P_U), (const bf16_t*)(wj + WJ_OUT), M, D, D, D, 0}; pg8::StaticOrder S; S.init(M / 256, D, c.G, c.bid);
                    EpiResid E{layer == 0 ? a->in[I_X] : (const float*)a->out, a->out, regA, ss_ffn};
                    pg8::gemm_phase<EpiResid, pg8::StaticOrder, 0, false, true>(c.lds, c.tid, g, S, E);
                }
            } else if (s < 8) {
                if (s == 0) { phase_rwkv_prep(c, a, layer, 0); phase_ffn_weights(c, a, layer); if (layer == 1) phase_static_weights(c, a, 1); }
                else if (s == 2) phase_rwkv_prep(c, a, layer, 1);
                else if (s == 1 || s == 3) {
                    { pg8::Gemm g{(const bf16_t*)(a->ws + P_LW), (const bf16_t*)(wj + WJ_RKV), M / 2, 3072, D, D, (size_t)(M / 2) * D * 2}; pg8::StaticOrder S; S.init(M / 512, 3072, c.G, c.bid);
                      EpiRkv E{(bf16_t*)(a->ws + P_R), (bf16_t*)(a->ws + P_WA), (bf16_t*)(a->ws + P_GL), s == 3 ? M / 2 : 0, 0};
                      pg8::gemm_phase<EpiRkv, pg8::StaticOrder, 3, false, true>(c.lds, c.tid, g, S, E); }
                    if (s == 1) {
                      asm volatile("" : "+s"(a), "+s"(c.bid), "+s"(c.G), "+s"(wj)); asm volatile("" : "+v"(c.tid));
                      pg8::Gemm g{(const bf16_t*)(a->ws + WS_A), (const bf16_t*)(wj + WJ_RKV + 6 * MiB), M, 512, 2048, D, 0}; pg8::StaticOrder S; S.init(M / 256, 512, c.G, c.bid);
                      EpiRkv E{(bf16_t*)(a->ws + P_R), (bf16_t*)(a->ws + P_WA), (bf16_t*)(a->ws + P_GL), 0, 12};
                      pg8::gemm_phase<EpiRkv, pg8::StaticOrder, 1, true, true>(c.lds, c.tid, g, S, E); }
                } else if (s == 4) {
                    { int kq = 128; asm volatile("" : "+s"(kq)); pg8::Gemm g{(const bf16_t*)(a->ws + P_WA), (const bf16_t*)(wj + WJ_L2WA), M, 2048, kq, kq, 0}; pg8::StaticOrder S; S.init(M / 256, 2048, c.G, c.bid);
                      EpiStore<false> E{(bf16_t*)(a->ws + P_LW), D, 2, (size_t)M * D, nullptr};
                      pg8::gemm_phase<EpiStore<false>, pg8::StaticOrder, 0, false, true>(c.lds, c.tid, g, S, E); }
                    asm volatile("" : "+s"(a), "+s"(c.bid), "+s"(c.G), "+s"(wj)); asm volatile("" : "+v"(c.tid));
                    { int kq = 256; asm volatile("" : "+s"(kq)); pg8::Gemm g{(const bf16_t*)(a->ws + P_GL), (const bf16_t*)(wj + WJ_L2G), M, D, kq, kq, 0}; pg8::StaticOrder S; S.init(M / 256, D, c.G, c.bid);
                      EpiStore<false> E{regA, D, 2, 0, nullptr};
                      pg8::gemm_phase<EpiStore<false>, pg8::StaticOrder, 0, false, true>(c.lds, c.tid, g, S, E); }
                } else if (s == 5) phase_scan(c, a, j, 0);
                else {
                    pg8::Gemm g{(const bf16_t*)(a->ws + P_R), (const bf16_t*)(wj + WJ_O), M, D, D, D, 0}; pg8::StaticOrder S; S.init(M / 256, D, c.G, c.bid);
                    EpiResid E{a->out, a->out, regA, ss_ffn};
                    pg8::gemm_phase<EpiResid, pg8::StaticOrder, 0, false, true>(c.lds, c.tid, g, S, E);
                }
            }
            else if (s == 8) {
                pg8::Gemm g{regA - 2 * D, (const bf16_t*)(a->ws + WS_WFFN), M, FF2, D, D, 0}; pg8::StaticOrder S; S.init(133, FF2, c.G, c.bid);
                EpiFfnUp E{(bf16_t*)(a->ws + P_ACT), ss_ffn, a->in[I_FCW] + (size_t)layer * 3 * FF2, a->in[I_FCB] + (size_t)layer * FF2};
                pg8::gemm_phase<EpiFfnUp, pg8::StaticOrder, 2, false, true>(c.lds, c.tid, g, S, E);
            }
            else {
                pg8::Gemm g{(const bf16_t*)(a->ws + P_ACT), (const bf16_t*)(a->ws + WS_WDOWN), M, D, FF, FF, 0}; pg8::StaticOrder S; S.init(M / 256, D, c.G, c.bid);
                EpiResid E{a->out, a->out, layer == 1 ? regA : (bf16_t*)nullptr, ss_next};
                pg8::gemm_phase<EpiResid, pg8::StaticOrder, 0, false, true>(c.lds, c.tid, g, S, E);
            }
        }
        }
        if (p + 1 < ph_hi) { if (p == 0) cg::this_grid().sync(); else xcd_barrier(xbar); }
    }
}

constexpr int LDS_BYTES = 147456;
#ifndef MK_ONE_LAUNCH
#define MK_ONE_LAUNCH 1
#endif
extern "C" void kernel_launch(void* const* d_in, const int* in_sizes, int n_in, void* d_out, int out_size, void* d_ws, size_t ws_size, hipStream_t stream) {
    static int grid = 0;
    if (grid == 0) {
        if (n_in != 32 || out_size != M * D || ws_size < WS_END) { fprintf(stderr, "kernel_launch: unexpected shapes (n_in %d out %d ws %zu, need %zu)\n", n_in, out_size, ws_size, (size_t)WS_END); grid = -1; return; }
        int dev = 0, cus = 0, per_cu = 0;
        (void)hipGetDevice(&dev); (void)hipDeviceGetAttribute(&cus, hipDeviceAttributeMultiprocessorCount, dev);
        if (hipFuncSetAttribute((const void*)mk_fwd, hipFuncAttributeMaxDynamicSharedMemorySize, LDS_BYTES) != hipSuccess) { fprintf(stderr, "kernel_launch: hipFuncSetAttribute failed\n"); grid = -1; return; }
        (void)hipOccupancyMaxActiveBlocksPerMultiprocessor(&per_cu, (const void*)mk_fwd, 512, LDS_BYTES);
        if (per_cu < 1) per_cu = 1;
        grid = cus * 1;
        (void)hipGetLastError();
    }
    if (grid < 0) return;
    if (hipMemsetAsync((char*)d_ws + WS_CTL, 0, CTL_BYTES, stream) != hipSuccess) { fprintf(stderr, "kernel_launch: memset failed\n"); return; }
    Args a{};
    for (int i = 0; i < 32; ++i) a.in[i] = (const float*)d_in[i];
    a.out = (float*)d_out; a.ws = (unsigned char*)d_ws;
#if MK_ONE_LAUNCH
    a.ph_lo = 0; a.ph_hi = NPH;
    void* args[] = {&a};
    hipError_t e = hipLaunchCooperativeKernel((const void*)mk_fwd, dim3(grid), dim3(512), args, LDS_BYTES, stream);
    if (e != hipSuccess) fprintf(stderr, "cooperative launch failed: %s (grid %d)\n", hipGetErrorString(e), grid);
#else
    for (int p = 0; p < NPH; ++p) { if (!phase_active(p)) continue; a.ph_lo = p; a.ph_hi = p + 1; hipLaunchKernelGGL(mk_fwd, dim3(grid), dim3(512), LDS_BYTES, stream, a); }
#endif
}
```

```cpp
#include <hip/hip_runtime.h>
#include <hip/hip_cooperative_groups.h>
#include <cstdio>
#include <cstdint>
#include <cmath>
namespace cg = cooperative_groups;
#ifndef MK_PROBE
#define MK_PROBE 0
#endif
#ifndef MK_PROBE_SEL
#define MK_PROBE_SEL 0
#endif
#ifndef MK_PROBE_MODE
#define MK_PROBE_MODE 1
#endif
namespace pg8 {
#define PG8_LAS __attribute__((address_space(3)))
typedef unsigned short bf16_t;
typedef short bf16x8 __attribute__((ext_vector_type(8)));
typedef float f32x4 __attribute__((ext_vector_type(4)));
typedef float f32x2 __attribute__((ext_vector_type(2)));
typedef unsigned u32x4 __attribute__((ext_vector_type(4)));
typedef unsigned u32x2 __attribute__((ext_vector_type(2)));
constexpr int BM = 256, BK = 64, HALF = 128, HTB = HALF * BK * 2  , STAGE_BYTES = 8 * HTB, NXCD = 8, WGM = 8;

__host__ __device__ __forceinline__ int lds_byte(int r, int c) { const int st = (r >> 4) * 2 + (c >> 5), rr = r & 15, cc = c & 31, ob = rr * 64 + cc * 2; return st * 1024 + (ob ^ (((ob >> 9) & 1) << 5)); }
__host__ __device__ __forceinline__ void stage_rc(int b, int& R, int& C) { const int st = b / 1024, sb = b % 1024, swz = sb ^ (((sb >> 9) & 1) << 5); R = (st >> 1) * 16 + swz / 64; C = (st & 1) * 32 + (swz % 64) / 2; }
__host__ __device__ __forceinline__ int perm32(int rho) { const int n = rho >> 4, i = rho & 15; return 8 * (i >> 2) + 4 * n + (i & 3); }

struct Unit { int pm, pn; };
struct Gemm { const bf16_t* A; const bf16_t* Bt; int M, N, K, lda; size_t astride; };

struct StaticOrder {
    int nM, nN, nwg, G, c;
    __host__ __device__ void init(int nM_, int N, int G_, int c_) { nM = nM_; nN = N / BM; nwg = nM * nN; G = G_; c = c_; }
    __host__ __device__ bool next(int i, Unit& u) const {
        const long L = (long)i * G + c; if (L >= nwg) return false;
        int wgid = (int)L; { const int q = nwg / NXCD, r = nwg % NXCD, xcd = wgid % NXCD, off = wgid / NXCD; wgid = (xcd < r ? xcd * (q + 1) : r * (q + 1) + (xcd - r) * q) + off; }
        const int nig = WGM * nN, gid = wgid / nig, fm = gid * WGM, gsz = (nM - fm) < WGM ? (nM - fm) : WGM;
        u.pm = fm + ((wgid % nig) % gsz); u.pn = (wgid % nig) / gsz; return true;
    }
};

__device__ __forceinline__ unsigned cvt_pk_bf16(float lo, float hi) { unsigned r; asm volatile("v_cvt_pk_bf16_f32 %0, %1, %2" : "=v"(r) : "v"(lo), "v"(hi)); return r; }
__device__ __forceinline__ f32x2 gelu_pk(f32x2 v) {
    const f32x2 av = __builtin_elementwise_abs(v), d = av * 0.2316418882f + 1.0f;
    f32x2 t; t.x = __builtin_amdgcn_rcpf(d.x); t.y = __builtin_amdgcn_rcpf(d.y);
    f32x2 q = t * 0.5307027145f + (-0.7265760135f); q = q * t + 0.7107068705f; q = q * t + (-0.142248368f); q = q * t + 0.127414796f; q = q * t;
    const f32x2 s = (v * v) * (-0.72134752044f);
    f32x2 e; e.x = __builtin_amdgcn_exp2f(s.x); e.y = __builtin_amdgcn_exp2f(s.y);
    const f32x2 m = v * (q * e), r = v - m;
    f32x2 o; o.x = v.x < 0.f ? m.x : r.x; o.y = v.y < 0.f ? m.y : r.y; return o;
}

template <class Epi, class Sched, int AMAP, bool KDBL, bool ALIGN_EPI>
__device__ __forceinline__ void gemm_phase(PG8_LAS unsigned char* lds, const int tid, const Gemm g, const Sched& S, const Epi& E) {
    const int wid = __builtin_amdgcn_readfirstlane(tid >> 6), lane = tid & 63, wr = wid >> 2, wc = wid & 3, fr = lane & 15, fq = lane >> 4;
    const int K = g.K, nt = K / BK, lda = g.lda;
    unsigned voffA[2], voffB[2];
#pragma unroll
    for (int i = 0; i < 2; ++i) { int R, C; stage_rc(tid * 16 + i * 8192, R, C); const int Rb = Epi::PERM ? ((R & ~31) + perm32(R & 31)) : R;
        const int Ra = (AMAP == 2) ? (R - 2 * (R >> 6)) : R;
        voffA[i] = (unsigned)(Ra * lda + C) * 2u; voffB[i] = (unsigned)(Rb * K + C) * 2u; }
    const size_t kstep = (size_t)(BK * 2);
    const size_t hstepA = (size_t)((AMAP == 2) ? 124 : HALF) * lda * 2;
    const size_t hstepB = (size_t)HALF * K * 2;
    const size_t tstepB = 2 * hstepB;
    const size_t rowA = (size_t)lda * 2;
    const unsigned ldsw = (unsigned)wid * 1024u;
    const int aoff = lds_byte(wr * 64 + fr, fq * 8), boff = lds_byte(wc * 32 + fr, fq * 8);
#define PG8_ABASE(pm, pn) ((const char*)g.A + (AMAP == 3 ? (size_t)((pn) >> 2) * g.astride + (size_t)(pm) * 256 * rowA : AMAP == 1 ? (size_t)(((pm) >> 4) * 4104 + 8 + ((pm) & 15) * 256) * rowA : (AMAP == 2 ? (size_t)(pm) * 248 * rowA : (size_t)(pm) * 256 * rowA)))
#define PG8_KA(base, t) (KDBL ? ((base) + (size_t)((t) & 15) * kstep - (size_t)((t) >> 4) * rowA) : ((base) + (size_t)(t) * kstep))
#define PG8_SA(b, h) (((b) * 2 + (h)) * HTB)
#define PG8_SB(b, h) ((4 + (b) * 2 + (h)) * HTB)
#define PG8_STAGE(bufoff, gbase, voff) do { _Pragma("unroll") for (int _i = 0; _i < 2; ++_i) \
        __builtin_amdgcn_global_load_lds((const unsigned*)((const char*)(gbase) + (voff)[_i]), (PG8_LAS unsigned*)(lds + (bufoff) + ldsw + _i * 8192), 16, 0, 0); } while (0)
#define PG8_LDA(dst, b, h) do { _Pragma("unroll") for (int m = 0; m < 4; ++m) _Pragma("unroll") for (int k = 0; k < 2; ++k) dst[m][k] = *(const PG8_LAS bf16x8*)(lds + PG8_SA(b, h) + aoff + m * 2048 + k * 1024); } while (0)
#define PG8_LDB(dst, b, h) do { _Pragma("unroll") for (int n = 0; n < 2; ++n) _Pragma("unroll") for (int k = 0; k < 2; ++k) dst[n][k] = *(const PG8_LAS bf16x8*)(lds + PG8_SB(b, h) + boff + n * 2048 + k * 1024); } while (0)
#define PG8_MMA(ai, bj, At, Bt) do { __builtin_amdgcn_s_setprio(1); _Pragma("unroll") for (int m = 0; m < 4; ++m) _Pragma("unroll") for (int n = 0; n < 2; ++n) _Pragma("unroll") for (int k = 0; k < 2; ++k) \
        acc[ai][bj][m][n] = __builtin_amdgcn_mfma_f32_16x16x32_bf16(Bt[n][k], At[m][k], acc[ai][bj][m][n], 0, 0, 0); __builtin_amdgcn_s_setprio(0); } while (0)
#define PG8_WAIT_V(n) asm volatile("s_waitcnt vmcnt(" #n ")" ::: "memory")
#define PG8_WAIT_L(n) asm volatile("s_waitcnt lgkmcnt(" #n ")" ::: "memory")
#define PG8_BAR __builtin_amdgcn_s_barrier()
#define PG8_SCHED __builtin_amdgcn_sched_barrier(0)
    Unit cur, nxt; int ui = 0;
    if (!S.next(0, cur)) return;
    f32x4 acc[2][2][4][2];
#pragma unroll
    for (int a = 0; a < 2; ++a)
#pragma unroll
        for (int b = 0; b < 2; ++b)
#pragma unroll
            for (int m = 0; m < 4; ++m)
#pragma unroll
                for (int n = 0; n < 2; ++n) acc[a][b][m][n] = (f32x4){0.f, 0.f, 0.f, 0.f};
    bf16x8 At[4][2], B0[2][2], B1[2][2];
    const char* cA = PG8_ABASE(cur.pm, cur.pn); const char* cB = (const char*)g.Bt + (size_t)cur.pn * tstepB;
    {
        const char* cA1 = PG8_KA(cA, 1);
        PG8_STAGE(PG8_SB(0, 0), cB, voffB); PG8_STAGE(PG8_SB(0, 1), cB + hstepB, voffB); PG8_STAGE(PG8_SA(0, 0), cA, voffA); PG8_STAGE(PG8_SA(0, 1), cA + hstepA, voffA);
        if (wr == 1) PG8_BAR;
        PG8_WAIT_V(2); PG8_BAR;
        PG8_STAGE(PG8_SB(1, 0), cB + kstep, voffB); PG8_STAGE(PG8_SA(1, 0), cA1, voffA); PG8_STAGE(PG8_SB(1, 1), cB + hstepB + kstep, voffB);
        PG8_WAIT_V(6); PG8_BAR;
    }
    for (;;) {
        const bool has_next = S.next(ui + 1, nxt);
        const char* nA = has_next ? PG8_ABASE(nxt.pm, nxt.pn) : cA; const char* nB = has_next ? (const char*)g.Bt + (size_t)nxt.pn * tstepB : cB;
        for (int t = 0; t < nt; t += 2) {
            const bool last = (t == nt - 2);
            const char* a1 = PG8_KA(cA, t + 1);
            const char* a2 = last ? nA : PG8_KA(cA, t + 2); const char* b2 = last ? nB : cB + (size_t)(t + 2) * kstep;
            const char* a3 = last ? PG8_KA(nA, 1) : PG8_KA(cA, t + 3); const char* b3 = b2 + kstep;
            PG8_LDB(B0, 0, 0); PG8_LDB(B1, 0, 1); PG8_SCHED; PG8_LDA(At, 0, 0); PG8_STAGE(PG8_SA(1, 1), a1 + hstepA, voffA);
            PG8_WAIT_V(8); PG8_WAIT_L(0); PG8_BAR; PG8_MMA(0, 0, At, B0); PG8_MMA(0, 1, At, B1); PG8_BAR; PG8_SCHED;
            PG8_LDA(At, 0, 1); PG8_STAGE(PG8_SB(0, 0), b2, voffB); PG8_STAGE(PG8_SB(0, 1), b2 + hstepB, voffB); PG8_STAGE(PG8_SA(0, 0), a2, voffA);
            PG8_WAIT_V(8); PG8_WAIT_L(0); PG8_BAR; PG8_MMA(1, 0, At, B0); PG8_MMA(1, 1, At, B1); PG8_BAR; PG8_SCHED;
            PG8_LDB(B0, 1, 0); PG8_LDB(B1, 1, 1); PG8_SCHED; PG8_LDA(At, 1, 0); PG8_STAGE(PG8_SA(0, 1), a2 + hstepA, voffA);
            PG8_WAIT_V(8); PG8_WAIT_L(0); PG8_BAR; PG8_MMA(0, 0, At, B0); PG8_MMA(0, 1, At, B1); PG8_BAR; PG8_SCHED;
            PG8_LDA(At, 1, 1); PG8_STAGE(PG8_SB(1, 0), b3, voffB); PG8_STAGE(PG8_SB(1, 1), b3 + hstepB, voffB); PG8_STAGE(PG8_SA(1, 0), a3, voffA);
            PG8_WAIT_V(8); PG8_WAIT_L(0); PG8_BAR; PG8_MMA(1, 0, At, B0); PG8_MMA(1, 1, At, B1); PG8_BAR; PG8_SCHED;
        }
        if constexpr (ALIGN_EPI) { if (wr == 0) PG8_BAR; }
        E(acc, cur, wr, wc, fr, fq);
        if (!has_next) break;
#pragma unroll
        for (int a = 0; a < 2; ++a)
#pragma unroll
            for (int b = 0; b < 2; ++b)
#pragma unroll
                for (int m = 0; m < 4; ++m)
#pragma unroll
                    for (int n = 0; n < 2; ++n) acc[a][b][m][n] = (f32x4){0.f, 0.f, 0.f, 0.f};
        cur = nxt; cA = nA; cB = nB; ++ui;
        if constexpr (ALIGN_EPI) { if (wr == 1) PG8_BAR; }
    }
    PG8_WAIT_V(0);
    if constexpr (!ALIGN_EPI) { if (wr == 0) PG8_BAR; }
    PG8_BAR;
#undef PG8_ABASE
#undef PG8_KA
#undef PG8_SA
#undef PG8_SB
#undef PG8_STAGE
#undef PG8_LDA
#undef PG8_LDB
#undef PG8_MMA
#undef PG8_WAIT_V
#undef PG8_WAIT_L
#undef PG8_BAR
#undef PG8_SCHED
}
}
using pg8::bf16_t; using pg8::f32x4; using pg8::f32x2; using pg8::u32x4; using pg8::u32x2; using pg8::Unit; using pg8::cvt_pk_bf16;
#define LAS __attribute__((address_space(3)))
constexpr int BATCH = 8, SEQ = 4096, D = 1024, M = BATCH * SEQ, FF = 2816, FF2 = 5632;
constexpr int PADR = 8, SEQP = SEQ + PADR;
constexpr float RMS_EPS = 1e-6f, GN_EPS = 64e-5f;
constexpr size_t MiB = 1u << 20;
constexpr size_t WS_CTL = 0, CTL_BYTES = 2048 * 1024, WS_XS = 1 * MiB;
constexpr size_t WS_WSTAT = 2 * MiB;
constexpr size_t WJ_IN = 0, WJ_OUT = 4 * MiB, WJ_RKV = 6 * MiB, WJ_L2WA = 20 * MiB, WJ_L2G = 20 * MiB + 512 * 1024, WJ_O = 21 * MiB, WJ_STRIDE = 23 * MiB;
constexpr size_t WS_WFFN = 48 * MiB;
constexpr size_t WS_WDOWN = WS_WFFN + 11 * MiB;
constexpr size_t WS_A = 67 * MiB;
constexpr size_t WS_P = 134 * MiB;
constexpr size_t P_R = WS_P, P_K = WS_P + 64 * MiB, P_V = WS_P + 128 * MiB, P_LW = WS_P + 192 * MiB, P_LA = WS_P + 256 * MiB, P_WA = WS_P + 320 * MiB, P_GL = WS_P + 328 * MiB;
constexpr size_t P_U = WS_P, P_SV = WS_P + 64 * MiB;
constexpr size_t P_Z = WS_P, P_ACT = WS_P + 176 * MiB;
constexpr size_t WS_PA = WS_P + 352 * MiB, WS_PB = WS_PA + 2 * MiB, WS_PV = WS_PB + 2 * MiB;
constexpr size_t WS_END = WS_PV + 2 * MiB;

struct Args {
    const float* in[32]; float* out; unsigned char* ws; int ph_lo, ph_hi;
};
enum { I_X = 0, I_NMIX, I_NFFN, I_NFIN, I_SWIN, I_SBIN, I_SGV, I_SWS, I_SBS, I_SWOUT, I_MU, I_WR, I_WK, I_WV, I_WO, I_W0, I_W1, I_W2, I_A0, I_A1, I_A2, I_G1, I_G2, I_KK, I_KA, I_RK, I_LNW, I_LNB, I_FUP, I_FCW, I_FCB, I_FDN };

__device__ __forceinline__ float bf2f(unsigned short b) { return __uint_as_float((unsigned)b << 16); }
__device__ __forceinline__ float bflo(unsigned w) { return __uint_as_float(w << 16); }
__device__ __forceinline__ float bfhi(unsigned w) { return __uint_as_float(w & 0xffff0000u); }
__device__ __forceinline__ float wave_sum(float v) {
#pragma unroll
    for (int o = 1; o < 64; o <<= 1) v += __shfl_xor(v, o);
    return v;
}
__device__ __forceinline__ float row_rstd(const float* P, int row) { const f32x4* p = (const f32x4*)(P + (size_t)row * 16); const f32x4 a = p[0], b = p[1], c = p[2], d = p[3];
    const float s = ((a.x + a.y) + (a.z + a.w)) + ((b.x + b.y) + (b.z + b.w)) + ((c.x + c.y) + (c.z + c.w)) + ((d.x + d.y) + (d.z + d.w)); return rsqrtf(s * (1.f / D) + RMS_EPS); }
__device__ __forceinline__ void row_rstd4(const float* P, int row0, int rstride, int lo, int hi, float (&rs)[4]) {
    f32x4 p[4][4];
#pragma unroll
    for (int m = 0; m < 4; ++m) { int r = row0 + m * rstride; r = r < lo ? lo : (r > hi ? hi : r); const f32x4* q = (const f32x4*)(P + (size_t)r * 16);
#pragma unroll
        for (int k = 0; k < 4; ++k) p[m][k] = q[k]; }
#pragma unroll
    for (int m = 0; m < 4; ++m) { const f32x4 a = p[m][0], b = p[m][1], c = p[m][2], d = p[m][3];
        const float s = ((a.x + a.y) + (a.z + a.w)) + ((b.x + b.y) + (b.z + b.w)) + ((c.x + c.y) + (c.z + c.w)) + ((d.x + d.y) + (d.z + d.w)); rs[m] = rsqrtf(s * (1.f / D) + RMS_EPS); }
}
template <int CTRL> __device__ __forceinline__ float dpp_f(float v) { return __int_as_float(__builtin_amdgcn_mov_dpp(__float_as_int(v), CTRL, 0xf, 0xf, true)); }
__device__ __forceinline__ float sum8(float v) { v += dpp_f<0x141>(v); v += dpp_f<0xB1>(v); v += dpp_f<0x4E>(v); return v; }
__device__ __forceinline__ float sigmoidf_(float x) { return 1.f / (1.f + __expf(-x)); }

template <bool SCALE> struct EpiStore {
    static constexpr bool PERM = true;
    bf16_t* O; int ldc; int tsh; size_t split_stride; const float* ss;
    __device__ __forceinline__ void operator()(const f32x4 (&acc)[2][2][4][2], const Unit& u, int wr, int wc, int fr, int fq) const {
        bf16_t* base = O + (size_t)(u.pn >> tsh) * split_stride + (size_t)(u.pm * 256 + wr * 64 + fr) * ldc + (u.pn & ((1 << tsh) - 1)) * 256 + wc * 32 + 8 * fq;
        const int row0 = u.pm * 256 + wr * 64 + fr;
#pragma unroll
        for (int ai = 0; ai < 2; ++ai)
#pragma unroll
            for (int m = 0; m < 4; ++m) {
                const float rs = SCALE ? row_rstd(ss, row0 + ai * 128 + m * 16) : 1.f;
                bf16_t* rowp = base + (size_t)(ai * 128 + m * 16) * ldc;
#pragma unroll
                for (int bj = 0; bj < 2; ++bj) { const f32x4 v0 = acc[ai][bj][m][0] * rs, v1 = acc[ai][bj][m][1] * rs;
                    u32x4 w; w.x = cvt_pk_bf16(v0[0], v0[1]); w.y = cvt_pk_bf16(v0[2], v0[3]); w.z = cvt_pk_bf16(v1[0], v1[1]); w.w = cvt_pk_bf16(v1[2], v1[3]);
                    *(u32x4*)(rowp + bj * 128) = w; } }
    }
};
struct EpiSguIn {
    static constexpr bool PERM = true;
    bf16_t* U; bf16_t* V; const float* ss; const float* bias; float* ssv;
    __device__ __forceinline__ void operator()(const f32x4 (&acc)[2][2][4][2], const Unit& u, int wr, int wc, int fr, int fq) const {
        const bool isv = u.pn >= 4; bf16_t* base = isv ? V : U; const int colt = (u.pn & 3) * 256 + wc * 32 + 8 * fq, bcol = u.pn * 256 + wc * 32 + 8 * fq;
        f32x4 bv[2][2];
#pragma unroll
        for (int bj = 0; bj < 2; ++bj)
#pragma unroll
            for (int n = 0; n < 2; ++n) bv[bj][n] = *(const f32x4*)(bias + bcol + bj * 128 + 4 * n);
#pragma unroll
        for (int ai = 0; ai < 2; ++ai) {
            float rs4[4]; row_rstd4(ss, u.pm * 256 + ai * 128 + wr * 64 + fr, 16, 0, M - 1, rs4);
#pragma unroll
            for (int m = 0; m < 4; ++m) { const int row = u.pm * 256 + ai * 128 + wr * 64 + m * 16 + fr;
                const float rs = rs4[m]; float s = 0.f;
                bf16_t* rowp = base + (size_t)row * D + colt;
#pragma unroll
                for (int bj = 0; bj < 2; ++bj) { f32x4 v0 = acc[ai][bj][m][0] * rs + bv[bj][0], v1 = acc[ai][bj][m][1] * rs + bv[bj][1];
                    const f32x2 a = pg8::gelu_pk((f32x2){v0[0], v0[1]}), b = pg8::gelu_pk((f32x2){v0[2], v0[3]}), c = pg8::gelu_pk((f32x2){v1[0], v1[1]}), d = pg8::gelu_pk((f32x2){v1[2], v1[3]});
                    s += (a.x * a.x + a.y * a.y) + (b.x * b.x + b.y * b.y) + (c.x * c.x + c.y * c.y) + (d.x * d.x + d.y * d.y);
                    u32x4 w; w.x = cvt_pk_bf16(a.x, a.y); w.y = cvt_pk_bf16(b.x, b.y); w.z = cvt_pk_bf16(c.x, c.y); w.w = cvt_pk_bf16(d.x, d.y);
                    *(u32x4*)(rowp + bj * 128) = w; }
                if (isv) { s += __shfl_xor(s, 16); s += __shfl_xor(s, 32); if (fq == 0) ssv[(size_t)row * 16 + (u.pn - 4) * 4 + wc] = s; } } }
    }
};
struct EpiResid {
    static constexpr bool PERM = true;
    const float* hin; float* h; bf16_t* hb; float* ssn;
    __device__ __forceinline__ void operator()(const f32x4 (&acc)[2][2][4][2], const Unit& u, int wr, int wc, int fr, int fq) const {
        const int colt = u.pn * 256 + wc * 32 + 8 * fq;
#pragma unroll
        for (int ai = 0; ai < 2; ++ai) {
            const int rowb = u.pm * 256 + ai * 128 + wr * 64 + fr;
            f32x4 pre[4][2][2];
#pragma unroll
            for (int m = 0; m < 4; ++m)
#pragma unroll
                for (int bj = 0; bj < 2; ++bj) { const float* hp = hin + (size_t)(rowb + m * 16) * D + colt + bj * 128; pre[m][bj][0] = *(const f32x4*)hp; pre[m][bj][1] = *(const f32x4*)(hp + 4); }
#pragma unroll
            for (int m = 0; m < 4; ++m) { const int row = rowb + m * 16; float s = 0.f;
                float* hp = h + (size_t)row * D + colt; bf16_t* bp = hb + (size_t)row * D + colt;
#pragma unroll
                for (int bj = 0; bj < 2; ++bj) { const f32x4 v0 = pre[m][bj][0] + acc[ai][bj][m][0], v1 = pre[m][bj][1] + acc[ai][bj][m][1];
                    *(f32x4*)(hp + bj * 128) = v0; *(f32x4*)(hp + bj * 128 + 4) = v1;
                    s += (v0[0] * v0[0] + v0[1] * v0[1]) + (v0[2] * v0[2] + v0[3] * v0[3]) + (v1[0] * v1[0] + v1[1] * v1[1]) + (v1[2] * v1[2] + v1[3] * v1[3]);
                    if (hb) { u32x4 w; w.x = cvt_pk_bf16(v0[0], v0[1]); w.y = cvt_pk_bf16(v0[2], v0[3]); w.z = cvt_pk_bf16(v1[0], v1[1]); w.w = cvt_pk_bf16(v1[2], v1[3]);
                    *(u32x4*)(bp + bj * 128) = w; } }
                s += __shfl_xor(s, 16); s += __shfl_xor(s, 32); if (fq == 0) ssn[(size_t)row * 16 + u.pn * 4 + wc] = s; }
            asm volatile("" ::: "memory");
        }
    }
};
template <int CTRL> __device__ __forceinline__ f32x4 dpp4(f32x4 v) { f32x4 r; r.x = dpp_f<CTRL>(v.x); r.y = dpp_f<CTRL>(v.y); r.z = dpp_f<CTRL>(v.z); r.w = dpp_f<CTRL>(v.w); return r; }
struct EpiFfnUp {
    static constexpr bool PERM = true;
    bf16_t* ACT; const float* ss; const float* cw; const float* cb;
    template <bool MASK> __device__ __forceinline__ void conv4(f32x4& z0, f32x4& z1, f32x4& z2, f32x4& z3, const float (&rs)[4], const int (&tt)[4], const float* wcol, const float* bcol, int fr) const {
        const f32x4 w0 = *(const f32x4*)wcol, w1 = *(const f32x4*)(wcol + FF2), w2 = *(const f32x4*)(wcol + 2 * FF2), bb = *(const f32x4*)bcol;
#pragma unroll
        for (int e = 0; e < 4; e += 2) {
            const f32x2 w0p = {w0[e], w0[e + 1]}, w1p = {w1[e], w1[e + 1]}, w2p = {w2[e], w2[e + 1]}, bp = {bb[e], bb[e + 1]};
            f32x2 cur = (f32x2){z3[e], z3[e + 1]} * rs[3];
            f32x2 c1 = {dpp_f<0x121>(cur.x), dpp_f<0x121>(cur.y)}, c2 = {dpp_f<0x122>(cur.x), dpp_f<0x122>(cur.y)};
#define CONV_STEP(ZM, ZP, MI, HASP) { f32x2 prv = cur, p1 = c1, p2 = c2; if (HASP) { prv = (f32x2){ZP[e], ZP[e + 1]} * rs[MI - (HASP)]; p1 = (f32x2){dpp_f<0x121>(prv.x), dpp_f<0x121>(prv.y)}; p2 = (f32x2){dpp_f<0x122>(prv.x), dpp_f<0x122>(prv.y)}; } \
            f32x2 y1 = (fr == 0) ? p1 : c1, y2 = (fr < 2) ? p2 : c2; if (MASK) { if (tt[MI] < 1) y1 = (f32x2){0.f, 0.f}; if (tt[MI] < 2) y2 = (f32x2){0.f, 0.f}; } \
            const f32x2 o = w0p * y2 + (w1p * y1 + (w2p * cur + bp)); ZM[e] = o.x; ZM[e + 1] = o.y; cur = prv; c1 = p1; c2 = p2; }
            CONV_STEP(z3, z2, 3, 1) CONV_STEP(z2, z1, 2, 1) CONV_STEP(z1, z0, 1, 1) CONV_STEP(z0, z0, 0, 0)
#undef CONV_STEP
            asm volatile("" : "+v"(z0[e]), "+v"(z1[e]), "+v"(z2[e]), "+v"(z3[e]), "+v"(z0[e + 1]), "+v"(z1[e + 1]), "+v"(z2[e + 1]), "+v"(z3[e + 1]));
        }
    }
    __device__ __forceinline__ void operator()(f32x4 (&acc)[2][2][4][2], const Unit& u, int wr, int wc, int fr, int fq) const {
        const int f0 = u.pn * 128 + wc * 32 + 8 * fq;
#pragma unroll
        for (int ai = 0; ai < 2; ++ai) {
            const int gbase = u.pm * 248 - 2 + 62 * (2 * ai + wr) + fr;
            float rs[4]; int tt[4];
            row_rstd4(ss, gbase, 16, 0, M - 1, rs);
            asm volatile("" : "+v"(rs[0]), "+v"(rs[1]), "+v"(rs[2]), "+v"(rs[3]) :: "memory");
            const int g0 = u.pm * 248 - 2 + 62 * (2 * ai + wr);
            const bool seqstart = ((g0 + 63) & (SEQ - 1)) < 65 || g0 < 0;
#pragma unroll
            for (int m = 0; m < 4; ++m) tt[m] = (gbase + 16 * m) & (SEQ - 1);
#pragma unroll
            for (int n = 0; n < 2; ++n) {
                if (seqstart) {
                    conv4<true>(acc[ai][0][0][n], acc[ai][0][1][n], acc[ai][0][2][n], acc[ai][0][3][n], rs, tt, cw + f0 + 4 * n, cb + f0 + 4 * n, fr);
                    asm volatile("" ::: "memory");
                    conv4<true>(acc[ai][1][0][n], acc[ai][1][1][n], acc[ai][1][2][n], acc[ai][1][3][n], rs, tt, cw + FF + f0 + 4 * n, cb + FF + f0 + 4 * n, fr);
                } else {
                    conv4<false>(acc[ai][0][0][n], acc[ai][0][1][n], acc[ai][0][2][n], acc[ai][0][3][n], rs, tt, cw + f0 + 4 * n, cb + f0 + 4 * n, fr);
                    asm volatile("" ::: "memory");
                    conv4<false>(acc[ai][1][0][n], acc[ai][1][1][n], acc[ai][1][2][n], acc[ai][1][3][n], rs, tt, cw + FF + f0 + 4 * n, cb + FF + f0 + 4 * n, fr);
                }
                asm volatile("" ::: "memory");
#pragma unroll
                for (int m = 0; m < 4; ++m) { const int g = gbase + 16 * m;
                    if ((m > 0 || fr >= 2) && g < M) { const f32x4 gt = acc[ai][0][m][n], vl = acc[ai][1][m][n]; f32x4 o;
#pragma unroll
                        for (int e = 0; e < 4; ++e) o[e] = gt[e] * sigmoidf_(gt[e]) * vl[e];
                        u32x2 w; w.x = cvt_pk_bf16(o[0], o[1]); w.y = cvt_pk_bf16(o[2], o[3]);
                        *(u32x2*)(ACT + (size_t)g * FF + f0 + 4 * n) = w; } }
            }
        }
    }
};
struct EpiRkv {
    static constexpr bool PERM = true;
    bf16_t* R; bf16_t* WA; bf16_t* GL; int row_off, pn_off;
    __device__ __forceinline__ void operator()(const f32x4 (&acc)[2][2][4][2], const Unit& u, int wr, int wc, int fr, int fq) const {
        const int pne = u.pn + pn_off; const int mode = pne < 12 ? 0 : (pne == 12 ? 1 : 2);
        bf16_t* base; int ldc, colt;
        if (mode == 0) { base = R + (size_t)(pne >> 2) * ((size_t)M * D); ldc = D; colt = (pne & 3) * 256 + wc * 32 + 8 * fq; }
        else if (mode == 1) { base = WA; ldc = 128; colt = wc * 32 + 8 * fq; }
        else { base = GL; ldc = 256; colt = wc * 32 + 8 * fq; }
#pragma unroll
        for (int ai = 0; ai < 2; ++ai)
#pragma unroll
            for (int m = 0; m < 4; ++m) { const int row = row_off + u.pm * 256 + ai * 128 + wr * 64 + m * 16 + fr;
                bf16_t* rowp = base + (size_t)row * ldc + colt;
#pragma unroll
                for (int bj = 0; bj < 2; ++bj) { f32x4 v0 = acc[ai][bj][m][0], v1 = acc[ai][bj][m][1];
                    if (mode == 1) { if (bj == 1) continue;
                        if (wc < 2) {
#pragma unroll
                            for (int e = 0; e < 4; ++e) { v0[e] = tanhf(v0[e]); v1[e] = tanhf(v1[e]); } } }
                    else if (mode == 2) {
#pragma unroll
                        for (int e = 0; e < 4; ++e) { v0[e] = sigmoidf_(v0[e]); v1[e] = sigmoidf_(v1[e]); } }
                    u32x4 w; w.x = cvt_pk_bf16(v0[0], v0[1]); w.y = cvt_pk_bf16(v0[2], v0[3]); w.z = cvt_pk_bf16(v1[0], v1[1]); w.w = cvt_pk_bf16(v1[2], v1[3]);
                    *(u32x4*)(rowp + bj * 128) = w; } }
    }
};

typedef const __attribute__((address_space(4))) Args* CA;
struct Ctx { LAS unsigned char* lds; int tid, lane, wave, G, bid; };

__device__ __forceinline__ void conv_mat(const Ctx& c, const float* src, int ldsrc, int K, int N, int Kp, int Np, bf16_t* dst, int ldd, int n_off, int k_off, const float* sc, int mode, int rot) {
    LAS float* tile = (LAS float*)c.lds;
    const int nnb = Np / 64, nit = (Kp / 64) * nnb; const int start = (c.bid + c.G - (rot % c.G)) % c.G;
    for (int it = start; it < nit; it += c.G) {
        const int kb = it / nnb, nb = it % nnb, k0 = kb * 64, n0 = nb * 64;
#pragma unroll
        for (int j = 0; j < 2; ++j) { const int kk = (c.tid >> 4) + 32 * j, nn = (c.tid & 15) * 4, k = k0 + kk, n = n0 + nn; f32x4 v = (f32x4){0.f, 0.f, 0.f, 0.f};
            if (src && k < K && n < N) { v = *(const f32x4*)(src + (size_t)k * ldsrc + n); if (mode == 1) v = v * sc[k]; else if (mode == 2) v = v * (1.f - sc[k]); }
            tile[nn * 65 + kk] = v.x; tile[(nn + 1) * 65 + kk] = v.y; tile[(nn + 2) * 65 + kk] = v.z; tile[(nn + 3) * 65 + kk] = v.w; }
        __syncthreads();
        { const int nn = c.tid >> 3, cc = c.tid & 7; const LAS float* s = tile + nn * 65 + 8 * cc;
            u32x4 o; o.x = cvt_pk_bf16(s[0], s[1]); o.y = cvt_pk_bf16(s[2], s[3]); o.z = cvt_pk_bf16(s[4], s[5]); o.w = cvt_pk_bf16(s[6], s[7]);
            *(u32x4*)(dst + (size_t)(n_off + n0 + nn) * ldd + k_off + k0 + 8 * cc) = o; }
        __syncthreads();
    }
}

__device__ __forceinline__ void phase_static_weights(const Ctx& c, CA a, int j);
__device__ __forceinline__ void phase_prologue(const Ctx& c, CA a) {
    float* ss = (float*)(a->ws + WS_PA);
    const int gw = c.bid * 8 + c.wave, NGW = c.G * 8;
    bf16_t* hb = (bf16_t*)(a->ws + WS_A);
    for (int m = gw; m < M; m += NGW) {
        const f32x4* xr = (const f32x4*)(a->in[I_X] + (size_t)m * D) + c.lane; u32x2* br = (u32x2*)(hb + (size_t)m * D) + c.lane;
        float s = 0.f;
#pragma unroll
        for (int j = 0; j < 4; ++j) { const f32x4 v = xr[64 * j]; s += (v.x * v.x + v.y * v.y) + (v.z * v.z + v.w * v.w); u32x2 w; w.x = cvt_pk_bf16(v.x, v.y); w.y = cvt_pk_bf16(v.z, v.w); br[64 * j] = w; }
        s = wave_sum(s); if (c.lane < 16) ss[(size_t)m * 16 + c.lane] = c.lane == 0 ? s : 0.f;
    }
    phase_static_weights(c, a, 0);
}
__device__ __forceinline__ void phase_static_weights(const Ctx& c, CA a, int j) {
    int rot = 0;
    {
        unsigned char* wj = a->ws + WS_WSTAT + (size_t)j * WJ_STRIDE;
        conv_mat(c, a->in[I_SWIN] + (size_t)j * D * 2048, 2048, D, 2048, D, 2048, (bf16_t*)(wj + WJ_IN), D, 0, 0, a->in[I_NMIX] + (size_t)(2 * j) * D, 1, rot); rot += 512;
        conv_mat(c, a->in[I_SWOUT] + (size_t)j * D * D, D, D, D, D, D, (bf16_t*)(wj + WJ_OUT), D, 0, 0, nullptr, 0, rot); rot += 256;
        const float* mu = a->in[I_MU] + (size_t)j * 6 * D; bf16_t* rkv3 = (bf16_t*)(wj + WJ_RKV); bf16_t* rkv = (bf16_t*)(wj + WJ_RKV + 6 * MiB) - (size_t)3072 * 2048;
#define CONV_BIG(IDX, Q, MUB) do { conv_mat(c, a->in[IDX] + (size_t)j * D * D, D, D, D, D, D, rkv3, 1024, (Q) * 1024, 0, nullptr, 0, rot); rot += 256; } while (0)
        CONV_BIG(I_WR, 0, 0); CONV_BIG(I_WK, 1, 2); CONV_BIG(I_WV, 2, 3);
#undef CONV_BIG
        conv_mat(c, a->in[I_W1] + (size_t)j * D * 64, 64, D, 64, D, 64, rkv, 2048, 3072, 0, mu + 1 * D, 2, rot); rot += 16;
        conv_mat(c, a->in[I_W1] + (size_t)j * D * 64, 64, D, 64, D, 64, rkv, 2048, 3072, 1024, mu + 1 * D, 1, rot); rot += 16;
        conv_mat(c, a->in[I_A1] + (size_t)j * D * 64, 64, D, 64, D, 64, rkv, 2048, 3136, 0, mu + 4 * D, 2, rot); rot += 16;
        conv_mat(c, a->in[I_A1] + (size_t)j * D * 64, 64, D, 64, D, 64, rkv, 2048, 3136, 1024, mu + 4 * D, 1, rot); rot += 16;
        conv_mat(c, nullptr, 0, 0, 0, 2048, 128, rkv, 2048, 3200, 0, nullptr, 0, rot); rot += 64;
        conv_mat(c, a->in[I_G1] + (size_t)j * D * 160, 160, D, 160, D, 256, rkv, 2048, 3328, 0, mu + 5 * D, 2, rot); rot += 64;
        conv_mat(c, a->in[I_G1] + (size_t)j * D * 160, 160, D, 160, D, 256, rkv, 2048, 3328, 1024, mu + 5 * D, 1, rot); rot += 64;
        bf16_t* l2wa = (bf16_t*)(wj + WJ_L2WA);
        conv_mat(c, a->in[I_W2] + (size_t)j * 64 * D, D, 64, D, 64, D, l2wa, 128, 0, 0, nullptr, 0, rot); rot += 16;
        conv_mat(c, nullptr, 0, 0, 0, 64, D, l2wa, 128, 0, 64, nullptr, 0, rot); rot += 16;
        conv_mat(c, nullptr, 0, 0, 0, 64, D, l2wa, 128, 1024, 0, nullptr, 0, rot); rot += 16;
        conv_mat(c, a->in[I_A2] + (size_t)j * 64 * D, D, 64, D, 64, D, l2wa, 128, 1024, 64, nullptr, 0, rot); rot += 16;
        conv_mat(c, a->in[I_G2] + (size_t)j * 160 * D, D, 160, D, 256, D, (bf16_t*)(wj + WJ_L2G), 256, 0, 0, nullptr, 0, rot); rot += 64;
        conv_mat(c, a->in[I_WO] + (size_t)j * D * D, D, D, D, D, D, (bf16_t*)(wj + WJ_O), D, 0, 0, nullptr, 0, rot); rot += 256;
    }
}
__device__ __forceinline__ void phase_ffn_weights(const Ctx& c, CA a, int layer) {
    for (int pn = 0; pn < FF / 128; ++pn) {
        conv_mat(c, a->in[I_FUP] + (size_t)layer * D * FF2 + pn * 128, FF2, D, 128, D, 128, (bf16_t*)(a->ws + WS_WFFN), D, pn * 256, 0, a->in[I_NFFN] + (size_t)layer * D, 1, pn * 64);
        conv_mat(c, a->in[I_FUP] + (size_t)layer * D * FF2 + FF + pn * 128, FF2, D, 128, D, 128, (bf16_t*)(a->ws + WS_WFFN), D, pn * 256 + 128, 0, a->in[I_NFFN] + (size_t)layer * D, 1, pn * 64 + 32);
    }
    conv_mat(c, a->in[I_FDN] + (size_t)layer * FF * D, D, FF, D, FF, D, (bf16_t*)(a->ws + WS_WDOWN), FF, 0, 0, nullptr, 0, 128);
}

__device__ __forceinline__ void phase_sgu_spatial(const Ctx& c, CA a, int j, int rp) {
    typedef short bf16x8 __attribute__((ext_vector_type(8)));
    bf16_t* U = (bf16_t*)(a->ws + P_U); const bf16_t* V = (const bf16_t*)(a->ws + P_SV); bf16_t* UO = rp ? (bf16_t*)(a->ws + P_SV) : U;
    const float* ssv = (const float*)(a->ws + WS_PV);
    LAS bf16_t* WL = (LAS bf16_t*)c.lds; LAS bf16_t* VT = WL + 128 * 136;
    const int g = c.bid & 15;
    const float* Ws = a->in[I_SWS] + ((size_t)j * 16 + g) * 128 * 128; const float* bs = a->in[I_SBS] + ((size_t)j * 16 + g) * 128; const float* gv = a->in[I_SGV] + (size_t)j * D + g * 64;
    __syncthreads();
    { const int t = c.tid >> 2, s0 = (c.tid & 3) * 32; const float* wp = Ws + (size_t)t * 128 + s0;
#pragma unroll
      for (int q = 0; q < 4; ++q) { f32x4 x0 = *(const f32x4*)(wp + 8 * q), x1 = *(const f32x4*)(wp + 8 * q + 4);
#pragma unroll
          for (int e = 0; e < 4; ++e) { if (s0 + 8 * q + e > t) x0[e] = 0.f; if (s0 + 8 * q + 4 + e > t) x1[e] = 0.f; }
          u32x4 w; w.x = cvt_pk_bf16(x0[0], x0[1]); w.y = cvt_pk_bf16(x0[2], x0[3]); w.z = cvt_pk_bf16(x1[0], x1[1]); w.w = cvt_pk_bf16(x1[2], x1[3]);
          *(LAS u32x4*)(WL + t * 136 + s0 + 8 * q) = w; } }
    const int w8 = c.wave, fr = c.lane & 15, fq = c.lane >> 4, t0 = 16 * w8, nk = (w8 >> 1) + 1;
    const int vs = c.tid >> 2, vc = (c.tid & 3) * 16;
    f32x4 gq[4];
#pragma unroll
    for (int e = 0; e < 4; ++e) gq[e] = *(const f32x4*)(gv + vc + 4 * e);
    const float bb = bs[t0 + fr];
    for (int ub = c.bid >> 4; ub < M / 128; ub += c.G >> 4) {
        const int m0 = ub * 128;
        { const bf16_t* vp = V + (size_t)(m0 + vs) * D + g * 64 + vc; const u32x4 v0 = *(const u32x4*)vp, v1 = *(const u32x4*)(vp + 8);
          const float rs = row_rstd(ssv, m0 + vs);
          const unsigned vw[8] = {v0.x, v0.y, v0.z, v0.w, v1.x, v1.y, v1.z, v1.w};
#pragma unroll
          for (int e = 0; e < 8; ++e) { const float lo = bflo(vw[e]) * rs * gq[e >> 1][(2 * e) & 3], hi = bfhi(vw[e]) * rs * gq[e >> 1][(2 * e + 1) & 3];
              const unsigned pk = cvt_pk_bf16(lo, hi);
              VT[(vc + 2 * e) * 136 + vs] = (bf16_t)(pk & 0xffffu); VT[(vc + 2 * e + 1) * 136 + vs] = (bf16_t)(pk >> 16); } }
        __syncthreads();
        f32x4 acc[4];
#pragma unroll
        for (int ct = 0; ct < 4; ++ct) acc[ct] = (f32x4){0.f, 0.f, 0.f, 0.f};
        for (int k = 0; k < nk; ++k) {
            const bf16x8 wf = *(const LAS bf16x8*)(WL + (t0 + fr) * 136 + 32 * k + 8 * fq);
#pragma unroll
            for (int ct = 0; ct < 4; ++ct) { const bf16x8 vf = *(const LAS bf16x8*)(VT + (16 * ct + fr) * 136 + 32 * k + 8 * fq);
                acc[ct] = __builtin_amdgcn_mfma_f32_16x16x32_bf16(vf, wf, acc[ct], 0, 0, 0); }
        }
        { const size_t ro = (size_t)(m0 + t0 + fr) * D + g * 64 + 4 * fq;
#pragma unroll
          for (int ct = 0; ct < 4; ++ct) { const u32x2 uu = *(const u32x2*)(U + ro + 16 * ct); const f32x4 o = acc[ct] + bb;
              u32x2 w; w.x = cvt_pk_bf16(bflo(uu.x) * o[0], bfhi(uu.x) * o[1]); w.y = cvt_pk_bf16(bflo(uu.y) * o[2], bfhi(uu.y) * o[3]);
              *(u32x2*)(UO + ro + 16 * ct) = w; } }
        __syncthreads();
    }
}

__device__ __forceinline__ void phase_ffn_conv(const Ctx& c, CA a, int layer, int half) {
    const bf16_t* Z = (const bf16_t*)(a->ws + P_Z); bf16_t* ACT = (bf16_t*)(a->ws + P_ACT) + (size_t)half * (M / 2) * FF;
    const float* cw = a->in[I_FCW] + (size_t)layer * 3 * FF2; const float* cb = a->in[I_FCB] + (size_t)layer * FF2;
    const int gt = c.bid * 512 + c.tid, NT = c.G * 512;
    for (int idx = gt; idx < (M / 2) * (FF / 8); idx += NT) {
        const int ml = idx / (FF / 8), f = (idx % (FF / 8)) * 8, t = ml & (SEQ - 1);
        float gsum[8], vsum[8];
#pragma unroll
        for (int e = 0; e < 8; ++e) { gsum[e] = cb[f + e]; vsum[e] = cb[FF + f + e]; }
#pragma unroll
        for (int jj = 0; jj < 3; ++jj) { const int dt = 2 - jj; if (t - dt < 0) continue;
            const u32x4 zg = *(const u32x4*)(Z + (size_t)(ml - dt) * FF2 + f), zv = *(const u32x4*)(Z + (size_t)(ml - dt) * FF2 + FF + f);
            const float* wg = cw + (size_t)jj * FF2 + f; const float* wv = wg + FF;
            const unsigned zgw[4] = {zg.x, zg.y, zg.z, zg.w}, zvw[4] = {zv.x, zv.y, zv.z, zv.w};
#pragma unroll
            for (int e = 0; e < 4; ++e) { gsum[2 * e] += wg[2 * e] * bflo(zgw[e]); gsum[2 * e + 1] += wg[2 * e + 1] * bfhi(zgw[e]); vsum[2 * e] += wv[2 * e] * bflo(zvw[e]); vsum[2 * e + 1] += wv[2 * e + 1] * bfhi(zvw[e]); } }
        float o[8];
#pragma unroll
        for (int e = 0; e < 8; ++e) o[e] = gsum[e] * sigmoidf_(gsum[e]) * vsum[e];
        u32x4 w; w.x = cvt_pk_bf16(o[0], o[1]); w.y = cvt_pk_bf16(o[2], o[3]); w.z = cvt_pk_bf16(o[4], o[5]); w.w = cvt_pk_bf16(o[6], o[7]);
        *(u32x4*)(ACT + (size_t)ml * FF + f) = w;
    }
}

__device__ __forceinline__ void phase_rwkv_prep(const Ctx& c, CA a, int layer, int mode) {
    const float* ss = (const float*)(a->ws + WS_PA); const float* g = a->in[I_NMIX] + (size_t)layer * D; const float* mu = a->in[I_MU] + (size_t)(layer >> 1) * 6 * D;
    bf16_t* hn = (bf16_t*)(a->ws + WS_A); bf16_t* X = (bf16_t*)(a->ws + P_LW);
    const int gw = c.bid * 8 + c.wave, NGW = c.G * 8;
    f32x4 gg[4], mr[4], mk[4], mv[4];
#pragma unroll
    for (int j = 0; j < 4; ++j) { gg[j] = *((const f32x4*)g + c.lane + 64 * j); mr[j] = *((const f32x4*)mu + c.lane + 64 * j); mk[j] = *((const f32x4*)(mu + 2 * D) + c.lane + 64 * j); mv[j] = *((const f32x4*)(mu + 3 * D) + c.lane + 64 * j); }
    for (int m = gw + (mode ? M / 2 : 0); m < M; m += NGW) {
        const float rs = row_rstd(ss, m); const int t = m & (SEQ - 1);
        const f32x4* hr = (const f32x4*)(a->out + (size_t)m * D) + c.lane;
        f32x4 cur[4];
#pragma unroll
        for (int j = 0; j < 4; ++j) cur[j] = hr[64 * j] * rs * gg[j];
        if (mode == 0) { const int prow = (m >> 12) * SEQP + PADR + t; u32x2* br = (u32x2*)(hn + (size_t)prow * D) + c.lane;
#pragma unroll
            for (int j = 0; j < 4; ++j) { u32x2 w; w.x = cvt_pk_bf16(cur[j].x, cur[j].y); w.y = cvt_pk_bf16(cur[j].z, cur[j].w); br[64 * j] = w; } }
        if (mode == 1 || m < M / 2) {
            const float rsp = t > 0 ? row_rstd(ss, m - 1) : 0.f; const f32x4* hp = (const f32x4*)(a->out + (size_t)(t > 0 ? m - 1 : m) * D) + c.lane;
            const size_t lo = (size_t)(m & (M / 2 - 1)) * D;
            u32x2* xr = (u32x2*)(X + lo) + c.lane; u32x2* xk = (u32x2*)(X + (size_t)(M / 2) * D + lo) + c.lane; u32x2* xv = (u32x2*)(X + (size_t)M * D + lo) + c.lane;
#pragma unroll
            for (int j = 0; j < 4; ++j) { const f32x4 dl = hp[64 * j] * rsp * gg[j] - cur[j];
                const f32x4 vr = cur[j] + dl * mr[j], vk = cur[j] + dl * mk[j], vv = cur[j] + dl * mv[j]; u32x2 w;
                w.x = cvt_pk_bf16(vr.x, vr.y); w.y = cvt_pk_bf16(vr.z, vr.w); xr[64 * j] = w;
                w.x = cvt_pk_bf16(vk.x, vk.y); w.y = cvt_pk_bf16(vk.z, vk.w); xk[64 * j] = w;
                w.x = cvt_pk_bf16(vv.x, vv.y); w.y = cvt_pk_bf16(vv.z, vv.w); xv[64 * j] = w; }
        }
    }
    if (mode == 0) for (int r = gw; r < BATCH * PADR; r += NGW) { const int prow = (r / PADR) * SEQP + (r % PADR); u32x2* br = (u32x2*)(hn + (size_t)prow * D) + c.lane;
#pragma unroll
        for (int j = 0; j < 4; ++j) br[64 * j] = (u32x2){0u, 0u}; }
}

__device__ __forceinline__ f32x4 bf4(u32x2 w) { return (f32x4){bflo(w.x), bfhi(w.x), bflo(w.y), bfhi(w.y)}; }
__device__ __forceinline__ float hsum4(f32x4 p) { return (p.x + p.y) + (p.z + p.w); }
__device__ __forceinline__ float sum16(float v) { v = sum8(v); v += dpp_f<0x140>(v); return v; }
__device__ __forceinline__ f32x4 bf4lo(u32x4 w) { return (f32x4){bflo(w.x), bfhi(w.x), bflo(w.y), bfhi(w.y)}; }
__device__ __forceinline__ f32x4 bf4hi(u32x4 w) { return (f32x4){bflo(w.z), bfhi(w.z), bflo(w.w), bfhi(w.w)}; }
__device__ __forceinline__ void phase_scan(const Ctx& c, CA a, int j, int rp_out) {
    constexpr int CH = 32, NCH = SEQ / CH, VSZ = CH * 64, YSZ = CH * 32;
    LAS float* BIG = (LAS float*)c.lds; LAS float* VB = BIG + 2 * 5 * VSZ; LAS float* YB = VB + 4 * VSZ; LAS float* BON = YB + 3 * YSZ; LAS float* SCR = BON + 128;
    bf16_t* R = (bf16_t*)(a->ws + P_R); const bf16_t* Kb = (const bf16_t*)(a->ws + P_K); const bf16_t* Vb = (const bf16_t*)(a->ws + P_V);
    const bf16_t* LWb = (const bf16_t*)(a->ws + P_LW); const bf16_t* LAb = (const bf16_t*)(a->ws + P_LA); const bf16_t* Gb = (const bf16_t*)(a->ws + WS_A);
    if (c.G != 256) return;
    const int unit = c.bid, b = unit >> 5, hh = (unit >> 1) & 15, half = unit & 1;
    unsigned long long* slot_own = (unsigned long long*)(a->ws + WS_XS) + (size_t)(j * 256 + unit) * 256; const unsigned long long* slot_par = (const unsigned long long*)(a->ws + WS_XS) + (size_t)(j * 256 + (unit ^ 1)) * 256;
    const bool cons = c.tid < 256;
    __syncthreads();
    if (cons) {
        const int rp = c.tid >> 3, q = c.tid & 7, row = 32 * half + rp;
        f32x4 S0 = (f32x4){0.f, 0.f, 0.f, 0.f}, S1 = S0;
        __builtin_amdgcn_s_setprio(2);
        __syncthreads();
        for (int i = 0; i <= NCH + 1; ++i) {
            if (i < NCH) {
                const LAS float* bg = BIG + (i & 1) * 5 * VSZ + 8 * q;
                const LAS f32x4* pw = (const LAS f32x4*)bg; const LAS f32x4* pa = (const LAS f32x4*)(bg + VSZ); const LAS f32x4* pb = (const LAS f32x4*)(bg + 2 * VSZ);
                const LAS f32x4* pk = (const LAS f32x4*)(bg + 3 * VSZ); const LAS f32x4* pr = (const LAS f32x4*)(bg + 4 * VSZ);
                const LAS float* pv = VB + (i & 3) * VSZ + row * 32; const int vf = (row ^ (row >> 3)) & 7; LAS float* py = YB + (i % 3) * YSZ + rp * CH;
                f32x4 a0v = pa[0], a1v = pa[1], b0v = pb[0], b1v = pb[1], k0v = pk[0], k1v = pk[1], r0v = pr[0], r1v = pr[1];
                for (int t8 = 0; t8 < CH; t8 += 8) {
                    f32x4 ya, yb;
                    const f32x4 va = *(const LAS f32x4*)(pv + ((((t8 >> 2)) ^ vf) << 2)), vb = *(const LAS f32x4*)(pv + ((((t8 >> 2) + 1) ^ vf) << 2));
#pragma unroll
                    for (int u = 0; u < 8; ++u) {
                        const int t = t8 + u, tn = (t + 1) & (CH - 1);
                        const f32x4 na0 = pa[tn * 16], na1 = pa[tn * 16 + 1], nb0 = pb[tn * 16], nb1 = pb[tn * 16 + 1],
                                    nk0 = pk[tn * 16], nk1 = pk[tn * 16 + 1], nr0 = pr[tn * 16], nr1 = pr[tn * 16 + 1];
                        const float vv = u < 4 ? va[u] : vb[u - 4];
                        const float sa = sum8(hsum4(S0 * a0v + S1 * a1v));
                        S0 = S0 + sa * b0v + vv * k0v; S1 = S1 + sa * b1v + vv * k1v;
                        const float y = sum8(hsum4(S0 * r0v + S1 * r1v));
                        if (u < 4) ya[u] = y; else yb[u - 4] = y;
                        if (u == 7) { S0 = S0 * pw[t * 16]; S1 = S1 * pw[t * 16 + 1]; if (q == 0) { *(LAS f32x4*)(py + t8) = ya; *(LAS f32x4*)(py + t8 + 4) = yb; } }
                        a0v = na0; a1v = na1; b0v = nb0; b1v = nb1; k0v = nk0; k1v = nk1; r0v = nr0; r1v = nr1;
                    }
                }
            }
            __syncthreads();
        }
        __builtin_amdgcn_s_setprio(0);
    } else {
        const int pt = c.tid - 256, st = pt >> 3, l8 = pt & 7, sc = l8 * 8, ch = hh * 64 + sc;
        const float* pp = a->in[I_W0] + (size_t)j * D + ch; const f32x4 w0a = *(const f32x4*)pp, w0b = *(const f32x4*)(pp + 4);
        pp = a->in[I_A0] + (size_t)j * D + ch; const f32x4 a0a = *(const f32x4*)pp, a0b = *(const f32x4*)(pp + 4);
        pp = a->in[I_KK] + (size_t)j * D + ch; const f32x4 kka = *(const f32x4*)pp, kkb = *(const f32x4*)(pp + 4);
        pp = a->in[I_KA] + (size_t)j * D + ch; const f32x4 kaa = *(const f32x4*)pp, kab = *(const f32x4*)(pp + 4);
        pp = a->in[I_RK] + (size_t)j * D + ch; const f32x4 rka = *(const f32x4*)pp, rkb = *(const f32x4*)(pp + 4);
        const int oc = 4 * l8, cho = hh * 64 + 32 * half + oc;
        const f32x4 lnw = *(const f32x4*)(a->in[I_LNW] + (size_t)j * D + cho), lnb = *(const f32x4*)(a->in[I_LNB] + (size_t)j * D + cho);
        const size_t gbase = ((size_t)b * SEQ + st) * D + ch, obase = ((size_t)b * SEQ + st) * D + cho;
        u32x4 qr = *(const u32x4*)(R + gbase), qk = *(const u32x4*)(Kb + gbase), qv = *(const u32x4*)(Vb + gbase), qlw = *(const u32x4*)(LWb + gbase), qla = *(const u32x4*)(LAb + gbase);
        u32x2 qg = (u32x2){0u, 0u};
#define SCAN_STAGE(n) { \
            f32x4 rr[2] = {bf4lo(qr), bf4hi(qr)}, kk_[2] = {bf4lo(qk), bf4hi(qk)}, vv_[2] = {bf4lo(qv), bf4hi(qv)}, lw_[2] = {bf4lo(qlw), bf4hi(qlw)}, la_[2] = {bf4lo(qla), bf4hi(qla)}; \
            const f32x4 w0_[2] = {w0a, w0b}, a0_[2] = {a0a, a0b}, kkp_[2] = {kka, kkb}, kap_[2] = {kaa, kab}, rkp_[2] = {rka, rkb}; \
            f32x4 dec[2], av[2], kn[2], kp[2]; float n2 = 0.f, bon = 0.f; \
            _Pragma("unroll") for (int h2 = 0; h2 < 2; ++h2) _Pragma("unroll") for (int e = 0; e < 4; ++e) { \
                const float xw = -(w0_[h2][e] + lw_[h2][e]); const float sp = xw > 20.f ? xw : __logf(1.f + __expf(xw)); \
                dec[h2][e] = __expf(-sp - 0.5f); av[h2][e] = __builtin_amdgcn_rcpf(1.f + __expf(-(a0_[h2][e] + la_[h2][e]))); \
                kn[h2][e] = kk_[h2][e] * kkp_[h2][e]; n2 += kn[h2][e] * kn[h2][e]; \
                kp[h2][e] = kk_[h2][e] * (1.f + (av[h2][e] - 1.f) * kap_[h2][e]); bon += rr[h2][e] * kp[h2][e] * rkp_[h2][e]; } \
            n2 = sum8(n2); bon = sum8(bon); const float inv = rsqrtf(fmaxf(n2, 1e-24f)); \
            LAS float* scr = SCR + (pt >> 6) * 512; *(LAS f32x4*)(scr + (st & 7) * 64 + sc) = dec[0]; *(LAS f32x4*)(scr + (st & 7) * 64 + sc + 4) = dec[1]; \
            f32x4 cum[2] = {(f32x4){0.f, 0.f, 0.f, 0.f}, (f32x4){0.f, 0.f, 0.f, 0.f}}; \
            asm volatile("s_waitcnt lgkmcnt(0)" ::: "memory"); \
            for (int t2 = 0; t2 <= (st & 7); ++t2) { cum[0] += *(const LAS f32x4*)(scr + t2 * 64 + sc); cum[1] += *(const LAS f32x4*)(scr + t2 * 64 + sc + 4); } \
            asm volatile("s_waitcnt lgkmcnt(0)" ::: "memory"); \
            LAS float* bg = BIG + ((n) & 1) * 5 * VSZ + st * 64 + sc; \
            _Pragma("unroll") for (int h2 = 0; h2 < 2; ++h2) { const f32x4 kq = kn[h2] * inv; f32x4 Pt, Pp, Pi; \
                _Pragma("unroll") for (int e = 0; e < 4; ++e) { Pt[e] = __expf(-cum[h2][e]); Pp[e] = __expf(dec[h2][e] - cum[h2][e]); Pi[e] = __expf(cum[h2][e]); } \
                *(LAS f32x4*)(bg + 4 * h2) = Pt; *(LAS f32x4*)(bg + VSZ + 4 * h2) = -kq * Pp; *(LAS f32x4*)(bg + 2 * VSZ + 4 * h2) = kq * av[h2] * Pi; \
                *(LAS f32x4*)(bg + 3 * VSZ + 4 * h2) = kp[h2] * Pi; *(LAS f32x4*)(bg + 4 * VSZ + 4 * h2) = rr[h2] * Pt; \
                _Pragma("unroll") for (int e = 0; e < 4; ++e) { const int ch_ = sc + 4 * h2 + e; VB[((n) & 3) * VSZ + ch_ * 32 + ((((st >> 2)) ^ ((ch_ ^ (ch_ >> 3)) & 7)) << 2) + (st & 3)] = vv_[h2][e]; } } \
            if (l8 == 0) BON[((n) & 3) * CH + st] = bon; }
#define SCAN_YSTATS(n) \
            const LAS float* yq_ = YB + ((n) % 3) * YSZ + oc * CH + st; const f32x4 y = {yq_[0], yq_[CH], yq_[2 * CH], yq_[3 * CH]}; \
            const float mh = sum8(hsum4(y)) * (1.f / 32.f); const f32x4 d = y - mh; const float m2h = sum8(hsum4(d * d));
        SCAN_STAGE(0)
        { const size_t go = gbase + (size_t)CH * D; qr = *(const u32x4*)(R + go); qk = *(const u32x4*)(Kb + go); qv = *(const u32x4*)(Vb + go); qlw = *(const u32x4*)(LWb + go); qla = *(const u32x4*)(LAb + go); }
        __syncthreads();
        for (int i = 0; i <= NCH + 1; ++i) {
            unsigned long long pw0 = 0ull, pw1 = 0ull; const unsigned long long* pp_ = slot_par + (((i - 2) & 3) * CH + st) * 2;
            if (i >= 2) { pw0 = __hip_atomic_load(pp_, __ATOMIC_RELAXED, __HIP_MEMORY_SCOPE_AGENT); pw1 = __hip_atomic_load(pp_ + 1, __ATOMIC_RELAXED, __HIP_MEMORY_SCOPE_AGENT); }
            if (i >= 1 && i <= NCH) {
                const int n = i - 1;
                SCAN_YSTATS(n)
                if (l8 == 0) { const unsigned long long tg = (unsigned long long)(unsigned)(n + 1) << 32; unsigned long long* sp_ = slot_own + ((n & 3) * CH + st) * 2;
                    __hip_atomic_store(sp_, tg | __float_as_uint(mh), __ATOMIC_RELAXED, __HIP_MEMORY_SCOPE_AGENT); __hip_atomic_store(sp_ + 1, tg | __float_as_uint(m2h), __ATOMIC_RELAXED, __HIP_MEMORY_SCOPE_AGENT); }
            }
            u32x4 nr = qr, nk = qk, nv = qv, nlw = qlw, nla = qla; u32x2 ng = qg;
            if (i + 2 < NCH) { const size_t go = gbase + (size_t)(i + 2) * CH * D; nr = *(const u32x4*)(R + go); nk = *(const u32x4*)(Kb + go); nv = *(const u32x4*)(Vb + go); nlw = *(const u32x4*)(LWb + go); nla = *(const u32x4*)(LAb + go); }
            if (i >= 1 && i <= NCH) ng = *(const u32x2*)(Gb + obase + (size_t)(i - 1) * CH * D);
            if (i + 1 < NCH) { SCAN_STAGE(i + 1) }
            if (i >= 2) {
                const int n = i - 2; const unsigned tag = (unsigned)(n + 1); unsigned sp = 0;
                while ((unsigned)(pw0 >> 32) != tag) { __builtin_amdgcn_s_sleep(1); if (++sp > (1u << 18)) break; pw0 = __hip_atomic_load(pp_, __ATOMIC_RELAXED, __HIP_MEMORY_SCOPE_AGENT); }
                while ((unsigned)(pw1 >> 32) != tag) { __builtin_amdgcn_s_sleep(1); if (++sp > (1u << 18)) break; pw1 = __hip_atomic_load(pp_ + 1, __ATOMIC_RELAXED, __HIP_MEMORY_SCOPE_AGENT); }
                const float mp = __uint_as_float((unsigned)pw0), m2p = __uint_as_float((unsigned)pw1);
                SCAN_YSTATS(n)
                const float mean = 0.5f * (mh + mp), dm = mh - mp; const float rstd = rsqrtf((m2h + m2p + 16.f * dm * dm) * (1.f / 64.f) + GN_EPS);
                f32x4 v;
#pragma unroll
                for (int e = 0; e < 4; ++e) { const int ch_ = 32 * half + oc + e; v[e] = VB[(n & 3) * VSZ + ch_ * 32 + ((((st >> 2)) ^ ((ch_ ^ (ch_ >> 3)) & 7)) << 2) + (st & 3)]; }
                const float bon = BON[(n & 3) * CH + st];
                const f32x4 o = ((y - mean) * rstd * lnw + lnb + bon * v) * bf4(qg);
                u32x2 w; w.x = cvt_pk_bf16(o.x, o.y); w.y = cvt_pk_bf16(o.z, o.w);
                *(u32x2*)(R + obase + (size_t)n * CH * D) = w;
            }
            qg = ng; qr = nr; qk = nk; qv = nv; qlw = nlw; qla = nla;
            __syncthreads();
        }
#undef SCAN_STAGE
#undef SCAN_YSTATS
    }
}

__device__ __forceinline__ void phase_final(const Ctx& c, CA a) {
    const float* ss = (const float*)(a->ws + WS_PA); const float* g = a->in[I_NFIN];
    const int gw = c.bid * 8 + c.wave, NGW = c.G * 8;
    f32x4 gg[4];
#pragma unroll
    for (int j = 0; j < 4; ++j) gg[j] = *((const f32x4*)g + c.lane + 64 * j);
    for (int m = gw; m < M; m += NGW) {
        const float rs = row_rstd(ss, m);
        f32x4* hr = (f32x4*)(a->out + (size_t)m * D) + c.lane;
#pragma unroll
        for (int j = 0; j < 4; ++j) hr[64 * j] = hr[64 * j] * rs * gg[j];
    }
}

#define XB_TMO      128
#define XB_XCNT(j)  (256  + 64 * (j))
#define XB_XSUB(j)  (1280 + 64 * (j))
#define XB_XGEN(j)  (2304 + 64 * (j))
#define XB_TOP      3328
#define XB_TOPGEN   3392
#define XCD_BAR_WORDS 3456
#define XB_SPIN_CAP (1u << 18)

__device__ __forceinline__ unsigned xb_ld(unsigned* p)              { return __hip_atomic_load(p, __ATOMIC_RELAXED, __HIP_MEMORY_SCOPE_AGENT); }
__device__ __forceinline__ unsigned xb_add(unsigned* p, unsigned v) { return __hip_atomic_fetch_add(p, v, __ATOMIC_RELAXED, __HIP_MEMORY_SCOPE_AGENT); }
__device__ __forceinline__ unsigned xb_xcc_id() { return (unsigned)__builtin_amdgcn_s_getreg((3 << 11) | 20) & 0xFu; }
#define XB_SPIN(cond, bar) do { unsigned _sp = 0; while (cond) { __builtin_amdgcn_s_sleep(1); \
    if ((++_sp & 255u) == 0u) { if (xb_ld(&(bar)[XB_TMO])) break; if (_sp > XB_SPIN_CAP) { atomicAdd(&(bar)[XB_TMO], 1u); break; } } } } while (0)

struct XcdBarrier {
    unsigned* bar; unsigned x;
    volatile LAS unsigned* st;
};

__device__ __forceinline__ XcdBarrier xcd_barrier_post(unsigned* bar, volatile LAS unsigned* st) {
    XcdBarrier b; b.bar = bar; b.x = xb_xcc_id(); b.st = st;
    if (threadIdx.x == 0) (void)xb_add(&bar[XB_XCNT(b.x)], 1u);
    return b;
}
__device__ __forceinline__ void xcd_barrier_complete(unsigned* bar, unsigned x, unsigned& nloc, unsigned& nx) {
    const unsigned G = gridDim.x * gridDim.y * gridDim.z;
    unsigned sum, cnt, mine, sp = 0u;
    for (;;) {
        sum = 0u; cnt = 0u; mine = 0u;
#pragma unroll
        for (unsigned j = 0; j < 16; ++j) { const unsigned c = xb_ld(&bar[XB_XCNT(j)]); sum += c; cnt += (c > 0u) ? 1u : 0u; mine = (j == x) ? c : mine; }
        if (sum == G) break;
        __builtin_amdgcn_s_sleep(1);
        if ((++sp & 255u) == 0u) { if (xb_ld(&bar[XB_TMO])) break; if (sp > XB_SPIN_CAP) { atomicAdd(&bar[XB_TMO], 1u); break; } }
    }
    nloc = mine > 0u ? mine : 1u; nx = cnt > 0u ? cnt : 1u;
}

__device__ __forceinline__ void xcd_barrier(const XcdBarrier& b) {
    asm volatile("s_waitcnt vmcnt(0)" ::: "memory");
    __syncthreads();
    if (threadIdx.x == 0) {
        unsigned* bar = b.bar;
        __builtin_amdgcn_s_waitcnt(0);
        unsigned nloc = b.st[0], nx = b.st[1];
        if (nloc == 0u) { xcd_barrier_complete(bar, b.x, nloc, nx); b.st[0] = nloc; b.st[1] = nx; }
        const unsigned old = xb_add(&bar[XB_XSUB(b.x)], 1u);
        const unsigned gen = old / nloc;
        if (old + 1u == (gen + 1u) * nloc) {
            __builtin_amdgcn_fence(__ATOMIC_RELEASE, "agent");
            asm volatile("s_waitcnt vmcnt(0)" ::: "memory");
            const unsigned og = xb_add(&bar[XB_TOP], 1u);
            const unsigned tg = og / nx;
            if (og + 1u == (tg + 1u) * nx) xb_add(&bar[XB_TOPGEN], 1u);
            else XB_SPIN(xb_ld(&bar[XB_TOPGEN]) == tg, bar);
            __builtin_amdgcn_fence(__ATOMIC_ACQUIRE, "agent");
            xb_add(&bar[XB_XGEN(b.x)], 1u);
            asm volatile("s_waitcnt vmcnt(0)" ::: "memory");
        } else {
            XB_SPIN(xb_ld(&bar[XB_XGEN(b.x)]) == gen, bar);
            __builtin_amdgcn_fence(__ATOMIC_ACQUIRE, "agent");
            asm volatile("s_waitcnt vmcnt(0)" ::: "memory");
        }
    }
    __syncthreads();
}

constexpr int SLOTS = 11, NPH = 2 + 4 * SLOTS;
__host__ __device__ inline bool phase_active(int p) {
    if (p == 0 || p == NPH - 1) return true;
    const int i = (p - 1) / SLOTS, s = (p - 1) % SLOTS;
    if (s >= 8) return s == 8 || s == 10;
    return (i & 1) ? (s <= 5 || s == 7) : (s < 3);
}

__global__ void __launch_bounds__(512, 2) mk_fwd(Args a_) {
    extern __shared__ __attribute__((aligned(16))) unsigned char lds_raw[];
    int tid_ = threadIdx.x, bid_ = blockIdx.x, G_ = gridDim.x;
    volatile LAS unsigned* xst = (volatile LAS unsigned*)((LAS unsigned char*)lds_raw + 144000);
    if (tid_ < 2) xst[tid_] = 0u;
    __syncthreads();
    const XcdBarrier xbar = xcd_barrier_post((unsigned*)(a_.ws + WS_CTL), xst);
    CA a = (CA)__builtin_amdgcn_kernarg_segment_ptr();
    const int ph_lo = a_.ph_lo, ph_hi = a_.ph_hi;
    for (int p = ph_lo; p < ph_hi; ++p) {
        if (!phase_active(p)) continue;
        const int PL = (p - 1) / SLOTS, PS = (p - 1) % SLOTS; (void)PL; (void)PS;
        const int nrep = (MK_PROBE && p < NPH - 1 && (MK_PROBE_SEL)) ? 2 : 1;
        for (int rp = 0; rp < nrep; ++rp) {
        if (rp) cg::this_grid().sync();
        asm volatile("" : "+s"(a), "+s"(bid_), "+s"(G_)); asm volatile("" : "+v"(tid_));
        Ctx c; c.lds = (LAS unsigned char*)lds_raw; c.tid = tid_; c.lane = c.tid & 63; c.wave = __builtin_amdgcn_readfirstlane(c.tid >> 6); c.G = G_; c.bid = bid_;
        bf16_t* regA = (bf16_t*)(a->ws + WS_A);
        if (p == 0) phase_prologue(c, a);
        else if (p == NPH - 1) phase_final(c, a);
        else {
            const int layer = (p - 1) / SLOTS, s = (p - 1) % SLOTS, j = layer >> 1;
            unsigned char* wj = a->ws + WS_WSTAT + (size_t)j * WJ_STRIDE;
            float* ss_mix = (float*)(a->ws + WS_PA); float* ss_ffn = (float*)(a->ws + WS_PB); float* ss_next = ss_mix;
            if (s < 8 && !(layer & 1)) {
                if (s == 0) {
                    pg8::Gemm g{regA, (const bf16_t*)(wj + WJ_IN), M, 2048, D, D, 0}; pg8::StaticOrder S; S.init(M / 256, 2048, c.G, c.bid);
                    EpiSguIn E{(bf16_t*)(a->ws + P_U), (bf16_t*)(a->ws + P_SV), ss_mix, a->in[I_SBIN] + (size_t)j * 2048, (float*)(a->ws + WS_PV)};
                    pg8::gemm_phase<EpiSguIn, pg8::StaticOrder, 0, false, true>(c.lds, c.tid, g, S, E);
                } else if (s == 1) { phase_ffn_weights(c, a, layer); phase_sgu_spatial(c, a, j, rp); }
                else {
                    pg8::Gemm g{(const bf16_t*)(a->ws + P_U), (const bf16_t*)(wj + WJ_OUT), M, D, D, D, 0}; pg8::StaticOrder S; S.init(M / 256, D, c.G, c.bid);
                    EpiResid E{layer == 0 ? a->in[I_X] : (const float*)a->out, a->out, regA, ss_ffn};
                    pg8::gemm_phase<EpiResid, pg8::StaticOrder, 0, false, true>(c.lds, c.tid, g, S, E);
                }
            } else if (s < 8) {
                if (s == 0) { phase_rwkv_prep(c, a, layer, 0); phase_ffn_weights(c, a, layer); if (layer == 1) phase_static_weights(c, a, 1); }
                else if (s == 2) phase_rwkv_prep(c, a, layer, 1);
                else if (s == 1 || s == 3) {
                    { pg8::Gemm g{(const bf16_t*)(a->ws + P_LW), (const bf16_t*)(wj + WJ_RKV), M / 2, 3072, D, D, (size_t)(M / 2) * D * 2}; pg8::StaticOrder S; S.init(M / 512, 3072, c.G, c.bid);
                      EpiRkv E{(bf16_t*)(a->ws + P_R), (bf16_t*)(a->ws + P_WA), (bf16_t*)(a->ws + P_GL), s == 3 ? M / 2 : 0, 0};
                      pg8::gemm_phase<EpiRkv, pg8::StaticOrder, 3, false, true>(c.lds, c.tid, g, S, E); }
                    if (s == 1) {
                      asm volatile("" : "+s"(a), "+s"(c.bid), "+s"(c.G), "+s"(wj)); asm volatile("" : "+v"(c.tid));
                      pg8::Gemm g{(const bf16_t*)(a->ws + WS_A), (const bf16_t*)(wj + WJ_RKV + 6 * MiB), M, 512, 2048, D, 0}; pg8::StaticOrder S; S.init(M / 256, 512, c.G, c.bid);
                      EpiRkv E{(bf16_t*)(a->ws + P_R), (bf16_t*)(a->ws + P_WA), (bf16_t*)(a->ws + P_GL), 0, 12};
                      pg8::gemm_phase<EpiRkv, pg8::StaticOrder, 1, true, true>(c.lds, c.tid, g, S, E); }
                } else if (s == 4) {
                    { int kq = 128; asm volatile("" : "+s"(kq)); pg8::Gemm g{(const bf16_t*)(a->ws + P_WA), (const bf16_t*)(wj + WJ_L2WA), M, 2048, kq, kq, 0}; pg8::StaticOrder S; S.init(M / 256, 2048, c.G, c.bid);
                      EpiStore<false> E{(bf16_t*)(a->ws + P_LW), D, 2, (size_t)M * D, nullptr};
                      pg8::gemm_phase<EpiStore<false>, pg8::StaticOrder, 0, false, true>(c.lds, c.tid, g, S, E); }
                    asm volatile("" : "+s"(a), "+s"(c.bid), "+s"(c.G), "+s"(wj)); asm volatile("" : "+v"(c.tid));
                    { int kq = 256; asm volatile("" : "+s"(kq)); pg8::Gemm g{(const bf16_t*)(a->ws + P_GL), (const bf16_t*)(wj + WJ_L2G), M, D, kq, kq, 0}; pg8::StaticOrder S; S.init(M / 256, D, c.G, c.bid);
                      EpiStore<false> E{regA, D, 2, 0, nullptr};
                      pg8::gemm_phase<EpiStore<false>, pg8::StaticOrder, 0, false, true>(c.lds, c.tid, g, S, E); }
                } else if (s == 5) phase_scan(c, a, j, 0);
                else {
                    pg8::Gemm g{(const bf16_t*)(a->ws + P_R), (const bf16_t*)(wj + WJ_O), M, D, D, D, 0}; pg8::StaticOrder S; S.init(M / 256, D, c.G, c.bid);
                    EpiResid E{a->out, a->out, regA, ss_ffn};
                    pg8::gemm_phase<EpiResid, pg8::StaticOrder, 0, false, true>(c.lds, c.tid, g, S, E);
                }
            }
            else if (s == 8) {
                pg8::Gemm g{regA - 2 * D, (const bf16_t*)(a->ws + WS_WFFN), M, FF2, D, D, 0}; pg8::StaticOrder S; S.init(133, FF2, c.G, c.bid);
                EpiFfnUp E{(bf16_t*)(a->ws + P_ACT), ss_ffn, a->in[I_FCW] + (size_t)layer * 3 * FF2, a->in[I_FCB] + (size_t)layer * FF2};
                pg8::gemm_phase<EpiFfnUp, pg8::StaticOrder, 2, false, true>(c.lds, c.tid, g, S, E);
            }
            else {
                pg8::Gemm g{(const bf16_t*)(a->ws + P_ACT), (const bf16_t*)(a->ws + WS_WDOWN), M, D, FF, FF, 0}; pg8::StaticOrder S; S.init(M / 256, D, c.G, c.bid);
                EpiResid E{a->out, a->out, layer == 1 ? regA : (bf16_t*)nullptr, ss_next};
                pg8::gemm_phase<EpiResid, pg8::StaticOrder, 0, false, true>(c.lds, c.tid, g, S, E);
            }
        }
        }
        if (p + 1 < ph_hi) { if (p == 0) cg::this_grid().sync(); else xcd_barrier(xbar); }
    }
}

constexpr int LDS_BYTES = 147456;
#ifndef MK_ONE_LAUNCH
#define MK_ONE_LAUNCH 1
#endif
extern "C" void kernel_launch(void* const* d_in, const int* in_sizes, int n_in, void* d_out, int out_size, void* d_ws, size_t ws_size, hipStream_t stream) {
    static int grid = 0;
    if (grid == 0) {
        if (n_in != 32 || out_size != M * D || ws_size < WS_END) { fprintf(stderr, "kernel_launch: unexpected shapes (n_in %d out %d ws %zu, need %zu)\n", n_in, out_size, ws_size, (size_t)WS_END); grid = -1; return; }
        int dev = 0, cus = 0, per_cu = 0;
        (void)hipGetDevice(&dev); (void)hipDeviceGetAttribute(&cus, hipDeviceAttributeMultiprocessorCount, dev);
        if (hipFuncSetAttribute((const void*)mk_fwd, hipFuncAttributeMaxDynamicSharedMemorySize, LDS_BYTES) != hipSuccess) { fprintf(stderr, "kernel_launch: hipFuncSetAttribute failed\n"); grid = -1; return; }
        (void)hipOccupancyMaxActiveBlocksPerMultiprocessor(&per_cu, (const void*)mk_fwd, 512, LDS_BYTES);
        if (per_cu < 1) per_cu = 1;
        grid = cus * 1;
        (void)hipGetLastError();
    }
    if (grid < 0) return;
    if (hipMemsetAsync((char*)d_ws + WS_CTL, 0, CTL_BYTES, stream) != hipSuccess) { fprintf(stderr, "kernel_launch: memset failed\n"); return; }
    Args a{};
    for (int i = 0; i < 32; ++i) a.in[i] = (const float*)d_in[i];
    a.out = (float*)d_out; a.ws = (unsigned char*)d_ws;
#if MK_ONE_LAUNCH
    a.ph_lo = 0; a.ph_hi = NPH;
    void* args[] = {&a};
    hipError_t e = hipLaunchCooperativeKernel((const void*)mk_fwd, dim3(grid), dim3(512), args, LDS_BYTES, stream);
    if (e != hipSuccess) fprintf(stderr, "cooperative launch failed: %s (grid %d)\n", hipGetErrorString(e), grid);
#else
    for (int p = 0; p < NPH; ++p) { if (!phase_active(p)) continue; a.ph_lo = p; a.ph_hi = p + 1; hipLaunchKernelGGL(mk_fwd, dim3(grid), dim3(512), LDS_BYTES, stream, a); }
#endif
}
```

```cpp
#include <hip/hip_runtime.h>
#include <hip/hip_cooperative_groups.h>
#include <cstdio>
#include <cstdint>
#include <cmath>
namespace cg = cooperative_groups;
#ifndef MK_PROBE
#define MK_PROBE 0
#endif
#ifndef MK_PROBE_SEL
#define MK_PROBE_SEL 0
#endif
#ifndef MK_PROBE_MODE
#define MK_PROBE_MODE 1
#endif
namespace pg8 {
#define PG8_LAS __attribute__((address_space(3)))
typedef unsigned short bf16_t;
typedef short bf16x8 __attribute__((ext_vector_type(8)));
typedef float f32x4 __attribute__((ext_vector_type(4)));
typedef float f32x2 __attribute__((ext_vector_type(2)));
typedef unsigned u32x4 __attribute__((ext_vector_type(4)));
typedef unsigned u32x2 __attribute__((ext_vector_type(2)));
constexpr int BM = 256, BK = 64, HALF = 128, HTB = HALF * BK * 2  , STAGE_BYTES = 8 * HTB, NXCD = 8, WGM = 8;

__host__ __device__ __forceinline__ int lds_byte(int r, int c) { const int st = (r >> 4) * 2 + (c >> 5), rr = r & 15, cc = c & 31, ob = rr * 64 + cc * 2; return st * 1024 + (ob ^ (((ob >> 9) & 1) << 5)); }
__host__ __device__ __forceinline__ void stage_rc(int b, int& R, int& C) { const int st = b / 1024, sb = b % 1024, swz = sb ^ (((sb >> 9) & 1) << 5); R = (st >> 1) * 16 + swz / 64; C = (st & 1) * 32 + (swz % 64) / 2; }
__host__ __device__ __forceinline__ int perm32(int rho) { const int n = rho >> 4, i = rho & 15; return 8 * (i >> 2) + 4 * n + (i & 3); }

struct Unit { int pm, pn; };
struct Gemm { const bf16_t* A; const bf16_t* Bt; int M, N, K, lda; size_t astride; };

struct StaticOrder {
    int nM, nN, nwg, G, c;
    __host__ __device__ void init(int nM_, int N, int G_, int c_) { nM = nM_; nN = N / BM; nwg = nM * nN; G = G_; c = c_; }
    __host__ __device__ bool next(int i, Unit& u) const {
        const long L = (long)i * G + c; if (L >= nwg) return false;
        int wgid = (int)L; { const int q = nwg / NXCD, r = nwg % NXCD, xcd = wgid % NXCD, off = wgid / NXCD; wgid = (xcd < r ? xcd * (q + 1) : r * (q + 1) + (xcd - r) * q) + off; }
        const int nig = WGM * nN, gid = wgid / nig, fm = gid * WGM, gsz = (nM - fm) < WGM ? (nM - fm) : WGM;
        u.pm = fm + ((wgid % nig) % gsz); u.pn = (wgid % nig) / gsz; return true;
    }
};

__device__ __forceinline__ unsigned cvt_pk_bf16(float lo, float hi) { unsigned r; asm volatile("v_cvt_pk_bf16_f32 %0, %1, %2" : "=v"(r) : "v"(lo), "v"(hi)); return r; }
__device__ __forceinline__ f32x2 gelu_pk(f32x2 v) {
    const f32x2 av = __builtin_elementwise_abs(v), d = av * 0.2316418882f + 1.0f;
    f32x2 t; t.x = __builtin_amdgcn_rcpf(d.x); t.y = __builtin_amdgcn_rcpf(d.y);
    f32x2 q = t * 0.5307027145f + (-0.7265760135f); q = q * t + 0.7107068705f; q = q * t + (-0.142248368f); q = q * t + 0.127414796f; q = q * t;
    const f32x2 s = (v * v) * (-0.72134752044f);
    f32x2 e; e.x = __builtin_amdgcn_exp2f(s.x); e.y = __builtin_amdgcn_exp2f(s.y);
    const f32x2 m = v * (q * e), r = v - m;
    f32x2 o; o.x = v.x < 0.f ? m.x : r.x; o.y = v.y < 0.f ? m.y : r.y; return o;
}

template <class Epi, class Sched, int AMAP, bool KDBL, bool ALIGN_EPI>
__device__ __forceinline__ void gemm_phase(PG8_LAS unsigned char* lds, const int tid, const Gemm g, const Sched& S, const Epi& E) {
    const int wid = __builtin_amdgcn_readfirstlane(tid >> 6), lane = tid & 63, wr = wid >> 2, wc = wid & 3, fr = lane & 15, fq = lane >> 4;
    const int K = g.K, nt = K / BK, lda = g.lda;
    unsigned voffA[2], voffB[2];
#pragma unroll
    for (int i = 0; i < 2; ++i) { int R, C; stage_rc(tid * 16 + i * 8192, R, C); const int Rb = Epi::PERM ? ((R & ~31) + perm32(R & 31)) : R;
        const int Ra = (AMAP == 2) ? (R - 2 * (R >> 6)) : R;
        voffA[i] = (unsigned)(Ra * lda + C) * 2u; voffB[i] = (unsigned)(Rb * K + C) * 2u; }
    const size_t kstep = (size_t)(BK * 2);
    const size_t hstepA = (size_t)((AMAP == 2) ? 124 : HALF) * lda * 2;
    const size_t hstepB = (size_t)HALF * K * 2;
    const size_t tstepB = 2 * hstepB;
    const size_t rowA = (size_t)lda * 2;
    const unsigned ldsw = (unsigned)wid * 1024u;
    const int aoff = lds_byte(wr * 64 + fr, fq * 8), boff = lds_byte(wc * 32 + fr, fq * 8);
#define PG8_ABASE(pm, pn) ((const char*)g.A + (AMAP == 3 ? (size_t)((pn) >> 2) * g.astride + (size_t)(pm) * 256 * rowA : AMAP == 1 ? (size_t)(((pm) >> 4) * 4104 + 8 + ((pm) & 15) * 256) * rowA : (AMAP == 2 ? (size_t)(pm) * 248 * rowA : (size_t)(pm) * 256 * rowA)))
#define PG8_KA(base, t) (KDBL ? ((base) + (size_t)((t) & 15) * kstep - (size_t)((t) >> 4) * rowA) : ((base) + (size_t)(t) * kstep))
#define PG8_SA(b, h) (((b) * 2 + (h)) * HTB)
#define PG8_SB(b, h) ((4 + (b) * 2 + (h)) * HTB)
#define PG8_STAGE(bufoff, gbase, voff) do { _Pragma("unroll") for (int _i = 0; _i < 2; ++_i) \
        __builtin_amdgcn_global_load_lds((const unsigned*)((const char*)(gbase) + (voff)[_i]), (PG8_LAS unsigned*)(lds + (bufoff) + ldsw + _i * 8192), 16, 0, 0); } while (0)
#define PG8_LDA(dst, b, h) do { _Pragma("unroll") for (int m = 0; m < 4; ++m) _Pragma("unroll") for (int k = 0; k < 2; ++k) dst[m][k] = *(const PG8_LAS bf16x8*)(lds + PG8_SA(b, h) + aoff + m * 2048 + k * 1024); } while (0)
#define PG8_LDB(dst, b, h) do { _Pragma("unroll") for (int n = 0; n < 2; ++n) _Pragma("unroll") for (int k = 0; k < 2; ++k) dst[n][k] = *(const PG8_LAS bf16x8*)(lds + PG8_SB(b, h) + boff + n * 2048 + k * 1024); } while (0)
#define PG8_MMA(ai, bj, At, Bt) do { __builtin_amdgcn_s_setprio(1); _Pragma("unroll") for (int m = 0; m < 4; ++m) _Pragma("unroll") for (int n = 0; n < 2; ++n) _Pragma("unroll") for (int k = 0; k < 2; ++k) \
        acc[ai][bj][m][n] = __builtin_amdgcn_mfma_f32_16x16x32_bf16(Bt[n][k], At[m][k], acc[ai][bj][m][n], 0, 0, 0); __builtin_amdgcn_s_setprio(0); } while (0)
#define PG8_WAIT_V(n) asm volatile("s_waitcnt vmcnt(" #n ")" ::: "memory")
#define PG8_WAIT_L(n) asm volatile("s_waitcnt lgkmcnt(" #n ")" ::: "memory")
#define PG8_BAR __builtin_amdgcn_s_barrier()
#define PG8_SCHED __builtin_amdgcn_sched_barrier(0)
    Unit cur, nxt; int ui = 0;
    if (!S.next(0, cur)) return;
    f32x4 acc[2][2][4][2];
#pragma unroll
    for (int a = 0; a < 2; ++a)
#pragma unroll
        for (int b = 0; b < 2; ++b)
#pragma unroll
            for (int m = 0; m < 4; ++m)
#pragma unroll
                for (int n = 0; n < 2; ++n) acc[a][b][m][n] = (f32x4){0.f, 0.f, 0.f, 0.f};
    bf16x8 At[4][2], B0[2][2], B1[2][2];
    const char* cA = PG8_ABASE(cur.pm, cur.pn); const char* cB = (const char*)g.Bt + (size_t)cur.pn * tstepB;
    {
        const char* cA1 = PG8_KA(cA, 1);
        PG8_STAGE(PG8_SB(0, 0), cB, voffB); PG8_STAGE(PG8_SB(0, 1), cB + hstepB, voffB); PG8_STAGE(PG8_SA(0, 0), cA, voffA); PG8_STAGE(PG8_SA(0, 1), cA + hstepA, voffA);
        if (wr == 1) PG8_BAR;
        PG8_WAIT_V(2); PG8_BAR;
        PG8_STAGE(PG8_SB(1, 0), cB + kstep, voffB); PG8_STAGE(PG8_SA(1, 0), cA1, voffA); PG8_STAGE(PG8_SB(1, 1), cB + hstepB + kstep, voffB);
        PG8_WAIT_V(6); PG8_BAR;
    }
    for (;;) {
        const bool has_next = S.next(ui + 1, nxt);
        const char* nA = has_next ? PG8_ABASE(nxt.pm, nxt.pn) : cA; const char* nB = has_next ? (const char*)g.Bt + (size_t)nxt.pn * tstepB : cB;
        for (int t = 0; t < nt; t += 2) {
            const bool last = (t == nt - 2);
            const char* a1 = PG8_KA(cA, t + 1);
            const char* a2 = last ? nA : PG8_KA(cA, t + 2); const char* b2 = last ? nB : cB + (size_t)(t + 2) * kstep;
            const char* a3 = last ? PG8_KA(nA, 1) : PG8_KA(cA, t + 3); const char* b3 = b2 + kstep;
            PG8_LDB(B0, 0, 0); PG8_LDB(B1, 0, 1); PG8_SCHED; PG8_LDA(At, 0, 0); PG8_STAGE(PG8_SA(1, 1), a1 + hstepA, voffA);
            PG8_WAIT_V(8); PG8_WAIT_L(0); PG8_BAR; PG8_MMA(0, 0, At, B0); PG8_MMA(0, 1, At, B1); PG8_BAR; PG8_SCHED;
            PG8_LDA(At, 0, 1); PG8_STAGE(PG8_SB(0, 0), b2, voffB); PG8_STAGE(PG8_SB(0, 1), b2 + hstepB, voffB); PG8_STAGE(PG8_SA(0, 0), a2, voffA);
            PG8_WAIT_V(8); PG8_WAIT_L(0); PG8_BAR; PG8_MMA(1, 0, At, B0); PG8_MMA(1, 1, At, B1); PG8_BAR; PG8_SCHED;
            PG8_LDB(B0, 1, 0); PG8_LDB(B1, 1, 1); PG8_SCHED; PG8_LDA(At, 1, 0); PG8_STAGE(PG8_SA(0, 1), a2 + hstepA, voffA);
            PG8_WAIT_V(8); PG8_WAIT_L(0); PG8_BAR; PG8_MMA(0, 0, At, B0); PG8_MMA(0, 1, At, B1); PG8_BAR; PG8_SCHED;
            PG8_LDA(At, 1, 1); PG8_STAGE(PG8_SB(1, 0), b3, voffB); PG8_STAGE(PG8_SB(1, 1), b3 + hstepB, voffB); PG8_STAGE(PG8_SA(1, 0), a3, voffA);
            PG8_WAIT_V(8); PG8_WAIT_L(0); PG8_BAR; PG8_MMA(1, 0, At, B0); PG8_MMA(1, 1, At, B1); PG8_BAR; PG8_SCHED;
        }
        if constexpr (ALIGN_EPI) { if (wr == 0) PG8_BAR; }
        E(acc, cur, wr, wc, fr, fq);
        if (!has_next) break;
#pragma unroll
        for (int a = 0; a < 2; ++a)
#pragma unroll
            for (int b = 0; b < 2; ++b)
#pragma unroll
                for (int m = 0; m < 4; ++m)
#pragma unroll
                    for (int n = 0; n < 2; ++n) acc[a][b][m][n] = (f32x4){0.f, 0.f, 0.f, 0.f};
        cur = nxt; cA = nA; cB = nB; ++ui;
        if constexpr (ALIGN_EPI) { if (wr == 1) PG8_BAR; }
    }
    PG8_WAIT_V(0);
    if constexpr (!ALIGN_EPI) { if (wr == 0) PG8_BAR; }
    PG8_BAR;
#undef PG8_ABASE
#undef PG8_KA
#undef PG8_SA
#undef PG8_SB
#undef PG8_STAGE
#undef PG8_LDA
#undef PG8_LDB
#undef PG8_MMA
#undef PG8_WAIT_V
#undef PG8_WAIT_L
#undef PG8_BAR
#undef PG8_SCHED
}
}
using pg8::bf16_t; using pg8::f32x4; using pg8::f32x2; using pg8::u32x4; using pg8::u32x2; using pg8::Unit; using pg8::cvt_pk_bf16;
#define LAS __attribute__((address_space(3)))
constexpr int BATCH = 8, SEQ = 4096, D = 1024, M = BATCH * SEQ, FF = 2816, FF2 = 5632;
constexpr int PADR = 8, SEQP = SEQ + PADR;
constexpr float RMS_EPS = 1e-6f, GN_EPS = 64e-5f;
constexpr size_t MiB = 1u << 20;
constexpr size_t WS_CTL = 0, CTL_BYTES = 2048 * 1024, WS_XS = 1 * MiB;
constexpr size_t WS_WSTAT = 2 * MiB;
constexpr size_t WJ_IN = 0, WJ_OUT = 4 * MiB, WJ_RKV = 6 * MiB, WJ_L2WA = 20 * MiB, WJ_L2G = 20 * MiB + 512 * 1024, WJ_O = 21 * MiB, WJ_STRIDE = 23 * MiB;
constexpr size_t WS_WFFN = 48 * MiB;
constexpr size_t WS_WDOWN = WS_WFFN + 11 * MiB;
constexpr size_t WS_A = 67 * MiB;
constexpr size_t WS_P = 134 * MiB;
constexpr size_t P_R = WS_P, P_K = WS_P + 64 * MiB, P_V = WS_P + 128 * MiB, P_LW = WS_P + 192 * MiB, P_LA = WS_P + 256 * MiB, P_WA = WS_P + 320 * MiB, P_GL = WS_P + 328 * MiB;
constexpr size_t P_U = WS_P, P_SV = WS_P + 64 * MiB;
constexpr size_t P_Z = WS_P, P_ACT = WS_P + 176 * MiB;
constexpr size_t WS_PA = WS_P + 352 * MiB, WS_PB = WS_PA + 2 * MiB, WS_PV = WS_PB + 2 * MiB;
constexpr size_t WS_END = WS_PV + 2 * MiB;

struct Args {
    const float* in[32]; float* out; unsigned char* ws; int ph_lo, ph_hi;
};
enum { I_X = 0, I_NMIX, I_NFFN, I_NFIN, I_SWIN, I_SBIN, I_SGV, I_SWS, I_SBS, I_SWOUT, I_MU, I_WR, I_WK, I_WV, I_WO, I_W0, I_W1, I_W2, I_A0, I_A1, I_A2, I_G1, I_G2, I_KK, I_KA, I_RK, I_LNW, I_LNB, I_FUP, I_FCW, I_FCB, I_FDN };

__device__ __forceinline__ float bf2f(unsigned short b) { return __uint_as_float((unsigned)b << 16); }
__device__ __forceinline__ float bflo(unsigned w) { return __uint_as_float(w << 16); }
__device__ __forceinline__ float bfhi(unsigned w) { return __uint_as_float(w & 0xffff0000u); }
__device__ __forceinline__ float wave_sum(float v) {
#pragma unroll
    for (int o = 1; o < 64; o <<= 1) v += __shfl_xor(v, o);
    return v;
}
__device__ __forceinline__ float row_rstd(const float* P, int row) { const f32x4* p = (const f32x4*)(P + (size_t)row * 16); const f32x4 a = p[0], b = p[1], c = p[2], d = p[3];
    const float s = ((a.x + a.y) + (a.z + a.w)) + ((b.x + b.y) + (b.z + b.w)) + ((c.x + c.y) + (c.z + c.w)) + ((d.x + d.y) + (d.z + d.w)); return rsqrtf(s * (1.f / D) + RMS_EPS); }
__device__ __forceinline__ void row_rstd4(const float* P, int row0, int rstride, int lo, int hi, float (&rs)[4]) {
    f32x4 p[4][4];
#pragma unroll
    for (int m = 0; m < 4; ++m) { int r = row0 + m * rstride; r = r < lo ? lo : (r > hi ? hi : r); const f32x4* q = (const f32x4*)(P + (size_t)r * 16);
#pragma unroll
        for (int k = 0; k < 4; ++k) p[m][k] = q[k]; }
#pragma unroll
    for (int m = 0; m < 4; ++m) { const f32x4 a = p[m][0], b = p[m][1], c = p[m][2], d = p[m][3];
        const float s = ((a.x + a.y) + (a.z + a.w)) + ((b.x + b.y) + (b.z + b.w)) + ((c.x + c.y) + (c.z + c.w)) + ((d.x + d.y) + (d.z + d.w)); rs[m] = rsqrtf(s * (1.f / D) + RMS_EPS); }
}
template <int CTRL> __device__ __forceinline__ float dpp_f(float v) { return __int_as_float(__builtin_amdgcn_mov_dpp(__float_as_int(v), CTRL, 0xf, 0xf, true)); }
__device__ __forceinline__ float sum8(float v) { v += dpp_f<0x141>(v); v += dpp_f<0xB1>(v); v += dpp_f<0x4E>(v); return v; }
__device__ __forceinline__ float sigmoidf_(float x) { return 1.f / (1.f + __expf(-x)); }

template <bool SCALE> struct EpiStore {
    static constexpr bool PERM = true;
    bf16_t* O; int ldc; int tsh; size_t split_stride; const float* ss;
    __device__ __forceinline__ void operator()(const f32x4 (&acc)[2][2][4][2], const Unit& u, int wr, int wc, int fr, int fq) const {
        bf16_t* base = O + (size_t)(u.pn >> tsh) * split_stride + (size_t)(u.pm * 256 + wr * 64 + fr) * ldc + (u.pn & ((1 << tsh) - 1)) * 256 + wc * 32 + 8 * fq;
        const int row0 = u.pm * 256 + wr * 64 + fr;
#pragma unroll
        for (int ai = 0; ai < 2; ++ai)
#pragma unroll
            for (int m = 0; m < 4; ++m) {
                const float rs = SCALE ? row_rstd(ss, row0 + ai * 128 + m * 16) : 1.f;
                bf16_t* rowp = base + (size_t)(ai * 128 + m * 16) * ldc;
#pragma unroll
                for (int bj = 0; bj < 2; ++bj) { const f32x4 v0 = acc[ai][bj][m][0] * rs, v1 = acc[ai][bj][m][1] * rs;
                    u32x4 w; w.x = cvt_pk_bf16(v0[0], v0[1]); w.y = cvt_pk_bf16(v0[2], v0[3]); w.z = cvt_pk_bf16(v1[0], v1[1]); w.w = cvt_pk_bf16(v1[2], v1[3]);
                    *(u32x4*)(rowp + bj * 128) = w; } }
    }
};
struct EpiSguIn {
    static constexpr bool PERM = true;
    bf16_t* U; bf16_t* V; const float* ss; const float* bias; float* ssv;
    __device__ __forceinline__ void operator()(const f32x4 (&acc)[2][2][4][2], const Unit& u, int wr, int wc, int fr, int fq) const {
        const bool isv = u.pn >= 4; bf16_t* base = isv ? V : U; const int colt = (u.pn & 3) * 256 + wc * 32 + 8 * fq, bcol = u.pn * 256 + wc * 32 + 8 * fq;
        f32x4 bv[2][2];
#pragma unroll
        for (int bj = 0; bj < 2; ++bj)
#pragma unroll
            for (int n = 0; n < 2; ++n) bv[bj][n] = *(const f32x4*)(bias + bcol + bj * 128 + 4 * n);
#pragma unroll
        for (int ai = 0; ai < 2; ++ai) {
            float rs4[4]; row_rstd4(ss, u.pm * 256 + ai * 128 + wr * 64 + fr, 16, 0, M - 1, rs4);
#pragma unroll
            for (int m = 0; m < 4; ++m) { const int row = u.pm * 256 + ai * 128 + wr * 64 + m * 16 + fr;
                const float rs = rs4[m]; float s = 0.f;
                bf16_t* rowp = base + (size_t)row * D + colt;
#pragma unroll
                for (int bj = 0; bj < 2; ++bj) { f32x4 v0 = acc[ai][bj][m][0] * rs + bv[bj][0], v1 = acc[ai][bj][m][1] * rs + bv[bj][1];
                    const f32x2 a = pg8::gelu_pk((f32x2){v0[0], v0[1]}), b = pg8::gelu_pk((f32x2){v0[2], v0[3]}), c = pg8::gelu_pk((f32x2){v1[0], v1[1]}), d = pg8::gelu_pk((f32x2){v1[2], v1[3]});
                    s += (a.x * a.x + a.y * a.y) + (b.x * b.x + b.y * b.y) + (c.x * c.x + c.y * c.y) + (d.x * d.x + d.y * d.y);
                    u32x4 w; w.x = cvt_pk_bf16(a.x, a.y); w.y = cvt_pk_bf16(b.x, b.y); w.z = cvt_pk_bf16(c.x, c.y); w.w = cvt_pk_bf16(d.x, d.y);
                    *(u32x4*)(rowp + bj * 128) = w; }
                if (isv) { s += __shfl_xor(s, 16); s += __shfl_xor(s, 32); if (fq == 0) ssv[(size_t)row * 16 + (u.pn - 4) * 4 + wc] = s; } } }
    }
};
struct EpiResid {
    static constexpr bool PERM = true;
    const float* hin; float* h; bf16_t* hb; float* ssn;
    __device__ __forceinline__ void operator()(const f32x4 (&acc)[2][2][4][2], const Unit& u, int wr, int wc, int fr, int fq) const {
        const int colt = u.pn * 256 + wc * 32 + 8 * fq;
#pragma unroll
        for (int ai = 0; ai < 2; ++ai) {
            const int rowb = u.pm * 256 + ai * 128 + wr * 64 + fr;
            f32x4 pre[4][2][2];
#pragma unroll
            for (int m = 0; m < 4; ++m)
#pragma unroll
                for (int bj = 0; bj < 2; ++bj) { const float* hp = hin + (size_t)(rowb + m * 16) * D + colt + bj * 128; pre[m][bj][0] = *(const f32x4*)hp; pre[m][bj][1] = *(const f32x4*)(hp + 4); }
#pragma unroll
            for (int m = 0; m < 4; ++m) { const int row = rowb + m * 16; float s = 0.f;
                float* hp = h + (size_t)row * D + colt; bf16_t* bp = hb + (size_t)row * D + colt;
#pragma unroll
                for (int bj = 0; bj < 2; ++bj) { const f32x4 v0 = pre[m][bj][0] + acc[ai][bj][m][0], v1 = pre[m][bj][1] + acc[ai][bj][m][1];
                    *(f32x4*)(hp + bj * 128) = v0; *(f32x4*)(hp + bj * 128 + 4) = v1;
                    s += (v0[0] * v0[0] + v0[1] * v0[1]) + (v0[2] * v0[2] + v0[3] * v0[3]) + (v1[0] * v1[0] + v1[1] * v1[1]) + (v1[2] * v1[2] + v1[3] * v1[3]);
                    if (hb) { u32x4 w; w.x = cvt_pk_bf16(v0[0], v0[1]); w.y = cvt_pk_bf16(v0[2], v0[3]); w.z = cvt_pk_bf16(v1[0], v1[1]); w.w = cvt_pk_bf16(v1[2], v1[3]);
                    *(u32x4*)(bp + bj * 128) = w; } }
                s += __shfl_xor(s, 16); s += __shfl_xor(s, 32); if (fq == 0) ssn[(size_t)row * 16 + u.pn * 4 + wc] = s; }
            asm volatile("" ::: "memory");
        }
    }
};
template <int CTRL> __device__ __forceinline__ f32x4 dpp4(f32x4 v) { f32x4 r; r.x = dpp_f<CTRL>(v.x); r.y = dpp_f<CTRL>(v.y); r.z = dpp_f<CTRL>(v.z); r.w = dpp_f<CTRL>(v.w); return r; }
struct EpiFfnUp {
    static constexpr bool PERM = true;
    bf16_t* ACT; const float* ss; const float* cw; const float* cb;
    template <bool MASK> __device__ __forceinline__ void conv4(f32x4& z0, f32x4& z1, f32x4& z2, f32x4& z3, const float (&rs)[4], const int (&tt)[4], const f32x4 w0, const f32x4 w1, const f32x4 w2, const f32x4 bb, int fr) const {
#pragma unroll
        for (int e = 0; e < 4; e += 2) {
            const f32x2 w0p = {w0[e], w0[e + 1]}, w1p = {w1[e], w1[e + 1]}, w2p = {w2[e], w2[e + 1]}, bp = {bb[e], bb[e + 1]};
            f32x2 cur = (f32x2){z3[e], z3[e + 1]} * rs[3];
            f32x2 c1 = {dpp_f<0x121>(cur.x), dpp_f<0x121>(cur.y)}, c2 = {dpp_f<0x122>(cur.x), dpp_f<0x122>(cur.y)};
#define CONV_STEP(ZM, ZP, MI, HASP) { f32x2 prv = cur, p1 = c1, p2 = c2; if (HASP) { prv = (f32x2){ZP[e], ZP[e + 1]} * rs[MI - (HASP)]; p1 = (f32x2){dpp_f<0x121>(prv.x), dpp_f<0x121>(prv.y)}; p2 = (f32x2){dpp_f<0x122>(prv.x), dpp_f<0x122>(prv.y)}; } \
            f32x2 y1 = (fr == 0) ? p1 : c1, y2 = (fr < 2) ? p2 : c2; if (MASK) { if (tt[MI] < 1) y1 = (f32x2){0.f, 0.f}; if (tt[MI] < 2) y2 = (f32x2){0.f, 0.f}; } \
            const f32x2 o = w0p * y2 + (w1p * y1 + (w2p * cur + bp)); ZM[e] = o.x; ZM[e + 1] = o.y; cur = prv; c1 = p1; c2 = p2; }
            CONV_STEP(z3, z2, 3, 1) CONV_STEP(z2, z1, 2, 1) CONV_STEP(z1, z0, 1, 1) CONV_STEP(z0, z0, 0, 0)
#undef CONV_STEP
            asm volatile("" : "+v"(z0[e]), "+v"(z1[e]), "+v"(z2[e]), "+v"(z3[e]), "+v"(z0[e + 1]), "+v"(z1[e + 1]), "+v"(z2[e + 1]), "+v"(z3[e + 1]));
        }
    }
    __device__ __forceinline__ void operator()(f32x4 (&acc)[2][2][4][2], const Unit& u, int wr, int wc, int fr, int fq) const {
        const int f0 = u.pn * 128 + wc * 32 + 8 * fq;
        float rs[2][4];
#pragma unroll
        for (int ai = 0; ai < 2; ++ai) { row_rstd4(ss, u.pm * 248 - 2 + 62 * (2 * ai + wr) + fr, 16, 0, M - 1, rs[ai]); asm volatile("" : "+v"(rs[ai][0]), "+v"(rs[ai][1]), "+v"(rs[ai][2]), "+v"(rs[ai][3]) :: "memory"); }
#pragma unroll
        for (int n = 0; n < 2; ++n) {
#pragma unroll
            for (int bj = 0; bj < 2; ++bj) {
                const float* wp = cw + bj * FF + f0 + 4 * n;
                const f32x4 w0 = *(const f32x4*)wp, w1 = *(const f32x4*)(wp + FF2), w2 = *(const f32x4*)(wp + 2 * FF2), wb = *(const f32x4*)(cb + bj * FF + f0 + 4 * n);
#pragma unroll
                for (int ai = 0; ai < 2; ++ai) {
                    const int g0r = u.pm * 248 - 2 + 62 * (2 * ai + wr);
                    const bool seqstart = ((g0r + 63) & (SEQ - 1)) < 65 || g0r < 0;
                    int tt[4];
#pragma unroll
                    for (int m = 0; m < 4; ++m) tt[m] = (g0r + fr + 16 * m) & (SEQ - 1);
                    if (seqstart) conv4<true>(acc[ai][bj][0][n], acc[ai][bj][1][n], acc[ai][bj][2][n], acc[ai][bj][3][n], rs[ai], tt, w0, w1, w2, wb, fr);
                    else conv4<false>(acc[ai][bj][0][n], acc[ai][bj][1][n], acc[ai][bj][2][n], acc[ai][bj][3][n], rs[ai], tt, w0, w1, w2, wb, fr);
                }
                asm volatile("" ::: "memory");
            }
#pragma unroll
            for (int ai = 0; ai < 2; ++ai) { const int gbase = u.pm * 248 - 2 + 62 * (2 * ai + wr) + fr;
#pragma unroll
                for (int m = 0; m < 4; ++m) { const int g = gbase + 16 * m;
                    if ((m > 0 || fr >= 2) && g < M) { const f32x4 gt = acc[ai][0][m][n], vl = acc[ai][1][m][n]; f32x4 o;
#pragma unroll
                        for (int e = 0; e < 4; ++e) o[e] = gt[e] * sigmoidf_(gt[e]) * vl[e];
                        u32x2 w; w.x = cvt_pk_bf16(o[0], o[1]); w.y = cvt_pk_bf16(o[2], o[3]);
                        *(u32x2*)(ACT + (size_t)g * FF + f0 + 4 * n) = w; } } }
        }
    }
};
struct EpiRkv {
    static constexpr bool PERM = true;
    bf16_t* R; bf16_t* WA; bf16_t* GL; int row_off, pn_off;
    __device__ __forceinline__ void operator()(const f32x4 (&acc)[2][2][4][2], const Unit& u, int wr, int wc, int fr, int fq) const {
        const int pne = u.pn + pn_off; const int mode = pne < 12 ? 0 : (pne == 12 ? 1 : 2);
        bf16_t* base; int ldc, colt;
        if (mode == 0) { base = R + (size_t)(pne >> 2) * ((size_t)M * D); ldc = D; colt = (pne & 3) * 256 + wc * 32 + 8 * fq; }
        else if (mode == 1) { base = WA; ldc = 128; colt = wc * 32 + 8 * fq; }
        else { base = GL; ldc = 256; colt = wc * 32 + 8 * fq; }
#pragma unroll
        for (int ai = 0; ai < 2; ++ai)
#pragma unroll
            for (int m = 0; m < 4; ++m) { const int row = row_off + u.pm * 256 + ai * 128 + wr * 64 + m * 16 + fr;
                bf16_t* rowp = base + (size_t)row * ldc + colt;
#pragma unroll
                for (int bj = 0; bj < 2; ++bj) { f32x4 v0 = acc[ai][bj][m][0], v1 = acc[ai][bj][m][1];
                    if (mode == 1) { if (bj == 1) continue;
                        if (wc < 2) {
#pragma unroll
                            for (int e = 0; e < 4; ++e) { v0[e] = tanhf(v0[e]); v1[e] = tanhf(v1[e]); } } }
                    else if (mode == 2) {
#pragma unroll
                        for (int e = 0; e < 4; ++e) { v0[e] = sigmoidf_(v0[e]); v1[e] = sigmoidf_(v1[e]); } }
                    u32x4 w; w.x = cvt_pk_bf16(v0[0], v0[1]); w.y = cvt_pk_bf16(v0[2], v0[3]); w.z = cvt_pk_bf16(v1[0], v1[1]); w.w = cvt_pk_bf16(v1[2], v1[3]);
                    *(u32x4*)(rowp + bj * 128) = w; } }
    }
};

typedef const __attribute__((address_space(4))) Args* CA;
struct Ctx { LAS unsigned char* lds; int tid, lane, wave, G, bid; };

__device__ __forceinline__ void conv_mat(const Ctx& c, const float* src, int ldsrc, int K, int N, int Kp, int Np, bf16_t* dst, int ldd, int n_off, int k_off, const float* sc, int mode, int rot) {
    LAS float* tile = (LAS float*)c.lds;
    const int nnb = Np / 64, nit = (Kp / 64) * nnb; const int start = (c.bid + c.G - (rot % c.G)) % c.G;
    for (int it = start; it < nit; it += c.G) {
        const int kb = it / nnb, nb = it % nnb, k0 = kb * 64, n0 = nb * 64;
#pragma unroll
        for (int j = 0; j < 2; ++j) { const int kk = (c.tid >> 4) + 32 * j, nn = (c.tid & 15) * 4, k = k0 + kk, n = n0 + nn; f32x4 v = (f32x4){0.f, 0.f, 0.f, 0.f};
            if (src && k < K && n < N) { v = *(const f32x4*)(src + (size_t)k * ldsrc + n); if (mode == 1) v = v * sc[k]; else if (mode == 2) v = v * (1.f - sc[k]); }
            tile[nn * 65 + kk] = v.x; tile[(nn + 1) * 65 + kk] = v.y; tile[(nn + 2) * 65 + kk] = v.z; tile[(nn + 3) * 65 + kk] = v.w; }
        __syncthreads();
        { const int nn = c.tid >> 3, cc = c.tid & 7; const LAS float* s = tile + nn * 65 + 8 * cc;
            u32x4 o; o.x = cvt_pk_bf16(s[0], s[1]); o.y = cvt_pk_bf16(s[2], s[3]); o.z = cvt_pk_bf16(s[4], s[5]); o.w = cvt_pk_bf16(s[6], s[7]);
            *(u32x4*)(dst + (size_t)(n_off + n0 + nn) * ldd + k_off + k0 + 8 * cc) = o; }
        __syncthreads();
    }
}

__device__ __forceinline__ void phase_static_weights(const Ctx& c, CA a, int j);
__device__ __forceinline__ void phase_prologue(const Ctx& c, CA a) {
    float* ss = (float*)(a->ws + WS_PA);
    const int gw = c.bid * 8 + c.wave, NGW = c.G * 8;
    bf16_t* hb = (bf16_t*)(a->ws + WS_A);
    for (int m = gw; m < M; m += NGW) {
        const f32x4* xr = (const f32x4*)(a->in[I_X] + (size_t)m * D) + c.lane; u32x2* br = (u32x2*)(hb + (size_t)m * D) + c.lane;
        float s = 0.f;
#pragma unroll
        for (int j = 0; j < 4; ++j) { const f32x4 v = xr[64 * j]; s += (v.x * v.x + v.y * v.y) + (v.z * v.z + v.w * v.w); u32x2 w; w.x = cvt_pk_bf16(v.x, v.y); w.y = cvt_pk_bf16(v.z, v.w); br[64 * j] = w; }
        s = wave_sum(s); if (c.lane < 16) ss[(size_t)m * 16 + c.lane] = c.lane == 0 ? s : 0.f;
    }
    phase_static_weights(c, a, 0);
}
__device__ __forceinline__ void phase_static_weights(const Ctx& c, CA a, int j) {
    int rot = 0;
    {
        unsigned char* wj = a->ws + WS_WSTAT + (size_t)j * WJ_STRIDE;
        conv_mat(c, a->in[I_SWIN] + (size_t)j * D * 2048, 2048, D, 2048, D, 2048, (bf16_t*)(wj + WJ_IN), D, 0, 0, a->in[I_NMIX] + (size_t)(2 * j) * D, 1, rot); rot += 512;
        conv_mat(c, a->in[I_SWOUT] + (size_t)j * D * D, D, D, D, D, D, (bf16_t*)(wj + WJ_OUT), D, 0, 0, nullptr, 0, rot); rot += 256;
        const float* mu = a->in[I_MU] + (size_t)j * 6 * D; bf16_t* rkv3 = (bf16_t*)(wj + WJ_RKV); bf16_t* rkv = (bf16_t*)(wj + WJ_RKV + 6 * MiB) - (size_t)3072 * 2048;
#define CONV_BIG(IDX, Q, MUB) do { conv_mat(c, a->in[IDX] + (size_t)j * D * D, D, D, D, D, D, rkv3, 1024, (Q) * 1024, 0, nullptr, 0, rot); rot += 256; } while (0)
        CONV_BIG(I_WR, 0, 0); CONV_BIG(I_WK, 1, 2); CONV_BIG(I_WV, 2, 3);
#undef CONV_BIG
        conv_mat(c, a->in[I_W1] + (size_t)j * D * 64, 64, D, 64, D, 64, rkv, 2048, 3072, 0, mu + 1 * D, 2, rot); rot += 16;
        conv_mat(c, a->in[I_W1] + (size_t)j * D * 64, 64, D, 64, D, 64, rkv, 2048, 3072, 1024, mu + 1 * D, 1, rot); rot += 16;
        conv_mat(c, a->in[I_A1] + (size_t)j * D * 64, 64, D, 64, D, 64, rkv, 2048, 3136, 0, mu + 4 * D, 2, rot); rot += 16;
        conv_mat(c, a->in[I_A1] + (size_t)j * D * 64, 64, D, 64, D, 64, rkv, 2048, 3136, 1024, mu + 4 * D, 1, rot); rot += 16;
        conv_mat(c, nullptr, 0, 0, 0, 2048, 128, rkv, 2048, 3200, 0, nullptr, 0, rot); rot += 64;
        conv_mat(c, a->in[I_G1] + (size_t)j * D * 160, 160, D, 160, D, 256, rkv, 2048, 3328, 0, mu + 5 * D, 2, rot); rot += 64;
        conv_mat(c, a->in[I_G1] + (size_t)j * D * 160, 160, D, 160, D, 256, rkv, 2048, 3328, 1024, mu + 5 * D, 1, rot); rot += 64;
        bf16_t* l2wa = (bf16_t*)(wj + WJ_L2WA);
        conv_mat(c, a->in[I_W2] + (size_t)j * 64 * D, D, 64, D, 64, D, l2wa, 128, 0, 0, nullptr, 0, rot); rot += 16;
        conv_mat(c, nullptr, 0, 0, 0, 64, D, l2wa, 128, 0, 64, nullptr, 0, rot); rot += 16;
        conv_mat(c, nullptr, 0, 0, 0, 64, D, l2wa, 128, 1024, 0, nullptr, 0, rot); rot += 16;
        conv_mat(c, a->in[I_A2] + (size_t)j * 64 * D, D, 64, D, 64, D, l2wa, 128, 1024, 64, nullptr, 0, rot); rot += 16;
        conv_mat(c, a->in[I_G2] + (size_t)j * 160 * D, D, 160, D, 256, D, (bf16_t*)(wj + WJ_L2G), 256, 0, 0, nullptr, 0, rot); rot += 64;
        conv_mat(c, a->in[I_WO] + (size_t)j * D * D, D, D, D, D, D, (bf16_t*)(wj + WJ_O), D, 0, 0, nullptr, 0, rot); rot += 256;
    }
}
__device__ __forceinline__ void phase_ffn_weights(const Ctx& c, CA a, int layer) {
    for (int pn = 0; pn < FF / 128; ++pn) {
        conv_mat(c, a->in[I_FUP] + (size_t)layer * D * FF2 + pn * 128, FF2, D, 128, D, 128, (bf16_t*)(a->ws + WS_WFFN), D, pn * 256, 0, a->in[I_NFFN] + (size_t)layer * D, 1, pn * 64);
        conv_mat(c, a->in[I_FUP] + (size_t)layer * D * FF2 + FF + pn * 128, FF2, D, 128, D, 128, (bf16_t*)(a->ws + WS_WFFN), D, pn * 256 + 128, 0, a->in[I_NFFN] + (size_t)layer * D, 1, pn * 64 + 32);
    }
    conv_mat(c, a->in[I_FDN] + (size_t)layer * FF * D, D, FF, D, FF, D, (bf16_t*)(a->ws + WS_WDOWN), FF, 0, 0, nullptr, 0, 128);
}

__device__ __forceinline__ void phase_sgu_spatial(const Ctx& c, CA a, int j, int rp) {
    typedef short bf16x8 __attribute__((ext_vector_type(8)));
    bf16_t* U = (bf16_t*)(a->ws + P_U); const bf16_t* V = (const bf16_t*)(a->ws + P_SV); bf16_t* UO = rp ? (bf16_t*)(a->ws + P_SV) : U;
    const float* ssv = (const float*)(a->ws + WS_PV);
    LAS bf16_t* WL = (LAS bf16_t*)c.lds; LAS bf16_t* VT = WL + 128 * 136;
    const int g = c.bid & 15;
    const float* Ws = a->in[I_SWS] + ((size_t)j * 16 + g) * 128 * 128; const float* bs = a->in[I_SBS] + ((size_t)j * 16 + g) * 128; const float* gv = a->in[I_SGV] + (size_t)j * D + g * 64;
    __syncthreads();
    { const int t = c.tid >> 2, s0 = (c.tid & 3) * 32; const float* wp = Ws + (size_t)t * 128 + s0;
#pragma unroll
      for (int q = 0; q < 4; ++q) { f32x4 x0 = *(const f32x4*)(wp + 8 * q), x1 = *(const f32x4*)(wp + 8 * q + 4);
#pragma unroll
          for (int e = 0; e < 4; ++e) { if (s0 + 8 * q + e > t) x0[e] = 0.f; if (s0 + 8 * q + 4 + e > t) x1[e] = 0.f; }
          u32x4 w; w.x = cvt_pk_bf16(x0[0], x0[1]); w.y = cvt_pk_bf16(x0[2], x0[3]); w.z = cvt_pk_bf16(x1[0], x1[1]); w.w = cvt_pk_bf16(x1[2], x1[3]);
          *(LAS u32x4*)(WL + t * 136 + s0 + 8 * q) = w; } }
    const int w8 = c.wave, fr = c.lane & 15, fq = c.lane >> 4, t0 = 16 * w8, nk = (w8 >> 1) + 1;
    const int vs = c.tid >> 2, vc = (c.tid & 3) * 16;
    f32x4 gq[4];
#pragma unroll
    for (int e = 0; e < 4; ++e) gq[e] = *(const f32x4*)(gv + vc + 4 * e);
    const float bb = bs[t0 + fr];
    for (int ub = c.bid >> 4; ub < M / 128; ub += c.G >> 4) {
        const int m0 = ub * 128;
        { const bf16_t* vp = V + (size_t)(m0 + vs) * D + g * 64 + vc; const u32x4 v0 = *(const u32x4*)vp, v1 = *(const u32x4*)(vp + 8);
          const float rs = row_rstd(ssv, m0 + vs);
          const unsigned vw[8] = {v0.x, v0.y, v0.z, v0.w, v1.x, v1.y, v1.z, v1.w};
#pragma unroll
          for (int e = 0; e < 8; ++e) { const float lo = bflo(vw[e]) * rs * gq[e >> 1][(2 * e) & 3], hi = bfhi(vw[e]) * rs * gq[e >> 1][(2 * e + 1) & 3];
              const unsigned pk = cvt_pk_bf16(lo, hi);
              VT[(vc + 2 * e) * 136 + vs] = (bf16_t)(pk & 0xffffu); VT[(vc + 2 * e + 1) * 136 + vs] = (bf16_t)(pk >> 16); } }
        __syncthreads();
        f32x4 acc[4];
#pragma unroll
        for (int ct = 0; ct < 4; ++ct) acc[ct] = (f32x4){0.f, 0.f, 0.f, 0.f};
        for (int k = 0; k < nk; ++k) {
            const bf16x8 wf = *(const LAS bf16x8*)(WL + (t0 + fr) * 136 + 32 * k + 8 * fq);
#pragma unroll
            for (int ct = 0; ct < 4; ++ct) { const bf16x8 vf = *(const LAS bf16x8*)(VT + (16 * ct + fr) * 136 + 32 * k + 8 * fq);
                acc[ct] = __builtin_amdgcn_mfma_f32_16x16x32_bf16(vf, wf, acc[ct], 0, 0, 0); }
        }
        { const size_t ro = (size_t)(m0 + t0 + fr) * D + g * 64 + 4 * fq;
#pragma unroll
          for (int ct = 0; ct < 4; ++ct) { const u32x2 uu = *(const u32x2*)(U + ro + 16 * ct); const f32x4 o = acc[ct] + bb;
              u32x2 w; w.x = cvt_pk_bf16(bflo(uu.x) * o[0], bfhi(uu.x) * o[1]); w.y = cvt_pk_bf16(bflo(uu.y) * o[2], bfhi(uu.y) * o[3]);
              *(u32x2*)(UO + ro + 16 * ct) = w; } }
        __syncthreads();
    }
}

__device__ __forceinline__ void phase_ffn_conv(const Ctx& c, CA a, int layer, int half) {
    const bf16_t* Z = (const bf16_t*)(a->ws + P_Z); bf16_t* ACT = (bf16_t*)(a->ws + P_ACT) + (size_t)half * (M / 2) * FF;
    const float* cw = a->in[I_FCW] + (size_t)layer * 3 * FF2; const float* cb = a->in[I_FCB] + (size_t)layer * FF2;
    const int gt = c.bid * 512 + c.tid, NT = c.G * 512;
    for (int idx = gt; idx < (M / 2) * (FF / 8); idx += NT) {
        const int ml = idx / (FF / 8), f = (idx % (FF / 8)) * 8, t = ml & (SEQ - 1);
        float gsum[8], vsum[8];
#pragma unroll
        for (int e = 0; e < 8; ++e) { gsum[e] = cb[f + e]; vsum[e] = cb[FF + f + e]; }
#pragma unroll
        for (int jj = 0; jj < 3; ++jj) { const int dt = 2 - jj; if (t - dt < 0) continue;
            const u32x4 zg = *(const u32x4*)(Z + (size_t)(ml - dt) * FF2 + f), zv = *(const u32x4*)(Z + (size_t)(ml - dt) * FF2 + FF + f);
            const float* wg = cw + (size_t)jj * FF2 + f; const float* wv = wg + FF;
            const unsigned zgw[4] = {zg.x, zg.y, zg.z, zg.w}, zvw[4] = {zv.x, zv.y, zv.z, zv.w};
#pragma unroll
            for (int e = 0; e < 4; ++e) { gsum[2 * e] += wg[2 * e] * bflo(zgw[e]); gsum[2 * e + 1] += wg[2 * e + 1] * bfhi(zgw[e]); vsum[2 * e] += wv[2 * e] * bflo(zvw[e]); vsum[2 * e + 1] += wv[2 * e + 1] * bfhi(zvw[e]); } }
        float o[8];
#pragma unroll
        for (int e = 0; e < 8; ++e) o[e] = gsum[e] * sigmoidf_(gsum[e]) * vsum[e];
        u32x4 w; w.x = cvt_pk_bf16(o[0], o[1]); w.y = cvt_pk_bf16(o[2], o[3]); w.z = cvt_pk_bf16(o[4], o[5]); w.w = cvt_pk_bf16(o[6], o[7]);
        *(u32x4*)(ACT + (size_t)ml * FF + f) = w;
    }
}

__device__ __forceinline__ void phase_rwkv_prep(const Ctx& c, CA a, int layer, int mode) {
    const float* ss = (const float*)(a->ws + WS_PA); const float* g = a->in[I_NMIX] + (size_t)layer * D; const float* mu = a->in[I_MU] + (size_t)(layer >> 1) * 6 * D;
    bf16_t* hn = (bf16_t*)(a->ws + WS_A); bf16_t* X = (bf16_t*)(a->ws + P_LW);
    const int gw = c.bid * 8 + c.wave, NGW = c.G * 8;
    f32x4 gg[4], mr[4], mk[4], mv[4];
#pragma unroll
    for (int j = 0; j < 4; ++j) { gg[j] = *((const f32x4*)g + c.lane + 64 * j); mr[j] = *((const f32x4*)mu + c.lane + 64 * j); mk[j] = *((const f32x4*)(mu + 2 * D) + c.lane + 64 * j); mv[j] = *((const f32x4*)(mu + 3 * D) + c.lane + 64 * j); }
    for (int m = gw + (mode ? M / 2 : 0); m < M; m += NGW) {
        const float rs = row_rstd(ss, m); const int t = m & (SEQ - 1);
        const f32x4* hr = (const f32x4*)(a->out + (size_t)m * D) + c.lane;
        f32x4 cur[4];
#pragma unroll
        for (int j = 0; j < 4; ++j) cur[j] = hr[64 * j] * rs * gg[j];
        if (mode == 0) { const int prow = (m >> 12) * SEQP + PADR + t; u32x2* br = (u32x2*)(hn + (size_t)prow * D) + c.lane;
#pragma unroll
            for (int j = 0; j < 4; ++j) { u32x2 w; w.x = cvt_pk_bf16(cur[j].x, cur[j].y); w.y = cvt_pk_bf16(cur[j].z, cur[j].w); br[64 * j] = w; } }
        if (mode == 1 || m < M / 2) {
            const float rsp = t > 0 ? row_rstd(ss, m - 1) : 0.f; const f32x4* hp = (const f32x4*)(a->out + (size_t)(t > 0 ? m - 1 : m) * D) + c.lane;
            const size_t lo = (size_t)(m & (M / 2 - 1)) * D;
            u32x2* xr = (u32x2*)(X + lo) + c.lane; u32x2* xk = (u32x2*)(X + (size_t)(M / 2) * D + lo) + c.lane; u32x2* xv = (u32x2*)(X + (size_t)M * D + lo) + c.lane;
#pragma unroll
            for (int j = 0; j < 4; ++j) { const f32x4 dl = hp[64 * j] * rsp * gg[j] - cur[j];
                const f32x4 vr = cur[j] + dl * mr[j], vk = cur[j] + dl * mk[j], vv = cur[j] + dl * mv[j]; u32x2 w;
                w.x = cvt_pk_bf16(vr.x, vr.y); w.y = cvt_pk_bf16(vr.z, vr.w); xr[64 * j] = w;
                w.x = cvt_pk_bf16(vk.x, vk.y); w.y = cvt_pk_bf16(vk.z, vk.w); xk[64 * j] = w;
                w.x = cvt_pk_bf16(vv.x, vv.y); w.y = cvt_pk_bf16(vv.z, vv.w); xv[64 * j] = w; }
        }
    }
    if (mode == 0) for (int r = gw; r < BATCH * PADR; r += NGW) { const int prow = (r / PADR) * SEQP + (r % PADR); u32x2* br = (u32x2*)(hn + (size_t)prow * D) + c.lane;
#pragma unroll
        for (int j = 0; j < 4; ++j) br[64 * j] = (u32x2){0u, 0u}; }
}

__device__ __forceinline__ f32x4 bf4(u32x2 w) { return (f32x4){bflo(w.x), bfhi(w.x), bflo(w.y), bfhi(w.y)}; }
__device__ __forceinline__ float hsum4(f32x4 p) { return (p.x + p.y) + (p.z + p.w); }
__device__ __forceinline__ float sum16(float v) { v = sum8(v); v += dpp_f<0x140>(v); return v; }
__device__ __forceinline__ f32x4 bf4lo(u32x4 w) { return (f32x4){bflo(w.x), bfhi(w.x), bflo(w.y), bfhi(w.y)}; }
__device__ __forceinline__ f32x4 bf4hi(u32x4 w) { return (f32x4){bflo(w.z), bfhi(w.z), bflo(w.w), bfhi(w.w)}; }
__device__ __forceinline__ void phase_scan(const Ctx& c, CA a, int j, int rp_out) {
    constexpr int CH = 32, NCH = SEQ / CH, VSZ = CH * 64, YSZ = CH * 32;
    LAS float* BIG = (LAS float*)c.lds; LAS float* VB = BIG + 2 * 5 * VSZ; LAS float* YB = VB + 4 * VSZ; LAS float* BON = YB + 3 * YSZ; LAS float* SCR = BON + 128;
    bf16_t* R = (bf16_t*)(a->ws + P_R); const bf16_t* Kb = (const bf16_t*)(a->ws + P_K); const bf16_t* Vb = (const bf16_t*)(a->ws + P_V);
    const bf16_t* LWb = (const bf16_t*)(a->ws + P_LW); const bf16_t* LAb = (const bf16_t*)(a->ws + P_LA); const bf16_t* Gb = (const bf16_t*)(a->ws + WS_A);
    if (c.G != 256) return;
    const int unit = c.bid, b = unit >> 5, hh = (unit >> 1) & 15, half = unit & 1;
    unsigned long long* slot_own = (unsigned long long*)(a->ws + WS_XS) + (size_t)(j * 256 + unit) * 256; const unsigned long long* slot_par = (const unsigned long long*)(a->ws + WS_XS) + (size_t)(j * 256 + (unit ^ 1)) * 256;
    const bool cons = c.tid < 256;
    __syncthreads();
    if (cons) {
        const int rp = c.tid >> 3, q = c.tid & 7, row = 32 * half + rp;
        f32x4 S0 = (f32x4){0.f, 0.f, 0.f, 0.f}, S1 = S0;
        __builtin_amdgcn_s_setprio(2);
        __syncthreads();
        for (int i = 0; i <= NCH + 1; ++i) {
            if (i < NCH) {
                const LAS float* bg = BIG + (i & 1) * 5 * VSZ + 8 * q;
                const LAS f32x4* pw = (const LAS f32x4*)bg; const LAS f32x4* pa = (const LAS f32x4*)(bg + VSZ); const LAS f32x4* pb = (const LAS f32x4*)(bg + 2 * VSZ);
                const LAS f32x4* pk = (const LAS f32x4*)(bg + 3 * VSZ); const LAS f32x4* pr = (const LAS f32x4*)(bg + 4 * VSZ);
                const LAS float* pv = VB + (i & 3) * VSZ + row * 32; const int vf = (row ^ (row >> 3)) & 7; LAS float* py = YB + (i % 3) * YSZ + rp * CH;
                f32x4 a0v = pa[0], a1v = pa[1], b0v = pb[0], b1v = pb[1], k0v = pk[0], k1v = pk[1], r0v = pr[0], r1v = pr[1];
                for (int t8 = 0; t8 < CH; t8 += 8) {
                    f32x4 ya, yb;
                    const f32x4 va = *(const LAS f32x4*)(pv + ((((t8 >> 2)) ^ vf) << 2)), vb = *(const LAS f32x4*)(pv + ((((t8 >> 2) + 1) ^ vf) << 2));
#pragma unroll
                    for (int u = 0; u < 8; ++u) {
                        const int t = t8 + u, tn = (t + 1) & (CH - 1);
                        const f32x4 na0 = pa[tn * 16], na1 = pa[tn * 16 + 1], nb0 = pb[tn * 16], nb1 = pb[tn * 16 + 1],
                                    nk0 = pk[tn * 16], nk1 = pk[tn * 16 + 1], nr0 = pr[tn * 16], nr1 = pr[tn * 16 + 1];
                        const float vv = u < 4 ? va[u] : vb[u - 4];
                        const float sa = sum8(hsum4(S0 * a0v + S1 * a1v));
                        S0 = S0 + sa * b0v + vv * k0v; S1 = S1 + sa * b1v + vv * k1v;
                        const float y = sum8(hsum4(S0 * r0v + S1 * r1v));
                        if (u < 4) ya[u] = y; else yb[u - 4] = y;
                        if (u == 7) { S0 = S0 * pw[t * 16]; S1 = S1 * pw[t * 16 + 1]; if (q == 0) { *(LAS f32x4*)(py + t8) = ya; *(LAS f32x4*)(py + t8 + 4) = yb; } }
                        a0v = na0; a1v = na1; b0v = nb0; b1v = nb1; k0v = nk0; k1v = nk1; r0v = nr0; r1v = nr1;
                    }
                }
            }
            __syncthreads();
        }
        __builtin_amdgcn_s_setprio(0);
    } else {
        const int pt = c.tid - 256, st = pt >> 3, l8 = pt & 7, sc = l8 * 8, ch = hh * 64 + sc;
        const float* pp = a->in[I_W0] + (size_t)j * D + ch; const f32x4 w0a = *(const f32x4*)pp, w0b = *(const f32x4*)(pp + 4);
        pp = a->in[I_A0] + (size_t)j * D + ch; const f32x4 a0a = *(const f32x4*)pp, a0b = *(const f32x4*)(pp + 4);
        pp = a->in[I_KK] + (size_t)j * D + ch; const f32x4 kka = *(const f32x4*)pp, kkb = *(const f32x4*)(pp + 4);
        pp = a->in[I_KA] + (size_t)j * D + ch; const f32x4 kaa = *(const f32x4*)pp, kab = *(const f32x4*)(pp + 4);
        pp = a->in[I_RK] + (size_t)j * D + ch; const f32x4 rka = *(const f32x4*)pp, rkb = *(const f32x4*)(pp + 4);
        const int oc = 4 * l8, cho = hh * 64 + 32 * half + oc;
        const f32x4 lnw = *(const f32x4*)(a->in[I_LNW] + (size_t)j * D + cho), lnb = *(const f32x4*)(a->in[I_LNB] + (size_t)j * D + cho);
        const size_t gbase = ((size_t)b * SEQ + st) * D + ch, obase = ((size_t)b * SEQ + st) * D + cho;
        u32x4 qr = *(const u32x4*)(R + gbase), qk = *(const u32x4*)(Kb + gbase), qv = *(const u32x4*)(Vb + gbase), qlw = *(const u32x4*)(LWb + gbase), qla = *(const u32x4*)(LAb + gbase);
        u32x2 qg = (u32x2){0u, 0u};
#define SCAN_STAGE(n) { \
            f32x4 rr[2] = {bf4lo(qr), bf4hi(qr)}, kk_[2] = {bf4lo(qk), bf4hi(qk)}, vv_[2] = {bf4lo(qv), bf4hi(qv)}, lw_[2] = {bf4lo(qlw), bf4hi(qlw)}, la_[2] = {bf4lo(qla), bf4hi(qla)}; \
            const f32x4 w0_[2] = {w0a, w0b}, a0_[2] = {a0a, a0b}, kkp_[2] = {kka, kkb}, kap_[2] = {kaa, kab}, rkp_[2] = {rka, rkb}; \
            f32x4 dec[2], av[2], kn[2], kp[2]; float n2 = 0.f, bon = 0.f; \
            _Pragma("unroll") for (int h2 = 0; h2 < 2; ++h2) _Pragma("unroll") for (int e = 0; e < 4; ++e) { \
                const float xw = -(w0_[h2][e] + lw_[h2][e]); const float sp = xw > 20.f ? xw : __logf(1.f + __expf(xw)); \
                dec[h2][e] = __expf(-sp - 0.5f); av[h2][e] = __builtin_amdgcn_rcpf(1.f + __expf(-(a0_[h2][e] + la_[h2][e]))); \
                kn[h2][e] = kk_[h2][e] * kkp_[h2][e]; n2 += kn[h2][e] * kn[h2][e]; \
                kp[h2][e] = kk_[h2][e] * (1.f + (av[h2][e] - 1.f) * kap_[h2][e]); bon += rr[h2][e] * kp[h2][e] * rkp_[h2][e]; } \
            n2 = sum8(n2); bon = sum8(bon); const float inv = rsqrtf(fmaxf(n2, 1e-24f)); \
            LAS float* scr = SCR + (pt >> 6) * 512; *(LAS f32x4*)(scr + (st & 7) * 64 + sc) = dec[0]; *(LAS f32x4*)(scr + (st & 7) * 64 + sc + 4) = dec[1]; \
            f32x4 cum[2] = {(f32x4){0.f, 0.f, 0.f, 0.f}, (f32x4){0.f, 0.f, 0.f, 0.f}}; \
            asm volatile("s_waitcnt lgkmcnt(0)" ::: "memory"); \
            for (int t2 = 0; t2 <= (st & 7); ++t2) { cum[0] += *(const LAS f32x4*)(scr + t2 * 64 + sc); cum[1] += *(const LAS f32x4*)(scr + t2 * 64 + sc + 4); } \
            asm volatile("s_waitcnt lgkmcnt(0)" ::: "memory"); \
            LAS float* bg = BIG + ((n) & 1) * 5 * VSZ + st * 64 + sc; \
            _Pragma("unroll") for (int h2 = 0; h2 < 2; ++h2) { const f32x4 kq = kn[h2] * inv; f32x4 Pt, Pp, Pi; \
                _Pragma("unroll") for (int e = 0; e < 4; ++e) { Pt[e] = __expf(-cum[h2][e]); Pp[e] = __expf(dec[h2][e] - cum[h2][e]); Pi[e] = __expf(cum[h2][e]); } \
                *(LAS f32x4*)(bg + 4 * h2) = Pt; *(LAS f32x4*)(bg + VSZ + 4 * h2) = -kq * Pp; *(LAS f32x4*)(bg + 2 * VSZ + 4 * h2) = kq * av[h2] * Pi; \
                *(LAS f32x4*)(bg + 3 * VSZ + 4 * h2) = kp[h2] * Pi; *(LAS f32x4*)(bg + 4 * VSZ + 4 * h2) = rr[h2] * Pt; \
                _Pragma("unroll") for (int e = 0; e < 4; ++e) { const int ch_ = sc + 4 * h2 + e; VB[((n) & 3) * VSZ + ch_ * 32 + ((((st >> 2)) ^ ((ch_ ^ (ch_ >> 3)) & 7)) << 2) + (st & 3)] = vv_[h2][e]; } } \
            if (l8 == 0) BON[((n) & 3) * CH + st] = bon; }
#define SCAN_YSTATS(n) \
            const LAS float* yq_ = YB + ((n) % 3) * YSZ + oc * CH + st; const f32x4 y = {yq_[0], yq_[CH], yq_[2 * CH], yq_[3 * CH]}; \
            const float mh = sum8(hsum4(y)) * (1.f / 32.f); const f32x4 d = y - mh; const float m2h = sum8(hsum4(d * d));
        SCAN_STAGE(0)
        { const size_t go = gbase + (size_t)CH * D; qr = *(const u32x4*)(R + go); qk = *(const u32x4*)(Kb + go); qv = *(const u32x4*)(Vb + go); qlw = *(const u32x4*)(LWb + go); qla = *(const u32x4*)(LAb + go); }
        __syncthreads();
        for (int i = 0; i <= NCH + 1; ++i) {
            unsigned long long pw0 = 0ull, pw1 = 0ull; const unsigned long long* pp_ = slot_par + (((i - 2) & 3) * CH + st) * 2;
            if (i >= 2) { pw0 = __hip_atomic_load(pp_, __ATOMIC_RELAXED, __HIP_MEMORY_SCOPE_AGENT); pw1 = __hip_atomic_load(pp_ + 1, __ATOMIC_RELAXED, __HIP_MEMORY_SCOPE_AGENT); }
            if (i >= 1 && i <= NCH) {
                const int n = i - 1;
                SCAN_YSTATS(n)
                if (l8 == 0) { const unsigned long long tg = (unsigned long long)(unsigned)(n + 1) << 32; unsigned long long* sp_ = slot_own + ((n & 3) * CH + st) * 2;
                    __hip_atomic_store(sp_, tg | __float_as_uint(mh), __ATOMIC_RELAXED, __HIP_MEMORY_SCOPE_AGENT); __hip_atomic_store(sp_ + 1, tg | __float_as_uint(m2h), __ATOMIC_RELAXED, __HIP_MEMORY_SCOPE_AGENT); }
            }
            u32x4 nr = qr, nk = qk, nv = qv, nlw = qlw, nla = qla; u32x2 ng = qg;
            if (i + 2 < NCH) { const size_t go = gbase + (size_t)(i + 2) * CH * D; nr = *(const u32x4*)(R + go); nk = *(const u32x4*)(Kb + go); nv = *(const u32x4*)(Vb + go); nlw = *(const u32x4*)(LWb + go); nla = *(const u32x4*)(LAb + go); }
            if (i >= 1 && i <= NCH) ng = *(const u32x2*)(Gb + obase + (size_t)(i - 1) * CH * D);
            if (i + 1 < NCH) { SCAN_STAGE(i + 1) }
            if (i >= 2) {
                const int n = i - 2; const unsigned tag = (unsigned)(n + 1); unsigned sp = 0;
                while ((unsigned)(pw0 >> 32) != tag) { __builtin_amdgcn_s_sleep(1); if (++sp > (1u << 18)) break; pw0 = __hip_atomic_load(pp_, __ATOMIC_RELAXED, __HIP_MEMORY_SCOPE_AGENT); }
                while ((unsigned)(pw1 >> 32) != tag) { __builtin_amdgcn_s_sleep(1); if (++sp > (1u << 18)) break; pw1 = __hip_atomic_load(pp_ + 1, __ATOMIC_RELAXED, __HIP_MEMORY_SCOPE_AGENT); }
                const float mp = __uint_as_float((unsigned)pw0), m2p = __uint_as_float((unsigned)pw1);
                SCAN_YSTATS(n)
                const float mean = 0.5f * (mh + mp), dm = mh - mp; const float rstd = rsqrtf((m2h + m2p + 16.f * dm * dm) * (1.f / 64.f) + GN_EPS);
                f32x4 v;
#pragma unroll
                for (int e = 0; e < 4; ++e) { const int ch_ = 32 * half + oc + e; v[e] = VB[(n & 3) * VSZ + ch_ * 32 + ((((st >> 2)) ^ ((ch_ ^ (ch_ >> 3)) & 7)) << 2) + (st & 3)]; }
                const float bon = BON[(n & 3) * CH + st];
                const f32x4 o = ((y - mean) * rstd * lnw + lnb + bon * v) * bf4(qg);
                u32x2 w; w.x = cvt_pk_bf16(o.x, o.y); w.y = cvt_pk_bf16(o.z, o.w);
                *(u32x2*)(R + obase + (size_t)n * CH * D) = w;
            }
            qg = ng; qr = nr; qk = nk; qv = nv; qlw = nlw; qla = nla;
            __syncthreads();
        }
#undef SCAN_STAGE
#undef SCAN_YSTATS
    }
}

__device__ __forceinline__ void phase_final(const Ctx& c, CA a) {
    const float* ss = (const float*)(a->ws + WS_PA); const float* g = a->in[I_NFIN];
    const int gw = c.bid * 8 + c.wave, NGW = c.G * 8;
    f32x4 gg[4];
#pragma unroll
    for (int j = 0; j < 4; ++j) gg[j] = *((const f32x4*)g + c.lane + 64 * j);
    for (int m = gw; m < M; m += NGW) {
        const float rs = row_rstd(ss, m);
        f32x4* hr = (f32x4*)(a->out + (size_t)m * D) + c.lane;
#pragma unroll
        for (int j = 0; j < 4; ++j) hr[64 * j] = hr[64 * j] * rs * gg[j];
    }
}

#define XB_TMO      128
#define XB_XCNT(j)  (256  + 64 * (j))
#define XB_XSUB(j)  (1280 + 64 * (j))
#define XB_XGEN(j)  (2304 + 64 * (j))
#define XB_TOP      3328
#define XB_TOPGEN   3392
#define XCD_BAR_WORDS 3456
#define XB_SPIN_CAP (1u << 18)

__device__ __forceinline__ unsigned xb_ld(unsigned* p)              { return __hip_atomic_load(p, __ATOMIC_RELAXED, __HIP_MEMORY_SCOPE_AGENT); }
__device__ __forceinline__ unsigned xb_add(unsigned* p, unsigned v) { return __hip_atomic_fetch_add(p, v, __ATOMIC_RELAXED, __HIP_MEMORY_SCOPE_AGENT); }
__device__ __forceinline__ unsigned xb_xcc_id() { return (unsigned)__builtin_amdgcn_s_getreg((3 << 11) | 20) & 0xFu; }
#define XB_SPIN(cond, bar) do { unsigned _sp = 0; while (cond) { __builtin_amdgcn_s_sleep(1); \
    if ((++_sp & 255u) == 0u) { if (xb_ld(&(bar)[XB_TMO])) break; if (_sp > XB_SPIN_CAP) { atomicAdd(&(bar)[XB_TMO], 1u); break; } } } } while (0)

struct XcdBarrier {
    unsigned* bar; unsigned x;
    volatile LAS unsigned* st;
};

__device__ __forceinline__ XcdBarrier xcd_barrier_post(unsigned* bar, volatile LAS unsigned* st) {
    XcdBarrier b; b.bar = bar; b.x = xb_xcc_id(); b.st = st;
    if (threadIdx.x == 0) (void)xb_add(&bar[XB_XCNT(b.x)], 1u);
    return b;
}
__device__ __forceinline__ void xcd_barrier_complete(unsigned* bar, unsigned x, unsigned& nloc, unsigned& nx) {
    const unsigned G = gridDim.x * gridDim.y * gridDim.z;
    unsigned sum, cnt, mine, sp = 0u;
    for (;;) {
        sum = 0u; cnt = 0u; mine = 0u;
#pragma unroll
        for (unsigned j = 0; j < 16; ++j) { const unsigned c = xb_ld(&bar[XB_XCNT(j)]); sum += c; cnt += (c > 0u) ? 1u : 0u; mine = (j == x) ? c : mine; }
        if (sum == G) break;
        __builtin_amdgcn_s_sleep(1);
        if ((++sp & 255u) == 0u) { if (xb_ld(&bar[XB_TMO])) break; if (sp > XB_SPIN_CAP) { atomicAdd(&bar[XB_TMO], 1u); break; } }
    }
    nloc = mine > 0u ? mine : 1u; nx = cnt > 0u ? cnt : 1u;
}

__device__ __forceinline__ void xcd_barrier(const XcdBarrier& b) {
    asm volatile("s_waitcnt vmcnt(0)" ::: "memory");
    __syncthreads();
    if (threadIdx.x == 0) {
        unsigned* bar = b.bar;
        __builtin_amdgcn_s_waitcnt(0);
        unsigned nloc = b.st[0], nx = b.st[1];
        if (nloc == 0u) { xcd_barrier_complete(bar, b.x, nloc, nx); b.st[0] = nloc; b.st[1] = nx; }
        const unsigned old = xb_add(&bar[XB_XSUB(b.x)], 1u);
        const unsigned gen = old / nloc;
        if (old + 1u == (gen + 1u) * nloc) {
            __builtin_amdgcn_fence(__ATOMIC_RELEASE, "agent");
            asm volatile("s_waitcnt vmcnt(0)" ::: "memory");
            const unsigned og = xb_add(&bar[XB_TOP], 1u);
            const unsigned tg = og / nx;
            if (og + 1u == (tg + 1u) * nx) xb_add(&bar[XB_TOPGEN], 1u);
            else XB_SPIN(xb_ld(&bar[XB_TOPGEN]) == tg, bar);
            __builtin_amdgcn_fence(__ATOMIC_ACQUIRE, "agent");
            xb_add(&bar[XB_XGEN(b.x)], 1u);
            asm volatile("s_waitcnt vmcnt(0)" ::: "memory");
        } else {
            XB_SPIN(xb_ld(&bar[XB_XGEN(b.x)]) == gen, bar);
            __builtin_amdgcn_fence(__ATOMIC_ACQUIRE, "agent");
            asm volatile("s_waitcnt vmcnt(0)" ::: "memory");
        }
    }
    __syncthreads();
}

constexpr int SLOTS = 11, NPH = 2 + 4 * SLOTS;
__host__ __device__ inline bool phase_active(int p) {
    if (p == 0 || p == NPH - 1) return true;
    const int i = (p - 1) / SLOTS, s = (p - 1) % SLOTS;
    if (s >= 8) return s == 8 || s == 10;
    return (i & 1) ? (s <= 5 || s == 7) : (s < 3);
}

__global__ void __launch_bounds__(512, 2) mk_fwd(Args a_) {
    extern __shared__ __attribute__((aligned(16))) unsigned char lds_raw[];
    int tid_ = threadIdx.x, bid_ = blockIdx.x, G_ = gridDim.x;
    volatile LAS unsigned* xst = (volatile LAS unsigned*)((LAS unsigned char*)lds_raw + 144000);
    if (tid_ < 2) xst[tid_] = 0u;
    __syncthreads();
    const XcdBarrier xbar = xcd_barrier_post((unsigned*)(a_.ws + WS_CTL), xst);
    CA a = (CA)__builtin_amdgcn_kernarg_segment_ptr();
    const int ph_lo = a_.ph_lo, ph_hi = a_.ph_hi;
    for (int p = ph_lo; p < ph_hi; ++p) {
        if (!phase_active(p)) continue;
        const int PL = (p - 1) / SLOTS, PS = (p - 1) % SLOTS; (void)PL; (void)PS;
        const int nrep = (MK_PROBE && p < NPH - 1 && (MK_PROBE_SEL)) ? 2 : 1;
        for (int rp = 0; rp < nrep; ++rp) {
        if (rp) cg::this_grid().sync();
        asm volatile("" : "+s"(a), "+s"(bid_), "+s"(G_)); asm volatile("" : "+v"(tid_));
        Ctx c; c.lds = (LAS unsigned char*)lds_raw; c.tid = tid_; c.lane = c.tid & 63; c.wave = __builtin_amdgcn_readfirstlane(c.tid >> 6); c.G = G_; c.bid = bid_;
        bf16_t* regA = (bf16_t*)(a->ws + WS_A);
        if (p == 0) phase_prologue(c, a);
        else if (p == NPH - 1) phase_final(c, a);
        else {
            const int layer = (p - 1) / SLOTS, s = (p - 1) % SLOTS, j = layer >> 1;
            unsigned char* wj = a->ws + WS_WSTAT + (size_t)j * WJ_STRIDE;
            float* ss_mix = (float*)(a->ws + WS_PA); float* ss_ffn = (float*)(a->ws + WS_PB); float* ss_next = ss_mix;
            if (s < 8 && !(layer & 1)) {
                if (s == 0) {
                    pg8::Gemm g{regA, (const bf16_t*)(wj + WJ_IN), M, 2048, D, D, 0}; pg8::StaticOrder S; S.init(M / 256, 2048, c.G, c.bid);
                    EpiSguIn E{(bf16_t*)(a->ws + P_U), (bf16_t*)(a->ws + P_SV), ss_mix, a->in[I_SBIN] + (size_t)j * 2048, (float*)(a->ws + WS_PV)};
                    pg8::gemm_phase<EpiSguIn, pg8::StaticOrder, 0, false, true>(c.lds, c.tid, g, S, E);
                } else if (s == 1) { phase_ffn_weights(c, a, layer); phase_sgu_spatial(c, a, j, rp); }
                else {
                    pg8::Gemm g{(const bf16_t*)(a->ws + P_U), (const bf16_t*)(wj + WJ_OUT), M, D, D, D, 0}; pg8::StaticOrder S; S.init(M / 256, D, c.G, c.bid);
                    EpiResid E{layer == 0 ? a->in[I_X] : (const float*)a->out, a->out, regA, ss_ffn};
                    pg8::gemm_phase<EpiResid, pg8::StaticOrder, 0, false, true>(c.lds, c.tid, g, S, E);
                }
            } else if (s < 8) {
                if (s == 0) { phase_rwkv_prep(c, a, layer, 0); phase_ffn_weights(c, a, layer); if (layer == 1) phase_static_weights(c, a, 1); }
                else if (s == 2) phase_rwkv_prep(c, a, layer, 1);
                else if (s == 1 || s == 3) {
                    { pg8::Gemm g{(const bf16_t*)(a->ws + P_LW), (const bf16_t*)(wj + WJ_RKV), M / 2, 3072, D, D, (size_t)(M / 2) * D * 2}; pg8::StaticOrder S; S.init(M / 512, 3072, c.G, c.bid);
                      EpiRkv E{(bf16_t*)(a->ws + P_R), (bf16_t*)(a->ws + P_WA), (bf16_t*)(a->ws + P_GL), s == 3 ? M / 2 : 0, 0};
                      pg8::gemm_phase<EpiRkv, pg8::StaticOrder, 3, false, true>(c.lds, c.tid, g, S, E); }
                    if (s == 1) {
                      asm volatile("" : "+s"(a), "+s"(c.bid), "+s"(c.G), "+s"(wj)); asm volatile("" : "+v"(c.tid));
                      pg8::Gemm g{(const bf16_t*)(a->ws + WS_A), (const bf16_t*)(wj + WJ_RKV + 6 * MiB), M, 512, 2048, D, 0}; pg8::StaticOrder S; S.init(M / 256, 512, c.G, c.bid);
                      EpiRkv E{(bf16_t*)(a->ws + P_R), (bf16_t*)(a->ws + P_WA), (bf16_t*)(a->ws + P_GL), 0, 12};
                      pg8::gemm_phase<EpiRkv, pg8::StaticOrder, 1, true, true>(c.lds, c.tid, g, S, E); }
                } else if (s == 4) {
                    { int kq = 128; asm volatile("" : "+s"(kq)); pg8::Gemm g{(const bf16_t*)(a->ws + P_WA), (const bf16_t*)(wj + WJ_L2WA), M, 2048, kq, kq, 0}; pg8::StaticOrder S; S.init(M / 256, 2048, c.G, c.bid);
                      EpiStore<false> E{(bf16_t*)(a->ws + P_LW), D, 2, (size_t)M * D, nullptr};
                      pg8::gemm_phase<EpiStore<false>, pg8::StaticOrder, 0, false, true>(c.lds, c.tid, g, S, E); }
                    asm volatile("" : "+s"(a), "+s"(c.bid), "+s"(c.G), "+s"(wj)); asm volatile("" : "+v"(c.tid));
                    { int kq = 256; asm volatile("" : "+s"(kq)); pg8::Gemm g{(const bf16_t*)(a->ws + P_GL), (const bf16_t*)(wj + WJ_L2G), M, D, kq, kq, 0}; pg8::StaticOrder S; S.init(M / 256, D, c.G, c.bid);
                      EpiStore<false> E{regA, D, 2, 0, nullptr};
                      pg8::gemm_phase<EpiStore<false>, pg8::StaticOrder, 0, false, true>(c.lds, c.tid, g, S, E); }
                } else if (s == 5) phase_scan(c, a, j, 0);
                else {
                    pg8::Gemm g{(const bf16_t*)(a->ws + P_R), (const bf16_t*)(wj + WJ_O), M, D, D, D, 0}; pg8::StaticOrder S; S.init(M / 256, D, c.G, c.bid);
                    EpiResid E{a->out, a->out, regA, ss_ffn};
                    pg8::gemm_phase<EpiResid, pg8::StaticOrder, 0, false, true>(c.lds, c.tid, g, S, E);
                }
            }
            else if (s == 8) {
                pg8::Gemm g{regA - 2 * D, (const bf16_t*)(a->ws + WS_WFFN), M, FF2, D, D, 0}; pg8::StaticOrder S; S.init(133, FF2, c.G, c.bid);
                EpiFfnUp E{(bf16_t*)(a->ws + P_ACT), ss_ffn, a->in[I_FCW] + (size_t)layer * 3 * FF2, a->in[I_FCB] + (size_t)layer * FF2};
                pg8::gemm_phase<EpiFfnUp, pg8::StaticOrder, 2, false, true>(c.lds, c.tid, g, S, E);
            }
            else {
                pg8::Gemm g{(const bf16_t*)(a->ws + P_ACT), (const bf16_t*)(a->ws + WS_WDOWN), M, D, FF, FF, 0}; pg8::StaticOrder S; S.init(M / 256, D, c.G, c.bid);
                EpiResid E{a->out, a->out, layer == 1 ? regA : (bf16_t*)nullptr, ss_next};
                pg8::gemm_phase<EpiResid, pg8::StaticOrder, 0, false, true>(c.lds, c.tid, g, S, E);
            }
        }
        }
        if (p + 1 < ph_hi) { if (p == 0) cg::this_grid().sync(); else xcd_barrier(xbar); }
    }
}

constexpr int LDS_BYTES = 147456;
#ifndef MK_ONE_LAUNCH
#define MK_ONE_LAUNCH 1
#endif
extern "C" void kernel_launch(void* const* d_in, const int* in_sizes, int n_in, void* d_out, int out_size, void* d_ws, size_t ws_size, hipStream_t stream) {
    static int grid = 0;
    if (grid == 0) {
        if (n_in != 32 || out_size != M * D || ws_size < WS_END) { fprintf(stderr, "kernel_launch: unexpected shapes (n_in %d out %d ws %zu, need %zu)\n", n_in, out_size, ws_size, (size_t)WS_END); grid = -1; return; }
        int dev = 0, cus = 0, per_cu = 0;
        (void)hipGetDevice(&dev); (void)hipDeviceGetAttribute(&cus, hipDeviceAttributeMultiprocessorCount, dev);
        if (hipFuncSetAttribute((const void*)mk_fwd, hipFuncAttributeMaxDynamicSharedMemorySize, LDS_BYTES) != hipSuccess) { fprintf(stderr, "kernel_launch: hipFuncSetAttribute failed\n"); grid = -1; return; }
        (void)hipOccupancyMaxActiveBlocksPerMultiprocessor(&per_cu, (const void*)mk_fwd, 512, LDS_BYTES);
        if (per_cu < 1) per_cu = 1;
        grid = cus * 1;
        (void)hipGetLastError();
    }
    if (grid < 0) return;
    if (hipMemsetAsync((char*)d_ws + WS_CTL, 0, CTL_BYTES, stream) != hipSuccess) { fprintf(stderr, "kernel_launch: memset failed\n"); return; }
    Args a{};
    for (int i = 0; i < 32; ++i) a.in[i] = (const float*)d_in[i];
    a.out = (float*)d_out; a.ws = (unsigned char*)d_ws;
#if MK_ONE_LAUNCH
    a.ph_lo = 0; a.ph_hi = NPH;
    void* args[] = {&a};
    hipError_t e = hipLaunchCooperativeKernel((const void*)mk_fwd, dim3(grid), dim3(512), args, LDS_BYTES, stream);
    if (e != hipSuccess) fprintf(stderr, "cooperative launch failed: %s (grid %d)\n", hipGetErrorString(e), grid);
#else
    for (int p = 0; p < NPH; ++p) { if (!phase_active(p)) continue; a.ph_lo = p; a.ph_hi = p + 1; hipLaunchKernelGGL(mk_fwd, dim3(grid), dim3(512), LDS_BYTES, stream, a); }
#endif
}
```
